# Optimizing an MI355X kernel written in HIP

```python
import math
import jax
import jax.numpy as jnp
from jax import lax
import numpy as np

D_MODEL = 1024
BATCH = 4
SEQ = 4096
DEPTH = 2
DEC_BATCH = 8
DEC_SEQ = 8192
PAST_LEN = 128

GRID_W = 64
NA_HEADS = 16
NA_HEAD_DIM = D_MODEL // NA_HEADS
NA_WIN_ROWS = 8
NA_WIN_COLS = 16
NA_RPB_ROWS = 2 * NA_WIN_ROWS - 1
NA_RPB_COLS = 2 * NA_WIN_COLS - 1
DA_HEAD_DIM = 64
DA_HEADS = D_MODEL // (2 * DA_HEAD_DIM)
DA_SUBLN_EPS = 1e-5
Q_BLOCK = 128
ROPE_THETA = 10000.0
D_FF = 2816
CONV_W = 3
NORM_EPS = 1e-6

N_NA_LAYERS = (DEPTH + 1) // 2
N_DA_LAYERS = DEPTH // 2

kernel_name = 'hybrid_natten_diffattn_convglu_encoder'


def rms_norm(x, g, eps=NORM_EPS):
    xf = x.astype(jnp.float32)
    y = xf * lax.rsqrt(jnp.mean(xf * xf, axis=-1, keepdims=True) + eps)
    return (y * g.astype(jnp.float32)).astype(x.dtype)


def rotary_tables(T, dim):
    inv = 1.0 / (ROPE_THETA ** (jnp.arange(0, dim, 2, dtype=jnp.float32) / dim))
    ang = jnp.arange(T, dtype=jnp.float32)[:, None] * inv[None, :]
    ang = jnp.concatenate([ang, ang], axis=-1)
    return jnp.cos(ang), jnp.sin(ang)


def apply_rotary(x, cos, sin):
    half = x.shape[-1] // 2
    rot = jnp.concatenate([-x[..., half:], x[..., :half]], axis=-1)
    return (x.astype(jnp.float32) * cos + rot.astype(jnp.float32) * sin).astype(x.dtype)


def neighborhood_attention(x, w_qkv, rpb, w_o):
    B, T, _ = x.shape
    rows = T // GRID_W
    wr = min(NA_WIN_ROWS, rows)
    qkv = (x @ w_qkv).reshape(B, rows, GRID_W, 3, NA_HEADS, NA_HEAD_DIM)
    q = qkv[:, :, :, 0].transpose(1, 0, 3, 2, 4)
    k = qkv[:, :, :, 1].transpose(0, 3, 1, 2, 4)
    v = qkv[:, :, :, 2].transpose(0, 3, 1, 2, 4)
    cols = np.arange(GRID_W)
    col_start = np.clip(cols - NA_WIN_COLS // 2, 0, GRID_W - NA_WIN_COLS)
    col_idx = col_start[:, None] + np.arange(NA_WIN_COLS)[None, :]
    dc_idx = col_idx - cols[:, None] + (NA_WIN_COLS - 1)
    scale = NA_HEAD_DIM ** -0.5

    def row_block(args):
        q_r, r = args
        r0 = jnp.clip(r - wr // 2, 0, rows - wr)
        k_rows = lax.dynamic_slice_in_dim(k, r0, wr, axis=2)
        v_rows = lax.dynamic_slice_in_dim(v, r0, wr, axis=2)
        k_nb = k_rows[:, :, :, col_idx, :]
        v_nb = v_rows[:, :, :, col_idx, :]
        s = jnp.einsum('bhqd,bhrqcd->bhqrc', q_r, k_nb).astype(jnp.float32) * scale
        dr_idx = r0 + jnp.arange(wr) - r + (NA_WIN_ROWS - 1)
        bias = rpb[:, dr_idx][:, :, dc_idx]
        s = s + bias.transpose(0, 2, 1, 3).astype(jnp.float32)[None]
        p = jax.nn.softmax(s.reshape(B, NA_HEADS, GRID_W, wr * NA_WIN_COLS), axis=-1)
        p = p.reshape(B, NA_HEADS, GRID_W, wr, NA_WIN_COLS).astype(v.dtype)
        return jnp.einsum('bhqrc,bhrqcd->bhqd', p, v_nb)

    o = lax.map(row_block, (q, jnp.arange(rows)))
    o = o.transpose(1, 0, 3, 2, 4).reshape(B, T, D_MODEL)
    return o @ w_o


def diff_attention(x, w_q, w_k, w_v, lq1, lk1, lq2, lk2, subln_g, w_o, lambda_init):
    B, T, _ = x.shape
    q = (x @ w_q).reshape(B, T, DA_HEADS, 2, DA_HEAD_DIM)
    k = (x @ w_k).reshape(B, T, DA_HEADS, 2, DA_HEAD_DIM)
    v = (x @ w_v).reshape(B, T, DA_HEADS, 2 * DA_HEAD_DIM)
    cos, sin = rotary_tables(T, DA_HEAD_DIM)
    cos, sin = cos[:, None, None, :], sin[:, None, None, :]
    q = apply_rotary(q, cos, sin).transpose(0, 2, 3, 1, 4)
    k = apply_rotary(k, cos, sin).transpose(0, 2, 3, 1, 4)
    v = v.transpose(0, 2, 1, 3)
    lam = (jnp.exp(jnp.sum(lq1.astype(jnp.float32) * lk1.astype(jnp.float32)))
           - jnp.exp(jnp.sum(lq2.astype(jnp.float32) * lk2.astype(jnp.float32)))
           + lambda_init)
    scale = DA_HEAD_DIM ** -0.5
    nb = T // Q_BLOCK
    qb = q.reshape(B, DA_HEADS, 2, nb, Q_BLOCK, DA_HEAD_DIM).transpose(3, 0, 1, 2, 4, 5)

    def q_block(qi):
        s = jnp.einsum('bhiqd,bhikd->bhiqk', qi, k).astype(jnp.float32) * scale
        p = jax.nn.softmax(s, axis=-1)
        a = (p[:, :, 0] - lam * p[:, :, 1]).astype(v.dtype)
        return jnp.einsum('bhqk,bhkd->bhqd', a, v)

    o = lax.map(q_block, qb)
    o = rms_norm(o, subln_g, DA_SUBLN_EPS) * (1.0 - lambda_init)
    o = o.transpose(1, 0, 3, 2, 4).reshape(B, T, DA_HEADS * 2 * DA_HEAD_DIM)
    return o @ w_o


def conv_glu_ffn(x, w_in, conv_w, conv_b, w_out):
    h = x @ w_in
    hp = jnp.pad(h, ((0, 0), (1, 1), (0, 0)))
    h = hp[:, :-2] * conv_w[0] + hp[:, 1:-1] * conv_w[1] + hp[:, 2:] * conv_w[2] + conv_b
    gate, up = jnp.split(h, 2, axis=-1)
    return (jax.nn.gelu(gate, approximate=True) * up) @ w_out


def lambda_init_fn(layer_idx):
    return 0.8 - 0.6 * math.exp(-0.3 * layer_idx)


def trunk(x, attn_pre_g, attn_post_g, ffn_pre_g, ffn_post_g,
          na_w_qkv, na_rpb, na_w_o,
          da_w_q, da_w_k, da_w_v, da_lambda_q1, da_lambda_k1, da_lambda_q2, da_lambda_k2,
          da_subln_g, da_w_o,
          ffn_w_in, ffn_conv_w, ffn_conv_b, ffn_w_out):
    for i in range(DEPTH):
        j = i // 2
        h = rms_norm(x, attn_pre_g[i])
        if i % 2 == 0:
            m = neighborhood_attention(h, na_w_qkv[j], na_rpb[j], na_w_o[j])
        else:
            m = diff_attention(h, da_w_q[j], da_w_k[j], da_w_v[j],
                               da_lambda_q1[j], da_lambda_k1[j], da_lambda_q2[j], da_lambda_k2[j],
                               da_subln_g[j], da_w_o[j], lambda_init_fn(i))
        x = x + rms_norm(m, attn_post_g[i])
        h = rms_norm(x, ffn_pre_g[i])
        f = conv_glu_ffn(h, ffn_w_in[i], ffn_conv_w[i], ffn_conv_b[i], ffn_w_out[i])
        x = x + rms_norm(f, ffn_post_g[i])
    return x


def _normal(k, shape, scale):
    return jax.random.normal(k, shape, jnp.float32) * scale


def setup_inputs(seed: int = 0) -> dict:
    key = jax.random.key(seed)
    ks = jax.random.split(key, 24)
    D, F = D_MODEL, D_FF
    da_qk = 2 * DA_HEADS * DA_HEAD_DIM
    da_v = DA_HEADS * 2 * DA_HEAD_DIM
    return {
        'x_prompt': _normal(ks[0], (BATCH, SEQ, D), 1.0),
        'x_sample': _normal(ks[1], (DEC_BATCH, DEC_SEQ, D), 1.0),
        'attn_pre_g': 1.0 + _normal(ks[2], (DEPTH, D), 0.1),
        'attn_post_g': 1.0 + _normal(ks[3], (DEPTH, D), 0.1),
        'ffn_pre_g': 1.0 + _normal(ks[4], (DEPTH, D), 0.1),
        'ffn_post_g': 1.0 + _normal(ks[5], (DEPTH, D), 0.1),
        'na_w_qkv': _normal(ks[6], (N_NA_LAYERS, D, 3 * D), D ** -0.5),
        'na_rpb': _normal(ks[7], (N_NA_LAYERS, NA_HEADS, NA_RPB_ROWS, NA_RPB_COLS), 0.1),
        'na_w_o': _normal(ks[8], (N_NA_LAYERS, D, D), D ** -0.5),
        'da_w_q': _normal(ks[9], (N_DA_LAYERS, D, da_qk), D ** -0.5),
        'da_w_k': _normal(ks[10], (N_DA_LAYERS, D, da_qk), D ** -0.5),
        'da_w_v': _normal(ks[11], (N_DA_LAYERS, D, da_v), D ** -0.5),
        'da_lambda_q1': _normal(ks[12], (N_DA_LAYERS, DA_HEAD_DIM), 0.1),
        'da_lambda_k1': _normal(ks[13], (N_DA_LAYERS, DA_HEAD_DIM), 0.1),
        'da_lambda_q2': _normal(ks[14], (N_DA_LAYERS, DA_HEAD_DIM), 0.1),
        'da_lambda_k2': _normal(ks[15], (N_DA_LAYERS, DA_HEAD_DIM), 0.1),
        'da_subln_g': 1.0 + _normal(ks[16], (N_DA_LAYERS, 2 * DA_HEAD_DIM), 0.1),
        'da_w_o': _normal(ks[17], (N_DA_LAYERS, da_v, D), da_v ** -0.5),
        'ffn_w_in': _normal(ks[18], (DEPTH, D, 2 * F), D ** -0.5),
        'ffn_conv_w': _normal(ks[19], (DEPTH, CONV_W, 2 * F), CONV_W ** -0.5),
        'ffn_conv_b': _normal(ks[20], (DEPTH, 2 * F), 0.01),
        'ffn_w_out': _normal(ks[21], (DEPTH, F, D), F ** -0.5),
    }


def reference(x_prompt, x_sample, attn_pre_g, attn_post_g, ffn_pre_g, ffn_post_g,
              na_w_qkv, na_rpb, na_w_o,
              da_w_q, da_w_k, da_w_v, da_lambda_q1, da_lambda_k1, da_lambda_q2, da_lambda_k2,
              da_subln_g, da_w_o,
              ffn_w_in, ffn_conv_w, ffn_conv_b, ffn_w_out):
    y_prompt = trunk(x_prompt, attn_pre_g, attn_post_g, ffn_pre_g, ffn_post_g,
                     na_w_qkv, na_rpb, na_w_o,
                     da_w_q, da_w_k, da_w_v, da_lambda_q1, da_lambda_k1, da_lambda_q2, da_lambda_k2,
                     da_subln_g, da_w_o,
                     ffn_w_in, ffn_conv_w, ffn_conv_b, ffn_w_out)
    y_sample = trunk(x_sample, attn_pre_g, attn_post_g, ffn_pre_g, ffn_post_g,
                     na_w_qkv, na_rpb, na_w_o,
                     da_w_q, da_w_k, da_w_v, da_lambda_q1, da_lambda_k1, da_lambda_q2, da_lambda_k2,
                     da_subln_g, da_w_o,
                     ffn_w_in, ffn_conv_w, ffn_conv_b, ffn_w_out)
    return (y_prompt, y_sample)
```

```cpp
#include <hip/hip_runtime.h>
#include <cstdio>
#include <cstdint>
#include <cmath>
namespace pg8 {
#define PG8_LAS __attribute__((address_space(3)))
typedef unsigned short bf16_t;
typedef short bf16x8 __attribute__((ext_vector_type(8)));
typedef float f32x4 __attribute__((ext_vector_type(4)));
typedef unsigned u32x4 __attribute__((ext_vector_type(4)));
constexpr int BM = 256, BK = 64, HALF = 128, HTB = HALF * BK * 2  , STAGE_BYTES = 8 * HTB, NXCD = 8, WGM = 8;

__host__ __device__ __forceinline__ int lds_byte(int r, int c) { const int st = (r >> 4) * 2 + (c >> 5), rr = r & 15, cc = c & 31, ob = rr * 64 + cc * 2; return st * 1024 + (ob ^ (((ob >> 9) & 1) << 5)); }
__host__ __device__ __forceinline__ void stage_rc(int b, int& R, int& C) { const int st = b / 1024, sb = b % 1024, swz = sb ^ (((sb >> 9) & 1) << 5); R = (st >> 1) * 16 + swz / 64; C = (st & 1) * 32 + (swz % 64) / 2; }
__host__ __device__ __forceinline__ int perm32(int rho) { const int n = rho >> 4, i = rho & 15; return 8 * (i >> 2) + 4 * n + (i & 3); }

struct Unit { int pm, pn; };
struct Gemm { const bf16_t* A; const bf16_t* Bt; int M, N, K; size_t tstepA; };

struct StaticOrder {
    int nM, nN, nwg, G, c;
    __host__ __device__ void init(int M, int N, int G_, int c_) { nM = M / BM; nN = N / BM; nwg = nM * nN; G = G_; c = c_; }
    __host__ __device__ void init_tiles(int nM_, int nN_, int G_, int c_) { nM = nM_; nN = nN_; nwg = nM * nN; G = G_; c = c_; }
    __host__ __device__ bool next(int i, Unit& u) const {
        const long L = (long)i * G + c; if (L >= nwg) return false;
        int wgid = (int)L; { const int q = nwg / NXCD, r = nwg % NXCD, xcd = wgid % NXCD, off = wgid / NXCD; wgid = (xcd < r ? xcd * (q + 1) : r * (q + 1) + (xcd - r) * q) + off; }
        const int nig = WGM * nN, gid = wgid / nig, fm = gid * WGM, gsz = (nM - fm) < WGM ? (nM - fm) : WGM;
        u.pm = fm + ((wgid % nig) % gsz); u.pn = (wgid % nig) / gsz; return true;
    }
    __device__ __forceinline__ void a_ready(const Unit&) const {}
    __device__ __forceinline__ void done(const Unit&) const {}
};

__device__ __forceinline__ unsigned cvt_pk_bf16(float lo, float hi) { unsigned r; asm volatile("v_cvt_pk_bf16_f32 %0, %1, %2" : "=v"(r) : "v"(lo), "v"(hi)); return r; }
typedef float f32x2 __attribute__((ext_vector_type(2)));
__device__ __forceinline__ f32x2 gelu_pk(f32x2 v) {
    const f32x2 av = __builtin_elementwise_abs(v), d = av * 0.2316418882f + 1.0f;
    f32x2 t; t.x = __builtin_amdgcn_rcpf(d.x); t.y = __builtin_amdgcn_rcpf(d.y);
    f32x2 q = t * 0.5307027145f + (-0.7265760135f); q = q * t + 0.7107068705f; q = q * t + (-0.142248368f); q = q * t + 0.127414796f; q = q * t;
    const f32x2 s = (v * v) * (-0.72134752044f);
    f32x2 e; e.x = __builtin_amdgcn_exp2f(s.x); e.y = __builtin_amdgcn_exp2f(s.y);
    const f32x2 m = v * (q * e), r = v - m;
    f32x2 o; o.x = v.x < 0.f ? m.x : r.x; o.y = v.y < 0.f ? m.y : r.y; return o;
}

template <int ACT  > struct EpiBf16 {
    static constexpr bool PERM = true, AFTER_DRAIN = false; static_assert(ACT == 0 || ACT == 1, "EpiBf16: ACT is 0 (none) or 1 (gelu_pk)");
    bf16_t* O; int ldc; const float* bias; int split_cols; size_t split_stride; float scale0;
    __device__ __forceinline__ void operator()(const f32x4 (&acc)[2][2][4][2], const Unit& u, int wr, int wc, int fr, int fq) const {
        const int row0 = u.pm * BM + wr * 64 + fr; int colt = u.pn * BM; bf16_t* base = O;
        float sc = 1.f; if (split_cols) { const int t = colt / split_cols; base += (size_t)t * split_stride; colt -= t * split_cols; if (t == 0) sc = scale0; }
        const int col0 = colt + wc * 32 + 8 * fq, bcol0 = u.pn * BM + wc * 32 + 8 * fq;
        f32x4 bv[2][2];
#pragma unroll
        for (int bj = 0; bj < 2; ++bj)
#pragma unroll
            for (int n = 0; n < 2; ++n) bv[bj][n] = bias ? *(const f32x4*)(bias + bcol0 + bj * HALF + 4 * n) : (f32x4){0.f, 0.f, 0.f, 0.f};
#pragma unroll
        for (int ai = 0; ai < 2; ++ai)
#pragma unroll
            for (int m = 0; m < 4; ++m) { bf16_t* rowp = base + (size_t)(row0 + ai * HALF + m * 16) * ldc + col0;
#pragma unroll
                for (int bj = 0; bj < 2; ++bj) { f32x4 v0 = acc[ai][bj][m][0] + bv[bj][0], v1 = acc[ai][bj][m][1] + bv[bj][1];
                    if (ACT == 1) { f32x2 a = gelu_pk((f32x2){v0[0], v0[1]}), b = gelu_pk((f32x2){v0[2], v0[3]}), c = gelu_pk((f32x2){v1[0], v1[1]}), d = gelu_pk((f32x2){v1[2], v1[3]});
                        v0 = (f32x4){a.x, a.y, b.x, b.y}; v1 = (f32x4){c.x, c.y, d.x, d.y}; }
                    v0 = v0 * sc; v1 = v1 * sc; u32x4 w; w.x = cvt_pk_bf16(v0[0], v0[1]); w.y = cvt_pk_bf16(v0[2], v0[3]); w.z = cvt_pk_bf16(v1[0], v1[1]); w.w = cvt_pk_bf16(v1[2], v1[3]);
                    *(u32x4*)(rowp + bj * HALF) = w; } }
    }
};

struct EpiRope {
    static constexpr bool PERM = true, AFTER_DRAIN = false;
    bf16_t* Q; bf16_t* Kk; bf16_t* V; const float* cs; const float* sn; float qscale;
    __device__ __forceinline__ void operator()(const f32x4 (&acc)[2][2][4][2], const Unit& u, int wr, int wc, int fr, int fq) const {
        const int which = u.pn >> 2;
        const int row0 = u.pm * BM + wr * 64 + fr;
        if (which == 2) {
            const int col0 = (u.pn - 8) * BM + wc * 32 + 8 * fq;
#pragma unroll
            for (int ai = 0; ai < 2; ++ai)
#pragma unroll
                for (int m = 0; m < 4; ++m) { bf16_t* rowp = V + (size_t)(row0 + ai * HALF + m * 16) * 1024 + col0;
#pragma unroll
                    for (int bj = 0; bj < 2; ++bj) { const f32x4 v0 = acc[ai][bj][m][0], v1 = acc[ai][bj][m][1];
                        u32x4 w; w.x = cvt_pk_bf16(v0[0], v0[1]); w.y = cvt_pk_bf16(v0[2], v0[3]); w.z = cvt_pk_bf16(v1[0], v1[1]); w.w = cvt_pk_bf16(v1[2], v1[3]);
                        *(u32x4*)(rowp + bj * HALF) = w; } }
        } else {
            bf16_t* base = which == 0 ? Q : Kk; const float sc = which == 0 ? qscale : 1.f;
            const int colb = ((u.pn & 3) * 4 + wc) * 64 + 8 * fq;
#pragma unroll
            for (int ai = 0; ai < 2; ++ai)
#pragma unroll
                for (int m = 0; m < 4; ++m) { const int row = row0 + ai * HALF + m * 16; const int t = row < 16384 ? (row & 4095) : (row & 8191);
                    const f32x4 c0 = *(const f32x4*)(cs + t * 32 + 8 * fq), c1 = *(const f32x4*)(cs + t * 32 + 8 * fq + 4);
                    const f32x4 s0 = *(const f32x4*)(sn + t * 32 + 8 * fq), s1 = *(const f32x4*)(sn + t * 32 + 8 * fq + 4);
                    const f32x4 x1a = acc[ai][0][m][0], x1b = acc[ai][0][m][1], x2a = acc[ai][1][m][0], x2b = acc[ai][1][m][1];
                    const f32x4 o1a = (x1a * c0 - x2a * s0) * sc, o1b = (x1b * c1 - x2b * s1) * sc, o2a = (x2a * c0 + x1a * s0) * sc, o2b = (x2b * c1 + x1b * s1) * sc;
                    u32x4 w1, w2; w1.x = cvt_pk_bf16(o1a[0], o1a[1]); w1.y = cvt_pk_bf16(o1a[2], o1a[3]); w1.z = cvt_pk_bf16(o1b[0], o1b[1]); w1.w = cvt_pk_bf16(o1b[2], o1b[3]);
                    w2.x = cvt_pk_bf16(o2a[0], o2a[1]); w2.y = cvt_pk_bf16(o2a[2], o2a[3]); w2.z = cvt_pk_bf16(o2b[0], o2b[1]); w2.w = cvt_pk_bf16(o2b[2], o2b[3]);
                    bf16_t* rowp = base + (size_t)row * 1024 + colb;
                    *(u32x4*)(rowp) = w1; *(u32x4*)(rowp + 32) = w2; }
        }
    }
};

template <int CTRL> __device__ __forceinline__ float dpp_f(float old, float src) { return __int_as_float(__builtin_amdgcn_update_dpp(__float_as_int(old), __float_as_int(src), CTRL, 0xf, 0xf, false)); }
__device__ __forceinline__ float gelu_tanh(float x) {
    const float u = 0.7978845608028654f * (x + 0.044715f * x * x * x);
    const float e = __builtin_amdgcn_exp2f(-2.8853900817779268f * u);
    return x * __builtin_amdgcn_rcpf(1.0f + e);
}
struct EpiConvGlu {
    static constexpr bool PERM = true, AFTER_DRAIN = false;
    bf16_t* G; const float* cw; const float* cb; PG8_LAS float* X; int Mrows;
    __device__ __forceinline__ void operator()(const f32x4 (&acc)[2][2][4][2], const Unit& u, int wr, int wc, int fr, int fq) const {
        const int xcol = wc * 32 + 8 * fq;
#pragma unroll
        for (int ai = 0; ai < 2; ++ai) { const int ch = 2 * ai + wr;
            if (fr == 0) {
#pragma unroll
                for (int bj = 0; bj < 2; ++bj)
#pragma unroll
                    for (int n = 0; n < 2; ++n) *(PG8_LAS f32x4*)(X + ((ch * 2 + 0) * 256 + bj * 128 + xcol + 4 * n)) = acc[ai][bj][0][n]; }
            if (fr == 15) {
#pragma unroll
                for (int bj = 0; bj < 2; ++bj)
#pragma unroll
                    for (int n = 0; n < 2; ++n) *(PG8_LAS f32x4*)(X + ((ch * 2 + 1) * 256 + bj * 128 + xcol + 4 * n)) = acc[ai][bj][3][n]; } }
        asm volatile("s_waitcnt lgkmcnt(0)" ::: "memory"); __builtin_amdgcn_s_barrier(); asm volatile("" ::: "memory");
        const int gc0 = u.pn * 128 + xcol;
        const int tg0 = u.pm * 254 - 1 + wr * 64 + fr;
#pragma unroll
        for (int n = 0; n < 2; ++n) {
            f32x4 wg[3], wu[3];
#pragma unroll
            for (int t = 0; t < 3; ++t) { wg[t] = *(const f32x4*)(cw + t * 5632 + gc0 + 4 * n); wu[t] = *(const f32x4*)(cw + t * 5632 + 2816 + gc0 + 4 * n); }
            const f32x4 bg = *(const f32x4*)(cb + gc0 + 4 * n), bu = *(const f32x4*)(cb + 2816 + gc0 + 4 * n);
#pragma unroll
            for (int ai = 0; ai < 2; ++ai) { const int ch = 2 * ai + wr;
                f32x4 pg = (f32x4){0.f, 0.f, 0.f, 0.f}, pu = pg, ng = pg, nu = pg;
                if (ch > 0) { pg = *(const PG8_LAS f32x4*)(X + (((ch - 1) * 2 + 1) * 256 + xcol + 4 * n)); pu = *(const PG8_LAS f32x4*)(X + (((ch - 1) * 2 + 1) * 256 + 128 + xcol + 4 * n)); }
                if (ch < 3) { ng = *(const PG8_LAS f32x4*)(X + (((ch + 1) * 2 + 0) * 256 + xcol + 4 * n)); nu = *(const PG8_LAS f32x4*)(X + (((ch + 1) * 2 + 0) * 256 + 128 + xcol + 4 * n)); }
#pragma unroll
                for (int m = 0; m < 4; ++m) {
                    const int row = ai * HALF + wr * 64 + m * 16 + fr; const int tg = tg0 + ai * HALF + m * 16;
                    const int ps = tg < 16384 ? (tg & 4095) : (tg & 8191); const int ps1 = (tg + 1) < 16384 ? ((tg + 1) & 4095) : ((tg + 1) & 8191);
                    const bool first = ps == 0, last = ps1 == 0;
                    float o[4];
#pragma unroll
                    for (int j = 0; j < 4; ++j) {
                        const float cg = acc[ai][0][m][n][j], cu = acc[ai][1][m][n][j];
                        float p0g, p0u, n15g, n15u;
                        if (m > 0) { p0g = dpp_f<0x121>(0.f, acc[ai][0][m > 0 ? m - 1 : 0][n][j]); p0u = dpp_f<0x121>(0.f, acc[ai][1][m > 0 ? m - 1 : 0][n][j]); } else { p0g = pg[j]; p0u = pu[j]; }
                        if (m < 3) { n15g = dpp_f<0x12F>(0.f, acc[ai][0][m < 3 ? m + 1 : 3][n][j]); n15u = dpp_f<0x12F>(0.f, acc[ai][1][m < 3 ? m + 1 : 3][n][j]); } else { n15g = ng[j]; n15u = nu[j]; }
                        float prg = dpp_f<0x111>(p0g, cg), pru = dpp_f<0x111>(p0u, cu);
                        float nxg = dpp_f<0x101>(n15g, cg), nxu = dpp_f<0x101>(n15u, cu);
                        if (first) { prg = 0.f; pru = 0.f; }
                        if (last) { nxg = 0.f; nxu = 0.f; }
                        const float yg = wg[0][j] * prg + (wg[1][j] * cg + (wg[2][j] * nxg + bg[j]));
                        const float yu = wu[0][j] * pru + (wu[1][j] * cu + (wu[2][j] * nxu + bu[j]));
                        o[j] = gelu_tanh(yg) * yu;
                    }
                    if (row >= 1 && row <= 254 && tg < Mrows) { typedef unsigned u32x2v __attribute__((ext_vector_type(2))); u32x2v w; w.x = cvt_pk_bf16(o[0], o[1]); w.y = cvt_pk_bf16(o[2], o[3]);
                        *(u32x2v*)(G + (size_t)tg * 2816 + gc0 + 4 * n) = w; }
                }
            }
        }
    }
};

template <class Epi, class Sched, bool ALIGN_EPI = false, bool SP2 = false>
__device__ __forceinline__ void gemm_phase(PG8_LAS unsigned char* lds, const Gemm g, const Sched& S, const Epi& E) {
    const int tid = threadIdx.x, wid = __builtin_amdgcn_readfirstlane(tid >> 6), lane = tid & 63, wr = wid >> 2, wc = wid & 3, fr = lane & 15, fq = lane >> 4;
    const int K = g.K, nt = K / BK;
    unsigned voffA[2], voffB[2];
#pragma unroll
    for (int i = 0; i < 2; ++i) { int R, C; stage_rc(tid * 16 + i * 8192, R, C); const int Rb = Epi::PERM ? ((R & ~31) + perm32(R & 31)) : R;
        voffA[i] = (unsigned)(R * K + C) * 2u; voffB[i] = (unsigned)(Rb * K + C) * 2u; }
    const size_t kstep = (size_t)(BK * 2);
    const size_t hstep = (size_t)HALF * K * 2;
    const size_t tstep = 2 * hstep;
    const unsigned ldsw = (unsigned)wid * 1024u;
    const int aoff = lds_byte(wr * 64 + fr, fq * 8), boff = lds_byte(wc * 32 + fr, fq * 8);
#define PG8_SA(b, h) (((b) * 2 + (h)) * HTB)
#define PG8_SB(b, h) ((4 + (b) * 2 + (h)) * HTB)
#define PG8_STAGE(bufoff, gbase, voff) do { _Pragma("unroll") for (int _i = 0; _i < 2; ++_i) \
        __builtin_amdgcn_global_load_lds((const unsigned*)((const char*)(gbase) + (voff)[_i]), (PG8_LAS unsigned*)(lds + (bufoff) + ldsw + _i * 8192), 16, 0, 0); } while (0)
#define PG8_LDA(dst, b, h) do { _Pragma("unroll") for (int m = 0; m < 4; ++m) _Pragma("unroll") for (int k = 0; k < 2; ++k) dst[m][k] = *(const PG8_LAS bf16x8*)(lds + PG8_SA(b, h) + aoff + m * 2048 + k * 1024); } while (0)
#define PG8_LDB(dst, b, h) do { _Pragma("unroll") for (int n = 0; n < 2; ++n) _Pragma("unroll") for (int k = 0; k < 2; ++k) dst[n][k] = *(const PG8_LAS bf16x8*)(lds + PG8_SB(b, h) + boff + n * 2048 + k * 1024); } while (0)
#define PG8_MMA(ai, bj, At, Bt) do { __builtin_amdgcn_s_setprio(1); _Pragma("unroll") for (int m = 0; m < 4; ++m) _Pragma("unroll") for (int n = 0; n < 2; ++n) _Pragma("unroll") for (int k = 0; k < 2; ++k) \
        acc[ai][bj][m][n] = __builtin_amdgcn_mfma_f32_16x16x32_bf16(Bt[n][k], At[m][k], acc[ai][bj][m][n], 0, 0, 0); __builtin_amdgcn_s_setprio(0); } while (0)
#define PG8_WAIT_V(n) asm volatile("s_waitcnt vmcnt(" #n ")" ::: "memory")
#define PG8_WAIT_L(n) asm volatile("s_waitcnt lgkmcnt(" #n ")" ::: "memory")
#define PG8_BAR __builtin_amdgcn_s_barrier()
#define PG8_SCHED __builtin_amdgcn_sched_barrier(0)
    Unit cur, nxt; int ui = 0;
    if (!S.next(0, cur)) return;
    f32x4 acc[2][2][4][2];
#pragma unroll
    for (int a = 0; a < 2; ++a)
#pragma unroll
        for (int b = 0; b < 2; ++b)
#pragma unroll
            for (int m = 0; m < 4; ++m)
#pragma unroll
                for (int n = 0; n < 2; ++n) acc[a][b][m][n] = (f32x4){0.f, 0.f, 0.f, 0.f};
    bf16x8 At[4][2], B0[2][2], B1[2][2];
    const char* cA = (const char*)g.A + (size_t)cur.pm * g.tstepA; const char* cB = (const char*)g.Bt + (size_t)cur.pn * tstep;
    S.a_ready(cur);
    if constexpr (SP2) {
        PG8_STAGE(PG8_SB(0, 0), cB, voffB); PG8_STAGE(PG8_SB(0, 1), cB + hstep, voffB); PG8_STAGE(PG8_SA(0, 0), cA, voffA); PG8_STAGE(PG8_SA(0, 1), cA + hstep, voffA);
        if (wr == 1) PG8_BAR;
        PG8_WAIT_V(2); PG8_BAR;
        PG8_STAGE(PG8_SB(1, 0), cB + kstep, voffB); PG8_STAGE(PG8_SA(1, 0), cA + kstep, voffA); PG8_STAGE(PG8_SB(1, 1), cB + hstep + kstep, voffB);
        PG8_WAIT_V(6); PG8_BAR;
    } else {
        PG8_STAGE(PG8_SB(0, 0), cB, voffB); PG8_STAGE(PG8_SA(0, 0), cA, voffA); PG8_STAGE(PG8_SB(0, 1), cB + hstep, voffB); PG8_STAGE(PG8_SA(0, 1), cA + hstep, voffA);
        if (wr == 1) PG8_BAR;
        PG8_WAIT_V(4); PG8_BAR;
        PG8_STAGE(PG8_SB(1, 0), cB + kstep, voffB); PG8_STAGE(PG8_SA(1, 0), cA + kstep, voffA); PG8_STAGE(PG8_SB(1, 1), cB + hstep + kstep, voffB);
        PG8_WAIT_V(6); PG8_BAR;
    }
    for (;;) {
        const bool has_next = S.next(ui + 1, nxt);
        const char* nA = has_next ? (const char*)g.A + (size_t)nxt.pm * g.tstepA : cA; const char* nB = has_next ? (const char*)g.Bt + (size_t)nxt.pn * tstep : cB;
        for (int t = 0; t < nt; t += 2) {
            const bool last = (t == nt - 2);
            const char* a1 = cA + (size_t)(t + 1) * kstep;
            const char* a2 = last ? nA : cA + (size_t)(t + 2) * kstep; const char* b2 = last ? nB : cB + (size_t)(t + 2) * kstep;
            const char* a3 = a2 + kstep; const char* b3 = b2 + kstep;
            if (last && has_next) S.a_ready(nxt);
            if constexpr (SP2) {
            PG8_LDB(B0, 0, 0); PG8_LDB(B1, 0, 1); PG8_SCHED; PG8_LDA(At, 0, 0); PG8_STAGE(PG8_SA(1, 1), a1 + hstep, voffA);
            PG8_WAIT_V(8); PG8_WAIT_L(0); PG8_BAR; PG8_MMA(0, 0, At, B0); PG8_MMA(0, 1, At, B1); PG8_BAR; PG8_SCHED;
            PG8_LDA(At, 0, 1); PG8_STAGE(PG8_SB(0, 0), b2, voffB); PG8_STAGE(PG8_SB(0, 1), b2 + hstep, voffB); PG8_STAGE(PG8_SA(0, 0), a2, voffA);
            PG8_WAIT_V(8); PG8_WAIT_L(0); PG8_BAR; PG8_MMA(1, 0, At, B0); PG8_MMA(1, 1, At, B1); PG8_BAR; PG8_SCHED;
            PG8_LDB(B0, 1, 0); PG8_LDB(B1, 1, 1); PG8_SCHED; PG8_LDA(At, 1, 0); PG8_STAGE(PG8_SA(0, 1), a2 + hstep, voffA);
            PG8_WAIT_V(8); PG8_WAIT_L(0); PG8_BAR; PG8_MMA(0, 0, At, B0); PG8_MMA(0, 1, At, B1); PG8_BAR; PG8_SCHED;
            PG8_LDA(At, 1, 1); PG8_STAGE(PG8_SB(1, 0), b3, voffB); PG8_STAGE(PG8_SB(1, 1), b3 + hstep, voffB); PG8_STAGE(PG8_SA(1, 0), a3, voffA);
            PG8_WAIT_V(8); PG8_WAIT_L(0); PG8_BAR; PG8_MMA(1, 0, At, B0); PG8_MMA(1, 1, At, B1); PG8_BAR; PG8_SCHED;
            } else {
            PG8_LDB(B0, 0, 0); PG8_SCHED; PG8_LDA(At, 0, 0); PG8_STAGE(PG8_SA(1, 1), a1 + hstep, voffA);
            PG8_WAIT_L(8); PG8_BAR; PG8_WAIT_L(0); PG8_MMA(0, 0, At, B0); PG8_BAR; PG8_SCHED;
            PG8_LDB(B1, 0, 1); PG8_STAGE(PG8_SB(0, 0), b2, voffB);
            PG8_BAR; PG8_WAIT_L(0); PG8_MMA(0, 1, At, B1); PG8_BAR;
            PG8_LDA(At, 0, 1); PG8_STAGE(PG8_SA(0, 0), a2, voffA);
            PG8_BAR; PG8_WAIT_L(0); PG8_MMA(1, 0, At, B0); PG8_BAR; PG8_SCHED;
            PG8_STAGE(PG8_SB(0, 1), b2 + hstep, voffB);
            PG8_WAIT_V(6); PG8_BAR; PG8_MMA(1, 1, At, B1); PG8_BAR;
            PG8_LDB(B0, 1, 0); PG8_SCHED; PG8_LDA(At, 1, 0); PG8_STAGE(PG8_SA(0, 1), a2 + hstep, voffA);
            PG8_WAIT_L(8); PG8_BAR; PG8_WAIT_L(0); PG8_MMA(0, 0, At, B0); PG8_BAR; PG8_SCHED;
            PG8_LDB(B1, 1, 1); PG8_STAGE(PG8_SB(1, 0), b3, voffB);
            PG8_BAR; PG8_WAIT_L(0); PG8_MMA(0, 1, At, B1); PG8_BAR;
            PG8_LDA(At, 1, 1); PG8_STAGE(PG8_SA(1, 0), a3, voffA);
            PG8_BAR; PG8_WAIT_L(0); PG8_MMA(1, 0, At, B0); PG8_BAR; PG8_SCHED;
            PG8_STAGE(PG8_SB(1, 1), b3 + hstep, voffB);
            PG8_WAIT_V(6); PG8_BAR; PG8_MMA(1, 1, At, B1); PG8_BAR;
            }
        }
        if constexpr (ALIGN_EPI) { if (wr == 0) PG8_BAR; }
        if constexpr (!Epi::AFTER_DRAIN) { E(acc, cur, wr, wc, fr, fq); S.done(cur); }
        if (!has_next) break;
#pragma unroll
        for (int a = 0; a < 2; ++a)
#pragma unroll
            for (int b = 0; b < 2; ++b)
#pragma unroll
                for (int m = 0; m < 4; ++m)
#pragma unroll
                    for (int n = 0; n < 2; ++n) acc[a][b][m][n] = (f32x4){0.f, 0.f, 0.f, 0.f};
        cur = nxt; cA = nA; cB = nB; ++ui;
        if constexpr (ALIGN_EPI) { if (wr == 1) PG8_BAR; }
    }
    PG8_WAIT_V(0);
    if constexpr (!ALIGN_EPI) { if (wr == 0) PG8_BAR; }
    PG8_BAR;
    if constexpr (Epi::AFTER_DRAIN) { E.fused(acc, cur, wr, wc, fr, fq, lds, wid, lane); S.done(cur); }
#undef PG8_SA
#undef PG8_SB
#undef PG8_STAGE
#undef PG8_LDA
#undef PG8_LDB
#undef PG8_MMA
#undef PG8_WAIT_V
#undef PG8_WAIT_L
#undef PG8_BAR
#undef PG8_SCHED
}
}

namespace att {
#define ATT_LAS __attribute__((address_space(3)))
typedef unsigned short bf16_t;
using bf16x8 = __attribute__((ext_vector_type(8))) short;
using s16x4  = __attribute__((ext_vector_type(4))) short;
using f32x16 = __attribute__((ext_vector_type(16))) float;
using f32x4  = __attribute__((ext_vector_type(4))) float;
using u32x4  = __attribute__((ext_vector_type(4))) unsigned;
typedef ATT_LAS char* lptr;
#define SBAR() __builtin_amdgcn_sched_barrier(0)
constexpr int PITCH = 1024;
constexpr float QSCALE = 0.125f * 1.4426950408889634f;
constexpr float THRL = 8.0f * 1.4426950408889634f;
__device__ __forceinline__ int crow(int r, int hi) { return (r & 3) + 8 * (r >> 2) + 4 * hi; }
__device__ __forceinline__ unsigned cvtpk(float lo, float hi) { unsigned r; asm volatile("v_cvt_pk_bf16_f32 %0, %1, %2" : "=v"(r) : "v"(lo), "v"(hi)); return r; }
__device__ __forceinline__ int koff(int row, int c) { return c * 1024 + ((row ^ c) << 4); }
__device__ __forceinline__ int v_st(int k, int c) { const int kk = (k & ~0xC) | ((k & 4) << 1) | ((k & 8) >> 1); return ((kk >> 3) * 4 + (c >> 5)) * 512 + ((kk & 7) * 32 + (c & 31)) * 2; }
__device__ __forceinline__ int v_rd_base(int lane) { return ((lane & 3) << 3) | (((lane >> 2) & 3) << 6) | (((lane >> 4) & 1) << 5) | (((lane >> 5) & 1) << 8); }
constexpr int v_rd_off(int d0, int ks, int half) { return d0 * 512 + ks * 4096 + half * 2048; }
template <int OFF> __device__ __forceinline__ s16x4 tr_read(int vb) { s16x4 r; asm volatile("ds_read_b64_tr_b16 %0, %1 offset:%2" : "=&v"(r) : "v"(vb), "i"(OFF) : "memory"); return r; }
template <int D0> __device__ __forceinline__ void pv_one(f32x16& od, int vb, bf16x8 pa0, bf16x8 pa1, bf16x8 pa2, bf16x8 pa3) {
  const s16x4 l0 = tr_read<v_rd_off(D0, 0, 0)>(vb), h0 = tr_read<v_rd_off(D0, 0, 1)>(vb), l1 = tr_read<v_rd_off(D0, 1, 0)>(vb), h1 = tr_read<v_rd_off(D0, 1, 1)>(vb);
  const s16x4 l2 = tr_read<v_rd_off(D0, 2, 0)>(vb), h2 = tr_read<v_rd_off(D0, 2, 1)>(vb), l3 = tr_read<v_rd_off(D0, 3, 0)>(vb), h3 = tr_read<v_rd_off(D0, 3, 1)>(vb);
  asm volatile("s_waitcnt lgkmcnt(0)" ::: "memory"); SBAR();
#define PK(L, H) (bf16x8){L[0], L[1], L[2], L[3], H[0], H[1], H[2], H[3]}
  od = __builtin_amdgcn_mfma_f32_32x32x16_bf16(pa0, PK(l0, h0), od, 0, 0, 0);
  od = __builtin_amdgcn_mfma_f32_32x32x16_bf16(pa1, PK(l1, h1), od, 0, 0, 0);
  od = __builtin_amdgcn_mfma_f32_32x32x16_bf16(pa2, PK(l2, h2), od, 0, 0, 0);
  od = __builtin_amdgcn_mfma_f32_32x32x16_bf16(pa3, PK(l3, h3), od, 0, 0, 0);
#undef PK
}
__device__ __forceinline__ void qkt(f32x16& p0, f32x16& p1, lptr Ks, const bf16x8* qr, int r32, int hi) {
  p0 = f32x16{}; p1 = f32x16{};
#pragma unroll
  for (int d0 = 0; d0 < 4; ++d0) { const int c = 2 * d0 + hi;
    const bf16x8 b0 = *(const ATT_LAS bf16x8*)(Ks + koff(r32, c));
    const bf16x8 b1 = *(const ATT_LAS bf16x8*)(Ks + koff(32 + r32, c));
    p0 = __builtin_amdgcn_mfma_f32_32x32x16_bf16(b0, qr[d0], p0, 0, 0, 0);
    p1 = __builtin_amdgcn_mfma_f32_32x32x16_bf16(b1, qr[d0], p1, 0, 0, 0); }
}
__device__ __forceinline__ float rowmax32(const f32x16& p0, const f32x16& p1) {
  float pmax = p0[0];
#pragma unroll
  for (int r = 1; r < 16; ++r) pmax = fmaxf(pmax, p0[r]);
#pragma unroll
  for (int r = 0; r < 16; ++r) pmax = fmaxf(pmax, p1[r]);
  auto rr = __builtin_amdgcn_permlane32_swap(__float_as_uint(pmax), __float_as_uint(pmax), false, false);
  return fmaxf(__uint_as_float(rr[0]), __uint_as_float(rr[1]));
}
__device__ __forceinline__ void partialSM(f32x16& p0, f32x16& p1, float& m_reg, float& mn, float& alpha) {
  const float pmax = rowmax32(p0, p1);
  if (__builtin_expect(__all(pmax - m_reg <= THRL), 1)) { mn = m_reg; alpha = 1.f; }
  else { mn = fmaxf(m_reg, pmax); alpha = __builtin_amdgcn_exp2f(m_reg - mn); m_reg = mn; }
#pragma unroll
  for (int r = 0; r < 16; ++r) p0[r] = p0[r] - mn;
#pragma unroll
  for (int r = 0; r < 16; ++r) p1[r] = p1[r] - mn;
#pragma unroll
  for (int r = 0; r < 16; ++r) p0[r] = __builtin_amdgcn_exp2f(p0[r]);
}
__device__ __forceinline__ void finishSM(f32x16& p0, f32x16& p1, float alpha, float& l_reg, bf16x8& pa0, bf16x8& pa1, bf16x8& pa2, bf16x8& pa3) {
#pragma unroll
  for (int r = 0; r < 16; ++r) p1[r] = __builtin_amdgcn_exp2f(p1[r]);
  float ps = 0;
#pragma unroll
  for (int r = 0; r < 16; ++r) ps += p0[r];
#pragma unroll
  for (int r = 0; r < 16; ++r) ps += p1[r];
  { auto rr = __builtin_amdgcn_permlane32_swap(__float_as_uint(ps), __float_as_uint(ps), false, false); ps = __uint_as_float(rr[0]) + __uint_as_float(rr[1]); }
  l_reg = l_reg * alpha + ps;
#define PK4(P, BASE, OUT) do { unsigned a0 = cvtpk(P[BASE + 0], P[BASE + 1]), a1 = cvtpk(P[BASE + 2], P[BASE + 3]);   \
    unsigned b0 = cvtpk(P[BASE + 4], P[BASE + 5]), b1 = cvtpk(P[BASE + 6], P[BASE + 7]);                              \
    auto r0 = __builtin_amdgcn_permlane32_swap(a0, b0, false, false); auto r1 = __builtin_amdgcn_permlane32_swap(a1, b1, false, false); \
    u32x4 w = {r0[0], r1[0], r0[1], r1[1]}; OUT = __builtin_bit_cast(bf16x8, w); } while (0)
  PK4(p0, 0, pa0); PK4(p0, 8, pa1); PK4(p1, 0, pa2); PK4(p1, 8, pa3);
#undef PK4
}

constexpr int DA_SHM_V = 16384, DA_SHM_K = 8192, DA_LDS_V = 0, DA_LDS_K = 2 * DA_SHM_V, DA_LDS_WS = DA_LDS_K + 2 * DA_SHM_K, DA_LDS_BYTES = DA_LDS_WS + 8 * 256;
__device__ __forceinline__ void da_pass(const bf16_t* __restrict__ Qw, const bf16_t* __restrict__ Kh, const bf16_t* __restrict__ Vh, int NT, lptr lds, int tid, int wid, int lane,
                                        f32x16 (&o)[4], float& l_out) {
  const int r32 = lane & 31, hi = lane >> 5;
  const lptr V_lds = lds + DA_LDS_V, K_lds = lds + DA_LDS_K;
  ATT_LAS float* al_l = (ATT_LAS float*)(lds + DA_LDS_WS) + wid * 64 + 32;
  float m_reg = -1e30f, l_reg = 0.f;
#pragma unroll
  for (int d = 0; d < 4; ++d) o[d] = f32x16{};
  bf16x8 qr[4];
#pragma unroll
  for (int d0 = 0; d0 < 4; ++d0) qr[d0] = *(const bf16x8*)(Qw + d0 * 16);
  const int sr = tid >> 4, sc = (tid & 15) * 8, vst0 = v_st(sr, sc), vst1 = v_st(32 + sr, sc);
  const int kr = tid >> 3, kc = tid & 7, kst = koff(kr, kc);
  const int vb0 = (int)(unsigned)(uintptr_t)V_lds + v_rd_base(lane);
  bf16x8 sv0[2], sv1[2], sk[2];
#define SLOAD(i, k0) do { sv0[i] = *(const bf16x8*)(Vh + (size_t)((k0) + sr) * PITCH + sc); sv1[i] = *(const bf16x8*)(Vh + (size_t)((k0) + 32 + sr) * PITCH + sc); \
    sk[i] = *(const bf16x8*)(Kh + (size_t)((k0) + kr) * PITCH + kc * 8); } while (0)
#define SWRITE(b, i) do { *(ATT_LAS bf16x8*)(V_lds + (b) * DA_SHM_V + vst0) = sv0[i]; *(ATT_LAS bf16x8*)(V_lds + (b) * DA_SHM_V + vst1) = sv1[i]; \
    *(ATT_LAS bf16x8*)(K_lds + (b) * DA_SHM_K + kst) = sk[i]; } while (0)
#define SWAIT() asm volatile("s_waitcnt vmcnt(3)" ::: "memory")
#define RESC(a) do { if (__any((a) < 1.f)) { if (hi == 0) al_l[r32] = (a); asm volatile("s_waitcnt lgkmcnt(0)" ::: "memory"); \
    _Pragma("unroll") for (int d = 0; d < 4; ++d) _Pragma("unroll") for (int r = 0; r < 16; ++r) o[d][r] *= al_l[crow(r, hi)]; } } while (0)
#define PVALL(vb) do { pv_one<0>(o[0], (vb), pa0, pa1, pa2, pa3); pv_one<1>(o[1], (vb), pa0, pa1, pa2, pa3); pv_one<2>(o[2], (vb), pa0, pa1, pa2, pa3); pv_one<3>(o[3], (vb), pa0, pa1, pa2, pa3); } while (0)
  f32x16 pA0, pA1, pB0, pB1; float mnA, mnB, alA, alB; bf16x8 pa0, pa1, pa2, pa3;
  SLOAD(0, 0); asm volatile("s_waitcnt vmcnt(0)" ::: "memory"); SWRITE(0, 0); __syncthreads();
  qkt(pA0, pA1, K_lds, qr, r32, hi); partialSM(pA0, pA1, m_reg, mnA, alA);
  SLOAD(1, 64); if (2 < NT) SLOAD(0, 128);
  SWAIT(); SWRITE(1, 1); __syncthreads();
  for (int j = 1; j + 1 < NT; j += 2) {
    SBAR(); qkt(pB0, pB1, K_lds + DA_SHM_K, qr, r32, hi);
    finishSM(pA0, pA1, alA, l_reg, pa0, pa1, pa2, pa3); SBAR();
    SLOAD(1, (j + 2) * 64); SBAR();
    PVALL(vb0); partialSM(pB0, pB1, m_reg, mnB, alB);
    __syncthreads(); SWAIT(); SWRITE(0, 0);
    RESC(alB); __syncthreads();
    SBAR(); qkt(pA0, pA1, K_lds, qr, r32, hi);
    finishSM(pB0, pB1, alB, l_reg, pa0, pa1, pa2, pa3); SBAR();
    if (j + 3 < NT) SLOAD(0, (j + 3) * 64); SBAR();
    PVALL(vb0 + DA_SHM_V); partialSM(pA0, pA1, m_reg, mnA, alA);
    __syncthreads(); SWAIT(); SWRITE(1, 1);
    RESC(alA); __syncthreads();
  }
  SBAR(); qkt(pB0, pB1, K_lds + DA_SHM_K, qr, r32, hi);
  finishSM(pA0, pA1, alA, l_reg, pa0, pa1, pa2, pa3); SBAR();
  PVALL(vb0); partialSM(pB0, pB1, m_reg, mnB, alB);
  __syncthreads(); RESC(alB);
  finishSM(pB0, pB1, alB, l_reg, pa0, pa1, pa2, pa3); SBAR();
  PVALL(vb0 + DA_SHM_V);
  l_out = l_reg;
  __syncthreads();
#undef SLOAD
#undef SWRITE
#undef SWAIT
#undef RESC
#undef PVALL
}
constexpr int DA_LDS_OST = DA_LDS_BYTES, DA_LDS_TOTAL = DA_LDS_OST + 8 * 8192;
__device__ __forceinline__ void da_unit(size_t rowbase, int T, int h, int qb, const bf16_t* Q, const bf16_t* K, const bf16_t* V, bf16_t* O, float* park, float lam, float outscale,
                                        const float* __restrict__ subg, lptr lds, int tid, int wid, int lane) {
  const int NT = T / 64;
  const size_t qrow = rowbase + (size_t)qb * 256 + wid * 32;
  f32x16 o[4]; float l_reg;
#pragma clang loop unroll(disable)
  for (int sub = 0; sub < 2; ++sub) {
    asm volatile("" : "+v"(tid)); lane = tid & 63;
    const int r32 = lane & 31, hi = lane >> 5;
    ATT_LAS float* li_l = (ATT_LAS float*)(lds + DA_LDS_WS) + wid * 64;
    da_pass(Q + (qrow + r32) * PITCH + (2 * h + sub) * 64 + hi * 8, K + rowbase * PITCH + (2 * h + sub) * 64, V + rowbase * PITCH + h * 128, NT, lds, tid, wid, lane, o, l_reg);
    if (hi == 0) li_l[r32] = l_reg; asm volatile("s_waitcnt lgkmcnt(0)" ::: "memory");
    f32x4* pk = (f32x4*)(park + ((size_t)wid * 64 + lane) * 64);
    if (sub == 0) {
#pragma unroll
      for (int q = 0; q < 4; ++q) { f32x4 rl;
#pragma unroll
        for (int j = 0; j < 4; ++j) rl[j] = __builtin_amdgcn_rcpf(li_l[crow(4 * q + j, hi)]);
#pragma unroll
        for (int d0 = 0; d0 < 4; ++d0) { f32x4 v; v[0] = o[d0][4 * q] * rl[0]; v[1] = o[d0][4 * q + 1] * rl[1]; v[2] = o[d0][4 * q + 2] * rl[2]; v[3] = o[d0][4 * q + 3] * rl[3]; pk[d0 * 4 + q] = v; } }
    } else {
      float gs[4];
#pragma unroll
      for (int d0 = 0; d0 < 4; ++d0) gs[d0] = subg[d0 * 32 + r32] * outscale;
      ATT_LAS bf16_t* stg = (ATT_LAS bf16_t*)(lds + DA_LDS_OST) + wid * 4096;
#pragma unroll
      for (int q = 0; q < 4; ++q) { f32x4 p[4];
#pragma unroll
        for (int d0 = 0; d0 < 4; ++d0) p[d0] = pk[d0 * 4 + q];
#pragma unroll
        for (int j = 0; j < 4; ++j) { const int r = 4 * q + j; const float rl = __builtin_amdgcn_rcpf(li_l[crow(r, hi)]) * lam; float ss = 0.f; float v[4];
#pragma unroll
          for (int d0 = 0; d0 < 4; ++d0) { v[d0] = p[d0][j] - o[d0][r] * rl; ss += v[d0] * v[d0]; }
          ss += __shfl_xor(ss, 1); ss += __shfl_xor(ss, 2); ss += __shfl_xor(ss, 4); ss += __shfl_xor(ss, 8); ss += __shfl_xor(ss, 16);
          const float rstd = __builtin_amdgcn_rsqf(ss * (1.0f / 128.0f) + 1e-5f);
#pragma unroll
          for (int d0 = 0; d0 < 4; ++d0) { const unsigned w = cvtpk(v[d0] * rstd * gs[d0], 0.f); stg[crow(r, hi) * 128 + d0 * 32 + r32] = (bf16_t)(w & 0xffffu); } } }
      asm volatile("s_waitcnt lgkmcnt(0)" ::: "memory");
      bf16_t* Ow = O + qrow * PITCH + h * 128;
#pragma unroll
      for (int i = 0; i < 8; ++i) { const int row = i * 4 + (lane >> 4), ch = lane & 15; const u32x4 v = *(const ATT_LAS u32x4*)(stg + row * 128 + ch * 8); *(u32x4*)(Ow + (size_t)row * PITCH + ch * 8) = v; }
    }
  }
}

constexpr int NA_LDS_V = 0, NA_LDS_K = 16384, NA_LDS_B = 24576, NA_LDS_WS = NA_LDS_B + 2560, NA_LDS_OST = NA_LDS_WS + 8 * 256, NA_LDS_BYTES = NA_LDS_OST + 8 * 4096, NA_BPAD = 64;
__device__ __forceinline__ void na_unit(size_t tok0, int rows, int h, int R, const bf16_t* Q, const bf16_t* K, const bf16_t* V, bf16_t* O, const float* __restrict__ rpb_h,
                                        lptr lds, int tid, int wid, int lane) {
  const int r32 = lane & 31, hi = lane >> 5;
  const lptr V_lds = lds + NA_LDS_V, K_lds = lds + NA_LDS_K;
  ATT_LAS float* bias = (ATT_LAS float*)(lds + NA_LDS_B);
  ATT_LAS float* li_l = (ATT_LAS float*)(lds + NA_LDS_WS) + wid * 64; ATT_LAS float* al_l = li_l + 32;
  for (int i = tid; i < 465; i += 512) bias[NA_BPAD + i] = rpb_h[i] * 1.4426950408889634f;
  const int qrow = R + (wid >> 1), half = wid & 1, c = 32 * half + r32;
  const int c0 = min(max(c - 8, 0), 48), tmask = 4 * hi - c0;
  const int rlo_w = min(max(qrow - 4, 0), rows - 8);
  const int kr_lo = min(max(R - 4, 0), rows - 8), kr_hi = min(max(R + 3 - 4, 0), rows - 8) + 7, nt = kr_hi - kr_lo + 1;
  const size_t qtok = tok0 + (size_t)qrow * 64 + c;
  bf16x8 qr[4];
#pragma unroll
  for (int d0 = 0; d0 < 4; ++d0) qr[d0] = *(const bf16x8*)(Q + qtok * PITCH + h * 64 + d0 * 16 + hi * 8);
  const int kr = tid >> 3, kc = tid & 7, kst = koff(kr, kc), vst = v_st(kr, kc * 8);
  const int vb0 = (int)(unsigned)(uintptr_t)V_lds + v_rd_base(lane);
  const bf16_t* Kh = K + tok0 * PITCH + h * 64; const bf16_t* Vh = V + tok0 * PITCH + h * 64;
  bf16x8 sk, sv;
#define NLOAD(row) do { sk = *(const bf16x8*)(Kh + (size_t)((row) * 64 + kr) * PITCH + kc * 8); sv = *(const bf16x8*)(Vh + (size_t)((row) * 64 + kr) * PITCH + kc * 8); } while (0)
  float m_reg = -INFINITY, l_reg = 0.f; f32x16 o[2]; o[0] = f32x16{}; o[1] = f32x16{};
  NLOAD(kr_lo);
  for (int t = 0; t < nt; ++t) {
    const int krow = kr_lo + t;
    __syncthreads();
    *(ATT_LAS bf16x8*)(K_lds + kst) = sk; *(ATT_LAS bf16x8*)(V_lds + vst) = sv;
    __syncthreads();
    if (t + 1 < nt) NLOAD(krow + 1);
    if (krow >= rlo_w && krow < rlo_w + 8) {
      f32x16 p0, p1; qkt(p0, p1, K_lds, qr, r32, hi);
      const int bofs = NA_BPAD + (krow - qrow + 7) * 31 + 15 - c + 4 * hi;
#pragma unroll
      for (int r = 0; r < 16; ++r) { const int kcol = (r & 3) + 8 * (r >> 2);
        p0[r] = ((unsigned)(kcol + tmask) < 16u) ? p0[r] + bias[bofs + kcol] : -INFINITY;
        p1[r] = ((unsigned)(kcol + 32 + tmask) < 16u) ? p1[r] + bias[bofs + kcol + 32] : -INFINITY; }
      const float pmax = rowmax32(p0, p1);
      const float mn = fmaxf(m_reg, pmax); const float alpha = __builtin_amdgcn_exp2f(m_reg - mn); m_reg = mn;
#pragma unroll
      for (int r = 0; r < 16; ++r) { p0[r] = __builtin_amdgcn_exp2f(p0[r] - mn); p1[r] = __builtin_amdgcn_exp2f(p1[r] - mn); }
      float ps = 0.f;
#pragma unroll
      for (int r = 0; r < 16; ++r) ps += p0[r] + p1[r];
      { auto rr = __builtin_amdgcn_permlane32_swap(__float_as_uint(ps), __float_as_uint(ps), false, false); ps = __uint_as_float(rr[0]) + __uint_as_float(rr[1]); }
      l_reg = l_reg * alpha + ps;
      if (hi == 0) al_l[r32] = alpha; asm volatile("s_waitcnt lgkmcnt(0)" ::: "memory");
#pragma unroll
      for (int r = 0; r < 16; ++r) { const float a = al_l[crow(r, hi)]; o[0][r] *= a; o[1][r] *= a; }
      bf16x8 pa0, pa1, pa2, pa3;
#define PK4(P, BASE, OUT) do { unsigned a0 = cvtpk(P[BASE + 0], P[BASE + 1]), a1 = cvtpk(P[BASE + 2], P[BASE + 3]);   \
    unsigned b0 = cvtpk(P[BASE + 4], P[BASE + 5]), b1 = cvtpk(P[BASE + 6], P[BASE + 7]);                              \
    auto r0 = __builtin_amdgcn_permlane32_swap(a0, b0, false, false); auto r1 = __builtin_amdgcn_permlane32_swap(a1, b1, false, false); \
    u32x4 w = {r0[0], r1[0], r0[1], r1[1]}; OUT = __builtin_bit_cast(bf16x8, w); } while (0)
      PK4(p0, 0, pa0); PK4(p0, 8, pa1); PK4(p1, 0, pa2); PK4(p1, 8, pa3);
#undef PK4
      pv_one<0>(o[0], vb0, pa0, pa1, pa2, pa3); pv_one<1>(o[1], vb0, pa0, pa1, pa2, pa3);
    }
  }
#undef NLOAD
  if (hi == 0) li_l[r32] = l_reg; asm volatile("s_waitcnt lgkmcnt(0)" ::: "memory");
  ATT_LAS bf16_t* stg = (ATT_LAS bf16_t*)(lds + NA_LDS_OST) + wid * 2048;
#pragma unroll
  for (int r = 0; r < 16; ++r) { const int orow = crow(r, hi); const float rl = __builtin_amdgcn_rcpf(li_l[orow]);
#pragma unroll
    for (int d0 = 0; d0 < 2; ++d0) { const unsigned w = cvtpk(o[d0][r] * rl, 0.f); stg[orow * 64 + d0 * 32 + r32] = (bf16_t)(w & 0xffffu); } }
  asm volatile("s_waitcnt lgkmcnt(0)" ::: "memory");
  bf16_t* Ow = O + (tok0 + (size_t)qrow * 64 + 32 * half) * PITCH + h * 64;
#pragma unroll
  for (int i = 0; i < 4; ++i) { const int row = i * 8 + (lane >> 3), ch = lane & 7; const u32x4 v = *(const ATT_LAS u32x4*)(stg + row * 64 + ch * 8); *(u32x4*)(Ow + (size_t)row * PITCH + ch * 8) = v; }
}
#undef SBAR
}
#define GAS __attribute__((address_space(1)))
#define LAS __attribute__((address_space(3)))
typedef unsigned short bf16;
typedef unsigned v4u __attribute__((ext_vector_type(4)));
typedef float f32x4 __attribute__((ext_vector_type(4)));
typedef short bf16x8 __attribute__((ext_vector_type(8)));
typedef GAS unsigned gu32;
typedef GAS unsigned long long gu64;
#define RLX_AGENT __ATOMIC_RELAXED, __HIP_MEMORY_SCOPE_AGENT
#define LDS_WAIT() asm volatile("s_waitcnt lgkmcnt(0)" ::: "memory")
#define VM_WAIT() asm volatile("s_waitcnt vmcnt(0)" ::: "memory")
__device__ __forceinline__ unsigned long long rt() { return __builtin_amdgcn_s_memrealtime(); }
__device__ __forceinline__ unsigned f2bf(float f) { unsigned u = __builtin_bit_cast(unsigned, f); return (u + 0x7fffu + ((u >> 16) & 1u)) >> 16; }
__device__ __forceinline__ unsigned pk2(float lo, float hi) { return f2bf(lo) | (f2bf(hi) << 16); }

#define XB_TMO      128
#define XB_XCNT(j)  (256  + 64 * (j))
#define XB_XSUB(j)  (1280 + 64 * (j))
#define XB_XGEN(j)  (2304 + 64 * (j))
#define XB_TOP      3328
#define XB_TOPGEN   3392
#define XCD_BAR_WORDS 3456
#define XB_SPIN_CAP (1u << 18)

__device__ __forceinline__ unsigned xb_ld(unsigned* p)              { return __hip_atomic_load(p, __ATOMIC_RELAXED, __HIP_MEMORY_SCOPE_AGENT); }
__device__ __forceinline__ unsigned xb_add(unsigned* p, unsigned v) { return __hip_atomic_fetch_add(p, v, __ATOMIC_RELAXED, __HIP_MEMORY_SCOPE_AGENT); }
__device__ __forceinline__ unsigned xb_xcc_id() { return (unsigned)__builtin_amdgcn_s_getreg((3 << 11) | 20) & 0xFu; }
#define XB_SPIN(cond, bar) do { unsigned _sp = 0; while (cond) { __builtin_amdgcn_s_sleep(1); \
    if ((++_sp & 255u) == 0u) { if (xb_ld(&(bar)[XB_TMO])) break; if (_sp > XB_SPIN_CAP) { atomicAdd(&(bar)[XB_TMO], 1u); break; } } } } while (0)

struct XcdBarrier {
    unsigned* bar; unsigned x;
    volatile LAS unsigned* st;
};

__device__ __forceinline__ XcdBarrier xcd_barrier_post(unsigned* bar, volatile LAS unsigned* st) {
    XcdBarrier b; b.bar = bar; b.x = xb_xcc_id(); b.st = st;
    if (threadIdx.x == 0) (void)xb_add(&bar[XB_XCNT(b.x)], 1u);
    return b;
}
__device__ __forceinline__ void xcd_barrier_complete(unsigned* bar, unsigned x, unsigned& nloc, unsigned& nx) {
    const unsigned G = gridDim.x * gridDim.y * gridDim.z;
    unsigned sum, cnt, mine, sp = 0u;
    for (;;) {
        sum = 0u; cnt = 0u; mine = 0u;
#pragma unroll
        for (unsigned j = 0; j < 16; ++j) { const unsigned c = xb_ld(&bar[XB_XCNT(j)]); sum += c; cnt += (c > 0u) ? 1u : 0u; mine = (j == x) ? c : mine; }
        if (sum == G) break;
        __builtin_amdgcn_s_sleep(1);
        if ((++sp & 255u) == 0u) { if (xb_ld(&bar[XB_TMO])) break; if (sp > XB_SPIN_CAP) { atomicAdd(&bar[XB_TMO], 1u); break; } }
    }
    nloc = mine > 0u ? mine : 1u; nx = cnt > 0u ? cnt : 1u;
}

__device__ __forceinline__ void xcd_barrier(const XcdBarrier& b) {
    asm volatile("s_waitcnt vmcnt(0)" ::: "memory");
    __syncthreads();
    if (threadIdx.x == 0) {
        unsigned* bar = b.bar;
        __builtin_amdgcn_s_waitcnt(0);
        unsigned nloc = b.st[0], nx = b.st[1];
        if (nloc == 0u) { xcd_barrier_complete(bar, b.x, nloc, nx); b.st[0] = nloc; b.st[1] = nx; }
        const unsigned old = xb_add(&bar[XB_XSUB(b.x)], 1u);
        const unsigned gen = old / nloc;
        if (old + 1u == (gen + 1u) * nloc) {
            __builtin_amdgcn_fence(__ATOMIC_RELEASE, "agent");
            asm volatile("s_waitcnt vmcnt(0)" ::: "memory");
            const unsigned og = xb_add(&bar[XB_TOP], 1u);
            const unsigned tg = og / nx;
            if (og + 1u == (tg + 1u) * nx) xb_add(&bar[XB_TOPGEN], 1u);
            else XB_SPIN(xb_ld(&bar[XB_TOPGEN]) == tg, bar);
            __builtin_amdgcn_fence(__ATOMIC_ACQUIRE, "agent");
            xb_add(&bar[XB_XGEN(b.x)], 1u);
            asm volatile("s_waitcnt vmcnt(0)" ::: "memory");
        } else {
            XB_SPIN(xb_ld(&bar[XB_XGEN(b.x)]) == gen, bar);
            __builtin_amdgcn_fence(__ATOMIC_ACQUIRE, "agent");
            asm volatile("s_waitcnt vmcnt(0)" ::: "memory");
        }
    }
    __syncthreads();
}

constexpr int NWAVES = 8;
#ifndef MK_PER_PHASE
#define MK_PER_PHASE 0
#endif
constexpr int NPH = 15;

constexpr int D = 1024, M_P = 4 * 4096, M_S = 8 * 8192, M = M_P + M_S, T_P = 4096, T_S = 8192, FF = 2816, FF2 = 2 * FF;
constexpr int NMT_CONV = (M + 253) / 254;
constexpr float NORM_EPS = 1e-6f;
constexpr float LAMBDA_INIT = 0.35550907f;

constexpr size_t MiB = 1u << 20;
constexpr size_t WS_CTL = 0, CTL_ZERO_BYTES = 1 * MiB;
constexpr size_t WS_ROPE_C = 1 * MiB, WS_ROPE_S = 2 * MiB;
constexpr size_t WS_WQKV0 = 4 * MiB, WS_WO0 = 10 * MiB, WS_WIN0 = 12 * MiB, WS_WOUT0 = 23 * MiB;
constexpr size_t WS_WQKV1 = 29 * MiB, WS_WO1 = 35 * MiB, WS_WIN1 = 37 * MiB, WS_WOUT1 = 48 * MiB;
constexpr size_t WS_XN = 56 * MiB;
constexpr size_t WS_Q = 218 * MiB, WS_K = 378 * MiB, WS_V = 538 * MiB;
constexpr size_t WS_G = 218 * MiB;
constexpr size_t WS_MB = 698 * MiB;
constexpr size_t WS_PARK = 858 * MiB;
constexpr size_t WS_END = 896 * MiB;
static_assert(WS_WOUT1 + (size_t)D * FF * 2 <= WS_XN - 4096 && WS_XN + (size_t)(NMT_CONV * 254 + 2) * D * 2 <= WS_Q && WS_G + (size_t)M * FF * 2 <= WS_MB && WS_MB + (size_t)M * D * 2 <= WS_PARK, "d_ws map");
constexpr int CW_BAR = 4096;

constexpr int RING_OFF = 0, RING_BYTES = 131072;
constexpr int LDSCTL_OFF = RING_BYTES, MISC_OFF = LDSCTL_OFF + 320;
constexpr int XCH_OFF = RING_BYTES + 1024;
constexpr int LDS_BYTES = 147456;
static_assert(XCH_OFF + 8192 <= LDS_BYTES && att::DA_LDS_TOTAL <= RING_BYTES && att::NA_LDS_BYTES <= RING_BYTES, "LDS map");

__device__ __forceinline__ float wave_sum(float v) {
#pragma unroll
    for (int o = 1; o < 64; o <<= 1) v += __shfl_xor(v, o);
    return v;
}
__device__ __forceinline__ void p0_transpose_item(const float* W, int K, int N, bf16* WT, int k0, int n0, int drow0, const float* gk, LAS float* scr, int lane) {
#pragma unroll 8
    for (int i = 0; i < 32; ++i) { const int kk = 2 * i + (lane >> 5); float w = W[(size_t)(k0 + kk) * N + n0 + (lane & 31)]; if (gk) w *= gk[k0 + kk]; scr[kk * 33 + (lane & 31)] = w; }
    LDS_WAIT(); asm volatile("" ::: "memory");
    const int c = lane & 7;
#pragma unroll
    for (int j = 0; j < 4; ++j) { const int n = (lane >> 3) + 8 * j; const LAS float* s = scr + (8 * c) * 33 + n;
        v4u o; o.x = pk2(s[0 * 33], s[1 * 33]); o.y = pk2(s[2 * 33], s[3 * 33]); o.z = pk2(s[4 * 33], s[5 * 33]); o.w = pk2(s[6 * 33], s[7 * 33]);
        *(GAS v4u*)(WT + (size_t)(drow0 + n) * K + k0 + 8 * c) = o; }
    LDS_WAIT(); asm volatile("" ::: "memory");
}
__device__ __forceinline__ void p0_matrix(const float* W, int K, int N, bf16* WT, const float* gk, int mode, int roff, LAS float* scr, int gw, int NGW, int lane) {
    const int nblk = N / 32, nitems = (K / 64) * nblk;
    for (int it = gw; it < nitems; it += NGW) {
        const int kb = it / nblk, nb = it % nblk, n0 = 32 * nb; int drow0;
        if (mode == 0) drow0 = roff + n0;
        else if (mode == 1) { const int bj = n0 >= FF ? 1 : 0, ch = n0 - bj * FF; drow0 = (ch >> 7) * 256 + bj * 128 + (ch & 127); }
        else { const int s = n0 >> 6, half = (n0 >> 5) & 1; drow0 = roff + (s >> 2) * 256 + half * 128 + (s & 3) * 32; }
        p0_transpose_item(W, K, N, WT, 64 * kb, n0, drow0, gk, scr, lane);
    }
}
__device__ __forceinline__ void sincos_small(double x, double& s, double& c) {
    const double x2 = x * x;
    double a = -1.0 / 25852016738884976640000.0;
    a = a * x2 + 1.0 / 51090942171709440000.0;
    a = a * x2 - 1.0 / 121645100408832000.0;
    a = a * x2 + 1.0 / 355687428096000.0;
    a = a * x2 - 1.0 / 1307674368000.0;
    a = a * x2 + 1.0 / 6227020800.0;
    a = a * x2 - 1.0 / 39916800.0;
    a = a * x2 + 1.0 / 362880.0;
    a = a * x2 - 1.0 / 5040.0;
    a = a * x2 + 1.0 / 120.0;
    a = a * x2 - 1.0 / 6.0;
    a = a * x2 + 1.0;
    s = a * x;
    double b = 1.0 / 620448401733239439360000.0;
    b = b * x2 - 1.0 / 1124000727777607680000.0;
    b = b * x2 + 1.0 / 2432902008176640000.0;
    b = b * x2 - 1.0 / 6402373705728000.0;
    b = b * x2 + 1.0 / 20922789888000.0;
    b = b * x2 - 1.0 / 87178291200.0;
    b = b * x2 + 1.0 / 479001600.0;
    b = b * x2 - 1.0 / 3628800.0;
    b = b * x2 + 1.0 / 40320.0;
    b = b * x2 - 1.0 / 720.0;
    b = b * x2 + 1.0 / 24.0;
    b = b * x2 - 0.5;
    b = b * x2 + 1.0;
    c = b;
}
template <bool HAS_M, bool FROM_IN, bool WRITE_X, bool WRITE_XN>
__device__ __forceinline__ void thin_pass(const float* xp, const float* xs, float* xio, const bf16* mb, const float* gpost, bf16* xn, int gw, int NGW, int lane) {
    f32x4 g[4];
    if (HAS_M) {
#pragma unroll
        for (int j = 0; j < 4; ++j) g[j] = *(const f32x4*)(gpost + 4 * lane + 256 * j);
    }
    for (int row = gw; row < M; row += NGW) {
        const float* xr = FROM_IN ? (row < M_P ? xp + (size_t)row * D : xs + (size_t)(row - M_P) * D) : xio + (size_t)row * D;
        f32x4 x[4];
#pragma unroll
        for (int j = 0; j < 4; ++j) x[j] = *(const GAS f32x4*)(xr + 4 * lane + 256 * j);
        if (HAS_M) {
            f32x4 mv[4]; float ss = 0.f;
#pragma unroll
            for (int j = 0; j < 4; ++j) { const unsigned long long w = *(const GAS unsigned long long*)(mb + (size_t)row * D + 4 * lane + 256 * j);
                mv[j].x = __uint_as_float((unsigned)(w & 0xffffull) << 16); mv[j].y = __uint_as_float((unsigned)((w >> 16) & 0xffffull) << 16);
                mv[j].z = __uint_as_float((unsigned)((w >> 32) & 0xffffull) << 16); mv[j].w = __uint_as_float((unsigned)(w >> 48) << 16);
                ss += (mv[j].x * mv[j].x + mv[j].y * mv[j].y) + (mv[j].z * mv[j].z + mv[j].w * mv[j].w); }
            const float rs = __builtin_amdgcn_rsqf(wave_sum(ss) * (1.f / D) + NORM_EPS);
#pragma unroll
            for (int j = 0; j < 4; ++j) x[j] = x[j] + mv[j] * g[j] * rs;
        }
        if (WRITE_X) {
#pragma unroll
            for (int j = 0; j < 4; ++j) *(GAS f32x4*)(xio + (size_t)row * D + 4 * lane + 256 * j) = x[j];
        }
        if (WRITE_XN) {
            float s2 = 0.f;
#pragma unroll
            for (int j = 0; j < 4; ++j) s2 += (x[j].x * x[j].x + x[j].y * x[j].y) + (x[j].z * x[j].z + x[j].w * x[j].w);
            const float rs = __builtin_amdgcn_rsqf(wave_sum(s2) * (1.f / D) + NORM_EPS);
#pragma unroll
            for (int j = 0; j < 4; ++j) *(GAS unsigned long long*)(xn + (size_t)row * D + 4 * lane + 256 * j) =
                (unsigned long long)pk2(x[j].x * rs, x[j].y * rs) | ((unsigned long long)pk2(x[j].z * rs, x[j].w * rs) << 32);
        }
    }
}

struct Args { const float* in[22]; float* out; unsigned char* ws; int ph_lo, ph_hi; };
__global__ void __launch_bounds__(NWAVES * 64, 2) mega_fwd(Args args) {
    extern __shared__ __attribute__((aligned(16))) unsigned char lds_raw[];
    LAS unsigned char* lds = (LAS unsigned char*)lds_raw;
    volatile LAS unsigned* MISC = (volatile LAS unsigned*)(lds + MISC_OFF);
    const int tid = threadIdx.x, lane = tid & 63, wave = __builtin_amdgcn_readfirstlane(tid >> 6);
    const int G = gridDim.x, bx = blockIdx.x, vcu = (G % 8 == 0) ? (bx % 8) * (G / 8) + bx / 8 : bx;
    const int gw = vcu * NWAVES + wave, NGW = G * NWAVES;
    unsigned char* ws = args.ws;
    gu32* ctl = (gu32*)(ws + WS_CTL);
    for (int u = tid; u < (LDS_BYTES - LDSCTL_OFF) / 4; u += NWAVES * 64) ((LAS unsigned*)(lds + LDSCTL_OFF))[u] = 0u;
    __syncthreads();
    XcdBarrier bar; bar.bar = (unsigned*)(ctl + CW_BAR); bar.x = 0; bar.st = nullptr;
    if (!MK_PER_PHASE) bar = xcd_barrier_post((unsigned*)(ctl + CW_BAR), MISC + 8);
#define GRID_BAR() do { if (!MK_PER_PHASE) xcd_barrier(bar); } while (0)
    const int lo = args.ph_lo, hi = args.ph_hi;
#ifndef PH_MASK
#define PH_MASK 0x7fff
#endif
#define IN(k) (((PH_MASK >> (k)) & 1) && lo <= (k) && (k) < hi)
#define BOTH(k) (IN(k) && IN((k) + 1))

    const float* x_p = args.in[0]; const float* x_s = args.in[1];
    const float* attn_pre_g = args.in[2]; const float* attn_post_g = args.in[3]; const float* ffn_pre_g = args.in[4]; const float* ffn_post_g = args.in[5];
    float* out = args.out;
    bf16* XN = (bf16*)(ws + WS_XN); bf16* QB = (bf16*)(ws + WS_Q); bf16* KB = (bf16*)(ws + WS_K); bf16* VB = (bf16*)(ws + WS_V); bf16* GB = (bf16*)(ws + WS_G); bf16* MB = (bf16*)(ws + WS_MB);
    float* ROPE_C = (float*)(ws + WS_ROPE_C); float* ROPE_S = (float*)(ws + WS_ROPE_S);
    constexpr size_t TSTEP_D = (size_t)256 * D * 2, TSTEP_FF = (size_t)256 * FF * 2, TSTEP_CONV = (size_t)254 * D * 2;

    if (IN(0)) {
        LAS float* scr = (LAS float*)(lds + RING_OFF + wave * 16384);
        p0_matrix(args.in[6], D, 3 * D, (bf16*)(ws + WS_WQKV0), attn_pre_g, 0, 0, scr, gw, NGW, lane);
        p0_matrix(args.in[8], D, D, (bf16*)(ws + WS_WO0), nullptr, 0, 0, scr, gw, NGW, lane);
        p0_matrix(args.in[18], D, FF2, (bf16*)(ws + WS_WIN0), ffn_pre_g, 1, 0, scr, gw, NGW, lane);
        p0_matrix(args.in[21], FF, D, (bf16*)(ws + WS_WOUT0), nullptr, 0, 0, scr, gw, NGW, lane);
        p0_matrix(args.in[9], D, D, (bf16*)(ws + WS_WQKV1), attn_pre_g + D, 2, 0, scr, gw, NGW, lane);
        p0_matrix(args.in[10], D, D, (bf16*)(ws + WS_WQKV1), attn_pre_g + D, 2, D, scr, gw, NGW, lane);
        p0_matrix(args.in[11], D, D, (bf16*)(ws + WS_WQKV1), attn_pre_g + D, 0, 2 * D, scr, gw, NGW, lane);
        p0_matrix(args.in[17], D, D, (bf16*)(ws + WS_WO1), nullptr, 0, 0, scr, gw, NGW, lane);
        p0_matrix(args.in[18] + (size_t)D * FF2, D, FF2, (bf16*)(ws + WS_WIN1), ffn_pre_g + D, 1, 0, scr, gw, NGW, lane);
        p0_matrix(args.in[21] + (size_t)FF * D, FF, D, (bf16*)(ws + WS_WOUT1), nullptr, 0, 0, scr, gw, NGW, lane);
        for (int i = gw * 64 + lane; i < T_S * 32; i += NGW * 64) {
            const int t = i >> 5, d = i & 31;
            double inv = 1.0; for (int q = 0; q < d; ++q) inv *= 0.7498942093324559;
            const double ang = (double)t * inv;
            const double k = __builtin_rint(ang * 0.15915494309189535);
            double xr = __builtin_fma(-k, 6.283185307179586, ang); xr = __builtin_fma(-k, 2.4492935982947064e-16, xr);
            double s, c; sincos_small(xr, s, c);
            ROPE_C[i] = (float)c; ROPE_S[i] = (float)s;
        }
        thin_pass<false, true, false, true>(x_p, x_s, nullptr, nullptr, nullptr, XN, gw, NGW, lane);
        if (BOTH(0)) GRID_BAR();
    }
    if (IN(1)) {
        pg8::Gemm g{XN, (const bf16*)(ws + WS_WQKV0), M, 3 * D, D, TSTEP_D}; pg8::StaticOrder S; S.init(M, 3 * D, G, bx);
        pg8::EpiBf16<0> E{QB, D, nullptr, D, (size_t)(WS_K - WS_Q) / 2, att::QSCALE};
        pg8::gemm_phase<pg8::EpiBf16<0>, pg8::StaticOrder, true, true>(lds + RING_OFF, g, S, E);
        if (BOTH(1)) GRID_BAR();
    }
    if (IN(2)) {
        constexpr int NU_P = 4 * 16 * 16, NU = NU_P + 8 * 16 * 32;
        const int per = (NU + G - 1) / G, u0 = vcu * per, u1 = (u0 + per < NU) ? u0 + per : NU;
        for (int u = u0; u < u1; ++u) {
            size_t tok0; int rows, h, R;
            if (u < NU_P) { const int b = u >> 8, r = u & 255; tok0 = (size_t)b * T_P; rows = 64; h = r >> 4; R = (r & 15) * 4; }
            else { const int v = u - NU_P, b = v >> 9, r = v & 511; tok0 = (size_t)M_P + (size_t)b * T_S; rows = 128; h = r >> 5; R = (r & 31) * 4; }
            __syncthreads();
            att::na_unit(tok0, rows, h, R, QB, KB, VB, QB, args.in[7] + h * 465, (att::lptr)(lds + RING_OFF), tid, wave, lane);
        }
        __syncthreads();
        if (BOTH(2)) GRID_BAR();
    }
    if (IN(3)) {
        pg8::Gemm g{QB, (const bf16*)(ws + WS_WO0), M, D, D, TSTEP_D}; pg8::StaticOrder S; S.init(M, D, G, bx);
        pg8::EpiBf16<0> E{MB, D, nullptr, 0, 0, 1.f};
        pg8::gemm_phase<pg8::EpiBf16<0>, pg8::StaticOrder, true, true>(lds + RING_OFF, g, S, E);
        if (BOTH(3)) GRID_BAR();
    }
    if (IN(4)) { thin_pass<true, true, true, true>(x_p, x_s, out, MB, attn_post_g, XN, gw, NGW, lane); if (BOTH(4)) GRID_BAR(); }
    if (IN(5)) {
        pg8::Gemm g{XN - D, (const bf16*)(ws + WS_WIN0), M, FF2, D, TSTEP_CONV}; pg8::StaticOrder S; S.init_tiles(NMT_CONV, FF2 / 256, G, bx);
        pg8::EpiConvGlu E{GB, args.in[19], args.in[20], (PG8_LAS float*)(lds + XCH_OFF), M};
        pg8::gemm_phase<pg8::EpiConvGlu, pg8::StaticOrder, true, true>(lds + RING_OFF, g, S, E);
        if (BOTH(5)) GRID_BAR();
    }
    if (IN(6)) {
        pg8::Gemm g{GB, (const bf16*)(ws + WS_WOUT0), M, D, FF, TSTEP_FF}; pg8::StaticOrder S; S.init(M, D, G, bx);
        pg8::EpiBf16<0> E{MB, D, nullptr, 0, 0, 1.f};
        pg8::gemm_phase<pg8::EpiBf16<0>, pg8::StaticOrder, true, true>(lds + RING_OFF, g, S, E);
        if (BOTH(6)) GRID_BAR();
    }
    if (IN(7)) { thin_pass<true, false, true, true>(nullptr, nullptr, out, MB, ffn_post_g, XN, gw, NGW, lane); if (BOTH(7)) GRID_BAR(); }
    if (IN(8)) {
        pg8::Gemm g{XN, (const bf16*)(ws + WS_WQKV1), M, 3 * D, D, TSTEP_D}; pg8::StaticOrder S; S.init(M, 3 * D, G, bx);
        pg8::EpiRope E{QB, KB, VB, ROPE_C, ROPE_S, att::QSCALE};
        pg8::gemm_phase<pg8::EpiRope, pg8::StaticOrder, true, true>(lds + RING_OFF, g, S, E);
        if (BOTH(8)) GRID_BAR();
    }
    if (IN(9)) {
        float lam;
        { const float a = wave_sum(args.in[12][lane] * args.in[13][lane]), b = wave_sum(args.in[14][lane] * args.in[15][lane]); lam = __expf(a) - __expf(b) + LAMBDA_INIT; }
        float* park = (float*)(ws + WS_PARK) + (size_t)bx * 32768;
        constexpr int NP = 4 * 8 * 16, NS = 8 * 8 * 32;
#pragma clang loop unroll(disable)
        for (int id = vcu; id < NP + NS; id += G) {
            size_t rowbase; int T, h, qb;
            if (id < NP) { const int bh = id >> 4; qb = id & 15; rowbase = (size_t)(bh >> 3) * T_P; T = T_P; h = bh & 7; }
            else { const int bh = (id - NP) >> 5; qb = (id - NP) & 31; rowbase = (size_t)M_P + (size_t)(bh >> 3) * T_S; T = T_S; h = bh & 7; }
            att::da_unit(rowbase, T, h, qb, QB, KB, VB, QB, park, lam, 1.0f - LAMBDA_INIT, args.in[16], (att::lptr)(lds + RING_OFF), tid, wave, lane);
        }
        if (BOTH(9)) GRID_BAR();
    }
    if (IN(10)) {
        pg8::Gemm g{QB, (const bf16*)(ws + WS_WO1), M, D, D, TSTEP_D}; pg8::StaticOrder S; S.init(M, D, G, bx);
        pg8::EpiBf16<0> E{MB, D, nullptr, 0, 0, 1.f};
        pg8::gemm_phase<pg8::EpiBf16<0>, pg8::StaticOrder, true, true>(lds + RING_OFF, g, S, E);
        if (BOTH(10)) GRID_BAR();
    }
    if (IN(11)) { thin_pass<true, false, true, true>(nullptr, nullptr, out, MB, attn_post_g + D, XN, gw, NGW, lane); if (BOTH(11)) GRID_BAR(); }
    if (IN(12)) {
        pg8::Gemm g{XN - D, (const bf16*)(ws + WS_WIN1), M, FF2, D, TSTEP_CONV}; pg8::StaticOrder S; S.init_tiles(NMT_CONV, FF2 / 256, G, bx);
        pg8::EpiConvGlu E{GB, args.in[19] + 3 * FF2, args.in[20] + FF2, (PG8_LAS float*)(lds + XCH_OFF), M};
        pg8::gemm_phase<pg8::EpiConvGlu, pg8::StaticOrder, true, true>(lds + RING_OFF, g, S, E);
        if (BOTH(12)) GRID_BAR();
    }
    if (IN(13)) {
        pg8::Gemm g{GB, (const bf16*)(ws + WS_WOUT1), M, D, FF, TSTEP_FF}; pg8::StaticOrder S; S.init(M, D, G, bx);
        pg8::EpiBf16<0> E{MB, D, nullptr, 0, 0, 1.f};
        pg8::gemm_phase<pg8::EpiBf16<0>, pg8::StaticOrder, true, true>(lds + RING_OFF, g, S, E);
        if (BOTH(13)) GRID_BAR();
    }
    if (IN(14)) { thin_pass<true, false, true, false>(nullptr, nullptr, out, MB, ffn_post_g + D, nullptr, gw, NGW, lane); }
#undef IN
#undef BOTH
#undef GRID_BAR
}

extern "C" void kernel_launch(void* const* d_in, const int* in_sizes, int n_in, void* d_out, int out_size, void* d_ws, size_t ws_size, hipStream_t stream) {
    static int grid = 0;
    if (grid == 0) {
        if (n_in != 22 || in_sizes[0] != M_P * D || in_sizes[1] != M_S * D || out_size != M * D || ws_size < WS_END) {
            fprintf(stderr, "kernel_launch: unexpected shapes (n_in %d, in0 %d, in1 %d, out %d, ws %zu); nothing launched\n", n_in, n_in > 0 ? in_sizes[0] : -1, n_in > 1 ? in_sizes[1] : -1, out_size, ws_size); grid = -1; return; }
        int dev = 0, cus = 0, per_cu = 0;
        if (hipGetDevice(&dev) != hipSuccess || hipDeviceGetAttribute(&cus, hipDeviceAttributeMultiprocessorCount, dev) != hipSuccess) { fprintf(stderr, "kernel_launch: device query failed\n"); grid = -1; return; }
        if (hipFuncSetAttribute((const void*)mega_fwd, hipFuncAttributeMaxDynamicSharedMemorySize, LDS_BYTES) != hipSuccess) { fprintf(stderr, "kernel_launch: hipFuncSetAttribute failed\n"); grid = -1; return; }
        if (hipOccupancyMaxActiveBlocksPerMultiprocessor(&per_cu, (const void*)mega_fwd, NWAVES * 64, LDS_BYTES) != hipSuccess || per_cu < 1) { fprintf(stderr, "kernel_launch: occupancy query says %d blocks per CU\n", per_cu); }
        (void)hipGetLastError();
        grid = cus;
    }
    if (grid < 0) return;
    if (hipMemsetAsync((char*)d_ws + WS_CTL, 0, CTL_ZERO_BYTES, stream) != hipSuccess) { fprintf(stderr, "kernel_launch: memset failed\n"); return; }
    Args a{};
    for (int i = 0; i < 22; ++i) a.in[i] = (const float*)d_in[i];
    a.out = (float*)d_out; a.ws = (unsigned char*)d_ws;
#if MK_PER_PHASE
    for (int p = 0; p < NPH; ++p) { a.ph_lo = p; a.ph_hi = p + 1; hipLaunchKernelGGL(mega_fwd, dim3(grid), dim3(NWAVES * 64), LDS_BYTES, stream, a); }
#else
    a.ph_lo = 0; a.ph_hi = NPH;
    hipLaunchKernelGGL(mega_fwd, dim3(grid), dim3(NWAVES * 64), LDS_BYTES, stream, a);
#endif
    const hipError_t le = hipPeekAtLastError();
    if (le != hipSuccess) fprintf(stderr, "kernel_launch: launch failed: %s\n", hipGetErrorName(le));
}
```

```cpp
#include <hip/hip_runtime.h>
#include <cstdio>
#include <cstdint>
#include <cmath>
#define PP_NS 3
#define GAS __attribute__((address_space(1)))
#define LAS __attribute__((address_space(3)))
typedef unsigned short bf16;
typedef unsigned v4u __attribute__((ext_vector_type(4)));
typedef float f32x4 __attribute__((ext_vector_type(4)));
typedef short bf16x8 __attribute__((ext_vector_type(8)));
typedef GAS unsigned gu32;
typedef GAS unsigned long long gu64;
#define RLX_AGENT __ATOMIC_RELAXED, __HIP_MEMORY_SCOPE_AGENT
#define LDS_WAIT() asm volatile("s_waitcnt lgkmcnt(0)" ::: "memory")
#define VM_WAIT() asm volatile("s_waitcnt vmcnt(0)" ::: "memory")
__device__ __forceinline__ unsigned long long rt() { return __builtin_amdgcn_s_memrealtime(); }
__device__ __forceinline__ unsigned f2bf(float f) { unsigned u = __builtin_bit_cast(unsigned, f); return (u + 0x7fffu + ((u >> 16) & 1u)) >> 16; }
__device__ __forceinline__ unsigned pk2(float lo, float hi) { return f2bf(lo) | (f2bf(hi) << 16); }
constexpr int D = 1024, M_P = 4 * 4096, M_S = 8 * 8192, M = M_P + M_S, T_P = 4096, T_S = 8192, FF = 2816, FF2 = 2 * FF;
constexpr int NMT_CONV = (M + 253) / 254;
constexpr float NORM_EPS = 1e-6f;
constexpr float LAMBDA_INIT = 0.35550907f;

__device__ __forceinline__ float wave_sum(float v) {
#pragma unroll
    for (int o = 1; o < 64; o <<= 1) v += __shfl_xor(v, o);
    return v;
}
__device__ __forceinline__ f32x4 bf4_to_f32(unsigned long long w) {
    f32x4 v; v.x = __uint_as_float((unsigned)(w & 0xffffull) << 16); v.y = __uint_as_float((unsigned)((w >> 16) & 0xffffull) << 16);
    v.z = __uint_as_float((unsigned)((w >> 32) & 0xffffull) << 16); v.w = __uint_as_float((unsigned)(w >> 48) << 16); return v;
}
__device__ __forceinline__ void bf8_to_f32(v4u w, f32x4& a, f32x4& b) {
    a.x = __uint_as_float(w.x << 16); a.y = __uint_as_float(w.x & 0xffff0000u); a.z = __uint_as_float(w.y << 16); a.w = __uint_as_float(w.y & 0xffff0000u);
    b.x = __uint_as_float(w.z << 16); b.y = __uint_as_float(w.z & 0xffff0000u); b.z = __uint_as_float(w.w << 16); b.w = __uint_as_float(w.w & 0xffff0000u);
}
__device__ __forceinline__ float sq4(f32x4 v) { return (v.x * v.x + v.y * v.y) + (v.z * v.z + v.w * v.w); }
template <int MODE, int R = 4>
__device__ __forceinline__ void thin_rows(const float* xp, const float* xs, bf16* xb, const bf16* mb, const float* gpost, float* rs, float* out, int row0, int row1, int rstep, int lane) {
    f32x4 g[2][2];
    if (MODE != 0) {
#pragma unroll
        for (int j = 0; j < 2; ++j) { g[j][0] = *(const f32x4*)(gpost + 8 * lane + 512 * j); g[j][1] = *(const f32x4*)(gpost + 8 * lane + 512 * j + 4); }
    }
    for (int rb = row0; rb < row1; rb += rstep) {
        f32x4 x[R][2][2];
        if (MODE == 0) { const float* xr = rb < M_P ? xp + (size_t)rb * D : xs + (size_t)(rb - M_P) * D;
#pragma unroll
            for (int r = 0; r < R; ++r)
#pragma unroll
                for (int j = 0; j < 2; ++j) { x[r][j][0] = *(const GAS f32x4*)(xr + (size_t)r * D + 8 * lane + 512 * j); x[r][j][1] = *(const GAS f32x4*)(xr + (size_t)r * D + 8 * lane + 512 * j + 4); }
        } else {
            v4u xw[R][2], mw[R][2];
#pragma unroll
            for (int r = 0; r < R; ++r)
#pragma unroll
                for (int j = 0; j < 2; ++j) { xw[r][j] = *(const GAS v4u*)(xb + (size_t)(rb + r) * D + 8 * lane + 512 * j); mw[r][j] = *(const GAS v4u*)(mb + (size_t)(rb + r) * D + 8 * lane + 512 * j); }
            f32x4 mv[R][2][2]; float ss[R];
#pragma unroll
            for (int r = 0; r < R; ++r) { ss[r] = 0.f;
#pragma unroll
                for (int j = 0; j < 2; ++j) { bf8_to_f32(xw[r][j], x[r][j][0], x[r][j][1]); bf8_to_f32(mw[r][j], mv[r][j][0], mv[r][j][1]); ss[r] += sq4(mv[r][j][0]) + sq4(mv[r][j][1]); } }
#pragma unroll
            for (int o = 1; o < 64; o <<= 1) {
#pragma unroll
                for (int r = 0; r < R; ++r) ss[r] += __shfl_xor(ss[r], o); }
#pragma unroll
            for (int r = 0; r < R; ++r) { const float rm = __builtin_amdgcn_rsqf(ss[r] * (1.f / D) + NORM_EPS);
#pragma unroll
                for (int j = 0; j < 2; ++j) { x[r][j][0] = x[r][j][0] + mv[r][j][0] * g[j][0] * rm; x[r][j][1] = x[r][j][1] + mv[r][j][1] * g[j][1] * rm; } }
        }
        if (MODE == 2) {
#pragma unroll
            for (int r = 0; r < R; ++r)
#pragma unroll
                for (int j = 0; j < 2; ++j) { *(GAS f32x4*)(out + (size_t)(rb + r) * D + 8 * lane + 512 * j) = x[r][j][0]; *(GAS f32x4*)(out + (size_t)(rb + r) * D + 8 * lane + 512 * j + 4) = x[r][j][1]; }
        } else {
            float s2[R];
#pragma unroll
            for (int r = 0; r < R; ++r) { s2[r] = 0.f;
#pragma unroll
                for (int j = 0; j < 2; ++j) { s2[r] += sq4(x[r][j][0]) + sq4(x[r][j][1]);
                    v4u w; w.x = pk2(x[r][j][0].x, x[r][j][0].y); w.y = pk2(x[r][j][0].z, x[r][j][0].w); w.z = pk2(x[r][j][1].x, x[r][j][1].y); w.w = pk2(x[r][j][1].z, x[r][j][1].w);
                    *(GAS v4u*)(xb + (size_t)(rb + r) * D + 8 * lane + 512 * j) = w; } }
#pragma unroll
            for (int o = 1; o < 64; o <<= 1) {
#pragma unroll
                for (int r = 0; r < R; ++r) s2[r] += __shfl_xor(s2[r], o); }
            if (lane < R) { float v = s2[0];
#pragma unroll
                for (int r = 1; r < R; ++r) v = lane == r ? s2[r] : v;
                rs[rb + lane] = __builtin_amdgcn_rsqf(v * (1.f / D) + NORM_EPS); }
        }
    }
}

template <int MODE, int R>
__device__ __forceinline__ void thin_rows_lean(bf16* xb, const bf16* mb, const float* gpost, float* rs, float* out, int row0, int row1, int lane) {
    for (int rb = row0; rb < row1; rb += R) {
        v4u xw[R][2], mw[R][2]; float ss[R], s2[R];
#pragma unroll
        for (int r = 0; r < R; ++r)
#pragma unroll
            for (int j = 0; j < 2; ++j) { xw[r][j] = *(const GAS v4u*)(xb + (size_t)(rb + r) * D + 8 * lane + 512 * j); mw[r][j] = *(const GAS v4u*)(mb + (size_t)(rb + r) * D + 8 * lane + 512 * j); }
#pragma unroll
        for (int r = 0; r < R; ++r) { ss[r] = 0.f;
#pragma unroll
            for (int j = 0; j < 2; ++j) { f32x4 a, b; bf8_to_f32(mw[r][j], a, b); ss[r] += sq4(a) + sq4(b); } }
#pragma unroll
        for (int o = 1; o < 64; o <<= 1) {
#pragma unroll
            for (int r = 0; r < R; ++r) ss[r] += __shfl_xor(ss[r], o); }
#pragma unroll
        for (int r = 0; r < R; ++r) { const float rm = __builtin_amdgcn_rsqf(ss[r] * (1.f / D) + NORM_EPS); s2[r] = 0.f;
#pragma unroll
            for (int j = 0; j < 2; ++j) { f32x4 xa, xb2, ma, mb2; bf8_to_f32(xw[r][j], xa, xb2); bf8_to_f32(mw[r][j], ma, mb2);
                const f32x4 g0 = *(const f32x4*)(gpost + 8 * lane + 512 * j), g1 = *(const f32x4*)(gpost + 8 * lane + 512 * j + 4);
                xa = xa + ma * g0 * rm; xb2 = xb2 + mb2 * g1 * rm;
                if (MODE == 2) { *(GAS f32x4*)(out + (size_t)(rb + r) * D + 8 * lane + 512 * j) = xa; *(GAS f32x4*)(out + (size_t)(rb + r) * D + 8 * lane + 512 * j + 4) = xb2; }
                else { s2[r] += sq4(xa) + sq4(xb2);
                    v4u w; w.x = pk2(xa.x, xa.y); w.y = pk2(xa.z, xa.w); w.z = pk2(xb2.x, xb2.y); w.w = pk2(xb2.z, xb2.w);
                    *(GAS v4u*)(xb + (size_t)(rb + r) * D + 8 * lane + 512 * j) = w; } } }
        if (MODE != 2) {
#pragma unroll
            for (int o = 1; o < 64; o <<= 1) {
#pragma unroll
                for (int r = 0; r < R; ++r) s2[r] += __shfl_xor(s2[r], o); }
            if (lane < R) { float v = s2[0];
#pragma unroll
                for (int r = 1; r < R; ++r) v = lane == r ? s2[r] : v;
                rs[rb + lane] = __builtin_amdgcn_rsqf(v * (1.f / D) + NORM_EPS); }
        }
    }
}
template <int MODE>
__device__ __forceinline__ void thin_pass(const float* xp, const float* xs, bf16* xb, const bf16* mb, const float* gpost, float* rs, float* out, int gw, int NGW, int lane) {
    thin_rows<MODE>(xp, xs, xb, mb, gpost, rs, out, gw * 4, M, NGW * 4, lane);
}

namespace pg8 {
#define PG8_LAS __attribute__((address_space(3)))
typedef unsigned short bf16_t;
typedef short bf16x8 __attribute__((ext_vector_type(8)));
typedef float f32x4 __attribute__((ext_vector_type(4)));
typedef unsigned u32x4 __attribute__((ext_vector_type(4)));
constexpr int BM = 256, BK = 64, HALF = 128, HTB = HALF * BK * 2  , STAGE_BYTES = 8 * HTB, NXCD = 8, WGM = 8;

__host__ __device__ __forceinline__ int lds_byte(int r, int c) { const int st = (r >> 4) * 2 + (c >> 5), rr = r & 15, cc = c & 31, ob = rr * 64 + cc * 2; return st * 1024 + (ob ^ (((ob >> 9) & 1) << 5)); }
__host__ __device__ __forceinline__ void stage_rc(int b, int& R, int& C) { const int st = b / 1024, sb = b % 1024, swz = sb ^ (((sb >> 9) & 1) << 5); R = (st >> 1) * 16 + swz / 64; C = (st & 1) * 32 + (swz % 64) / 2; }
__host__ __device__ __forceinline__ int perm32(int rho) { const int n = rho >> 4, i = rho & 15; return 8 * (i >> 2) + 4 * n + (i & 3); }

struct Unit { int pm, pn; };
struct Gemm { const bf16_t* A; const bf16_t* Bt; int M, N, K; size_t tstepA; };

struct StaticOrder {
    int nM, nN, nwg, G, c;
    __host__ __device__ void init(int M, int N, int G_, int c_) { nM = M / BM; nN = N / BM; nwg = nM * nN; G = G_; c = c_; }
    __host__ __device__ void init_tiles(int nM_, int nN_, int G_, int c_) { nM = nM_; nN = nN_; nwg = nM * nN; G = G_; c = c_; }
    __host__ __device__ bool next(int i, Unit& u) const {
        const long L = (long)i * G + c; if (L >= nwg) return false;
        int wgid = (int)L; { const int q = nwg / NXCD, r = nwg % NXCD, xcd = wgid % NXCD, off = wgid / NXCD; wgid = (xcd < r ? xcd * (q + 1) : r * (q + 1) + (xcd - r) * q) + off; }
        const int nig = WGM * nN, gid = wgid / nig, fm = gid * WGM, gsz = (nM - fm) < WGM ? (nM - fm) : WGM;
        u.pm = fm + ((wgid % nig) % gsz); u.pn = (wgid % nig) / gsz; return true;
    }
    __device__ __forceinline__ void a_ready(const Unit&) const {}
    __device__ __forceinline__ void done(const Unit&) const {}
};

__device__ __forceinline__ unsigned cvt_pk_bf16(float lo, float hi) { unsigned r; asm volatile("v_cvt_pk_bf16_f32 %0, %1, %2" : "=v"(r) : "v"(lo), "v"(hi)); return r; }
typedef float f32x2 __attribute__((ext_vector_type(2)));
__device__ __forceinline__ f32x2 gelu_pk(f32x2 v) {
    const f32x2 av = __builtin_elementwise_abs(v), d = av * 0.2316418882f + 1.0f;
    f32x2 t; t.x = __builtin_amdgcn_rcpf(d.x); t.y = __builtin_amdgcn_rcpf(d.y);
    f32x2 q = t * 0.5307027145f + (-0.7265760135f); q = q * t + 0.7107068705f; q = q * t + (-0.142248368f); q = q * t + 0.127414796f; q = q * t;
    const f32x2 s = (v * v) * (-0.72134752044f);
    f32x2 e; e.x = __builtin_amdgcn_exp2f(s.x); e.y = __builtin_amdgcn_exp2f(s.y);
    const f32x2 m = v * (q * e), r = v - m;
    f32x2 o; o.x = v.x < 0.f ? m.x : r.x; o.y = v.y < 0.f ? m.y : r.y; return o;
}

template <int ACT  > struct EpiBf16 {
    static constexpr bool PERM = true, AFTER_DRAIN = false, HAS_FLUSH = false; static_assert(ACT == 0 || ACT == 1, "EpiBf16: ACT is 0 (none) or 1 (gelu_pk)");
    bf16_t* O; int ldc; const float* rs; int split_cols; size_t split_stride; float scale0;
    __device__ __forceinline__ void operator()(const f32x4 (&acc)[2][2][4][2], const Unit& u, int wr, int wc, int fr, int fq) const {
        const int row0 = u.pm * BM + wr * 64 + fr; int colt = u.pn * BM; bf16_t* base = O;
        float sc = 1.f; if (split_cols) { const int t = colt / split_cols; base += (size_t)t * split_stride; colt -= t * split_cols; if (t == 0) sc = scale0; }
        const int col0 = colt + wc * 32 + 8 * fq;
#pragma unroll
        for (int ai = 0; ai < 2; ++ai)
#pragma unroll
            for (int m = 0; m < 4; ++m) { bf16_t* rowp = base + (size_t)(row0 + ai * HALF + m * 16) * ldc + col0; const float rsc = rs ? rs[row0 + ai * HALF + m * 16] * sc : sc;
#pragma unroll
                for (int bj = 0; bj < 2; ++bj) { f32x4 v0 = acc[ai][bj][m][0], v1 = acc[ai][bj][m][1];
                    if (ACT == 1) { f32x2 a = gelu_pk((f32x2){v0[0], v0[1]}), b = gelu_pk((f32x2){v0[2], v0[3]}), c = gelu_pk((f32x2){v1[0], v1[1]}), d = gelu_pk((f32x2){v1[2], v1[3]});
                        v0 = (f32x4){a.x, a.y, b.x, b.y}; v1 = (f32x4){c.x, c.y, d.x, d.y}; }
                    v0 = v0 * rsc; v1 = v1 * rsc; u32x4 w; w.x = cvt_pk_bf16(v0[0], v0[1]); w.y = cvt_pk_bf16(v0[2], v0[3]); w.z = cvt_pk_bf16(v1[0], v1[1]); w.w = cvt_pk_bf16(v1[2], v1[3]);
#if defined(EPI_NT_STORE)
                    __builtin_nontemporal_store(w, (u32x4*)(rowp + bj * HALF)); } }
#else
                    *(u32x4*)(rowp + bj * HALF) = w; } }
#endif
    }
};

struct EpiRope {
    static constexpr bool PERM = true, AFTER_DRAIN = false, HAS_FLUSH = false;
    bf16_t* Q; bf16_t* Kk; bf16_t* V; const float* cs; const float* sn; float qscale; const float* rs; unsigned* kmax;
    __device__ __forceinline__ void operator()(const f32x4 (&acc)[2][2][4][2], const Unit& u, int wr, int wc, int fr, int fq) const {
        const int which = u.pn >> 2;
        const int row0 = u.pm * BM + wr * 64 + fr;
        if (which == 2) {
            const int col0 = (u.pn - 8) * BM + wc * 32 + 8 * fq;
#pragma unroll
            for (int ai = 0; ai < 2; ++ai)
#pragma unroll
                for (int m = 0; m < 4; ++m) { bf16_t* rowp = V + (size_t)(row0 + ai * HALF + m * 16) * 1024 + col0; const float r = rs[row0 + ai * HALF + m * 16];
#pragma unroll
                    for (int bj = 0; bj < 2; ++bj) { const f32x4 v0 = acc[ai][bj][m][0] * r, v1 = acc[ai][bj][m][1] * r;
                        u32x4 w; w.x = cvt_pk_bf16(v0[0], v0[1]); w.y = cvt_pk_bf16(v0[2], v0[3]); w.z = cvt_pk_bf16(v1[0], v1[1]); w.w = cvt_pk_bf16(v1[2], v1[3]);
                        *(u32x4*)(rowp + bj * HALF) = w; } }
        } else {
            bf16_t* base = which == 0 ? Q : Kk; const float sc = which == 0 ? qscale : 1.f;
            const int colb = ((u.pn & 3) * 4 + wc) * 64 + 8 * fq; float kn2 = 0.f;
#pragma unroll
            for (int ai = 0; ai < 2; ++ai)
#pragma unroll
                for (int m = 0; m < 4; ++m) { const int row = row0 + ai * HALF + m * 16; const int t = row < 16384 ? (row & 4095) : (row & 8191); const float scr = sc * rs[row];
                    const f32x4 c0 = *(const f32x4*)(cs + t * 32 + 8 * fq), c1 = *(const f32x4*)(cs + t * 32 + 8 * fq + 4);
                    const f32x4 s0 = *(const f32x4*)(sn + t * 32 + 8 * fq), s1 = *(const f32x4*)(sn + t * 32 + 8 * fq + 4);
                    const f32x4 x1a = acc[ai][0][m][0], x1b = acc[ai][0][m][1], x2a = acc[ai][1][m][0], x2b = acc[ai][1][m][1];
                    const f32x4 o1a = (x1a * c0 - x2a * s0) * scr, o1b = (x1b * c1 - x2b * s1) * scr, o2a = (x2a * c0 + x1a * s0) * scr, o2b = (x2b * c1 + x1b * s1) * scr;
                    u32x4 w1, w2; w1.x = cvt_pk_bf16(o1a[0], o1a[1]); w1.y = cvt_pk_bf16(o1a[2], o1a[3]); w1.z = cvt_pk_bf16(o1b[0], o1b[1]); w1.w = cvt_pk_bf16(o1b[2], o1b[3]);
                    w2.x = cvt_pk_bf16(o2a[0], o2a[1]); w2.y = cvt_pk_bf16(o2a[2], o2a[3]); w2.z = cvt_pk_bf16(o2b[0], o2b[1]); w2.w = cvt_pk_bf16(o2b[2], o2b[3]);
                    bf16_t* rowp = base + (size_t)row * 1024 + colb;
                    *(u32x4*)(rowp) = w1; *(u32x4*)(rowp + 32) = w2;
                    if (which == 1) { const f32x4 q4 = o1a * o1a + o1b * o1b + o2a * o2a + o2b * o2b; float ss = (q4[0] + q4[1]) + (q4[2] + q4[3]); ss += __shfl_xor(ss, 16); ss += __shfl_xor(ss, 32); kn2 = fmaxf(kn2, ss); } }
            if (which == 1) { kn2 = fmaxf(kn2, __shfl_xor(kn2, 1)); kn2 = fmaxf(kn2, __shfl_xor(kn2, 2)); kn2 = fmaxf(kn2, __shfl_xor(kn2, 4)); kn2 = fmaxf(kn2, __shfl_xor(kn2, 8));
                const int r0 = u.pm * BM; const int batch = r0 < 16384 ? (r0 >> 12) : 4 + ((r0 - 16384) >> 13);
                if (fr == 0 && fq == 0) atomicMax(kmax + batch * 16 + (u.pn & 3) * 4 + wc, __float_as_uint(kn2)); }
        }
    }
};

template <int CTRL> __device__ __forceinline__ float dpp_f(float old, float src) { return __int_as_float(__builtin_amdgcn_update_dpp(__float_as_int(old), __float_as_int(src), CTRL, 0xf, 0xf, false)); }
__device__ __forceinline__ float gelu_tanh(float x) {
    const float u = 0.7978845608028654f * (x + 0.044715f * x * x * x);
    const float e = __builtin_amdgcn_exp2f(-2.8853900817779268f * u);
    return x * __builtin_amdgcn_rcpf(1.0f + e);
}
struct EpiConvGlu {
    static constexpr bool PERM = true, AFTER_DRAIN = false, HAS_FLUSH = false;
    bf16_t* G; const float* cw; const float* cb; PG8_LAS float* X; int Mrows; const float* rs; PG8_LAS float* WT;
    __device__ __forceinline__ void operator()(f32x4 (&acc)[2][2][4][2], const Unit& u, int wr, int wc, int fr, int fq) const {
        const int xcol = wc * 32 + 8 * fq;
        const int gc0 = u.pn * 128 + xcol;
        float rsv[2][4];
#pragma unroll
        for (int ai = 0; ai < 2; ++ai)
#pragma unroll
            for (int m = 0; m < 4; ++m) { int tr = u.pm * 254 - 1 + ai * HALF + wr * 64 + m * 16 + fr; tr = tr < 0 ? 0 : (tr >= Mrows ? Mrows - 1 : tr); rsv[ai][m] = rs[tr]; }
        { const int tidx = (wr * 4 + wc) * 64 + fq * 16 + fr, e0 = 2 * tidx, t = e0 >> 8, c = e0 & 255;
          const float* src = (t < 3 ? cw + t * 5632 : cb) + (c < 128 ? u.pn * 128 + c : 2816 + u.pn * 128 + c - 128);
          typedef float f32x2v __attribute__((ext_vector_type(2)));
          *(PG8_LAS f32x2v*)(WT + e0) = *(const f32x2v*)src; }
#pragma unroll
        for (int ai = 0; ai < 2; ++ai)
#pragma unroll
            for (int m = 0; m < 4; ++m) {
#pragma unroll
                for (int bj = 0; bj < 2; ++bj)
#pragma unroll
                    for (int n = 0; n < 2; ++n) acc[ai][bj][m][n] = acc[ai][bj][m][n] * rsv[ai][m]; }
#pragma unroll
        for (int ai = 0; ai < 2; ++ai) { const int ch = 2 * ai + wr;
            if (fr == 0) {
#pragma unroll
                for (int bj = 0; bj < 2; ++bj)
#pragma unroll
                    for (int n = 0; n < 2; ++n) *(PG8_LAS f32x4*)(X + ((ch * 2 + 0) * 256 + bj * 128 + xcol + 4 * n)) = acc[ai][bj][0][n]; }
            if (fr == 15) {
#pragma unroll
                for (int bj = 0; bj < 2; ++bj)
#pragma unroll
                    for (int n = 0; n < 2; ++n) *(PG8_LAS f32x4*)(X + ((ch * 2 + 1) * 256 + bj * 128 + xcol + 4 * n)) = acc[ai][bj][3][n]; } }
        asm volatile("s_waitcnt lgkmcnt(0)" ::: "memory"); __builtin_amdgcn_s_barrier(); asm volatile("" ::: "memory");
        const int tg0 = u.pm * 254 - 1 + wr * 64 + fr;
        const int tb = u.pm * 254 - 1; const bool bnd = ((tb + 4096 + 257) >> 12) != ((tb + 4096 - 1) >> 12);
        if (bnd) body<true>(acc, u, wr, wc, fr, fq, xcol, gc0, tg0); else body<false>(acc, u, wr, wc, fr, fq, xcol, gc0, tg0);
    }
    template <bool bnd>
    __device__ __forceinline__ void body(f32x4 (&acc)[2][2][4][2], const Unit& u, int wr, int wc, int fr, int fq, int xcol, int gc0, int tg0) const {
#pragma unroll
        for (int ai = 0; ai < 2; ++ai) { const int ch = 2 * ai + wr;
#pragma unroll
            for (int m = 0; m < 4; ++m) {
                const int row = ai * HALF + wr * 64 + m * 16 + fr; const int tg = tg0 + ai * HALF + m * 16;
                const int ps = tg < 16384 ? (tg & 4095) : (tg & 8191); const int ps1 = (tg + 1) < 16384 ? ((tg + 1) & 4095) : ((tg + 1) & 8191);
                const bool first = bnd && ps == 0, last = bnd && ps1 == 0;
                u32x4 w;
#pragma unroll
                for (int n = 0; n < 2; ++n) {
                    f32x4 wgv[3], wuv[3];
#pragma unroll
                    for (int t = 0; t < 3; ++t) { wgv[t] = *(const PG8_LAS f32x4*)(WT + t * 256 + xcol + 4 * n); wuv[t] = *(const PG8_LAS f32x4*)(WT + t * 256 + 128 + xcol + 4 * n); }
                    const f32x4 bgv = *(const PG8_LAS f32x4*)(WT + 768 + xcol + 4 * n), buv = *(const PG8_LAS f32x4*)(WT + 768 + 128 + xcol + 4 * n);
                    f32x4 pg = (f32x4){0.f, 0.f, 0.f, 0.f}, pu = pg, ng = pg, nu = pg;
                    if (m == 0 && ch > 0) { pg = *(const PG8_LAS f32x4*)(X + (((ch - 1) * 2 + 1) * 256 + xcol + 4 * n)); pu = *(const PG8_LAS f32x4*)(X + (((ch - 1) * 2 + 1) * 256 + 128 + xcol + 4 * n)); }
                    if (m == 3 && ch < 3) { ng = *(const PG8_LAS f32x4*)(X + (((ch + 1) * 2 + 0) * 256 + xcol + 4 * n)); nu = *(const PG8_LAS f32x4*)(X + (((ch + 1) * 2 + 0) * 256 + 128 + xcol + 4 * n)); }
                    float o[4];
#pragma unroll
                    for (int j = 0; j < 4; ++j) {
                        const float cg = acc[ai][0][m][n][j], cu = acc[ai][1][m][n][j];
                        float p0g, p0u, n15g, n15u;
                        if (m > 0) { p0g = dpp_f<0x121>(0.f, acc[ai][0][m > 0 ? m - 1 : 0][n][j]); p0u = dpp_f<0x121>(0.f, acc[ai][1][m > 0 ? m - 1 : 0][n][j]); } else { p0g = pg[j]; p0u = pu[j]; }
                        if (m < 3) { n15g = dpp_f<0x12F>(0.f, acc[ai][0][m < 3 ? m + 1 : 3][n][j]); n15u = dpp_f<0x12F>(0.f, acc[ai][1][m < 3 ? m + 1 : 3][n][j]); } else { n15g = ng[j]; n15u = nu[j]; }
                        float prg = dpp_f<0x111>(p0g, cg), pru = dpp_f<0x111>(p0u, cu);
                        float nxg = dpp_f<0x101>(n15g, cg), nxu = dpp_f<0x101>(n15u, cu);
                        if (first) { prg = 0.f; pru = 0.f; }
                        if (last) { nxg = 0.f; nxu = 0.f; }
                        const float yg = wgv[0][j] * prg + (wgv[1][j] * cg + (wgv[2][j] * nxg + bgv[j]));
                        const float yu = wuv[0][j] * pru + (wuv[1][j] * cu + (wuv[2][j] * nxu + buv[j]));
                        o[j] = gelu_tanh(yg) * yu;
                    }
                    if (n == 0) { w.x = cvt_pk_bf16(o[0], o[1]); w.y = cvt_pk_bf16(o[2], o[3]); } else { w.z = cvt_pk_bf16(o[0], o[1]); w.w = cvt_pk_bf16(o[2], o[3]); }
                }
                if (row >= 1 && row <= 254 && tg < Mrows) *(u32x4*)(G + (size_t)tg * 2816 + gc0) = w;
            }
        }
    }
};

template <int MODE>
struct EpiThin {
    static constexpr bool PERM = true, AFTER_DRAIN = false, HAS_FLUSH = true;
    bf16_t* mb; bf16_t* xb; const float* g; float* rs; float* out; unsigned* cnt; PG8_LAS unsigned* flag; int ntn;
    __device__ __forceinline__ void publish(int wid, int lane) const {
        asm volatile("s_waitcnt vmcnt(0)" ::: "memory"); __builtin_amdgcn_s_barrier(); asm volatile("" ::: "memory");
        const int ppm = (int)flag[1] - 1;
        if (ppm >= 0) {
            if (wid == 0 && lane == 0) { const unsigned old = __hip_atomic_fetch_add(cnt + 64 * ppm, 1u, __ATOMIC_RELAXED, __HIP_MEMORY_SCOPE_AGENT); flag[0] = (old == (unsigned)(ntn - 1)) ? 1u : 0u; }
            asm volatile("s_waitcnt vmcnt(0) lgkmcnt(0)" ::: "memory"); __builtin_amdgcn_s_barrier(); asm volatile("" ::: "memory");
            if (flag[0] != 0u) {
                if (wid == 0) { __builtin_amdgcn_fence(__ATOMIC_ACQUIRE, "agent"); asm volatile("s_waitcnt vmcnt(0)" ::: "memory"); }
                asm volatile("s_waitcnt lgkmcnt(0)" ::: "memory"); __builtin_amdgcn_s_barrier(); asm volatile("" ::: "memory");
                thin_rows_lean<MODE, 4>(xb, mb, g, rs, out, ppm * BM + wid * 32, ppm * BM + wid * 32 + 32, lane);
            }
        }
    }
    __device__ __forceinline__ void operator()(const f32x4 (&acc)[2][2][4][2], const Unit& u, int wr, int wc, int fr, int fq) const {
        const int wid = wr * 4 + wc, lane = fq * 16 + fr;
        u32x4 w[2][4][2];
#pragma unroll
        for (int ai = 0; ai < 2; ++ai)
#pragma unroll
            for (int m = 0; m < 4; ++m)
#pragma unroll
                for (int bj = 0; bj < 2; ++bj) { const f32x4 v0 = acc[ai][bj][m][0], v1 = acc[ai][bj][m][1];
                    w[ai][m][bj].x = cvt_pk_bf16(v0[0], v0[1]); w[ai][m][bj].y = cvt_pk_bf16(v0[2], v0[3]); w[ai][m][bj].z = cvt_pk_bf16(v1[0], v1[1]); w[ai][m][bj].w = cvt_pk_bf16(v1[2], v1[3]); }
        publish(wid, lane);
        asm volatile("s_waitcnt lgkmcnt(0)" ::: "memory"); __builtin_amdgcn_s_barrier(); asm volatile("" ::: "memory");
        if (wid == 0 && lane == 0) flag[1] = (unsigned)(u.pm + 1);
        const __amdgpu_buffer_rsrc_t rsrc = __builtin_amdgcn_make_buffer_rsrc((void*)mb, 0, M * 1024 * 2, 0x00020000);
        const int row0 = u.pm * BM + wr * 64 + fr, col0 = u.pn * BM + wc * 32 + 8 * fq;
#pragma unroll
        for (int ai = 0; ai < 2; ++ai)
#pragma unroll
            for (int m = 0; m < 4; ++m)
#pragma unroll
                for (int bj = 0; bj < 2; ++bj) __builtin_amdgcn_raw_buffer_store_b128(w[ai][m][bj], rsrc, ((row0 + ai * HALF + m * 16) * 1024 + col0 + bj * HALF) * 2, 0, 16);
    }
    __device__ __forceinline__ void flush(const Unit&, int wr, int wc, int fr, int fq) const {
        const int wid = wr * 4 + wc, lane = fq * 16 + fr;
        publish(wid, lane);
        asm volatile("s_waitcnt lgkmcnt(0)" ::: "memory"); __builtin_amdgcn_s_barrier(); asm volatile("" ::: "memory");
        if (wid == 0 && lane == 0) flag[1] = 0u;
        asm volatile("s_waitcnt lgkmcnt(0)" ::: "memory"); __builtin_amdgcn_s_barrier(); asm volatile("" ::: "memory");
    }
};

struct EpiNull {
    static constexpr bool PERM = true, AFTER_DRAIN = false, HAS_FLUSH = false;
    float* sink;
    __device__ __forceinline__ void operator()(const f32x4 (&acc)[2][2][4][2], const Unit& u, int wr, int wc, int fr, int fq) const {
        float s = 0.f;
#pragma unroll
        for (int ai = 0; ai < 2; ++ai)
#pragma unroll
            for (int bj = 0; bj < 2; ++bj)
#pragma unroll
                for (int m = 0; m < 4; ++m)
#pragma unroll
                    for (int n = 0; n < 2; ++n) s += acc[ai][bj][m][n][0] + acc[ai][bj][m][n][1] + acc[ai][bj][m][n][2] + acc[ai][bj][m][n][3];
        if (s == 123456.789f) sink[0] = s;
    }
};
template <class Epi, class Sched, bool ALIGN_EPI = false, bool SP2 = false>
__device__ __forceinline__ void gemm_phase(PG8_LAS unsigned char* lds, const Gemm g, const Sched& S, const Epi& E, unsigned* tpw = nullptr) {
    const int tid = threadIdx.x, wid = __builtin_amdgcn_readfirstlane(tid >> 6), lane = tid & 63, wr = wid >> 2, wc = wid & 3, fr = lane & 15, fq = lane >> 4;
    const int K = g.K, nt = K / BK;
    unsigned voffA[2], voffB[2];
#pragma unroll
    for (int i = 0; i < 2; ++i) { int R, C; stage_rc(tid * 16 + i * 8192, R, C); const int Rb = Epi::PERM ? ((R & ~31) + perm32(R & 31)) : R;
        voffA[i] = (unsigned)(R * K + C) * 2u; voffB[i] = (unsigned)(Rb * K + C) * 2u; }
    const size_t kstep = (size_t)(BK * 2);
    const size_t hstep = (size_t)HALF * K * 2;
    const size_t tstep = 2 * hstep;
    const unsigned ldsw = (unsigned)wid * 1024u;
    const int aoff = lds_byte(wr * 64 + fr, fq * 8), boff = lds_byte(wc * 32 + fr, fq * 8);
#define PG8_SA(b, h) (((b) * 2 + (h)) * HTB)
#define PG8_SB(b, h) ((4 + (b) * 2 + (h)) * HTB)
#define PG8_STAGE(bufoff, gbase, voff) do { _Pragma("unroll") for (int _i = 0; _i < 2; ++_i) \
        __builtin_amdgcn_global_load_lds((const unsigned*)((const char*)(gbase) + (voff)[_i]), (PG8_LAS unsigned*)(lds + (bufoff) + ldsw + _i * 8192), 16, 0, 0); } while (0)
#define PG8_LDA(dst, b, h) do { _Pragma("unroll") for (int m = 0; m < 4; ++m) _Pragma("unroll") for (int k = 0; k < 2; ++k) dst[m][k] = *(const PG8_LAS bf16x8*)(lds + PG8_SA(b, h) + aoff + m * 2048 + k * 1024); } while (0)
#define PG8_LDB(dst, b, h) do { _Pragma("unroll") for (int n = 0; n < 2; ++n) _Pragma("unroll") for (int k = 0; k < 2; ++k) dst[n][k] = *(const PG8_LAS bf16x8*)(lds + PG8_SB(b, h) + boff + n * 2048 + k * 1024); } while (0)
#define PG8_MMA(ai, bj, At, Bt) do { __builtin_amdgcn_s_setprio(1); _Pragma("unroll") for (int m = 0; m < 4; ++m) _Pragma("unroll") for (int n = 0; n < 2; ++n) _Pragma("unroll") for (int k = 0; k < 2; ++k) \
        acc[ai][bj][m][n] = __builtin_amdgcn_mfma_f32_16x16x32_bf16(Bt[n][k], At[m][k], acc[ai][bj][m][n], 0, 0, 0); __builtin_amdgcn_s_setprio(0); } while (0)
#define PG8_WAIT_V(n) asm volatile("s_waitcnt vmcnt(" #n ")" ::: "memory")
#define PG8_WAIT_L(n) asm volatile("s_waitcnt lgkmcnt(" #n ")" ::: "memory")
#define PG8_BAR __builtin_amdgcn_s_barrier()
#define PG8_SCHED __builtin_amdgcn_sched_barrier(0)
    Unit cur, nxt; int ui = 0;
    if (!S.next(0, cur)) return;
#if defined(GPROBE)
    unsigned long long gp_acc = 0, gp_t = 0; const bool gp_on = tpw != nullptr && blockIdx.x == 0 && wid == 0;
#define GP_MARK() do { if (gp_on) gp_t = __builtin_amdgcn_s_memrealtime(); } while (0)
#define GP_ADD() do { if (gp_on) gp_acc += __builtin_amdgcn_s_memrealtime() - gp_t; } while (0)
#else
#define GP_MARK() do {} while (0)
#define GP_ADD() do {} while (0)
#endif
#if defined(GEMM_STAGGER_TICKS)
    { const unsigned long long t0_ = __builtin_amdgcn_s_memrealtime(); const unsigned long long dly_ = (unsigned long long)((blockIdx.x >> 3) & 3) * GEMM_STAGGER_TICKS;
      while (__builtin_amdgcn_s_memrealtime() - t0_ < dly_) __builtin_amdgcn_s_sleep(8); }
#endif
    f32x4 acc[2][2][4][2];
#pragma unroll
    for (int a = 0; a < 2; ++a)
#pragma unroll
        for (int b = 0; b < 2; ++b)
#pragma unroll
            for (int m = 0; m < 4; ++m)
#pragma unroll
                for (int n = 0; n < 2; ++n) acc[a][b][m][n] = (f32x4){0.f, 0.f, 0.f, 0.f};
    bf16x8 At[4][2], B0[2][2], B1[2][2];
    const char* cA = (const char*)g.A + (size_t)cur.pm * g.tstepA; const char* cB = (const char*)g.Bt + (size_t)cur.pn * tstep;
    S.a_ready(cur);
    if constexpr (SP2) {
        PG8_STAGE(PG8_SB(0, 0), cB, voffB); PG8_STAGE(PG8_SB(0, 1), cB + hstep, voffB); PG8_STAGE(PG8_SA(0, 0), cA, voffA); PG8_STAGE(PG8_SA(0, 1), cA + hstep, voffA);
        if (wr == 1) PG8_BAR;
        PG8_WAIT_V(2); PG8_BAR;
        PG8_STAGE(PG8_SB(1, 0), cB + kstep, voffB); PG8_STAGE(PG8_SA(1, 0), cA + kstep, voffA); PG8_STAGE(PG8_SB(1, 1), cB + hstep + kstep, voffB);
        PG8_WAIT_V(6); PG8_BAR;
    } else {
        PG8_STAGE(PG8_SB(0, 0), cB, voffB); PG8_STAGE(PG8_SA(0, 0), cA, voffA); PG8_STAGE(PG8_SB(0, 1), cB + hstep, voffB); PG8_STAGE(PG8_SA(0, 1), cA + hstep, voffA);
        if (wr == 1) PG8_BAR;
        PG8_WAIT_V(4); PG8_BAR;
        PG8_STAGE(PG8_SB(1, 0), cB + kstep, voffB); PG8_STAGE(PG8_SA(1, 0), cA + kstep, voffA); PG8_STAGE(PG8_SB(1, 1), cB + hstep + kstep, voffB);
        PG8_WAIT_V(6); PG8_BAR;
    }
    for (;;) {
        const bool has_next = S.next(ui + 1, nxt);
        const char* nA = has_next ? (const char*)g.A + (size_t)nxt.pm * g.tstepA : cA; const char* nB = has_next ? (const char*)g.Bt + (size_t)nxt.pn * tstep : cB;
        for (int t = 0; t < nt; t += 2) {
            const bool last = (t == nt - 2);
#if defined(GPROBE) && GPROBE == 2
            if (t == 0) GP_MARK(); if (t == 4) GP_ADD();
#elif defined(GPROBE) && GPROBE == 3
            if (t == 4) GP_MARK(); if (t == 6) GP_ADD();
#elif defined(GPROBE) && GPROBE == 4
            if (t == nt - 2) GP_MARK();
#endif
            const char* a1 = cA + (size_t)(t + 1) * kstep;
            const char* a2 = last ? nA : cA + (size_t)(t + 2) * kstep; const char* b2 = last ? nB : cB + (size_t)(t + 2) * kstep;
            const char* a3 = a2 + kstep; const char* b3 = b2 + kstep;
            if (last && has_next) S.a_ready(nxt);
            if constexpr (SP2) {
            PG8_LDB(B0, 0, 0); PG8_LDB(B1, 0, 1); PG8_SCHED; PG8_LDA(At, 0, 0); PG8_STAGE(PG8_SA(1, 1), a1 + hstep, voffA);
            PG8_WAIT_V(8); PG8_WAIT_L(0); PG8_BAR; PG8_MMA(0, 0, At, B0); PG8_MMA(0, 1, At, B1); PG8_BAR; PG8_SCHED;
            PG8_LDA(At, 0, 1); PG8_STAGE(PG8_SB(0, 0), b2, voffB); PG8_STAGE(PG8_SB(0, 1), b2 + hstep, voffB); PG8_STAGE(PG8_SA(0, 0), a2, voffA);
            PG8_WAIT_V(8); PG8_WAIT_L(0); PG8_BAR; PG8_MMA(1, 0, At, B0); PG8_MMA(1, 1, At, B1); PG8_BAR; PG8_SCHED;
            PG8_LDB(B0, 1, 0); PG8_LDB(B1, 1, 1); PG8_SCHED; PG8_LDA(At, 1, 0); PG8_STAGE(PG8_SA(0, 1), a2 + hstep, voffA);
            PG8_WAIT_V(8); PG8_WAIT_L(0); PG8_BAR; PG8_MMA(0, 0, At, B0); PG8_MMA(0, 1, At, B1); PG8_BAR; PG8_SCHED;
            PG8_LDA(At, 1, 1); PG8_STAGE(PG8_SB(1, 0), b3, voffB); PG8_STAGE(PG8_SB(1, 1), b3 + hstep, voffB); PG8_STAGE(PG8_SA(1, 0), a3, voffA);
            PG8_WAIT_V(8); PG8_WAIT_L(0); PG8_BAR; PG8_MMA(1, 0, At, B0); PG8_MMA(1, 1, At, B1); PG8_BAR; PG8_SCHED;
            } else {
            PG8_LDB(B0, 0, 0); PG8_SCHED; PG8_LDA(At, 0, 0); PG8_STAGE(PG8_SA(1, 1), a1 + hstep, voffA);
            PG8_WAIT_L(8); PG8_BAR; PG8_WAIT_L(0); PG8_MMA(0, 0, At, B0); PG8_BAR; PG8_SCHED;
            PG8_LDB(B1, 0, 1); PG8_STAGE(PG8_SB(0, 0), b2, voffB);
            PG8_BAR; PG8_WAIT_L(0); PG8_MMA(0, 1, At, B1); PG8_BAR;
            PG8_LDA(At, 0, 1); PG8_STAGE(PG8_SA(0, 0), a2, voffA);
            PG8_BAR; PG8_WAIT_L(0); PG8_MMA(1, 0, At, B0); PG8_BAR; PG8_SCHED;
            PG8_STAGE(PG8_SB(0, 1), b2 + hstep, voffB);
            PG8_WAIT_V(6); PG8_BAR; PG8_MMA(1, 1, At, B1); PG8_BAR;
            PG8_LDB(B0, 1, 0); PG8_SCHED; PG8_LDA(At, 1, 0); PG8_STAGE(PG8_SA(0, 1), a2 + hstep, voffA);
            PG8_WAIT_L(8); PG8_BAR; PG8_WAIT_L(0); PG8_MMA(0, 0, At, B0); PG8_BAR; PG8_SCHED;
            PG8_LDB(B1, 1, 1); PG8_STAGE(PG8_SB(1, 0), b3, voffB);
            PG8_BAR; PG8_WAIT_L(0); PG8_MMA(0, 1, At, B1); PG8_BAR;
            PG8_LDA(At, 1, 1); PG8_STAGE(PG8_SA(1, 0), a3, voffA);
            PG8_BAR; PG8_WAIT_L(0); PG8_MMA(1, 0, At, B0); PG8_BAR; PG8_SCHED;
            PG8_STAGE(PG8_SB(1, 1), b3 + hstep, voffB);
            PG8_WAIT_V(6); PG8_BAR; PG8_MMA(1, 1, At, B1); PG8_BAR;
            }
        }
#if defined(GPROBE) && GPROBE == 4
        GP_ADD();
#endif
        if constexpr (ALIGN_EPI) { if (wr == 0) PG8_BAR; }
#if defined(GPROBE) && GPROBE == 1
        GP_MARK();
#elif defined(GPROBE) && GPROBE == 6
        if (ui > 0) GP_ADD();
#endif
        if constexpr (!Epi::AFTER_DRAIN) { E(acc, cur, wr, wc, fr, fq); S.done(cur); }
#if defined(GPROBE) && GPROBE == 1
        GP_ADD();
#elif defined(GPROBE) && GPROBE == 6
        GP_MARK();
#endif
        if (!has_next) break;
#pragma unroll
        for (int a = 0; a < 2; ++a)
#pragma unroll
            for (int b = 0; b < 2; ++b)
#pragma unroll
                for (int m = 0; m < 4; ++m)
#pragma unroll
                    for (int n = 0; n < 2; ++n) acc[a][b][m][n] = (f32x4){0.f, 0.f, 0.f, 0.f};
        cur = nxt; cA = nA; cB = nB; ++ui;
        if constexpr (ALIGN_EPI) { if (wr == 1) PG8_BAR; }
    }
#if defined(GPROBE)
    if (gp_on && (threadIdx.x & 63) == 0) tpw[0] = (unsigned)gp_acc;
#endif
    PG8_WAIT_V(0);
    if constexpr (!ALIGN_EPI) { if (wr == 0) PG8_BAR; }
    PG8_BAR;
    if constexpr (Epi::AFTER_DRAIN) { E.fused(acc, cur, wr, wc, fr, fq, lds, wid, lane); S.done(cur); }
    if constexpr (Epi::HAS_FLUSH) E.flush(cur, wr, wc, fr, fq);
#undef PG8_SA
#undef PG8_SB
#undef PG8_STAGE
#undef PG8_LDA
#undef PG8_LDB
#undef PG8_MMA
#undef PG8_WAIT_V
#undef PG8_WAIT_L
#undef PG8_BAR
#undef PG8_SCHED
}
}

namespace att {
#define ATT_LAS __attribute__((address_space(3)))
typedef unsigned short bf16_t;
using bf16x8 = __attribute__((ext_vector_type(8))) short;
using s16x4  = __attribute__((ext_vector_type(4))) short;
using f32x16 = __attribute__((ext_vector_type(16))) float;
using f32x4  = __attribute__((ext_vector_type(4))) float;
using u32x4  = __attribute__((ext_vector_type(4))) unsigned;
typedef ATT_LAS char* lptr;
#define SBAR() __builtin_amdgcn_sched_barrier(0)
constexpr int PITCH = 1024;
constexpr float QSCALE = 0.125f * 1.4426950408889634f;
constexpr float THRL = 8.0f * 1.4426950408889634f;
__device__ __forceinline__ int crow(int r, int hi) { return (r & 3) + 8 * (r >> 2) + 4 * hi; }
__device__ __forceinline__ unsigned cvtpk(float lo, float hi) { unsigned r; asm volatile("v_cvt_pk_bf16_f32 %0, %1, %2" : "=v"(r) : "v"(lo), "v"(hi)); return r; }
__device__ __forceinline__ int koff(int row, int c) { return c * 1024 + ((row ^ c) << 4); }
__device__ __forceinline__ int v_st(int k, int c) { const int kk = (k & ~0xC) | ((k & 4) << 1) | ((k & 8) >> 1); return ((kk >> 3) * 4 + (c >> 5)) * 512 + ((kk & 7) * 32 + (c & 31)) * 2; }
__device__ __forceinline__ int v_rd_base(int lane) { return ((lane & 3) << 3) | (((lane >> 2) & 3) << 6) | (((lane >> 4) & 1) << 5) | (((lane >> 5) & 1) << 8); }
constexpr int v_rd_off(int d0, int ks, int half) { return d0 * 512 + ks * 4096 + half * 2048; }
template <int OFF> __device__ __forceinline__ s16x4 tr_read(int vb) { s16x4 r; asm volatile("ds_read_b64_tr_b16 %0, %1 offset:%2" : "=&v"(r) : "v"(vb), "i"(OFF) : "memory"); return r; }
template <int D0> __device__ __forceinline__ void pv_one(f32x16& od, int vb, bf16x8 pa0, bf16x8 pa1, bf16x8 pa2, bf16x8 pa3) {
  const s16x4 l0 = tr_read<v_rd_off(D0, 0, 0)>(vb), h0 = tr_read<v_rd_off(D0, 0, 1)>(vb), l1 = tr_read<v_rd_off(D0, 1, 0)>(vb), h1 = tr_read<v_rd_off(D0, 1, 1)>(vb);
  const s16x4 l2 = tr_read<v_rd_off(D0, 2, 0)>(vb), h2 = tr_read<v_rd_off(D0, 2, 1)>(vb), l3 = tr_read<v_rd_off(D0, 3, 0)>(vb), h3 = tr_read<v_rd_off(D0, 3, 1)>(vb);
  asm volatile("s_waitcnt lgkmcnt(0)" ::: "memory"); SBAR();
#define PK(L, H) (bf16x8){L[0], L[1], L[2], L[3], H[0], H[1], H[2], H[3]}
  od = __builtin_amdgcn_mfma_f32_32x32x16_bf16(pa0, PK(l0, h0), od, 0, 0, 0);
  od = __builtin_amdgcn_mfma_f32_32x32x16_bf16(pa1, PK(l1, h1), od, 0, 0, 0);
  od = __builtin_amdgcn_mfma_f32_32x32x16_bf16(pa2, PK(l2, h2), od, 0, 0, 0);
  od = __builtin_amdgcn_mfma_f32_32x32x16_bf16(pa3, PK(l3, h3), od, 0, 0, 0);
#undef PK
}
__device__ __forceinline__ void qkt(f32x16& p0, f32x16& p1, lptr Ks, const bf16x8* qr, int r32, int hi) {
  p0 = f32x16{}; p1 = f32x16{};
#pragma unroll
  for (int d0 = 0; d0 < 4; ++d0) { const int c = 2 * d0 + hi;
    const bf16x8 b0 = *(const ATT_LAS bf16x8*)(Ks + koff(r32, c));
    const bf16x8 b1 = *(const ATT_LAS bf16x8*)(Ks + koff(32 + r32, c));
    p0 = __builtin_amdgcn_mfma_f32_32x32x16_bf16(b0, qr[d0], p0, 0, 0, 0);
    p1 = __builtin_amdgcn_mfma_f32_32x32x16_bf16(b1, qr[d0], p1, 0, 0, 0); }
}
__device__ __forceinline__ float rowmax32(const f32x16& p0, const f32x16& p1) {
  float pmax = p0[0];
#pragma unroll
  for (int r = 1; r < 16; ++r) pmax = fmaxf(pmax, p0[r]);
#pragma unroll
  for (int r = 0; r < 16; ++r) pmax = fmaxf(pmax, p1[r]);
  auto rr = __builtin_amdgcn_permlane32_swap(__float_as_uint(pmax), __float_as_uint(pmax), false, false);
  return fmaxf(__uint_as_float(rr[0]), __uint_as_float(rr[1]));
}
__device__ __forceinline__ void partialSM(f32x16& p0, f32x16& p1, float& m_reg, float& mn, float& alpha) {
  const float pmax = rowmax32(p0, p1);
  if (__builtin_expect(__all(pmax - m_reg <= THRL), 1)) { mn = m_reg; alpha = 1.f; }
  else { mn = fmaxf(m_reg, pmax); alpha = __builtin_amdgcn_exp2f(m_reg - mn); m_reg = mn; }
#pragma unroll
  for (int r = 0; r < 16; ++r) p0[r] = p0[r] - mn;
#pragma unroll
  for (int r = 0; r < 16; ++r) p1[r] = p1[r] - mn;
#pragma unroll
  for (int r = 0; r < 16; ++r) p0[r] = __builtin_amdgcn_exp2f(p0[r]);
}
__device__ __forceinline__ void finishSM(f32x16& p0, f32x16& p1, float alpha, float& l_reg, bf16x8& pa0, bf16x8& pa1, bf16x8& pa2, bf16x8& pa3) {
#pragma unroll
  for (int r = 0; r < 16; ++r) p1[r] = __builtin_amdgcn_exp2f(p1[r]);
  float ps = 0;
#pragma unroll
  for (int r = 0; r < 16; ++r) ps += p0[r];
#pragma unroll
  for (int r = 0; r < 16; ++r) ps += p1[r];
  { auto rr = __builtin_amdgcn_permlane32_swap(__float_as_uint(ps), __float_as_uint(ps), false, false); ps = __uint_as_float(rr[0]) + __uint_as_float(rr[1]); }
  l_reg = l_reg * alpha + ps;
#define PK4(P, BASE, OUT) do { unsigned a0 = cvtpk(P[BASE + 0], P[BASE + 1]), a1 = cvtpk(P[BASE + 2], P[BASE + 3]);   \
    unsigned b0 = cvtpk(P[BASE + 4], P[BASE + 5]), b1 = cvtpk(P[BASE + 6], P[BASE + 7]);                              \
    auto r0 = __builtin_amdgcn_permlane32_swap(a0, b0, false, false); auto r1 = __builtin_amdgcn_permlane32_swap(a1, b1, false, false); \
    u32x4 w = {r0[0], r1[0], r0[1], r1[1]}; OUT = __builtin_bit_cast(bf16x8, w); } while (0)
  PK4(p0, 0, pa0); PK4(p0, 8, pa1); PK4(p1, 0, pa2); PK4(p1, 8, pa3);
#undef PK4
}

__device__ __forceinline__ void finishSM_noexp(f32x16& p0, f32x16& p1, float& l_reg, bf16x8& pa0, bf16x8& pa1, bf16x8& pa2, bf16x8& pa3) {
  float ps = 0;
#pragma unroll
  for (int r = 0; r < 16; ++r) ps += p0[r];
#pragma unroll
  for (int r = 0; r < 16; ++r) ps += p1[r];
  { auto rr = __builtin_amdgcn_permlane32_swap(__float_as_uint(ps), __float_as_uint(ps), false, false); ps = __uint_as_float(rr[0]) + __uint_as_float(rr[1]); }
  l_reg += ps;
#define PK4(P, BASE, OUT) do { unsigned a0 = cvtpk(P[BASE + 0], P[BASE + 1]), a1 = cvtpk(P[BASE + 2], P[BASE + 3]);   \
    unsigned b0 = cvtpk(P[BASE + 4], P[BASE + 5]), b1 = cvtpk(P[BASE + 6], P[BASE + 7]);                              \
    auto r0 = __builtin_amdgcn_permlane32_swap(a0, b0, false, false); auto r1 = __builtin_amdgcn_permlane32_swap(a1, b1, false, false); \
    u32x4 w = {r0[0], r1[0], r0[1], r1[1]}; OUT = __builtin_bit_cast(bf16x8, w); } while (0)
  PK4(p0, 0, pa0); PK4(p0, 8, pa1); PK4(p1, 0, pa2); PK4(p1, 8, pa3);
#undef PK4
}

__device__ __forceinline__ void finish_T(const f32x16& p0, const f32x16& p1, float& l_reg, bf16x8& pa0, bf16x8& pa1, bf16x8& pa2, bf16x8& pa3) {
  float ps = 0;
#pragma unroll
  for (int r = 0; r < 16; ++r) ps += p0[r];
#pragma unroll
  for (int r = 0; r < 16; ++r) ps += p1[r];
  l_reg += ps;
#define PK8(P, BASE, OUT) do { u32x4 w = {cvtpk(P[BASE + 0], P[BASE + 1]), cvtpk(P[BASE + 2], P[BASE + 3]), cvtpk(P[BASE + 4], P[BASE + 5]), cvtpk(P[BASE + 6], P[BASE + 7])}; OUT = __builtin_bit_cast(bf16x8, w); } while (0)
  PK8(p0, 0, pa0); PK8(p0, 8, pa1); PK8(p1, 0, pa2); PK8(p1, 8, pa3);
#undef PK8
}

constexpr int DA_SHM_V = 16384, DA_SHM_K = 8192, DA_LDS_V = 0, DA_LDS_K = 2 * DA_SHM_V, DA_LDS_WS = DA_LDS_K + 2 * DA_SHM_K, DA_LDS_BYTES = DA_LDS_WS + 8 * 256;
__device__ __forceinline__ void da_pass(const bf16_t* __restrict__ Qw, const bf16_t* __restrict__ Kh, const bf16_t* __restrict__ Vh, int NT, lptr lds, int tid, int wid, int lane,
                                        f32x16 (&o)[4], float& l_out) {
  const int r32 = lane & 31, hi = lane >> 5;
  const lptr V_lds = lds + DA_LDS_V, K_lds = lds + DA_LDS_K;
  ATT_LAS float* al_l = (ATT_LAS float*)(lds + DA_LDS_WS) + wid * 64 + 32;
  float m_reg = -1e30f, l_reg = 0.f;
#pragma unroll
  for (int d = 0; d < 4; ++d) o[d] = f32x16{};
  bf16x8 qr[4];
#pragma unroll
  for (int d0 = 0; d0 < 4; ++d0) qr[d0] = *(const bf16x8*)(Qw + d0 * 16);
  const int sr = tid >> 4, sc = (tid & 15) * 8, vst0 = v_st(sr, sc), vst1 = v_st(32 + sr, sc);
  const int kr = tid >> 3, kc = tid & 7, kst = koff(kr, kc);
  const int vb0 = (int)(unsigned)(uintptr_t)V_lds + v_rd_base(lane);
  bf16x8 sv0[2], sv1[2], sk[2];
#define SLOAD(i, k0) do { sv0[i] = *(const bf16x8*)(Vh + (size_t)((k0) + sr) * PITCH + sc); sv1[i] = *(const bf16x8*)(Vh + (size_t)((k0) + 32 + sr) * PITCH + sc); \
    sk[i] = *(const bf16x8*)(Kh + (size_t)((k0) + kr) * PITCH + kc * 8); } while (0)
#define SWRITE(b, i) do { *(ATT_LAS bf16x8*)(V_lds + (b) * DA_SHM_V + vst0) = sv0[i]; *(ATT_LAS bf16x8*)(V_lds + (b) * DA_SHM_V + vst1) = sv1[i]; \
    *(ATT_LAS bf16x8*)(K_lds + (b) * DA_SHM_K + kst) = sk[i]; } while (0)
#define SWAIT() asm volatile("s_waitcnt vmcnt(3)" ::: "memory")
#define RESC(a) do { if (__any((a) < 1.f)) { if (hi == 0) al_l[r32] = (a); asm volatile("s_waitcnt lgkmcnt(0)" ::: "memory"); \
    _Pragma("unroll") for (int d = 0; d < 4; ++d) _Pragma("unroll") for (int r = 0; r < 16; ++r) o[d][r] *= al_l[crow(r, hi)]; } } while (0)
#define PVALL(vb) do { pv_one<0>(o[0], (vb), pa0, pa1, pa2, pa3); pv_one<1>(o[1], (vb), pa0, pa1, pa2, pa3); pv_one<2>(o[2], (vb), pa0, pa1, pa2, pa3); pv_one<3>(o[3], (vb), pa0, pa1, pa2, pa3); } while (0)
  f32x16 pA0, pA1, pB0, pB1; float mnA, mnB, alA, alB; bf16x8 pa0, pa1, pa2, pa3;
  SLOAD(0, 0); asm volatile("s_waitcnt vmcnt(0)" ::: "memory"); SWRITE(0, 0); __syncthreads();
  qkt(pA0, pA1, K_lds, qr, r32, hi); partialSM(pA0, pA1, m_reg, mnA, alA);
  SLOAD(1, 64); if (2 < NT) SLOAD(0, 128);
  SWAIT(); SWRITE(1, 1); __syncthreads();
  for (int j = 1; j + 1 < NT; j += 2) {
    SBAR(); qkt(pB0, pB1, K_lds + DA_SHM_K, qr, r32, hi);
    finishSM(pA0, pA1, alA, l_reg, pa0, pa1, pa2, pa3); SBAR();
    SLOAD(1, (j + 2) * 64); SBAR();
    PVALL(vb0); partialSM(pB0, pB1, m_reg, mnB, alB);
    __syncthreads(); SWAIT(); SWRITE(0, 0);
    RESC(alB); __syncthreads();
    SBAR(); qkt(pA0, pA1, K_lds, qr, r32, hi);
    finishSM(pB0, pB1, alB, l_reg, pa0, pa1, pa2, pa3); SBAR();
    if (j + 3 < NT) SLOAD(0, (j + 3) * 64); SBAR();
    PVALL(vb0 + DA_SHM_V); partialSM(pA0, pA1, m_reg, mnA, alA);
    __syncthreads(); SWAIT(); SWRITE(1, 1);
    RESC(alA); __syncthreads();
  }
  SBAR(); qkt(pB0, pB1, K_lds + DA_SHM_K, qr, r32, hi);
  finishSM(pA0, pA1, alA, l_reg, pa0, pa1, pa2, pa3); SBAR();
  PVALL(vb0); partialSM(pB0, pB1, m_reg, mnB, alB);
  __syncthreads(); RESC(alB);
  finishSM(pB0, pB1, alB, l_reg, pa0, pa1, pa2, pa3); SBAR();
  PVALL(vb0 + DA_SHM_V);
  l_out = l_reg;
  __syncthreads();
#undef SLOAD
#undef SWRITE
#undef SWAIT
#undef RESC
#undef PVALL
}
#ifndef PP_PREF
#define PP_PREF 0
#endif
#ifndef PP_DMA_LATE
#define PP_DMA_LATE 0
#endif
#ifndef PP_DMA_IN_M
#define PP_DMA_IN_M 1
#endif
#ifndef PP_PRIO
#define PP_PRIO 1
#endif
#ifndef PP_NS
#define PP_NS 4
#endif
constexpr int PP_K = 0, PP_V = PP_NS * 8192, PP_WS = PP_V + PP_NS * 16384, PP_BYTES = PP_WS + 8 * 256;
typedef short v4i16_t __attribute__((ext_vector_type(4)));
__device__ __forceinline__ short qr_raw(const bf16x8& v, int e) { return v[e]; }
__device__ __forceinline__ s16x4 vtr(lptr p) { return __builtin_bit_cast(s16x4, __builtin_amdgcn_ds_read_tr16_b64_v4i16((ATT_LAS v4i16_t*)p)); }
#define PP_BAR() do { __builtin_amdgcn_sched_barrier(0); asm volatile("s_waitcnt lgkmcnt(0)" ::: "memory"); __builtin_amdgcn_s_barrier(); __builtin_amdgcn_sched_barrier(0); } while (0)
template <int GRP>
__device__ __forceinline__ void da_pass_pp(const bf16_t* __restrict__ Qw, const bf16_t* __restrict__ Kh, const bf16_t* __restrict__ Vh, int NT, lptr lds, int wid, int lane,
                                           float kmax2, f32x16 (&o)[4], float& l_out, unsigned* dbg = nullptr, int variant = 0) {
  const int r32 = lane & 31, hi = lane >> 5;
  const lptr Kr = lds + PP_K, Vr = lds + PP_V;
  ATT_LAS float* al_l = (ATT_LAS float*)(lds + PP_WS) + wid * 64 + 32;
  const bf16_t* ksrc = Kh + (size_t)(lane ^ wid) * PITCH + wid * 8;
  const bf16_t* vsrc0; const bf16_t* vsrc1;
  { const int j = lane & 31;
    { const int sidx = 2 * (2 * wid) + (lane >> 5), kk = (sidx >> 2) * 8 + (j >> 2), col = (sidx & 3) * 32 + (j & 3) * 8, k = kk; vsrc0 = Vh + (size_t)k * PITCH + col; }
    { const int sidx = 2 * (2 * wid + 1) + (lane >> 5), kk = (sidx >> 2) * 8 + (j >> 2), col = (sidx & 3) * 32 + (j & 3) * 8, k = kk; vsrc1 = Vh + (size_t)k * PITCH + col; } }
#define DMA_K(t, slot) __builtin_amdgcn_global_load_lds((const unsigned*)(ksrc + (size_t)(t) * 64 * PITCH), (ATT_LAS unsigned*)(Kr + (slot) * 8192 + wid * 1024), 16, 0, 0)
#define DMA_V0(t, slot) __builtin_amdgcn_global_load_lds((const unsigned*)(vsrc0 + (size_t)(t) * 64 * PITCH), (ATT_LAS unsigned*)(Vr + (slot) * 16384 + (2 * wid) * 1024), 16, 0, 0)
#define DMA_V1(t, slot) __builtin_amdgcn_global_load_lds((const unsigned*)(vsrc1 + (size_t)(t) * 64 * PITCH), (ATT_LAS unsigned*)(Vr + (slot) * 16384 + (2 * wid + 1) * 1024), 16, 0, 0)
#define DMA_V(t, slot) do { DMA_V0(t, slot); DMA_V1(t, slot); } while (0)
  bf16x8 qr[4];
#pragma unroll
  for (int d0 = 0; d0 < 4; ++d0) qr[d0] = *(const bf16x8*)(Qw + d0 * 16);
  DMA_K(0, 0); DMA_V(0, 0); DMA_K(1, 1); if (PP_NS == 4) { DMA_K(2, 2); DMA_V(1, 1); }
  bool fast;
  { float qn = 0.f;
#pragma unroll
    for (int d0 = 0; d0 < 4; ++d0) {
#pragma unroll
      for (int e = 0; e < 8; ++e) { const float v = __uint_as_float(((unsigned)(unsigned short)qr_raw(qr[d0], e)) << 16); qn += v * v; } }
    { auto rr = __builtin_amdgcn_permlane32_swap(__float_as_uint(qn), __float_as_uint(qn), false, false); qn = __uint_as_float(rr[0]) + __uint_as_float(rr[1]); }
#ifdef PROBE_FORCE_FAST
    fast = true; }
#elif defined(PROBE_FORCE_SLOW)
    fast = false; }
#else
    fast = __all(qn * kmax2 * 1.05f < 10000.f) != 0; }
#endif
#pragma unroll
  for (int d = 0; d < 4; ++d) o[d] = f32x16{};
  float mref = 0.f, l_reg = 0.f;
  f32x16 S0, S1; bf16x8 pa0, pa1, pa2, pa3; const f32x16 zero16 = f32x16{};
  const int kq0 = koff(r32, hi), kq1 = koff(32 + r32, hi);
  const int vbase = v_rd_base(lane);
  asm volatile("s_waitcnt vmcnt(0)" ::: "memory");
  PP_BAR();
  int ks_cur = 0, vs_prev = PP_NS - 1, vs_new = PP_NS - 2;
#define SB0() __builtin_amdgcn_sched_barrier(0)
#define VRD8(d0, L0, H0, L1, H1, L2, H2, L3, H3) do { L0 = vtr(Vt + v_rd_off(d0, 0, 0)); H0 = vtr(Vt + v_rd_off(d0, 0, 1)); L1 = vtr(Vt + v_rd_off(d0, 1, 0)); H1 = vtr(Vt + v_rd_off(d0, 1, 1)); \
    L2 = vtr(Vt + v_rd_off(d0, 2, 0)); H2 = vtr(Vt + v_rd_off(d0, 2, 1)); L3 = vtr(Vt + v_rd_off(d0, 3, 0)); H3 = vtr(Vt + v_rd_off(d0, 3, 1)); } while (0)
#define PV4(d0, L0, H0, L1, H1, L2, H2, L3, H3) do { \
    o[d0] = __builtin_amdgcn_mfma_f32_32x32x16_bf16((bf16x8){L0[0], L0[1], L0[2], L0[3], H0[0], H0[1], H0[2], H0[3]}, pa0, o[d0], 0, 0, 0); \
    o[d0] = __builtin_amdgcn_mfma_f32_32x32x16_bf16((bf16x8){L1[0], L1[1], L1[2], L1[3], H1[0], H1[1], H1[2], H1[3]}, pa1, o[d0], 0, 0, 0); \
    o[d0] = __builtin_amdgcn_mfma_f32_32x32x16_bf16((bf16x8){L2[0], L2[1], L2[2], L2[3], H2[0], H2[1], H2[2], H2[3]}, pa2, o[d0], 0, 0, 0); \
    o[d0] = __builtin_amdgcn_mfma_f32_32x32x16_bf16((bf16x8){L3[0], L3[1], L3[2], L3[3], H3[0], H3[1], H3[2], H3[3]}, pa3, o[d0], 0, 0, 0); } while (0)
#define KRD8(KS) do { const lptr Kt = Kr + (KS) * 8192; \
    kf[0] = *(const ATT_LAS bf16x8*)(Kt + koff(r32, hi)); kf[1] = *(const ATT_LAS bf16x8*)(Kt + koff(32 + r32, hi)); \
    kf[2] = *(const ATT_LAS bf16x8*)(Kt + koff(r32, 2 + hi)); kf[3] = *(const ATT_LAS bf16x8*)(Kt + koff(32 + r32, 2 + hi)); \
    kf[4] = *(const ATT_LAS bf16x8*)(Kt + koff(r32, 4 + hi)); kf[5] = *(const ATT_LAS bf16x8*)(Kt + koff(32 + r32, 4 + hi)); \
    kf[6] = *(const ATT_LAS bf16x8*)(Kt + koff(r32, 6 + hi)); kf[7] = *(const ATT_LAS bf16x8*)(Kt + koff(32 + r32, 6 + hi)); } while (0)
#define QK8() do { \
    S0 = __builtin_amdgcn_mfma_f32_32x32x16_bf16(kf[0], qr[0], zero16, 0, 0, 0); S1 = __builtin_amdgcn_mfma_f32_32x32x16_bf16(kf[1], qr[0], zero16, 0, 0, 0); \
    S0 = __builtin_amdgcn_mfma_f32_32x32x16_bf16(kf[2], qr[1], S0, 0, 0, 0);   S1 = __builtin_amdgcn_mfma_f32_32x32x16_bf16(kf[3], qr[1], S1, 0, 0, 0); \
    S0 = __builtin_amdgcn_mfma_f32_32x32x16_bf16(kf[4], qr[2], S0, 0, 0, 0);   S1 = __builtin_amdgcn_mfma_f32_32x32x16_bf16(kf[5], qr[2], S1, 0, 0, 0); \
    S0 = __builtin_amdgcn_mfma_f32_32x32x16_bf16(kf[6], qr[3], S0, 0, 0, 0);   S1 = __builtin_amdgcn_mfma_f32_32x32x16_bf16(kf[7], qr[3], S1, 0, 0, 0); } while (0)
  bf16x8 kf[8]; s16x4 a0, a1, a2, a3, a4, a5, a6, a7, b0_, b1_, b2_, b3_, b4_, b5_, b6_, b7_;
#define PREF(DO_K, DO_V, kslot, vslot) do { if (DO_V) { const lptr Vt = Vr + (vslot) * 16384 + vbase; VRD8(0, a0, a1, a2, a3, a4, a5, a6, a7); } \
    if (DO_K) { const int ks_cur_ = (kslot); KRD8(ks_cur_); } } while (0)
#define MB_DMA_K(tt) do { if (PP_DMA_IN_M && (tt) + PP_NS - 1 < NT) { DMA_K((tt) + PP_NS - 1, vs_prev); SB0(); } } while (0)
#define MB_DMA_V0(tt) do { if (PP_DMA_IN_M && (tt) + PP_NS - 2 < NT) { DMA_V0((tt) + PP_NS - 2, vs_new); SB0(); } } while (0)
#define MB_DMA_V1(tt) do { if (PP_DMA_IN_M && (tt) + PP_NS - 2 < NT) { DMA_V1((tt) + PP_NS - 2, vs_new); SB0(); } } while (0)
#define MBLOCK(DO_QK, DO_PV, tt) do { if (PP_PRIO == 1) __builtin_amdgcn_s_setprio(1); const lptr Vt = Vr + vs_prev * 16384 + vbase; \
    if (!PP_PREF) { if (DO_PV) VRD8(0, a0, a1, a2, a3, a4, a5, a6, a7); if (DO_QK) KRD8(ks_cur); SB0(); } \
    if (DO_QK && variant != 2) { QK8(); SB0(); } \
    if (DO_PV && variant != 2) { VRD8(1, b0_, b1_, b2_, b3_, b4_, b5_, b6_, b7_); SB0(); PV4(0, a0, a1, a2, a3, a4, a5, a6, a7); SB0(); MB_DMA_K(tt); VRD8(2, a0, a1, a2, a3, a4, a5, a6, a7); SB0(); \
                 PV4(1, b0_, b1_, b2_, b3_, b4_, b5_, b6_, b7_); SB0(); MB_DMA_V0(tt); VRD8(3, b0_, b1_, b2_, b3_, b4_, b5_, b6_, b7_); SB0(); \
                 PV4(2, a0, a1, a2, a3, a4, a5, a6, a7); SB0(); MB_DMA_V1(tt); PV4(3, b0_, b1_, b2_, b3_, b4_, b5_, b6_, b7_); } \
    else { MB_DMA_K(tt); MB_DMA_V0(tt); MB_DMA_V1(tt); } \
    if (PP_PRIO == 1) __builtin_amdgcn_s_setprio(0); } while (0)
#define VBLOCK(t) do { if ((t) >= 0 && (t) < NT && variant != 1) { if (PP_PRIO == 2) __builtin_amdgcn_s_setprio(1); \
    if (!fast) { const float rm = rowmax32(S0, S1); \
      if ((t) == 0 || __any(rm - mref > THRL)) { const float mn = (t) == 0 ? rm : fmaxf(rm, mref); \
        if ((t) != 0) { const float f = __builtin_amdgcn_exp2f(mref - mn); l_reg *= f; \
          _Pragma("unroll") for (int d = 0; d < 4; ++d) _Pragma("unroll") for (int r = 0; r < 16; ++r) o[d][r] *= f; } \
        mref = mn; } \
      _Pragma("unroll") for (int r = 0; r < 16; ++r) { S0[r] -= mref; S1[r] -= mref; } } \
    _Pragma("unroll") for (int r = 0; r < 16; ++r) { S0[r] = __builtin_amdgcn_exp2f(S0[r]); S1[r] = __builtin_amdgcn_exp2f(S1[r]); } \
    finish_T(S0, S1, l_reg, pa0, pa1, pa2, pa3); if (PP_PRIO == 2) __builtin_amdgcn_s_setprio(0); } } while (0)
#define ROT3() do { vs_new = vs_prev; vs_prev = ks_cur; ks_cur = ks_cur == PP_NS - 1 ? 0 : ks_cur + 1; } while (0)
#define TAILWAIT(t) do { if (PP_NS == 3) { if ((t) + 2 < NT) asm volatile("s_waitcnt vmcnt(3)" ::: "memory"); else if ((t) + 1 < NT) asm volatile("s_waitcnt vmcnt(2)" ::: "memory"); else asm volatile("s_waitcnt vmcnt(0)" ::: "memory"); } \
    else { if ((t) + 3 < NT) asm volatile("s_waitcnt vmcnt(6)" ::: "memory"); else if ((t) + 2 < NT) asm volatile("s_waitcnt vmcnt(5)" ::: "memory"); else if ((t) + 1 < NT) asm volatile("s_waitcnt vmcnt(2)" ::: "memory"); else asm volatile("s_waitcnt vmcnt(0)" ::: "memory"); } } while (0)
#define NXT3(x) ((x) == PP_NS - 1 ? 0 : (x) + 1)
#if defined(DPROBE)
  unsigned long long dp_acc = 0, dp_prev = 0; const bool dp_on = dbg != nullptr && blockIdx.x == 0 && wid == (DPROBE_GRP ? 4 : 0) && GRP == DPROBE_GRP;
#define DP_T(i) do { if (dp_on) { const unsigned long long now_ = __builtin_amdgcn_s_memtime(); if ((i) == DPROBE) dp_acc += now_ - dp_prev; dp_prev = now_; } } while (0)
#else
#define DP_T(i) do {} while (0)
#endif
#define DMA_ISSUE(t) do { if ((t) + PP_NS - 1 < NT) DMA_K((t) + PP_NS - 1, vs_prev); if ((t) + PP_NS - 2 < NT) DMA_V((t) + PP_NS - 2, vs_new); } while (0)
  { if (!PP_DMA_IN_M && !(PP_DMA_LATE && GRP == 0)) { DMA_ISSUE(0); SB0(); }
    if (PP_PREF) { PREF(true, false, ks_cur, 0); SB0(); }
    if (GRP == 0) MBLOCK(true, false, 0);
    if (!PP_DMA_IN_M && PP_DMA_LATE && GRP == 0) { SB0(); DMA_ISSUE(0); }
    SB0(); if (PP_PREF) TAILWAIT(0); PP_BAR();
    if (GRP == 0) { if (PP_PREF == 1) { PREF(1 < NT, true, NXT3(ks_cur), NXT3(vs_prev)); SB0(); } VBLOCK(0); if (PP_PREF == 2) { SB0(); PREF(1 < NT, true, NXT3(ks_cur), NXT3(vs_prev)); } } else MBLOCK(true, false, 0);
    SB0(); if (!PP_PREF) TAILWAIT(0); PP_BAR(); ROT3(); }
#pragma clang loop unroll(disable)
  for (int t = 1; t < NT; ++t) {
    DP_T(0);
    if (!PP_DMA_IN_M && !(PP_DMA_LATE && GRP == 0)) { DMA_ISSUE(t); SB0(); }
    if (GRP == 0) MBLOCK(true, true, t); else { if (PP_PREF == 1) { PREF(true, true, ks_cur, vs_prev); SB0(); } VBLOCK(t - 1); if (PP_PREF == 2) { SB0(); PREF(true, true, ks_cur, vs_prev); } }
    if (!PP_DMA_IN_M && PP_DMA_LATE && GRP == 0) { SB0(); DMA_ISSUE(t); }
    SB0(); if (PP_PREF) TAILWAIT(t); DP_T(1); PP_BAR(); DP_T(2);
    if (GRP == 0) { if (PP_PREF == 1) { PREF(t + 1 < NT, true, NXT3(ks_cur), NXT3(vs_prev)); SB0(); } VBLOCK(t); if (PP_PREF == 2) { SB0(); PREF(t + 1 < NT, true, NXT3(ks_cur), NXT3(vs_prev)); } } else MBLOCK(true, true, t);
    SB0(); if (!PP_PREF) TAILWAIT(t); DP_T(3); PP_BAR(); DP_T(4); ROT3();
  }
  { if (GRP == 0) MBLOCK(false, true, NT); else { if (PP_PREF == 1) { PREF(false, true, 0, vs_prev); SB0(); } VBLOCK(NT - 1); if (PP_PREF == 2) { SB0(); PREF(false, true, 0, vs_prev); } }
    PP_BAR();
    if (GRP == 1) MBLOCK(false, true, NT);
    PP_BAR(); }
#if defined(DPROBE)
  if (dp_on && lane == 0) atomicAdd(dbg, (unsigned)(dp_acc >> 4));
#endif
  l_out = l_reg;
#undef DMA_K
#undef DMA_V
#undef MBLOCK
#undef MB_DMA_K
#undef MB_DMA_V0
#undef MB_DMA_V1
#undef VBLOCK
#undef SB0
#undef VRD8
#undef PV4
#undef KRD8
#undef QK8
#undef ROT3
#undef TAILWAIT
#undef PREF
#undef NXT3
#undef DMA_ISSUE
}
constexpr int DA_LDS_OST = 0, DA_LDS_TOTAL = PP_BYTES;
__device__ __forceinline__ void da_unit(size_t rowbase, int T, int h, int qb, const bf16_t* Q, const bf16_t* K, const bf16_t* V, bf16_t* O, float* park, float lam, float outscale,
                                        const float* __restrict__ subg, const unsigned* kmaxp, lptr lds, int tid, int wid, int lane, unsigned* dbg = nullptr, int variant = 0) {
  const int NT = T / 64;
  const size_t qrow = rowbase + (size_t)qb * 256 + wid * 32;
  f32x16 o[4]; float l_reg;
#pragma clang loop unroll(disable)
  for (int sub = 0; sub < 2; ++sub) {
    asm volatile("" : "+v"(tid)); lane = tid & 63;
    const int r32 = lane & 31, hi = lane >> 5;
    ATT_LAS float* li_l = (ATT_LAS float*)(lds + PP_WS) + wid * 64;
    const float kmax2 = __uint_as_float(__builtin_nontemporal_load(kmaxp + 2 * h + sub));
    if (wid < 4) da_pass_pp<0>(Q + (qrow + r32) * PITCH + (2 * h + sub) * 64 + hi * 8, K + rowbase * PITCH + (2 * h + sub) * 64, V + rowbase * PITCH + h * 128, NT, lds, wid, lane, kmax2, o, l_reg, dbg, variant);
    else da_pass_pp<1>(Q + (qrow + r32) * PITCH + (2 * h + sub) * 64 + hi * 8, K + rowbase * PITCH + (2 * h + sub) * 64, V + rowbase * PITCH + h * 128, NT, lds, wid, lane, kmax2, o, l_reg, dbg, variant);
    { auto rr = __builtin_amdgcn_permlane32_swap(__float_as_uint(l_reg), __float_as_uint(l_reg), false, false); l_reg = __uint_as_float(rr[0]) + __uint_as_float(rr[1]); }
    const float rl = __builtin_amdgcn_rcpf(l_reg);
    f32x4* pk = (f32x4*)(park + ((size_t)wid * 64 + lane) * 64);
    if (sub == 0) {
#pragma unroll
      for (int d0 = 0; d0 < 4; ++d0)
#pragma unroll
        for (int q = 0; q < 4; ++q) { f32x4 v; v[0] = o[d0][4 * q] * rl; v[1] = o[d0][4 * q + 1] * rl; v[2] = o[d0][4 * q + 2] * rl; v[3] = o[d0][4 * q + 3] * rl; pk[d0 * 4 + q] = v; }
    } else {
      const float rll = rl * lam; float ss = 0.f;
#pragma unroll
      for (int d0 = 0; d0 < 4; ++d0)
#pragma unroll
        for (int q = 0; q < 4; ++q) { const f32x4 p = pk[d0 * 4 + q];
#pragma unroll
          for (int j = 0; j < 4; ++j) { const float v = p[j] - o[d0][4 * q + j] * rll; o[d0][4 * q + j] = v; ss += v * v; } }
      { auto rr = __builtin_amdgcn_permlane32_swap(__float_as_uint(ss), __float_as_uint(ss), false, false); ss = __uint_as_float(rr[0]) + __uint_as_float(rr[1]); }
      const float rstd = __builtin_amdgcn_rsqf(ss * (1.0f / 128.0f) + 1e-5f) * outscale;
      ATT_LAS bf16_t* stg = (ATT_LAS bf16_t*)(lds + DA_LDS_OST) + wid * 4096;
#pragma unroll
      for (int d0 = 0; d0 < 4; ++d0)
#pragma unroll
        for (int q = 0; q < 4; ++q) { const f32x4 gv = *(const f32x4*)(subg + d0 * 32 + 8 * q + 4 * hi);
          typedef unsigned u32x2v __attribute__((ext_vector_type(2))); u32x2v w;
          w.x = cvtpk(o[d0][4 * q] * rstd * gv[0], o[d0][4 * q + 1] * rstd * gv[1]); w.y = cvtpk(o[d0][4 * q + 2] * rstd * gv[2], o[d0][4 * q + 3] * rstd * gv[3]);
          *(ATT_LAS u32x2v*)(stg + r32 * 128 + d0 * 32 + 8 * q + 4 * hi) = w; }
      asm volatile("s_waitcnt lgkmcnt(0)" ::: "memory");
      bf16_t* Ow = O + qrow * PITCH + h * 128;
#pragma unroll
      for (int i = 0; i < 8; ++i) { const int row = i * 4 + (lane >> 4), ch = lane & 15; const u32x4 v = *(const ATT_LAS u32x4*)(stg + row * 128 + ch * 8); *(u32x4*)(Ow + (size_t)row * PITCH + ch * 8) = v; }
      asm volatile("s_waitcnt lgkmcnt(0)" ::: "memory"); __builtin_amdgcn_s_barrier();
    }
  }
}

constexpr int NA_NS = 4, NA_SLOT = 16384, NA_LDS_B = NA_NS * NA_SLOT, NA_LDS_WS = NA_LDS_B + 2560, NA_LDS_OST = NA_LDS_WS + 8 * 256, NA_LDS_BYTES = NA_LDS_OST + 8 * 4096, NA_BPAD = 64;
template <int D0, int KS0, int KS1> __device__ __forceinline__ void pv_ks(f32x16& od, int vb, bf16x8 pa0, bf16x8 pa1, bf16x8 pa2, bf16x8 pa3) {
  s16x4 l[4], h[4];
#pragma unroll
  for (int ks = 0; ks < 4; ++ks) if (ks >= KS0 && ks <= KS1) {
      asm volatile("ds_read_b64_tr_b16 %0, %1 offset:%2" : "=&v"(l[ks]) : "v"(vb), "i"(D0 * 512 + ks * 2048) : "memory");
      asm volatile("ds_read_b64_tr_b16 %0, %1 offset:%2" : "=&v"(h[ks]) : "v"(vb), "i"(D0 * 512 + ks * 2048 + 1024) : "memory"); }
  asm volatile("s_waitcnt lgkmcnt(0)" ::: "memory"); SBAR();
#define PK(L, H) (bf16x8){L[0], L[1], L[2], L[3], H[0], H[1], H[2], H[3]}
  if (0 >= KS0 && 0 <= KS1) od = __builtin_amdgcn_mfma_f32_32x32x16_bf16(pa0, PK(l[0], h[0]), od, 0, 0, 0);
  if (1 >= KS0 && 1 <= KS1) od = __builtin_amdgcn_mfma_f32_32x32x16_bf16(pa1, PK(l[1], h[1]), od, 0, 0, 0);
  if (2 >= KS0 && 2 <= KS1) od = __builtin_amdgcn_mfma_f32_32x32x16_bf16(pa2, PK(l[2], h[2]), od, 0, 0, 0);
  if (3 >= KS0 && 3 <= KS1) od = __builtin_amdgcn_mfma_f32_32x32x16_bf16(pa3, PK(l[3], h[3]), od, 0, 0, 0);
#undef PK
}
template <int H>
__device__ __forceinline__ void na_tiles(size_t tok0, int rows, int h, int R, int qrow, const bf16_t* Q, const bf16_t* K, const bf16_t* V, bf16_t* O, lptr lds, int tid, int wid, int lane) {
  const int r32 = lane & 31, hi = lane >> 5;
  ATT_LAS float* bias = (ATT_LAS float*)(lds + NA_LDS_B);
  ATT_LAS float* li_l = (ATT_LAS float*)(lds + NA_LDS_WS) + wid * 64; ATT_LAS float* al_l = li_l + 32;
  const int c = 32 * H + r32;
  const int c0 = min(max(c - 8, 0), 48), tmask = 4 * hi - c0;
  const int rlo_w = min(max(qrow - 4, 0), rows - 8);
  const int kr_lo = min(max(R - 4, 0), rows - 8), kr_hi = min(max(R + 3 - 4, 0), rows - 8) + 7, nt = kr_hi - kr_lo + 1;
  const size_t qtok = tok0 + (size_t)qrow * 64 + c;
  bf16x8 qr[4];
#pragma unroll
  for (int d0 = 0; d0 < 4; ++d0) qr[d0] = *(const bf16x8*)(Q + qtok * PITCH + h * 64 + d0 * 16 + hi * 8);
  const int vb0 = (int)(unsigned)(uintptr_t)lds + v_rd_base(lane);
  const bf16_t* ksrc = K + (tok0 + (size_t)(lane ^ wid)) * PITCH + h * 64 + wid * 8;
  const bf16_t* vsrc;
  { const int j = lane & 31, kk = wid * 8 + (j >> 2), col = (lane >> 5) * 32 + (j & 3) * 8, k = (kk & ~0xC) | ((kk & 4) << 1) | ((kk & 8) >> 1); vsrc = V + (tok0 + (size_t)k) * PITCH + h * 64 + col; }
#define NDMA(row, slot) do { __builtin_amdgcn_global_load_lds((const unsigned*)(vsrc + (size_t)(row) * 64 * PITCH), (ATT_LAS unsigned*)(lds + (slot) * NA_SLOT + wid * 1024), 16, 0, 0); \
                             __builtin_amdgcn_global_load_lds((const unsigned*)(ksrc + (size_t)(row) * 64 * PITCH), (ATT_LAS unsigned*)(lds + (slot) * NA_SLOT + 8192 + wid * 1024), 16, 0, 0); } while (0)
#define NBAR() do { __builtin_amdgcn_sched_barrier(0); asm volatile("s_waitcnt lgkmcnt(0)" ::: "memory"); __builtin_amdgcn_s_barrier(); __builtin_amdgcn_sched_barrier(0); } while (0)
  float mref = 0.f, l_reg = 0.f; f32x16 o[2]; o[0] = f32x16{}; o[1] = f32x16{};
  asm volatile("" :: "v"(qr[0]), "v"(qr[1]), "v"(qr[2]), "v"(qr[3]));
  NDMA(kr_lo, 0); if (1 < nt) NDMA(kr_lo + 1, 1); if (2 < nt) NDMA(kr_lo + 2, 2);
  int slot = 0;
  for (int t = 0; t < nt; ++t) {
    const int krow = kr_lo + t;
    if (t + 2 < nt) asm volatile("s_waitcnt vmcnt(4)" ::: "memory"); else if (t + 1 < nt) asm volatile("s_waitcnt vmcnt(2)" ::: "memory"); else asm volatile("s_waitcnt vmcnt(0)" ::: "memory");
    NBAR();
    if (t + 3 < nt) NDMA(krow + 3, (slot + 3) & 3);
    __builtin_amdgcn_sched_barrier(0);
    if (krow >= rlo_w && krow < rlo_w + 8) {
      f32x16 p0, p1; qkt(p0, p1, lds + slot * NA_SLOT + 8192, qr, r32, hi);
      const int bofs = NA_BPAD + (krow - qrow + 7) * 31 + 15 - c + 4 * hi;
#define BM(P, r, koffc) do { const int kcol = ((r) & 3) + 8 * ((r) >> 2) + (koffc); float bv_ = bias[bofs + kcol]; asm volatile("" : "+v"(bv_));   \
        P[r] = ((unsigned)(kcol + tmask) < 16u) ? P[r] + bv_ : -INFINITY; } while (0)
      float pm;
      if (H == 0) {
#pragma unroll
        for (int r = 0; r < 16; ++r) BM(p0, r, 0);
#pragma unroll
        for (int r = 0; r < 4; ++r) BM(p1, r, 32);
        pm = p0[0];
#pragma unroll
        for (int r = 1; r < 16; ++r) pm = fmaxf(pm, p0[r]);
#pragma unroll
        for (int r = 0; r < 4; ++r) pm = fmaxf(pm, p1[r]);
      } else {
#pragma unroll
        for (int r = 12; r < 16; ++r) BM(p0, r, 0);
#pragma unroll
        for (int r = 0; r < 16; ++r) BM(p1, r, 32);
        pm = p1[0];
#pragma unroll
        for (int r = 1; r < 16; ++r) pm = fmaxf(pm, p1[r]);
#pragma unroll
        for (int r = 12; r < 16; ++r) pm = fmaxf(pm, p0[r]);
      }
#undef BM
      { auto rr = __builtin_amdgcn_permlane32_swap(__float_as_uint(pm), __float_as_uint(pm), false, false); pm = fmaxf(__uint_as_float(rr[0]), __uint_as_float(rr[1])); }
      const bool first = krow == rlo_w;
      if (first || __any(pm - mref > THRL)) { const float mn = first ? pm : fmaxf(pm, mref);
        if (!first) { const float f = __builtin_amdgcn_exp2f(mref - mn); l_reg *= f; if (hi == 0) al_l[r32] = f; asm volatile("s_waitcnt lgkmcnt(0)" ::: "memory");
#pragma unroll
          for (int r = 0; r < 16; ++r) { const float a = al_l[crow(r, hi)]; o[0][r] *= a; o[1][r] *= a; } }
        mref = mn; }
      float ps = 0.f;
      if (H == 0) {
#pragma unroll
        for (int r = 0; r < 16; ++r) { p0[r] = __builtin_amdgcn_exp2f(p0[r] - mref); ps += p0[r]; }
#pragma unroll
        for (int r = 0; r < 4; ++r) { p1[r] = __builtin_amdgcn_exp2f(p1[r] - mref); ps += p1[r]; }
#pragma unroll
        for (int r = 4; r < 8; ++r) p1[r] = 0.f;
      } else {
#pragma unroll
        for (int r = 12; r < 16; ++r) { p0[r] = __builtin_amdgcn_exp2f(p0[r] - mref); ps += p0[r]; }
#pragma unroll
        for (int r = 0; r < 16; ++r) { p1[r] = __builtin_amdgcn_exp2f(p1[r] - mref); ps += p1[r]; }
#pragma unroll
        for (int r = 8; r < 12; ++r) p0[r] = 0.f;
      }
      { auto rr = __builtin_amdgcn_permlane32_swap(__float_as_uint(ps), __float_as_uint(ps), false, false); ps = __uint_as_float(rr[0]) + __uint_as_float(rr[1]); }
      l_reg += ps;
      bf16x8 pa0 = bf16x8{}, pa1, pa2, pa3 = bf16x8{};
#define PK4(P, BASE, OUT) do { unsigned a0 = cvtpk(P[BASE + 0], P[BASE + 1]), a1 = cvtpk(P[BASE + 2], P[BASE + 3]);   \
    unsigned b0 = cvtpk(P[BASE + 4], P[BASE + 5]), b1 = cvtpk(P[BASE + 6], P[BASE + 7]);                              \
    auto r0 = __builtin_amdgcn_permlane32_swap(a0, b0, false, false); auto r1 = __builtin_amdgcn_permlane32_swap(a1, b1, false, false); \
    u32x4 w = {r0[0], r1[0], r0[1], r1[1]}; OUT = __builtin_bit_cast(bf16x8, w); } while (0)
      const int vb = vb0 + slot * NA_SLOT;
      if (H == 0) { PK4(p0, 0, pa0); PK4(p0, 8, pa1); PK4(p1, 0, pa2); pv_ks<0, 0, 2>(o[0], vb, pa0, pa1, pa2, pa3); pv_ks<1, 0, 2>(o[1], vb, pa0, pa1, pa2, pa3); }
      else        { PK4(p0, 8, pa1); PK4(p1, 0, pa2); PK4(p1, 8, pa3); pv_ks<0, 1, 3>(o[0], vb, pa0, pa1, pa2, pa3); pv_ks<1, 1, 3>(o[1], vb, pa0, pa1, pa2, pa3); }
#undef PK4
    }
    slot = (slot + 1) & 3;
  }
#undef NDMA
  if (hi == 0) li_l[r32] = l_reg; asm volatile("s_waitcnt lgkmcnt(0)" ::: "memory");
  ATT_LAS bf16_t* stg = (ATT_LAS bf16_t*)(lds + NA_LDS_OST) + wid * 2048;
#pragma unroll
  for (int r = 0; r < 16; ++r) { const int orow = crow(r, hi); const float rl = __builtin_amdgcn_rcpf(li_l[orow]);
#pragma unroll
    for (int d0 = 0; d0 < 2; ++d0) { const unsigned w = cvtpk(o[d0][r] * rl, 0.f); stg[orow * 64 + d0 * 32 + r32] = (bf16_t)(w & 0xffffu); } }
  asm volatile("s_waitcnt lgkmcnt(0)" ::: "memory");
  bf16_t* Ow = O + (tok0 + (size_t)qrow * 64 + 32 * H) * PITCH + h * 64;
#pragma unroll
  for (int i = 0; i < 4; ++i) { const int row = i * 8 + (lane >> 3), ch = lane & 7; const u32x4 v = *(const ATT_LAS u32x4*)(stg + row * 64 + ch * 8); *(u32x4*)(Ow + (size_t)row * PITCH + ch * 8) = v; }
  NBAR();
#undef NBAR
}
__device__ __forceinline__ void na_unit(size_t tok0, int rows, int h, int R, const bf16_t* Q, const bf16_t* K, const bf16_t* V, bf16_t* O, const float* __restrict__ rpb_h,
                                        lptr lds, int tid, int wid, int lane) {
  asm volatile("" : "+v"(tid)); lane = tid & 63;
  ATT_LAS float* bias = (ATT_LAS float*)(lds + NA_LDS_B);
  for (int i = tid; i < 465; i += 512) bias[NA_BPAD + i] = rpb_h[i] * 1.4426950408889634f;
  const int qrow = R + (wid >> 1);
  if ((wid & 1) == 0) na_tiles<0>(tok0, rows, h, R, qrow, Q, K, V, O, lds, tid, wid, lane);
  else                na_tiles<1>(tok0, rows, h, R, qrow, Q, K, V, O, lds, tid, wid, lane);
}
#undef SBAR
}

#define XB_TMO      128
#define XB_XCNT(j)  (256  + 64 * (j))
#define XB_XSUB(j)  (1280 + 64 * (j))
#define XB_XGEN(j)  (2304 + 64 * (j))
#define XB_TOP      3328
#define XB_TOPGEN   3392
#define XCD_BAR_WORDS 3456
#define XB_SPIN_CAP (1u << 18)

__device__ __forceinline__ unsigned xb_ld(unsigned* p)              { return __hip_atomic_load(p, __ATOMIC_RELAXED, __HIP_MEMORY_SCOPE_AGENT); }
__device__ __forceinline__ unsigned xb_add(unsigned* p, unsigned v) { return __hip_atomic_fetch_add(p, v, __ATOMIC_RELAXED, __HIP_MEMORY_SCOPE_AGENT); }
__device__ __forceinline__ unsigned xb_xcc_id() { return (unsigned)__builtin_amdgcn_s_getreg((3 << 11) | 20) & 0xFu; }
#define XB_SPIN(cond, bar) do { unsigned _sp = 0; while (cond) { __builtin_amdgcn_s_sleep(1); \
    if ((++_sp & 255u) == 0u) { if (xb_ld(&(bar)[XB_TMO])) break; if (_sp > XB_SPIN_CAP) { atomicAdd(&(bar)[XB_TMO], 1u); break; } } } } while (0)

struct XcdBarrier {
    unsigned* bar; unsigned x;
    volatile LAS unsigned* st;
};

__device__ __forceinline__ XcdBarrier xcd_barrier_post(unsigned* bar, volatile LAS unsigned* st) {
    XcdBarrier b; b.bar = bar; b.x = xb_xcc_id(); b.st = st;
    if (threadIdx.x == 0) (void)xb_add(&bar[XB_XCNT(b.x)], 1u);
    return b;
}
__device__ __forceinline__ void xcd_barrier_complete(unsigned* bar, unsigned x, unsigned& nloc, unsigned& nx) {
    const unsigned G = gridDim.x * gridDim.y * gridDim.z;
    unsigned sum, cnt, mine, sp = 0u;
    for (;;) {
        sum = 0u; cnt = 0u; mine = 0u;
#pragma unroll
        for (unsigned j = 0; j < 16; ++j) { const unsigned c = xb_ld(&bar[XB_XCNT(j)]); sum += c; cnt += (c > 0u) ? 1u : 0u; mine = (j == x) ? c : mine; }
        if (sum == G) break;
        __builtin_amdgcn_s_sleep(1);
        if ((++sp & 255u) == 0u) { if (xb_ld(&bar[XB_TMO])) break; if (sp > XB_SPIN_CAP) { atomicAdd(&bar[XB_TMO], 1u); break; } }
    }
    nloc = mine > 0u ? mine : 1u; nx = cnt > 0u ? cnt : 1u;
}

__device__ __forceinline__ void xcd_barrier(const XcdBarrier& b) {
    asm volatile("s_waitcnt vmcnt(0)" ::: "memory");
    __syncthreads();
    if (threadIdx.x == 0) {
        unsigned* bar = b.bar;
        __builtin_amdgcn_s_waitcnt(0);
        unsigned nloc = b.st[0], nx = b.st[1];
        if (nloc == 0u) { xcd_barrier_complete(bar, b.x, nloc, nx); b.st[0] = nloc; b.st[1] = nx; }
        const unsigned old = xb_add(&bar[XB_XSUB(b.x)], 1u);
        const unsigned gen = old / nloc;
        if (old + 1u == (gen + 1u) * nloc) {
            __builtin_amdgcn_fence(__ATOMIC_RELEASE, "agent");
            asm volatile("s_waitcnt vmcnt(0)" ::: "memory");
            const unsigned og = xb_add(&bar[XB_TOP], 1u);
            const unsigned tg = og / nx;
            if (og + 1u == (tg + 1u) * nx) xb_add(&bar[XB_TOPGEN], 1u);
            else XB_SPIN(xb_ld(&bar[XB_TOPGEN]) == tg, bar);
            __builtin_amdgcn_fence(__ATOMIC_ACQUIRE, "agent");
            xb_add(&bar[XB_XGEN(b.x)], 1u);
            asm volatile("s_waitcnt vmcnt(0)" ::: "memory");
        } else {
            XB_SPIN(xb_ld(&bar[XB_XGEN(b.x)]) == gen, bar);
            __builtin_amdgcn_fence(__ATOMIC_ACQUIRE, "agent");
            asm volatile("s_waitcnt vmcnt(0)" ::: "memory");
        }
    }
    __syncthreads();
}

constexpr int NWAVES = 8;
#ifndef FUSE_THIN
#define FUSE_THIN 0
#endif
#ifndef MK_PER_PHASE
#define MK_PER_PHASE 0
#endif
constexpr int NPH = 15;

constexpr size_t MiB = 1u << 20;
constexpr size_t WS_CTL = 0, CTL_ZERO_BYTES = 1 * MiB;
constexpr size_t WS_ROPE_C = 1 * MiB, WS_ROPE_S = 2 * MiB, WS_RS = 3 * MiB;
constexpr size_t WS_WQKV0 = 4 * MiB, WS_WO0 = 10 * MiB, WS_WIN0 = 12 * MiB, WS_WOUT0 = 23 * MiB;
constexpr size_t WS_WQKV1 = 29 * MiB, WS_WO1 = 35 * MiB, WS_WIN1 = 37 * MiB, WS_WOUT1 = 48 * MiB;
constexpr size_t WS_XN = 56 * MiB;
constexpr size_t WS_Q = 218 * MiB, WS_K = 378 * MiB, WS_V = 538 * MiB;
constexpr size_t WS_G = 218 * MiB;
constexpr size_t WS_MB = 698 * MiB;
constexpr size_t WS_PARK = 858 * MiB;
constexpr size_t WS_END = 896 * MiB;
static_assert(WS_WOUT1 + (size_t)D * FF * 2 <= WS_XN - 4096 && WS_XN + (size_t)(NMT_CONV * 254 + 2) * D * 2 <= WS_Q && WS_G + (size_t)M * FF * 2 <= WS_MB && WS_MB + (size_t)M * D * 2 <= WS_PARK, "d_ws map");
constexpr int CW_PANEL = 16384, PANEL_BANK = 320 * 64;
constexpr int CW_TP = 8000;
constexpr int CW_KMAX = 8192;
constexpr int CW_BAR = 4096;

constexpr int RING_OFF = 0, RING_BYTES = 131072;
constexpr int LDSCTL_OFF = RING_BYTES, MISC_OFF = LDSCTL_OFF + 320;
constexpr int XCH_OFF = RING_BYTES + 1024;
constexpr int LDS_BYTES = 147456;
static_assert(XCH_OFF + 8192 + 4096 <= LDS_BYTES && att::DA_LDS_TOTAL <= RING_BYTES && att::NA_LDS_BYTES <= RING_BYTES, "LDS map");

__device__ __forceinline__ void p0_transpose_item(const float* W, int K, int N, bf16* WT, int k0, int n0, int drow0, const float* gk, LAS float* scr, int lane) {
#pragma unroll 8
    for (int i = 0; i < 32; ++i) { const int kk = 2 * i + (lane >> 5); float w = W[(size_t)(k0 + kk) * N + n0 + (lane & 31)]; if (gk) w *= gk[k0 + kk]; scr[kk * 33 + (lane & 31)] = w; }
    LDS_WAIT(); asm volatile("" ::: "memory");
    const int c = lane & 7;
#pragma unroll
    for (int j = 0; j < 4; ++j) { const int n = (lane >> 3) + 8 * j; const LAS float* s = scr + (8 * c) * 33 + n;
        v4u o; o.x = pk2(s[0 * 33], s[1 * 33]); o.y = pk2(s[2 * 33], s[3 * 33]); o.z = pk2(s[4 * 33], s[5 * 33]); o.w = pk2(s[6 * 33], s[7 * 33]);
        *(GAS v4u*)(WT + (size_t)(drow0 + n) * K + k0 + 8 * c) = o; }
    LDS_WAIT(); asm volatile("" ::: "memory");
}
__device__ __forceinline__ void p0_matrix(const float* W, int K, int N, bf16* WT, const float* gk, int mode, int roff, LAS float* scr, int gw, int NGW, int lane) {
    const int nblk = N / 32, nitems = (K / 64) * nblk;
    for (int it = gw; it < nitems; it += NGW) {
        const int kb = it / nblk, nb = it % nblk, n0 = 32 * nb; int drow0;
        if (mode == 0) drow0 = roff + n0;
        else if (mode == 1) { const int bj = n0 >= FF ? 1 : 0, ch = n0 - bj * FF; drow0 = (ch >> 7) * 256 + bj * 128 + (ch & 127); }
        else { const int s = n0 >> 6, half = (n0 >> 5) & 1; drow0 = roff + (s >> 2) * 256 + half * 128 + (s & 3) * 32; }
        p0_transpose_item(W, K, N, WT, 64 * kb, n0, drow0, gk, scr, lane);
    }
}
__device__ __forceinline__ void sincos_small(double x, double& s, double& c) {
    const double x2 = x * x;
    double a = -1.0 / 25852016738884976640000.0;
    a = a * x2 + 1.0 / 51090942171709440000.0;
    a = a * x2 - 1.0 / 121645100408832000.0;
    a = a * x2 + 1.0 / 355687428096000.0;
    a = a * x2 - 1.0 / 1307674368000.0;
    a = a * x2 + 1.0 / 6227020800.0;
    a = a * x2 - 1.0 / 39916800.0;
    a = a * x2 + 1.0 / 362880.0;
    a = a * x2 - 1.0 / 5040.0;
    a = a * x2 + 1.0 / 120.0;
    a = a * x2 - 1.0 / 6.0;
    a = a * x2 + 1.0;
    s = a * x;
    double b = 1.0 / 620448401733239439360000.0;
    b = b * x2 - 1.0 / 1124000727777607680000.0;
    b = b * x2 + 1.0 / 2432902008176640000.0;
    b = b * x2 - 1.0 / 6402373705728000.0;
    b = b * x2 + 1.0 / 20922789888000.0;
    b = b * x2 - 1.0 / 87178291200.0;
    b = b * x2 + 1.0 / 479001600.0;
    b = b * x2 - 1.0 / 3628800.0;
    b = b * x2 + 1.0 / 40320.0;
    b = b * x2 - 1.0 / 720.0;
    b = b * x2 + 1.0 / 24.0;
    b = b * x2 - 0.5;
    b = b * x2 + 1.0;
    c = b;
}
struct Args { const float* in[22]; float* out; unsigned char* ws; int ph_lo, ph_hi; };
__global__ void __launch_bounds__(NWAVES * 64, 2) mega_fwd(Args args) {
    extern __shared__ __attribute__((aligned(16))) unsigned char lds_raw[];
    LAS unsigned char* lds = (LAS unsigned char*)lds_raw;
    volatile LAS unsigned* MISC = (volatile LAS unsigned*)(lds + MISC_OFF);
    const int tid = threadIdx.x, lane = tid & 63, wave = __builtin_amdgcn_readfirstlane(tid >> 6);
    const int G = gridDim.x, bx = blockIdx.x, vcu = (G % 8 == 0) ? (bx % 8) * (G / 8) + bx / 8 : bx;
    const int gw = vcu * NWAVES + wave, NGW = G * NWAVES;
    unsigned char* ws = args.ws;
    gu32* ctl = (gu32*)(ws + WS_CTL);
    for (int u = tid; u < (LDS_BYTES - LDSCTL_OFF) / 4; u += NWAVES * 64) ((LAS unsigned*)(lds + LDSCTL_OFF))[u] = 0u;
    __syncthreads();
    XcdBarrier bar; bar.bar = (unsigned*)(ctl + CW_BAR); bar.x = 0; bar.st = nullptr;
    if (!MK_PER_PHASE) bar = xcd_barrier_post((unsigned*)(ctl + CW_BAR), MISC + 8);
#if defined(BPROBE)
    unsigned long long bp_acc = 0; int bp_k = 0;
#define GRID_BAR() do { const unsigned long long t_ = __builtin_amdgcn_s_memrealtime(); xcd_barrier(bar); if (bp_k >= BPROBE_LO && bp_k < BPROBE_HI) bp_acc += __builtin_amdgcn_s_memrealtime() - t_; ++bp_k; } while (0)
#else
#define GRID_BAR() do { if (!MK_PER_PHASE) xcd_barrier(bar); } while (0)
#endif
    const int lo = args.ph_lo, hi = args.ph_hi;
#ifndef PH_MASK
#define PH_MASK 0x7fff
#endif
#define IN(k) (((PH_MASK >> (k)) & 1) && lo <= (k) && (k) < hi)
#define BOTH(k) (IN(k) && IN((k) + 1))
#ifndef PROBE_DUP
#define PROBE_DUP -1
#endif
#define REPS(k) (((k) == PROBE_DUP) ? 2 : 1)

#if defined(GPROBE)
#define GP_ARG(k) ((k) == GPROBE_PHASE ? (unsigned*)(ctl + CW_TP) : (unsigned*)nullptr)
#else
#define GP_ARG(k) ((unsigned*)nullptr)
#endif
#if defined(DPROBE)
#define DP_ARG ((unsigned*)(ctl + CW_TP))
#else
#define DP_ARG ((unsigned*)nullptr)
#endif
#if defined(PPROBE)
    unsigned long long pp_t0 = 0, pp_t1 = 0;
#define PP_BEGIN(k) do { if ((k) == PPROBE) pp_t0 = __builtin_amdgcn_s_memrealtime(); } while (0)
#define PP_END(k) do { if ((k) == PPROBE) pp_t1 = __builtin_amdgcn_s_memrealtime(); } while (0)
#else
#define PP_BEGIN(k) do {} while (0)
#define PP_END(k) do {} while (0)
#endif
#if defined(TPROBE)
    unsigned long long tp_c0 = 0, tp_r0 = 0, tp_c1 = 0, tp_r1 = 0;
#define TP_BEGIN(k) do { if ((k) == TPROBE) { tp_c0 = __builtin_amdgcn_s_memtime(); tp_r0 = __builtin_amdgcn_s_memrealtime(); } } while (0)
#define TP_END(k) do { if ((k) == TPROBE) { tp_c1 = __builtin_amdgcn_s_memtime(); tp_r1 = __builtin_amdgcn_s_memrealtime(); } } while (0)
#else
#define TP_BEGIN(k) do {} while (0)
#define TP_END(k) do {} while (0)
#endif
    const float* x_p = args.in[0]; const float* x_s = args.in[1];
    const float* attn_pre_g = args.in[2]; const float* attn_post_g = args.in[3]; const float* ffn_pre_g = args.in[4]; const float* ffn_post_g = args.in[5];
    float* out = args.out;
    bf16* XN = (bf16*)(ws + WS_XN); bf16* QB = (bf16*)(ws + WS_Q); bf16* KB = (bf16*)(ws + WS_K); bf16* VB = (bf16*)(ws + WS_V); bf16* GB = (bf16*)(ws + WS_G); bf16* MB = (bf16*)(ws + WS_MB);
    float* ROPE_C = (float*)(ws + WS_ROPE_C); float* ROPE_S = (float*)(ws + WS_ROPE_S); float* RS = (float*)(ws + WS_RS);
    constexpr size_t TSTEP_D = (size_t)256 * D * 2, TSTEP_FF = (size_t)256 * FF * 2, TSTEP_CONV = (size_t)254 * D * 2;

    if (IN(0)) for (int rep_ = 0; rep_ < REPS(0); ++rep_) { PP_BEGIN(0);
        LAS float* scr = (LAS float*)(lds + RING_OFF + wave * 16384);
        p0_matrix(args.in[6], D, 3 * D, (bf16*)(ws + WS_WQKV0), attn_pre_g, 0, 0, scr, gw, NGW, lane);
        p0_matrix(args.in[8], D, D, (bf16*)(ws + WS_WO0), nullptr, 0, 0, scr, gw, NGW, lane);
        p0_matrix(args.in[18], D, FF2, (bf16*)(ws + WS_WIN0), ffn_pre_g, 1, 0, scr, gw, NGW, lane);
        p0_matrix(args.in[21], FF, D, (bf16*)(ws + WS_WOUT0), nullptr, 0, 0, scr, gw, NGW, lane);
        p0_matrix(args.in[9], D, D, (bf16*)(ws + WS_WQKV1), attn_pre_g + D, 2, 0, scr, gw, NGW, lane);
        p0_matrix(args.in[10], D, D, (bf16*)(ws + WS_WQKV1), attn_pre_g + D, 2, D, scr, gw, NGW, lane);
        p0_matrix(args.in[11], D, D, (bf16*)(ws + WS_WQKV1), attn_pre_g + D, 0, 2 * D, scr, gw, NGW, lane);
        p0_matrix(args.in[17], D, D, (bf16*)(ws + WS_WO1), nullptr, 0, 0, scr, gw, NGW, lane);
        p0_matrix(args.in[18] + (size_t)D * FF2, D, FF2, (bf16*)(ws + WS_WIN1), ffn_pre_g + D, 1, 0, scr, gw, NGW, lane);
        p0_matrix(args.in[21] + (size_t)FF * D, FF, D, (bf16*)(ws + WS_WOUT1), nullptr, 0, 0, scr, gw, NGW, lane);
        for (int i = gw * 64 + lane; i < T_S * 32; i += NGW * 64) {
            const int t = i >> 5, d = i & 31;
            double inv = 1.0; for (int q = 0; q < d; ++q) inv *= 0.7498942093324559;
            const double ang = (double)t * inv;
            const double k = __builtin_rint(ang * 0.15915494309189535);
            double xr = __builtin_fma(-k, 6.283185307179586, ang); xr = __builtin_fma(-k, 2.4492935982947064e-16, xr);
            double s, c; sincos_small(xr, s, c);
            ROPE_C[i] = (float)c; ROPE_S[i] = (float)s;
        }
        thin_pass<0>(x_p, x_s, XN, nullptr, nullptr, RS, nullptr, gw, NGW, lane);
        PP_END(0); if (BOTH(0)) GRID_BAR();
    }
    if (IN(1)) for (int rep_ = 0; rep_ < REPS(1); ++rep_) { PP_BEGIN(1);
        pg8::Gemm g{XN, (const bf16*)(ws + WS_WQKV0), M, 3 * D, D, TSTEP_D}; pg8::StaticOrder S; S.init(M, 3 * D, G, bx);
        pg8::EpiBf16<0> E{QB, D, RS, D, (size_t)(WS_K - WS_Q) / 2, att::QSCALE};
        pg8::gemm_phase<pg8::EpiBf16<0>, pg8::StaticOrder, true, true>(lds + RING_OFF, g, S, E, GP_ARG(1));
        PP_END(1); if (BOTH(1)) GRID_BAR();
    }
    if (IN(2)) for (int rep_ = 0; rep_ < REPS(2); ++rep_) { PP_BEGIN(2);
        constexpr int NU_P = 4 * 16 * 16, NU = NU_P + 8 * 16 * 32;
        const int per = (NU + G - 1) / G, u0 = vcu * per, u1 = (u0 + per < NU) ? u0 + per : NU;
        for (int u = u0; u < u1; ++u) {
            size_t tok0; int rows, h, R;
            if (u < NU_P) { const int b = u >> 8, r = u & 255; tok0 = (size_t)b * T_P; rows = 64; h = r >> 4; R = (r & 15) * 4; }
            else { const int v = u - NU_P, b = v >> 9, r = v & 511; tok0 = (size_t)M_P + (size_t)b * T_S; rows = 128; h = r >> 5; R = (r & 31) * 4; }
            __syncthreads();
            att::na_unit(tok0, rows, h, R, QB, KB, VB, MB, args.in[7] + h * 465, (att::lptr)(lds + RING_OFF), tid, wave, lane);
        }
        __syncthreads();
        PP_END(2); if (BOTH(2)) GRID_BAR();
    }
    if (IN(3)) for (int rep_ = 0; rep_ < REPS(3); ++rep_) { PP_BEGIN(3);
        pg8::Gemm g{MB, (const bf16*)(ws + WS_WO0), M, D, D, TSTEP_D}; pg8::StaticOrder S; S.init(M, D, G, bx);
        #if FUSE_THIN
        pg8::EpiThin<1> E{QB, XN, attn_post_g, RS, nullptr, (unsigned*)(ctl + CW_PANEL + 0 * PANEL_BANK), (PG8_LAS unsigned*)(lds + MISC_OFF + 64), D / 256};
        pg8::gemm_phase<pg8::EpiThin<1>, pg8::StaticOrder, true, true>(lds + RING_OFF, g, S, E);
#else
        pg8::EpiBf16<0> E{QB, D, nullptr, 0, 0, 1.f};
        pg8::gemm_phase<pg8::EpiBf16<0>, pg8::StaticOrder, true, true>(lds + RING_OFF, g, S, E);
#endif
        PP_END(3); if (BOTH(3)) GRID_BAR();
    }
    if (!FUSE_THIN && IN(4)) for (int rep_ = 0; rep_ < REPS(4); ++rep_) { PP_BEGIN(4); thin_pass<1>(nullptr, nullptr, XN, QB, attn_post_g, RS, nullptr, gw, NGW, lane); PP_END(4); if (BOTH(4)) GRID_BAR(); }
#if defined(PROBE_NULL5)
    if (IN(5)) {
        pg8::Gemm g{XN - D, (const bf16*)(ws + WS_WIN0), M, FF2, D, TSTEP_CONV}; pg8::StaticOrder S; S.init_tiles(NMT_CONV, FF2 / 256, G, bx);
        pg8::EpiNull E{(float*)(ws + WS_PARK)};
        pg8::gemm_phase<pg8::EpiNull, pg8::StaticOrder, true, true>(lds + RING_OFF, g, S, E);
        GRID_BAR();
    }
#endif
    if (IN(5)) for (int rep_ = 0; rep_ < REPS(5); ++rep_) { PP_BEGIN(5); TP_BEGIN(5);
        pg8::Gemm g{XN - D, (const bf16*)(ws + WS_WIN0), M, FF2, D, TSTEP_CONV}; pg8::StaticOrder S; S.init_tiles(NMT_CONV, FF2 / 256, G, bx);
        pg8::EpiConvGlu E{GB, args.in[19], args.in[20], (PG8_LAS float*)(lds + XCH_OFF), M, RS, (PG8_LAS float*)(lds + XCH_OFF + 8192)};
        pg8::gemm_phase<pg8::EpiConvGlu, pg8::StaticOrder, true, true>(lds + RING_OFF, g, S, E, GP_ARG(5));
        TP_END(5); PP_END(5); if (BOTH(5)) GRID_BAR();
    }
    if (IN(6)) for (int rep_ = 0; rep_ < REPS(6); ++rep_) { PP_BEGIN(6); TP_BEGIN(6);
        pg8::Gemm g{GB, (const bf16*)(ws + WS_WOUT0), M, D, FF, TSTEP_FF}; pg8::StaticOrder S; S.init(M, D, G, bx);
        #if FUSE_THIN
        pg8::EpiThin<1> E{MB, XN, ffn_post_g, RS, nullptr, (unsigned*)(ctl + CW_PANEL + 1 * PANEL_BANK), (PG8_LAS unsigned*)(lds + MISC_OFF + 64), D / 256};
        pg8::gemm_phase<pg8::EpiThin<1>, pg8::StaticOrder, true, true>(lds + RING_OFF, g, S, E);
#else
        pg8::EpiBf16<0> E{MB, D, nullptr, 0, 0, 1.f};
        pg8::gemm_phase<pg8::EpiBf16<0>, pg8::StaticOrder, true, true>(lds + RING_OFF, g, S, E);
#endif
        TP_END(6); PP_END(6); if (BOTH(6)) GRID_BAR();
    }
    if (!FUSE_THIN && IN(7)) for (int rep_ = 0; rep_ < REPS(7); ++rep_) { PP_BEGIN(7); thin_pass<1>(nullptr, nullptr, XN, MB, ffn_post_g, RS, nullptr, gw, NGW, lane); PP_END(7); if (BOTH(7)) GRID_BAR(); }
    if (IN(8)) for (int rep_ = 0; rep_ < REPS(8); ++rep_) { PP_BEGIN(8);
        pg8::Gemm g{XN, (const bf16*)(ws + WS_WQKV1), M, 3 * D, D, TSTEP_D}; pg8::StaticOrder S; S.init(M, 3 * D, G, bx);
        pg8::EpiRope E{QB, KB, VB, ROPE_C, ROPE_S, att::QSCALE, RS, (unsigned*)(ctl + CW_KMAX)};
        pg8::gemm_phase<pg8::EpiRope, pg8::StaticOrder, true, true>(lds + RING_OFF, g, S, E, GP_ARG(8));
        PP_END(8); if (BOTH(8)) GRID_BAR();
    }
#if defined(PROBE_DAV)
    if (IN(9)) for (int vrep_ = 0; vrep_ < 2; ++vrep_) { const int variant_ = vrep_ == 0 ? PROBE_DAV : 0;
#else
    if (IN(9)) { const int variant_ = 0;
#endif
    for (int rep_ = 0; rep_ < REPS(9); ++rep_) { PP_BEGIN(9); TP_BEGIN(9);
        float lam;
        { const float a = wave_sum(args.in[12][lane] * args.in[13][lane]), b = wave_sum(args.in[14][lane] * args.in[15][lane]); lam = __expf(a) - __expf(b) + LAMBDA_INIT; }
        float* park = (float*)(ws + WS_PARK) + (size_t)bx * 32768;
        constexpr int NP = 4 * 8 * 16, NS = 8 * 8 * 32;
#pragma clang loop unroll(disable)
        for (int id = vcu; id < NP + NS; id += G) {
            size_t rowbase; int T, h, qb, bidx;
            if (id < NP) { const int bh = id >> 4; qb = id & 15; bidx = bh >> 3; rowbase = (size_t)bidx * T_P; T = T_P; h = bh & 7; }
            else { const int bh = (id - NP) >> 5; qb = (id - NP) & 31; bidx = 4 + (bh >> 3); rowbase = (size_t)M_P + (size_t)(bh >> 3) * T_S; T = T_S; h = bh & 7; }
            att::da_unit(rowbase, T, h, qb, QB, KB, VB, MB, park, lam, 1.0f - LAMBDA_INIT, args.in[16], (const unsigned*)(ctl + CW_KMAX) + bidx * 16, (att::lptr)(lds + RING_OFF), tid, wave, lane, DP_ARG, variant_);
        }
        TP_END(9); PP_END(9); if (BOTH(9)) GRID_BAR();
    } }
    if (IN(10)) for (int rep_ = 0; rep_ < REPS(10); ++rep_) { PP_BEGIN(10);
        pg8::Gemm g{MB, (const bf16*)(ws + WS_WO1), M, D, D, TSTEP_D}; pg8::StaticOrder S; S.init(M, D, G, bx);
        #if FUSE_THIN
        pg8::EpiThin<1> E{QB, XN, attn_post_g + D, RS, nullptr, (unsigned*)(ctl + CW_PANEL + 2 * PANEL_BANK), (PG8_LAS unsigned*)(lds + MISC_OFF + 64), D / 256};
        pg8::gemm_phase<pg8::EpiThin<1>, pg8::StaticOrder, true, true>(lds + RING_OFF, g, S, E);
#else
        pg8::EpiBf16<0> E{QB, D, nullptr, 0, 0, 1.f};
        pg8::gemm_phase<pg8::EpiBf16<0>, pg8::StaticOrder, true, true>(lds + RING_OFF, g, S, E);
#endif
        PP_END(10); if (BOTH(10)) GRID_BAR();
    }
    if (!FUSE_THIN && IN(11)) for (int rep_ = 0; rep_ < REPS(11); ++rep_) { PP_BEGIN(11); thin_pass<1>(nullptr, nullptr, XN, QB, attn_post_g + D, RS, nullptr, gw, NGW, lane); PP_END(11); if (BOTH(11)) GRID_BAR(); }
    if (IN(12)) for (int rep_ = 0; rep_ < REPS(12); ++rep_) { PP_BEGIN(12);
        pg8::Gemm g{XN - D, (const bf16*)(ws + WS_WIN1), M, FF2, D, TSTEP_CONV}; pg8::StaticOrder S; S.init_tiles(NMT_CONV, FF2 / 256, G, bx);
        pg8::EpiConvGlu E{GB, args.in[19] + 3 * FF2, args.in[20] + FF2, (PG8_LAS float*)(lds + XCH_OFF), M, RS, (PG8_LAS float*)(lds + XCH_OFF + 8192)};
        pg8::gemm_phase<pg8::EpiConvGlu, pg8::StaticOrder, true, true>(lds + RING_OFF, g, S, E);
        PP_END(12); if (BOTH(12)) GRID_BAR();
    }
    if (IN(13)) for (int rep_ = 0; rep_ < REPS(13); ++rep_) { PP_BEGIN(13);
        pg8::Gemm g{GB, (const bf16*)(ws + WS_WOUT1), M, D, FF, TSTEP_FF}; pg8::StaticOrder S; S.init(M, D, G, bx);
        #if FUSE_THIN
        pg8::EpiThin<2> E{MB, XN, ffn_post_g + D, RS, out, (unsigned*)(ctl + CW_PANEL + 3 * PANEL_BANK), (PG8_LAS unsigned*)(lds + MISC_OFF + 64), D / 256};
        pg8::gemm_phase<pg8::EpiThin<2>, pg8::StaticOrder, true, true>(lds + RING_OFF, g, S, E);
#else
        pg8::EpiBf16<0> E{MB, D, nullptr, 0, 0, 1.f};
        pg8::gemm_phase<pg8::EpiBf16<0>, pg8::StaticOrder, true, true>(lds + RING_OFF, g, S, E);
#endif
        PP_END(13); if (BOTH(13)) GRID_BAR();
    }
    if (!FUSE_THIN && IN(14)) for (int rep_ = 0; rep_ < REPS(14); ++rep_) { PP_BEGIN(14); thin_pass<2>(nullptr, nullptr, XN, MB, ffn_post_g + D, nullptr, out, gw, NGW, lane); }
#if defined(DPROBE)
    if (bx == 0 && hi > 14) {
        const unsigned long long tk = (unsigned long long)__hip_atomic_load(ctl + CW_TP, __ATOMIC_RELAXED, __HIP_MEMORY_SCOPE_AGENT);
        const unsigned long long t0_ = __builtin_amdgcn_s_memrealtime(); while (__builtin_amdgcn_s_memrealtime() - t0_ < tk) __builtin_amdgcn_s_sleep(16); }
#endif
#if defined(PPROBE)
    if (hi > 14) {
        const unsigned dur = (unsigned)(pp_t1 - pp_t0);
        if (tid == 0) { if (PPROBE_STAT == 1) atomicMax((unsigned*)(ctl + CW_TP), dur); else if (PPROBE_STAT == 2) atomicMax((unsigned*)(ctl + CW_TP), 0x40000000u - dur); else if (bx == 0) __hip_atomic_store(ctl + CW_TP, dur, __ATOMIC_RELAXED, __HIP_MEMORY_SCOPE_AGENT); }
        xcd_barrier(bar);
        if (bx == 0) { unsigned v = __hip_atomic_load(ctl + CW_TP, __ATOMIC_RELAXED, __HIP_MEMORY_SCOPE_AGENT); if (PPROBE_STAT == 2) v = 0x40000000u - v;
            const unsigned long long tk = (unsigned long long)v * PPROBE_SCALE;
            const unsigned long long t0_ = __builtin_amdgcn_s_memrealtime(); while (__builtin_amdgcn_s_memrealtime() - t0_ < tk) __builtin_amdgcn_s_sleep(16); }
    }
#endif
#if defined(BPROBE)
    if (hi > 14) {
        if (bx == BPROBE_BLOCK && tid == 0) __hip_atomic_store(ctl + CW_TP, (unsigned)bp_acc, __ATOMIC_RELAXED, __HIP_MEMORY_SCOPE_AGENT);
        xcd_barrier(bar);
        if (bx == 0) { const unsigned long long tk = (unsigned long long)__hip_atomic_load(ctl + CW_TP, __ATOMIC_RELAXED, __HIP_MEMORY_SCOPE_AGENT);
            const unsigned long long t0_ = __builtin_amdgcn_s_memrealtime(); while (__builtin_amdgcn_s_memrealtime() - t0_ < tk) __builtin_amdgcn_s_sleep(16); }
    }
#endif
#if defined(GPROBE)
    if (bx == 0 && hi > 14) {
        const unsigned long long tk = (unsigned long long)__hip_atomic_load(ctl + CW_TP, __ATOMIC_RELAXED, __HIP_MEMORY_SCOPE_AGENT) * GPROBE_SCALE;
        const unsigned long long t0_ = __builtin_amdgcn_s_memrealtime(); while (__builtin_amdgcn_s_memrealtime() - t0_ < tk) __builtin_amdgcn_s_sleep(16);
    }
#endif
#if defined(TPROBE)
    if (bx == 0 && hi > 14) {
        const unsigned long long mhz = (tp_c1 - tp_c0) * 100ull / (tp_r1 - tp_r0 + 1ull);
        const unsigned long long t0_ = __builtin_amdgcn_s_memrealtime(); while (__builtin_amdgcn_s_memrealtime() - t0_ < mhz * 100ull) __builtin_amdgcn_s_sleep(16);
    }
#endif
#undef IN
#undef BOTH
#undef GRID_BAR
}

extern "C" void kernel_launch(void* const* d_in, const int* in_sizes, int n_in, void* d_out, int out_size, void* d_ws, size_t ws_size, hipStream_t stream) {
    static int grid = 0;
    if (grid == 0) {
        if (n_in != 22 || in_sizes[0] != M_P * D || in_sizes[1] != M_S * D || out_size != M * D || ws_size < WS_END) {
            fprintf(stderr, "kernel_launch: unexpected shapes (n_in %d, in0 %d, in1 %d, out %d, ws %zu); nothing launched\n", n_in, n_in > 0 ? in_sizes[0] : -1, n_in > 1 ? in_sizes[1] : -1, out_size, ws_size); grid = -1; return; }
        int dev = 0, cus = 0, per_cu = 0;
        if (hipGetDevice(&dev) != hipSuccess || hipDeviceGetAttribute(&cus, hipDeviceAttributeMultiprocessorCount, dev) != hipSuccess) { fprintf(stderr, "kernel_launch: device query failed\n"); grid = -1; return; }
        if (hipFuncSetAttribute((const void*)mega_fwd, hipFuncAttributeMaxDynamicSharedMemorySize, LDS_BYTES) != hipSuccess) { fprintf(stderr, "kernel_launch: hipFuncSetAttribute failed\n"); grid = -1; return; }
        if (hipOccupancyMaxActiveBlocksPerMultiprocessor(&per_cu, (const void*)mega_fwd, NWAVES * 64, LDS_BYTES) != hipSuccess || per_cu < 1) { fprintf(stderr, "kernel_launch: occupancy query says %d blocks per CU\n", per_cu); }
        (void)hipGetLastError();
        grid = cus;
    }
    if (grid < 0) return;
    if (hipMemsetAsync((char*)d_ws + WS_CTL, 0, CTL_ZERO_BYTES, stream) != hipSuccess) { fprintf(stderr, "kernel_launch: memset failed\n"); return; }
    Args a{};
    for (int i = 0; i < 22; ++i) a.in[i] = (const float*)d_in[i];
    a.out = (float*)d_out; a.ws = (unsigned char*)d_ws;
#if MK_PER_PHASE
    for (int p = 0; p < NPH; ++p) { a.ph_lo = p; a.ph_hi = p + 1; hipLaunchKernelGGL(mega_fwd, dim3(grid), dim3(NWAVES * 64), LDS_BYTES, stream, a); }
#else
    a.ph_lo = 0; a.ph_hi = NPH;
    hipLaunchKernelGGL(mega_fwd, dim3(grid), dim3(NWAVES * 64), LDS_BYTES, stream, a);
#endif
    const hipError_t le = hipPeekAtLastError();
    if (le != hipSuccess) fprintf(stderr, "kernel_launch: launch failed: %s\n", hipGetErrorName(le));
}
```

```cpp
#include <hip/hip_runtime.h>
#include <cstdio>
#include <cstdint>
#include <cmath>
#define GAS __attribute__((address_space(1)))
#define LAS __attribute__((address_space(3)))
typedef unsigned short bf16;
typedef unsigned v4u __attribute__((ext_vector_type(4)));
typedef float f32x4 __attribute__((ext_vector_type(4)));
typedef short bf16x8 __attribute__((ext_vector_type(8)));
typedef GAS unsigned gu32;
typedef GAS unsigned long long gu64;
__device__ __forceinline__ int lane_id_fresh() { int x; asm volatile("v_mbcnt_lo_u32_b32 %0, -1, 0\n\tv_mbcnt_hi_u32_b32 %0, -1, %0" : "=v"(x)); return x; }
#define LANE_ID() lane_id_fresh()
#define RLX_AGENT __ATOMIC_RELAXED, __HIP_MEMORY_SCOPE_AGENT
#define LDS_WAIT() asm volatile("s_waitcnt lgkmcnt(0)" ::: "memory")
#define VM_WAIT() asm volatile("s_waitcnt vmcnt(0)" ::: "memory")
__device__ __forceinline__ unsigned long long rt() { return __builtin_amdgcn_s_memrealtime(); }
__device__ __forceinline__ unsigned f2bf(float f) { unsigned u = __builtin_bit_cast(unsigned, f); return (u + 0x7fffu + ((u >> 16) & 1u)) >> 16; }
__device__ __forceinline__ unsigned pk2(float lo, float hi) { return f2bf(lo) | (f2bf(hi) << 16); }
constexpr int D = 1024, M_P = 4 * 4096, M_S = 8 * 8192, M = M_P + M_S, T_P = 4096, T_S = 8192, FF = 2816, FF2 = 2 * FF;
constexpr int NMT_CONV = (M + 253) / 254;
constexpr float NORM_EPS = 1e-6f;
constexpr float LAMBDA_INIT = 0.35550907f;

__device__ __forceinline__ float wave_sum(float v) {
#pragma unroll
    for (int o = 1; o < 64; o <<= 1) v += __shfl_xor(v, o);
    return v;
}
__device__ __forceinline__ f32x4 bf4_to_f32(unsigned long long w) {
    f32x4 v; v.x = __uint_as_float((unsigned)(w & 0xffffull) << 16); v.y = __uint_as_float((unsigned)((w >> 16) & 0xffffull) << 16);
    v.z = __uint_as_float((unsigned)((w >> 32) & 0xffffull) << 16); v.w = __uint_as_float((unsigned)(w >> 48) << 16); return v;
}
__device__ __forceinline__ void bf8_to_f32(v4u w, f32x4& a, f32x4& b) {
    a.x = __uint_as_float(w.x << 16); a.y = __uint_as_float(w.x & 0xffff0000u); a.z = __uint_as_float(w.y << 16); a.w = __uint_as_float(w.y & 0xffff0000u);
    b.x = __uint_as_float(w.z << 16); b.y = __uint_as_float(w.z & 0xffff0000u); b.z = __uint_as_float(w.w << 16); b.w = __uint_as_float(w.w & 0xffff0000u);
}
__device__ __forceinline__ float sq4(f32x4 v) { return (v.x * v.x + v.y * v.y) + (v.z * v.z + v.w * v.w); }
template <int MODE, int R = 4>
__device__ __forceinline__ void thin_rows(const float* xp, const float* xs, bf16* xb, const bf16* mb, const float* gpost, float* rs, float* out, int row0, int row1, int rstep, int lane) {
    f32x4 g[2][2];
    if (MODE != 0) {
#pragma unroll
        for (int j = 0; j < 2; ++j) { g[j][0] = *(const f32x4*)(gpost + 8 * lane + 512 * j); g[j][1] = *(const f32x4*)(gpost + 8 * lane + 512 * j + 4); }
    }
    for (int rb = row0; rb < row1; rb += rstep) {
        f32x4 x[R][2][2];
        if (MODE == 0) { const float* xr = rb < M_P ? xp + (size_t)rb * D : xs + (size_t)(rb - M_P) * D;
#pragma unroll
            for (int r = 0; r < R; ++r)
#pragma unroll
                for (int j = 0; j < 2; ++j) { x[r][j][0] = *(const GAS f32x4*)(xr + (size_t)r * D + 8 * lane + 512 * j); x[r][j][1] = *(const GAS f32x4*)(xr + (size_t)r * D + 8 * lane + 512 * j + 4); }
        } else {
            v4u xw[R][2], mw[R][2];
#pragma unroll
            for (int r = 0; r < R; ++r)
#pragma unroll
                for (int j = 0; j < 2; ++j) { xw[r][j] = *(const GAS v4u*)(xb + (size_t)(rb + r) * D + 8 * lane + 512 * j); mw[r][j] = *(const GAS v4u*)(mb + (size_t)(rb + r) * D + 8 * lane + 512 * j); }
            f32x4 mv[R][2][2]; float ss[R];
#pragma unroll
            for (int r = 0; r < R; ++r) { ss[r] = 0.f;
#pragma unroll
                for (int j = 0; j < 2; ++j) { bf8_to_f32(xw[r][j], x[r][j][0], x[r][j][1]); bf8_to_f32(mw[r][j], mv[r][j][0], mv[r][j][1]); ss[r] += sq4(mv[r][j][0]) + sq4(mv[r][j][1]); } }
#pragma unroll
            for (int o = 1; o < 64; o <<= 1) {
#pragma unroll
                for (int r = 0; r < R; ++r) ss[r] += __shfl_xor(ss[r], o); }
#pragma unroll
            for (int r = 0; r < R; ++r) { const float rm = __builtin_amdgcn_rsqf(ss[r] * (1.f / D) + NORM_EPS);
#pragma unroll
                for (int j = 0; j < 2; ++j) { x[r][j][0] = x[r][j][0] + mv[r][j][0] * g[j][0] * rm; x[r][j][1] = x[r][j][1] + mv[r][j][1] * g[j][1] * rm; } }
        }
        if (MODE == 2) {
#pragma unroll
            for (int r = 0; r < R; ++r)
#pragma unroll
                for (int j = 0; j < 2; ++j) { *(GAS f32x4*)(out + (size_t)(rb + r) * D + 8 * lane + 512 * j) = x[r][j][0]; *(GAS f32x4*)(out + (size_t)(rb + r) * D + 8 * lane + 512 * j + 4) = x[r][j][1]; }
        } else {
            float s2[R];
#pragma unroll
            for (int r = 0; r < R; ++r) { s2[r] = 0.f;
#pragma unroll
                for (int j = 0; j < 2; ++j) { s2[r] += sq4(x[r][j][0]) + sq4(x[r][j][1]);
                    v4u w; w.x = pk2(x[r][j][0].x, x[r][j][0].y); w.y = pk2(x[r][j][0].z, x[r][j][0].w); w.z = pk2(x[r][j][1].x, x[r][j][1].y); w.w = pk2(x[r][j][1].z, x[r][j][1].w);
                    *(GAS v4u*)(xb + (size_t)(rb + r) * D + 8 * lane + 512 * j) = w; } }
#pragma unroll
            for (int o = 1; o < 64; o <<= 1) {
#pragma unroll
                for (int r = 0; r < R; ++r) s2[r] += __shfl_xor(s2[r], o); }
            if (lane < R) { float v = s2[0];
#pragma unroll
                for (int r = 1; r < R; ++r) v = lane == r ? s2[r] : v;
                rs[rb + lane] = __builtin_amdgcn_rsqf(v * (1.f / D) + NORM_EPS); }
        }
    }
}

template <int MODE, int R>
__device__ __forceinline__ void thin_rows_lean(bf16* xb, const bf16* mb, const float* gpost, float* rs, float* out, int row0, int row1, int lane) {
    for (int rb = row0; rb < row1; rb += R) {
        v4u xw[R][2], mw[R][2]; float ss[R], s2[R];
#pragma unroll
        for (int r = 0; r < R; ++r)
#pragma unroll
            for (int j = 0; j < 2; ++j) { xw[r][j] = *(const GAS v4u*)(xb + (size_t)(rb + r) * D + 8 * lane + 512 * j); mw[r][j] = *(const GAS v4u*)(mb + (size_t)(rb + r) * D + 8 * lane + 512 * j); }
#pragma unroll
        for (int r = 0; r < R; ++r) { ss[r] = 0.f;
#pragma unroll
            for (int j = 0; j < 2; ++j) { f32x4 a, b; bf8_to_f32(mw[r][j], a, b); ss[r] += sq4(a) + sq4(b); } }
#pragma unroll
        for (int o = 1; o < 64; o <<= 1) {
#pragma unroll
            for (int r = 0; r < R; ++r) ss[r] += __shfl_xor(ss[r], o); }
#pragma unroll
        for (int r = 0; r < R; ++r) { const float rm = __builtin_amdgcn_rsqf(ss[r] * (1.f / D) + NORM_EPS); s2[r] = 0.f;
#pragma unroll
            for (int j = 0; j < 2; ++j) { f32x4 xa, xb2, ma, mb2; bf8_to_f32(xw[r][j], xa, xb2); bf8_to_f32(mw[r][j], ma, mb2);
                const f32x4 g0 = *(const f32x4*)(gpost + 8 * lane + 512 * j), g1 = *(const f32x4*)(gpost + 8 * lane + 512 * j + 4);
                xa = xa + ma * g0 * rm; xb2 = xb2 + mb2 * g1 * rm;
                if (MODE == 2) { *(GAS f32x4*)(out + (size_t)(rb + r) * D + 8 * lane + 512 * j) = xa; *(GAS f32x4*)(out + (size_t)(rb + r) * D + 8 * lane + 512 * j + 4) = xb2; }
                else { s2[r] += sq4(xa) + sq4(xb2);
                    v4u w; w.x = pk2(xa.x, xa.y); w.y = pk2(xa.z, xa.w); w.z = pk2(xb2.x, xb2.y); w.w = pk2(xb2.z, xb2.w);
                    *(GAS v4u*)(xb + (size_t)(rb + r) * D + 8 * lane + 512 * j) = w; } } }
        if (MODE != 2) {
#pragma unroll
            for (int o = 1; o < 64; o <<= 1) {
#pragma unroll
                for (int r = 0; r < R; ++r) s2[r] += __shfl_xor(s2[r], o); }
            if (lane < R) { float v = s2[0];
#pragma unroll
                for (int r = 1; r < R; ++r) v = lane == r ? s2[r] : v;
                rs[rb + lane] = __builtin_amdgcn_rsqf(v * (1.f / D) + NORM_EPS); }
        }
    }
}
template <int MODE>
__device__ __forceinline__ void thin_pass(const float* xp, const float* xs, bf16* xb, const bf16* mb, const float* gpost, float* rs, float* out, int gw, int NGW, int lane) {
    thin_rows<MODE>(xp, xs, xb, mb, gpost, rs, out, gw * 4, M, NGW * 4, lane);
}

namespace pg8 {
#define PG8_LAS __attribute__((address_space(3)))
typedef unsigned short bf16_t;
typedef short bf16x8 __attribute__((ext_vector_type(8)));
typedef float f32x4 __attribute__((ext_vector_type(4)));
typedef unsigned u32x4 __attribute__((ext_vector_type(4)));
constexpr int BM = 256, BK = 64, HALF = 128, HTB = HALF * BK * 2  , STAGE_BYTES = 8 * HTB, NXCD = 8, WGM = 8;

__host__ __device__ __forceinline__ int lds_byte(int r, int c) { const int st = (r >> 4) * 2 + (c >> 5), rr = r & 15, cc = c & 31, ob = rr * 64 + cc * 2; return st * 1024 + (ob ^ (((ob >> 9) & 1) << 5)); }
__host__ __device__ __forceinline__ void stage_rc(int b, int& R, int& C) { const int st = b / 1024, sb = b % 1024, swz = sb ^ (((sb >> 9) & 1) << 5); R = (st >> 1) * 16 + swz / 64; C = (st & 1) * 32 + (swz % 64) / 2; }
__host__ __device__ __forceinline__ int perm32(int rho) { const int n = rho >> 4, i = rho & 15; return 8 * (i >> 2) + 4 * n + (i & 3); }

struct Unit { int pm, pn; };
struct Gemm { const bf16_t* A; const bf16_t* Bt; int M, N, K; size_t tstepA; };

struct StaticOrder {
    int nM, nN, nwg, G, c;
    __host__ __device__ void init(int M, int N, int G_, int c_) { nM = M / BM; nN = N / BM; nwg = nM * nN; G = G_; c = c_; }
    __host__ __device__ void init_tiles(int nM_, int nN_, int G_, int c_) { nM = nM_; nN = nN_; nwg = nM * nN; G = G_; c = c_; }
    __host__ __device__ bool next(int i, Unit& u) const {
        const long L = (long)i * G + c; if (L >= nwg) return false;
        int wgid = (int)L; { const int q = nwg / NXCD, r = nwg % NXCD, xcd = wgid % NXCD, off = wgid / NXCD; wgid = (xcd < r ? xcd * (q + 1) : r * (q + 1) + (xcd - r) * q) + off; }
        const int nig = WGM * nN, gid = wgid / nig, fm = gid * WGM, gsz = (nM - fm) < WGM ? (nM - fm) : WGM;
        u.pm = fm + ((wgid % nig) % gsz); u.pn = (wgid % nig) / gsz; return true;
    }
    __device__ __forceinline__ void a_ready(const Unit&) const {}
    __device__ __forceinline__ void done(const Unit&) const {}
};

__device__ __forceinline__ unsigned cvt_pk_bf16(float lo, float hi) { unsigned r; asm volatile("v_cvt_pk_bf16_f32 %0, %1, %2" : "=v"(r) : "v"(lo), "v"(hi)); return r; }
typedef float f32x2 __attribute__((ext_vector_type(2)));
__device__ __forceinline__ f32x2 gelu_pk(f32x2 v) {
    const f32x2 av = __builtin_elementwise_abs(v), d = av * 0.2316418882f + 1.0f;
    f32x2 t; t.x = __builtin_amdgcn_rcpf(d.x); t.y = __builtin_amdgcn_rcpf(d.y);
    f32x2 q = t * 0.5307027145f + (-0.7265760135f); q = q * t + 0.7107068705f; q = q * t + (-0.142248368f); q = q * t + 0.127414796f; q = q * t;
    const f32x2 s = (v * v) * (-0.72134752044f);
    f32x2 e; e.x = __builtin_amdgcn_exp2f(s.x); e.y = __builtin_amdgcn_exp2f(s.y);
    const f32x2 m = v * (q * e), r = v - m;
    f32x2 o; o.x = v.x < 0.f ? m.x : r.x; o.y = v.y < 0.f ? m.y : r.y; return o;
}

template <int ACT  > struct EpiBf16 {
    static constexpr bool PERM = true, AFTER_DRAIN = false, HAS_FLUSH = false; static_assert(ACT == 0 || ACT == 1, "EpiBf16: ACT is 0 (none) or 1 (gelu_pk)");
    bf16_t* O; int ldc; const float* rs; int split_cols; size_t split_stride; float scale0;
    __device__ __forceinline__ void operator()(const f32x4 (&acc)[2][2][4][2], const Unit& u, int wr, int wc, int fr, int fq) const {
        const int row0 = u.pm * BM + wr * 64 + fr; int colt = u.pn * BM; bf16_t* base = O;
        float sc = 1.f; if (split_cols) { const int t = colt / split_cols; base += (size_t)t * split_stride; colt -= t * split_cols; if (t == 0) sc = scale0; }
        const int col0 = colt + wc * 32 + 8 * fq;
#pragma unroll
        for (int ai = 0; ai < 2; ++ai)
#pragma unroll
            for (int m = 0; m < 4; ++m) { bf16_t* rowp = base + (size_t)(row0 + ai * HALF + m * 16) * ldc + col0; const float rsc = rs ? rs[row0 + ai * HALF + m * 16] * sc : sc;
#pragma unroll
                for (int bj = 0; bj < 2; ++bj) { f32x4 v0 = acc[ai][bj][m][0], v1 = acc[ai][bj][m][1];
                    if (ACT == 1) { f32x2 a = gelu_pk((f32x2){v0[0], v0[1]}), b = gelu_pk((f32x2){v0[2], v0[3]}), c = gelu_pk((f32x2){v1[0], v1[1]}), d = gelu_pk((f32x2){v1[2], v1[3]});
                        v0 = (f32x4){a.x, a.y, b.x, b.y}; v1 = (f32x4){c.x, c.y, d.x, d.y}; }
                    v0 = v0 * rsc; v1 = v1 * rsc; u32x4 w; w.x = cvt_pk_bf16(v0[0], v0[1]); w.y = cvt_pk_bf16(v0[2], v0[3]); w.z = cvt_pk_bf16(v1[0], v1[1]); w.w = cvt_pk_bf16(v1[2], v1[3]);
#if defined(EPI_NT_STORE)
                    __builtin_nontemporal_store(w, (u32x4*)(rowp + bj * HALF)); } }
#else
                    *(u32x4*)(rowp + bj * HALF) = w; } }
#endif
    }
};

struct EpiRope {
    static constexpr bool PERM = true, AFTER_DRAIN = false, HAS_FLUSH = false;
    bf16_t* Q; bf16_t* Kk; bf16_t* V; const float* cs; const float* sn; float qscale; const float* rs; unsigned* kmax;
    __device__ __forceinline__ void operator()(const f32x4 (&acc)[2][2][4][2], const Unit& u, int wr, int wc, int fr, int fq) const {
        const int which = u.pn >> 2;
        const int row0 = u.pm * BM + wr * 64 + fr;
        if (which == 2) {
            const int col0 = (u.pn - 8) * BM + wc * 32 + 8 * fq;
#pragma unroll
            for (int ai = 0; ai < 2; ++ai)
#pragma unroll
                for (int m = 0; m < 4; ++m) { bf16_t* rowp = V + (size_t)(row0 + ai * HALF + m * 16) * 1024 + col0; const float r = rs[row0 + ai * HALF + m * 16];
#pragma unroll
                    for (int bj = 0; bj < 2; ++bj) { const f32x4 v0 = acc[ai][bj][m][0] * r, v1 = acc[ai][bj][m][1] * r;
                        u32x4 w; w.x = cvt_pk_bf16(v0[0], v0[1]); w.y = cvt_pk_bf16(v0[2], v0[3]); w.z = cvt_pk_bf16(v1[0], v1[1]); w.w = cvt_pk_bf16(v1[2], v1[3]);
                        *(u32x4*)(rowp + bj * HALF) = w; } }
        } else {
            bf16_t* base = which == 0 ? Q : Kk; const float sc = which == 0 ? qscale : 1.f;
            const int colb = ((u.pn & 3) * 4 + wc) * 64 + 8 * fq; float kn2 = 0.f;
#pragma unroll
            for (int ai = 0; ai < 2; ++ai)
#pragma unroll
                for (int m = 0; m < 4; ++m) { const int row = row0 + ai * HALF + m * 16; const int t = row < 16384 ? (row & 4095) : (row & 8191); const float scr = sc * rs[row];
                    const f32x4 c0 = *(const f32x4*)(cs + t * 32 + 8 * fq), c1 = *(const f32x4*)(cs + t * 32 + 8 * fq + 4);
                    const f32x4 s0 = *(const f32x4*)(sn + t * 32 + 8 * fq), s1 = *(const f32x4*)(sn + t * 32 + 8 * fq + 4);
                    const f32x4 x1a = acc[ai][0][m][0], x1b = acc[ai][0][m][1], x2a = acc[ai][1][m][0], x2b = acc[ai][1][m][1];
                    const f32x4 o1a = (x1a * c0 - x2a * s0) * scr, o1b = (x1b * c1 - x2b * s1) * scr, o2a = (x2a * c0 + x1a * s0) * scr, o2b = (x2b * c1 + x1b * s1) * scr;
                    u32x4 w1, w2; w1.x = cvt_pk_bf16(o1a[0], o1a[1]); w1.y = cvt_pk_bf16(o1a[2], o1a[3]); w1.z = cvt_pk_bf16(o1b[0], o1b[1]); w1.w = cvt_pk_bf16(o1b[2], o1b[3]);
                    w2.x = cvt_pk_bf16(o2a[0], o2a[1]); w2.y = cvt_pk_bf16(o2a[2], o2a[3]); w2.z = cvt_pk_bf16(o2b[0], o2b[1]); w2.w = cvt_pk_bf16(o2b[2], o2b[3]);
                    bf16_t* rowp = base + (size_t)row * 1024 + colb;
                    *(u32x4*)(rowp) = w1; *(u32x4*)(rowp + 32) = w2;
                    if (which == 1) { const f32x4 q4 = o1a * o1a + o1b * o1b + o2a * o2a + o2b * o2b; float ss = (q4[0] + q4[1]) + (q4[2] + q4[3]); ss += __shfl_xor(ss, 16); ss += __shfl_xor(ss, 32); kn2 = fmaxf(kn2, ss); } }
            if (which == 1) { kn2 = fmaxf(kn2, __shfl_xor(kn2, 1)); kn2 = fmaxf(kn2, __shfl_xor(kn2, 2)); kn2 = fmaxf(kn2, __shfl_xor(kn2, 4)); kn2 = fmaxf(kn2, __shfl_xor(kn2, 8));
                const int r0 = u.pm * BM; const int batch = r0 < 16384 ? (r0 >> 12) : 4 + ((r0 - 16384) >> 13);
                if (fr == 0 && fq == 0) atomicMax(kmax + batch * 16 + (u.pn & 3) * 4 + wc, __float_as_uint(kn2)); }
        }
    }
};

template <int CTRL> __device__ __forceinline__ float dpp_f(float old, float src) { return __int_as_float(__builtin_amdgcn_update_dpp(__float_as_int(old), __float_as_int(src), CTRL, 0xf, 0xf, false)); }
__device__ __forceinline__ float gelu_tanh(float x) {
    const float u = 0.7978845608028654f * (x + 0.044715f * x * x * x);
    const float e = __builtin_amdgcn_exp2f(-2.8853900817779268f * u);
    return x * __builtin_amdgcn_rcpf(1.0f + e);
}
struct EpiConvGlu {
    static constexpr bool PERM = true, AFTER_DRAIN = false, HAS_FLUSH = false;
    bf16_t* G; const float* cw; const float* cb; PG8_LAS float* X; int Mrows; const float* rs; PG8_LAS float* WT;
    __device__ __forceinline__ void operator()(f32x4 (&acc)[2][2][4][2], const Unit& u, int wr, int wc, int fr, int fq) const {
        const int xcol = wc * 32 + 8 * fq;
        const int gc0 = u.pn * 128 + xcol;
        float rsv[2][4];
#pragma unroll
        for (int ai = 0; ai < 2; ++ai)
#pragma unroll
            for (int m = 0; m < 4; ++m) { int tr = u.pm * 254 - 1 + ai * HALF + wr * 64 + m * 16 + fr; tr = tr < 0 ? 0 : (tr >= Mrows ? Mrows - 1 : tr); rsv[ai][m] = rs[tr]; }
        { const int tidx = (wr * 4 + wc) * 64 + fq * 16 + fr, e0 = 2 * tidx, t = e0 >> 8, c = e0 & 255;
          const float* src = (t < 3 ? cw + t * 5632 : cb) + (c < 128 ? u.pn * 128 + c : 2816 + u.pn * 128 + c - 128);
          typedef float f32x2v __attribute__((ext_vector_type(2)));
          *(PG8_LAS f32x2v*)(WT + e0) = *(const f32x2v*)src; }
#pragma unroll
        for (int ai = 0; ai < 2; ++ai)
#pragma unroll
            for (int m = 0; m < 4; ++m) {
#pragma unroll
                for (int bj = 0; bj < 2; ++bj)
#pragma unroll
                    for (int n = 0; n < 2; ++n) acc[ai][bj][m][n] = acc[ai][bj][m][n] * rsv[ai][m]; }
#pragma unroll
        for (int ai = 0; ai < 2; ++ai) { const int ch = 2 * ai + wr;
            if (fr == 0) {
#pragma unroll
                for (int bj = 0; bj < 2; ++bj)
#pragma unroll
                    for (int n = 0; n < 2; ++n) *(PG8_LAS f32x4*)(X + ((ch * 2 + 0) * 256 + bj * 128 + xcol + 4 * n)) = acc[ai][bj][0][n]; }
            if (fr == 15) {
#pragma unroll
                for (int bj = 0; bj < 2; ++bj)
#pragma unroll
                    for (int n = 0; n < 2; ++n) *(PG8_LAS f32x4*)(X + ((ch * 2 + 1) * 256 + bj * 128 + xcol + 4 * n)) = acc[ai][bj][3][n]; } }
        asm volatile("s_waitcnt lgkmcnt(0)" ::: "memory"); __builtin_amdgcn_s_barrier(); asm volatile("" ::: "memory");
        const int tg0 = u.pm * 254 - 1 + wr * 64 + fr;
        const int tb = u.pm * 254 - 1; const bool bnd = ((tb + 4096 + 257) >> 12) != ((tb + 4096 - 1) >> 12);
        if (bnd) body<true>(acc, u, wr, wc, fr, fq, xcol, gc0, tg0); else body<false>(acc, u, wr, wc, fr, fq, xcol, gc0, tg0);
    }
    template <bool bnd>
    __device__ __forceinline__ void body(f32x4 (&acc)[2][2][4][2], const Unit& u, int wr, int wc, int fr, int fq, int xcol, int gc0, int tg0) const {
#pragma unroll
        for (int ai = 0; ai < 2; ++ai) { const int ch = 2 * ai + wr;
#pragma unroll
            for (int m = 0; m < 4; ++m) {
                const int row = ai * HALF + wr * 64 + m * 16 + fr; const int tg = tg0 + ai * HALF + m * 16;
                const int ps = tg < 16384 ? (tg & 4095) : (tg & 8191); const int ps1 = (tg + 1) < 16384 ? ((tg + 1) & 4095) : ((tg + 1) & 8191);
                const bool first = bnd && ps == 0, last = bnd && ps1 == 0;
                u32x4 w;
#pragma unroll
                for (int n = 0; n < 2; ++n) {
                    f32x4 wgv[3], wuv[3];
#pragma unroll
                    for (int t = 0; t < 3; ++t) { wgv[t] = *(const PG8_LAS f32x4*)(WT + t * 256 + xcol + 4 * n); wuv[t] = *(const PG8_LAS f32x4*)(WT + t * 256 + 128 + xcol + 4 * n); }
                    const f32x4 bgv = *(const PG8_LAS f32x4*)(WT + 768 + xcol + 4 * n), buv = *(const PG8_LAS f32x4*)(WT + 768 + 128 + xcol + 4 * n);
                    f32x4 pg = (f32x4){0.f, 0.f, 0.f, 0.f}, pu = pg, ng = pg, nu = pg;
                    if (m == 0 && ch > 0) { pg = *(const PG8_LAS f32x4*)(X + (((ch - 1) * 2 + 1) * 256 + xcol + 4 * n)); pu = *(const PG8_LAS f32x4*)(X + (((ch - 1) * 2 + 1) * 256 + 128 + xcol + 4 * n)); }
                    if (m == 3 && ch < 3) { ng = *(const PG8_LAS f32x4*)(X + (((ch + 1) * 2 + 0) * 256 + xcol + 4 * n)); nu = *(const PG8_LAS f32x4*)(X + (((ch + 1) * 2 + 0) * 256 + 128 + xcol + 4 * n)); }
                    float o[4];
#pragma unroll
                    for (int j = 0; j < 4; ++j) {
                        const float cg = acc[ai][0][m][n][j], cu = acc[ai][1][m][n][j];
                        float p0g, p0u, n15g, n15u;
                        if (m > 0) { p0g = dpp_f<0x121>(0.f, acc[ai][0][m > 0 ? m - 1 : 0][n][j]); p0u = dpp_f<0x121>(0.f, acc[ai][1][m > 0 ? m - 1 : 0][n][j]); } else { p0g = pg[j]; p0u = pu[j]; }
                        if (m < 3) { n15g = dpp_f<0x12F>(0.f, acc[ai][0][m < 3 ? m + 1 : 3][n][j]); n15u = dpp_f<0x12F>(0.f, acc[ai][1][m < 3 ? m + 1 : 3][n][j]); } else { n15g = ng[j]; n15u = nu[j]; }
                        float prg = dpp_f<0x111>(p0g, cg), pru = dpp_f<0x111>(p0u, cu);
                        float nxg = dpp_f<0x101>(n15g, cg), nxu = dpp_f<0x101>(n15u, cu);
                        if (first) { prg = 0.f; pru = 0.f; }
                        if (last) { nxg = 0.f; nxu = 0.f; }
                        const float yg = wgv[0][j] * prg + (wgv[1][j] * cg + (wgv[2][j] * nxg + bgv[j]));
                        const float yu = wuv[0][j] * pru + (wuv[1][j] * cu + (wuv[2][j] * nxu + buv[j]));
                        o[j] = gelu_tanh(yg) * yu;
                    }
                    if (n == 0) { w.x = cvt_pk_bf16(o[0], o[1]); w.y = cvt_pk_bf16(o[2], o[3]); } else { w.z = cvt_pk_bf16(o[0], o[1]); w.w = cvt_pk_bf16(o[2], o[3]); }
                }
                if (row >= 1 && row <= 254 && tg < Mrows) *(u32x4*)(G + (size_t)tg * 2816 + gc0) = w;
            }
        }
    }
};

template <int MODE>
struct EpiThin {
    static constexpr bool PERM = true, AFTER_DRAIN = false, HAS_FLUSH = true;
    bf16_t* mb; bf16_t* xb; const float* g; float* rs; float* out; unsigned* cnt; PG8_LAS unsigned* flag; int ntn;
    __device__ __forceinline__ void publish(int wid, int lane) const {
        asm volatile("s_waitcnt vmcnt(0)" ::: "memory"); __builtin_amdgcn_s_barrier(); asm volatile("" ::: "memory");
        const int ppm = (int)flag[1] - 1;
        if (ppm >= 0) {
            if (wid == 0 && lane == 0) { const unsigned old = __hip_atomic_fetch_add(cnt + 64 * ppm, 1u, __ATOMIC_RELAXED, __HIP_MEMORY_SCOPE_AGENT); flag[0] = (old == (unsigned)(ntn - 1)) ? 1u : 0u; }
            asm volatile("s_waitcnt vmcnt(0) lgkmcnt(0)" ::: "memory"); __builtin_amdgcn_s_barrier(); asm volatile("" ::: "memory");
            if (flag[0] != 0u) {
                if (wid == 0) { __builtin_amdgcn_fence(__ATOMIC_ACQUIRE, "agent"); asm volatile("s_waitcnt vmcnt(0)" ::: "memory"); }
                asm volatile("s_waitcnt lgkmcnt(0)" ::: "memory"); __builtin_amdgcn_s_barrier(); asm volatile("" ::: "memory");
                thin_rows_lean<MODE, 4>(xb, mb, g, rs, out, ppm * BM + wid * 32, ppm * BM + wid * 32 + 32, lane);
            }
        }
    }
    __device__ __forceinline__ void operator()(const f32x4 (&acc)[2][2][4][2], const Unit& u, int wr, int wc, int fr, int fq) const {
        const int wid = wr * 4 + wc, lane = fq * 16 + fr;
        u32x4 w[2][4][2];
#pragma unroll
        for (int ai = 0; ai < 2; ++ai)
#pragma unroll
            for (int m = 0; m < 4; ++m)
#pragma unroll
                for (int bj = 0; bj < 2; ++bj) { const f32x4 v0 = acc[ai][bj][m][0], v1 = acc[ai][bj][m][1];
                    w[ai][m][bj].x = cvt_pk_bf16(v0[0], v0[1]); w[ai][m][bj].y = cvt_pk_bf16(v0[2], v0[3]); w[ai][m][bj].z = cvt_pk_bf16(v1[0], v1[1]); w[ai][m][bj].w = cvt_pk_bf16(v1[2], v1[3]); }
        publish(wid, lane);
        asm volatile("s_waitcnt lgkmcnt(0)" ::: "memory"); __builtin_amdgcn_s_barrier(); asm volatile("" ::: "memory");
        if (wid == 0 && lane == 0) flag[1] = (unsigned)(u.pm + 1);
        const __amdgpu_buffer_rsrc_t rsrc = __builtin_amdgcn_make_buffer_rsrc((void*)mb, 0, M * 1024 * 2, 0x00020000);
        const int row0 = u.pm * BM + wr * 64 + fr, col0 = u.pn * BM + wc * 32 + 8 * fq;
#pragma unroll
        for (int ai = 0; ai < 2; ++ai)
#pragma unroll
            for (int m = 0; m < 4; ++m)
#pragma unroll
                for (int bj = 0; bj < 2; ++bj) __builtin_amdgcn_raw_buffer_store_b128(w[ai][m][bj], rsrc, ((row0 + ai * HALF + m * 16) * 1024 + col0 + bj * HALF) * 2, 0, 16);
    }
    __device__ __forceinline__ void flush(const Unit&, int wr, int wc, int fr, int fq) const {
        const int wid = wr * 4 + wc, lane = fq * 16 + fr;
        publish(wid, lane);
        asm volatile("s_waitcnt lgkmcnt(0)" ::: "memory"); __builtin_amdgcn_s_barrier(); asm volatile("" ::: "memory");
        if (wid == 0 && lane == 0) flag[1] = 0u;
        asm volatile("s_waitcnt lgkmcnt(0)" ::: "memory"); __builtin_amdgcn_s_barrier(); asm volatile("" ::: "memory");
    }
};

struct EpiNull {
    static constexpr bool PERM = true, AFTER_DRAIN = false, HAS_FLUSH = false;
    float* sink;
    __device__ __forceinline__ void operator()(const f32x4 (&acc)[2][2][4][2], const Unit& u, int wr, int wc, int fr, int fq) const {
        float s = 0.f;
#pragma unroll
        for (int ai = 0; ai < 2; ++ai)
#pragma unroll
            for (int bj = 0; bj < 2; ++bj)
#pragma unroll
                for (int m = 0; m < 4; ++m)
#pragma unroll
                    for (int n = 0; n < 2; ++n) s += acc[ai][bj][m][n][0] + acc[ai][bj][m][n][1] + acc[ai][bj][m][n][2] + acc[ai][bj][m][n][3];
        if (s == 123456.789f) sink[0] = s;
    }
};
template <class Epi, class Sched, bool ALIGN_EPI = false, bool SP2 = false>
__device__ __forceinline__ void gemm_phase(PG8_LAS unsigned char* lds, const Gemm g, const Sched& S, const Epi& E, int wave_arg, unsigned* tpw = nullptr) {
    const int wid = wave_arg, lane = LANE_ID(), tid = wid * 64 + lane, wr = wid >> 2, wc = wid & 3, fr = lane & 15, fq = lane >> 4;
    const int K = g.K, nt = K / BK;
    unsigned voffA[2], voffB[2];
#pragma unroll
    for (int i = 0; i < 2; ++i) { int R, C; stage_rc(tid * 16 + i * 8192, R, C); const int Rb = Epi::PERM ? ((R & ~31) + perm32(R & 31)) : R;
        voffA[i] = (unsigned)(R * K + C) * 2u; voffB[i] = (unsigned)(Rb * K + C) * 2u; }
    const size_t kstep = (size_t)(BK * 2);
    const size_t hstep = (size_t)HALF * K * 2;
    const size_t tstep = 2 * hstep;
    const unsigned ldsw = (unsigned)wid * 1024u;
    const int aoff = lds_byte(wr * 64 + fr, fq * 8), boff = lds_byte(wc * 32 + fr, fq * 8);
#define PG8_SA(b, h) (((b) * 2 + (h)) * HTB)
#define PG8_SB(b, h) ((4 + (b) * 2 + (h)) * HTB)
#define PG8_STAGE(bufoff, gbase, voff) do { _Pragma("unroll") for (int _i = 0; _i < 2; ++_i) \
        __builtin_amdgcn_global_load_lds((const unsigned*)((const char*)(gbase) + (voff)[_i]), (PG8_LAS unsigned*)(lds + (bufoff) + ldsw + _i * 8192), 16, 0, 0); } while (0)
#define PG8_LDA(dst, b, h) do { _Pragma("unroll") for (int m = 0; m < 4; ++m) _Pragma("unroll") for (int k = 0; k < 2; ++k) dst[m][k] = *(const PG8_LAS bf16x8*)(lds + PG8_SA(b, h) + aoff + m * 2048 + k * 1024); } while (0)
#define PG8_LDB(dst, b, h) do { _Pragma("unroll") for (int n = 0; n < 2; ++n) _Pragma("unroll") for (int k = 0; k < 2; ++k) dst[n][k] = *(const PG8_LAS bf16x8*)(lds + PG8_SB(b, h) + boff + n * 2048 + k * 1024); } while (0)
#define PG8_MMA(ai, bj, At, Bt) do { __builtin_amdgcn_s_setprio(1); _Pragma("unroll") for (int m = 0; m < 4; ++m) _Pragma("unroll") for (int n = 0; n < 2; ++n) _Pragma("unroll") for (int k = 0; k < 2; ++k) \
        acc[ai][bj][m][n] = __builtin_amdgcn_mfma_f32_16x16x32_bf16(Bt[n][k], At[m][k], acc[ai][bj][m][n], 0, 0, 0); __builtin_amdgcn_s_setprio(0); } while (0)
#define PG8_WAIT_V(n) asm volatile("s_waitcnt vmcnt(" #n ")" ::: "memory")
#define PG8_WAIT_L(n) asm volatile("s_waitcnt lgkmcnt(" #n ")" ::: "memory")
#define PG8_BAR __builtin_amdgcn_s_barrier()
#define PG8_SCHED __builtin_amdgcn_sched_barrier(0)
    Unit cur, nxt; int ui = 0;
    if (!S.next(0, cur)) return;
#if defined(GPROBE)
    unsigned long long gp_acc = 0, gp_t = 0; const bool gp_on = tpw != nullptr && blockIdx.x == 0 && wid == 0;
#define GP_MARK() do { if (gp_on) gp_t = __builtin_amdgcn_s_memrealtime(); } while (0)
#define GP_ADD() do { if (gp_on) gp_acc += __builtin_amdgcn_s_memrealtime() - gp_t; } while (0)
#else
#define GP_MARK() do {} while (0)
#define GP_ADD() do {} while (0)
#endif
#if defined(GEMM_STAGGER_TICKS)
    { const unsigned long long t0_ = __builtin_amdgcn_s_memrealtime(); const unsigned long long dly_ = (unsigned long long)((blockIdx.x >> 3) & 3) * GEMM_STAGGER_TICKS;
      while (__builtin_amdgcn_s_memrealtime() - t0_ < dly_) __builtin_amdgcn_s_sleep(8); }
#endif
    f32x4 acc[2][2][4][2];
#pragma unroll
    for (int a = 0; a < 2; ++a)
#pragma unroll
        for (int b = 0; b < 2; ++b)
#pragma unroll
            for (int m = 0; m < 4; ++m)
#pragma unroll
                for (int n = 0; n < 2; ++n) acc[a][b][m][n] = (f32x4){0.f, 0.f, 0.f, 0.f};
    bf16x8 At[4][2], B0[2][2], B1[2][2];
    const char* cA = (const char*)g.A + (size_t)cur.pm * g.tstepA; const char* cB = (const char*)g.Bt + (size_t)cur.pn * tstep;
    S.a_ready(cur);
    if constexpr (SP2) {
        PG8_STAGE(PG8_SB(0, 0), cB, voffB); PG8_STAGE(PG8_SB(0, 1), cB + hstep, voffB); PG8_STAGE(PG8_SA(0, 0), cA, voffA); PG8_STAGE(PG8_SA(0, 1), cA + hstep, voffA);
        if (wr == 1) PG8_BAR;
        PG8_WAIT_V(2); PG8_BAR;
        PG8_STAGE(PG8_SB(1, 0), cB + kstep, voffB); PG8_STAGE(PG8_SA(1, 0), cA + kstep, voffA); PG8_STAGE(PG8_SB(1, 1), cB + hstep + kstep, voffB);
        PG8_WAIT_V(6); PG8_BAR;
    } else {
        PG8_STAGE(PG8_SB(0, 0), cB, voffB); PG8_STAGE(PG8_SA(0, 0), cA, voffA); PG8_STAGE(PG8_SB(0, 1), cB + hstep, voffB); PG8_STAGE(PG8_SA(0, 1), cA + hstep, voffA);
        if (wr == 1) PG8_BAR;
        PG8_WAIT_V(4); PG8_BAR;
        PG8_STAGE(PG8_SB(1, 0), cB + kstep, voffB); PG8_STAGE(PG8_SA(1, 0), cA + kstep, voffA); PG8_STAGE(PG8_SB(1, 1), cB + hstep + kstep, voffB);
        PG8_WAIT_V(6); PG8_BAR;
    }
    for (;;) {
        const bool has_next = S.next(ui + 1, nxt);
        const char* nA = has_next ? (const char*)g.A + (size_t)nxt.pm * g.tstepA : cA; const char* nB = has_next ? (const char*)g.Bt + (size_t)nxt.pn * tstep : cB;
        for (int t = 0; t < nt; t += 2) {
            const bool last = (t == nt - 2);
#if defined(GPROBE) && GPROBE == 2
            if (t == 0) GP_MARK(); if (t == 4) GP_ADD();
#elif defined(GPROBE) && GPROBE == 3
            if (t == 4) GP_MARK(); if (t == 6) GP_ADD();
#elif defined(GPROBE) && GPROBE == 4
            if (t == nt - 2) GP_MARK();
#endif
            const char* a1 = cA + (size_t)(t + 1) * kstep;
            const char* a2 = last ? nA : cA + (size_t)(t + 2) * kstep; const char* b2 = last ? nB : cB + (size_t)(t + 2) * kstep;
            const char* a3 = a2 + kstep; const char* b3 = b2 + kstep;
            if (last && has_next) S.a_ready(nxt);
            if constexpr (SP2) {
            PG8_LDB(B0, 0, 0); PG8_LDB(B1, 0, 1); PG8_SCHED; PG8_LDA(At, 0, 0); PG8_STAGE(PG8_SA(1, 1), a1 + hstep, voffA);
            PG8_WAIT_V(8); PG8_WAIT_L(0); PG8_BAR; PG8_MMA(0, 0, At, B0); PG8_MMA(0, 1, At, B1); PG8_BAR; PG8_SCHED;
            PG8_LDA(At, 0, 1); PG8_STAGE(PG8_SB(0, 0), b2, voffB); PG8_STAGE(PG8_SB(0, 1), b2 + hstep, voffB); PG8_STAGE(PG8_SA(0, 0), a2, voffA);
            PG8_WAIT_V(8); PG8_WAIT_L(0); PG8_BAR; PG8_MMA(1, 0, At, B0); PG8_MMA(1, 1, At, B1); PG8_BAR; PG8_SCHED;
            PG8_LDB(B0, 1, 0); PG8_LDB(B1, 1, 1); PG8_SCHED; PG8_LDA(At, 1, 0); PG8_STAGE(PG8_SA(0, 1), a2 + hstep, voffA);
            PG8_WAIT_V(8); PG8_WAIT_L(0); PG8_BAR; PG8_MMA(0, 0, At, B0); PG8_MMA(0, 1, At, B1); PG8_BAR; PG8_SCHED;
            PG8_LDA(At, 1, 1); PG8_STAGE(PG8_SB(1, 0), b3, voffB); PG8_STAGE(PG8_SB(1, 1), b3 + hstep, voffB); PG8_STAGE(PG8_SA(1, 0), a3, voffA);
            PG8_WAIT_V(8); PG8_WAIT_L(0); PG8_BAR; PG8_MMA(1, 0, At, B0); PG8_MMA(1, 1, At, B1); PG8_BAR; PG8_SCHED;
            } else {
            PG8_LDB(B0, 0, 0); PG8_SCHED; PG8_LDA(At, 0, 0); PG8_STAGE(PG8_SA(1, 1), a1 + hstep, voffA);
            PG8_WAIT_L(8); PG8_BAR; PG8_WAIT_L(0); PG8_MMA(0, 0, At, B0); PG8_BAR; PG8_SCHED;
            PG8_LDB(B1, 0, 1); PG8_STAGE(PG8_SB(0, 0), b2, voffB);
            PG8_BAR; PG8_WAIT_L(0); PG8_MMA(0, 1, At, B1); PG8_BAR;
            PG8_LDA(At, 0, 1); PG8_STAGE(PG8_SA(0, 0), a2, voffA);
            PG8_BAR; PG8_WAIT_L(0); PG8_MMA(1, 0, At, B0); PG8_BAR; PG8_SCHED;
            PG8_STAGE(PG8_SB(0, 1), b2 + hstep, voffB);
            PG8_WAIT_V(6); PG8_BAR; PG8_MMA(1, 1, At, B1); PG8_BAR;
            PG8_LDB(B0, 1, 0); PG8_SCHED; PG8_LDA(At, 1, 0); PG8_STAGE(PG8_SA(0, 1), a2 + hstep, voffA);
            PG8_WAIT_L(8); PG8_BAR; PG8_WAIT_L(0); PG8_MMA(0, 0, At, B0); PG8_BAR; PG8_SCHED;
            PG8_LDB(B1, 1, 1); PG8_STAGE(PG8_SB(1, 0), b3, voffB);
            PG8_BAR; PG8_WAIT_L(0); PG8_MMA(0, 1, At, B1); PG8_BAR;
            PG8_LDA(At, 1, 1); PG8_STAGE(PG8_SA(1, 0), a3, voffA);
            PG8_BAR; PG8_WAIT_L(0); PG8_MMA(1, 0, At, B0); PG8_BAR; PG8_SCHED;
            PG8_STAGE(PG8_SB(1, 1), b3 + hstep, voffB);
            PG8_WAIT_V(6); PG8_BAR; PG8_MMA(1, 1, At, B1); PG8_BAR;
            }
        }
#if defined(GPROBE) && GPROBE == 4
        GP_ADD();
#endif
        if constexpr (ALIGN_EPI) { if (wr == 0) PG8_BAR; }
#if defined(GPROBE) && GPROBE == 1
        GP_MARK();
#elif defined(GPROBE) && GPROBE == 6
        if (ui > 0) GP_ADD();
#endif
        if constexpr (!Epi::AFTER_DRAIN) { E(acc, cur, wr, wc, fr, fq); S.done(cur); }
#if defined(GPROBE) && GPROBE == 1
        GP_ADD();
#elif defined(GPROBE) && GPROBE == 6
        GP_MARK();
#endif
        if (!has_next) break;
#pragma unroll
        for (int a = 0; a < 2; ++a)
#pragma unroll
            for (int b = 0; b < 2; ++b)
#pragma unroll
                for (int m = 0; m < 4; ++m)
#pragma unroll
                    for (int n = 0; n < 2; ++n) acc[a][b][m][n] = (f32x4){0.f, 0.f, 0.f, 0.f};
        cur = nxt; cA = nA; cB = nB; ++ui;
        if constexpr (ALIGN_EPI) { if (wr == 1) PG8_BAR; }
    }
#if defined(GPROBE)
    if (gp_on && lane == 0) tpw[0] = (unsigned)gp_acc;
#endif
    PG8_WAIT_V(0);
    if constexpr (!ALIGN_EPI) { if (wr == 0) PG8_BAR; }
    PG8_BAR;
    if constexpr (Epi::AFTER_DRAIN) { E.fused(acc, cur, wr, wc, fr, fq, lds, wid, lane); S.done(cur); }
    if constexpr (Epi::HAS_FLUSH) E.flush(cur, wr, wc, fr, fq);
#undef PG8_SA
#undef PG8_SB
#undef PG8_STAGE
#undef PG8_LDA
#undef PG8_LDB
#undef PG8_MMA
#undef PG8_WAIT_V
#undef PG8_WAIT_L
#undef PG8_BAR
#undef PG8_SCHED
}
}

namespace att {
#define ATT_LAS __attribute__((address_space(3)))
typedef unsigned short bf16_t;
using bf16x8 = __attribute__((ext_vector_type(8))) short;
using s16x4  = __attribute__((ext_vector_type(4))) short;
using f32x16 = __attribute__((ext_vector_type(16))) float;
using f32x4  = __attribute__((ext_vector_type(4))) float;
using u32x4  = __attribute__((ext_vector_type(4))) unsigned;
typedef ATT_LAS char* lptr;
#define SBAR() __builtin_amdgcn_sched_barrier(0)
constexpr int PITCH = 1024;
constexpr float QSCALE = 0.125f * 1.4426950408889634f;
constexpr float THRL = 8.0f * 1.4426950408889634f;
__device__ __forceinline__ int crow(int r, int hi) { return (r & 3) + 8 * (r >> 2) + 4 * hi; }
__device__ __forceinline__ unsigned cvtpk(float lo, float hi) { unsigned r; asm volatile("v_cvt_pk_bf16_f32 %0, %1, %2" : "=v"(r) : "v"(lo), "v"(hi)); return r; }
__device__ __forceinline__ int koff(int row, int c) { return c * 1024 + ((row ^ c) << 4); }
__device__ __forceinline__ int v_st(int k, int c) { const int kk = (k & ~0xC) | ((k & 4) << 1) | ((k & 8) >> 1); return ((kk >> 3) * 4 + (c >> 5)) * 512 + ((kk & 7) * 32 + (c & 31)) * 2; }
__device__ __forceinline__ int v_rd_base(int lane) { return ((lane & 3) << 3) | (((lane >> 2) & 3) << 6) | (((lane >> 4) & 1) << 5) | (((lane >> 5) & 1) << 8); }
constexpr int v_rd_off(int d0, int ks, int half) { return d0 * 512 + ks * 4096 + half * 2048; }
template <int OFF> __device__ __forceinline__ s16x4 tr_read(int vb) { s16x4 r; asm volatile("ds_read_b64_tr_b16 %0, %1 offset:%2" : "=&v"(r) : "v"(vb), "i"(OFF) : "memory"); return r; }
template <int D0> __device__ __forceinline__ void pv_one(f32x16& od, int vb, bf16x8 pa0, bf16x8 pa1, bf16x8 pa2, bf16x8 pa3) {
  const s16x4 l0 = tr_read<v_rd_off(D0, 0, 0)>(vb), h0 = tr_read<v_rd_off(D0, 0, 1)>(vb), l1 = tr_read<v_rd_off(D0, 1, 0)>(vb), h1 = tr_read<v_rd_off(D0, 1, 1)>(vb);
  const s16x4 l2 = tr_read<v_rd_off(D0, 2, 0)>(vb), h2 = tr_read<v_rd_off(D0, 2, 1)>(vb), l3 = tr_read<v_rd_off(D0, 3, 0)>(vb), h3 = tr_read<v_rd_off(D0, 3, 1)>(vb);
  asm volatile("s_waitcnt lgkmcnt(0)" ::: "memory"); SBAR();
#define PK(L, H) (bf16x8){L[0], L[1], L[2], L[3], H[0], H[1], H[2], H[3]}
  od = __builtin_amdgcn_mfma_f32_32x32x16_bf16(pa0, PK(l0, h0), od, 0, 0, 0);
  od = __builtin_amdgcn_mfma_f32_32x32x16_bf16(pa1, PK(l1, h1), od, 0, 0, 0);
  od = __builtin_amdgcn_mfma_f32_32x32x16_bf16(pa2, PK(l2, h2), od, 0, 0, 0);
  od = __builtin_amdgcn_mfma_f32_32x32x16_bf16(pa3, PK(l3, h3), od, 0, 0, 0);
#undef PK
}
__device__ __forceinline__ void qkt(f32x16& p0, f32x16& p1, lptr Ks, const bf16x8* qr, int r32, int hi) {
  p0 = f32x16{}; p1 = f32x16{};
#pragma unroll
  for (int d0 = 0; d0 < 4; ++d0) { const int c = 2 * d0 + hi;
    const bf16x8 b0 = *(const ATT_LAS bf16x8*)(Ks + koff(r32, c));
    const bf16x8 b1 = *(const ATT_LAS bf16x8*)(Ks + koff(32 + r32, c));
    p0 = __builtin_amdgcn_mfma_f32_32x32x16_bf16(b0, qr[d0], p0, 0, 0, 0);
    p1 = __builtin_amdgcn_mfma_f32_32x32x16_bf16(b1, qr[d0], p1, 0, 0, 0); }
}
__device__ __forceinline__ float rowmax32(const f32x16& p0, const f32x16& p1) {
  float pmax = p0[0];
#pragma unroll
  for (int r = 1; r < 16; ++r) pmax = fmaxf(pmax, p0[r]);
#pragma unroll
  for (int r = 0; r < 16; ++r) pmax = fmaxf(pmax, p1[r]);
  auto rr = __builtin_amdgcn_permlane32_swap(__float_as_uint(pmax), __float_as_uint(pmax), false, false);
  return fmaxf(__uint_as_float(rr[0]), __uint_as_float(rr[1]));
}
__device__ __forceinline__ void partialSM(f32x16& p0, f32x16& p1, float& m_reg, float& mn, float& alpha) {
  const float pmax = rowmax32(p0, p1);
  if (__builtin_expect(__all(pmax - m_reg <= THRL), 1)) { mn = m_reg; alpha = 1.f; }
  else { mn = fmaxf(m_reg, pmax); alpha = __builtin_amdgcn_exp2f(m_reg - mn); m_reg = mn; }
#pragma unroll
  for (int r = 0; r < 16; ++r) p0[r] = p0[r] - mn;
#pragma unroll
  for (int r = 0; r < 16; ++r) p1[r] = p1[r] - mn;
#pragma unroll
  for (int r = 0; r < 16; ++r) p0[r] = __builtin_amdgcn_exp2f(p0[r]);
}
__device__ __forceinline__ void finishSM(f32x16& p0, f32x16& p1, float alpha, float& l_reg, bf16x8& pa0, bf16x8& pa1, bf16x8& pa2, bf16x8& pa3) {
#pragma unroll
  for (int r = 0; r < 16; ++r) p1[r] = __builtin_amdgcn_exp2f(p1[r]);
  float ps = 0;
#pragma unroll
  for (int r = 0; r < 16; ++r) ps += p0[r];
#pragma unroll
  for (int r = 0; r < 16; ++r) ps += p1[r];
  { auto rr = __builtin_amdgcn_permlane32_swap(__float_as_uint(ps), __float_as_uint(ps), false, false); ps = __uint_as_float(rr[0]) + __uint_as_float(rr[1]); }
  l_reg = l_reg * alpha + ps;
#define PK4(P, BASE, OUT) do { unsigned a0 = cvtpk(P[BASE + 0], P[BASE + 1]), a1 = cvtpk(P[BASE + 2], P[BASE + 3]);   \
    unsigned b0 = cvtpk(P[BASE + 4], P[BASE + 5]), b1 = cvtpk(P[BASE + 6], P[BASE + 7]);                              \
    auto r0 = __builtin_amdgcn_permlane32_swap(a0, b0, false, false); auto r1 = __builtin_amdgcn_permlane32_swap(a1, b1, false, false); \
    u32x4 w = {r0[0], r1[0], r0[1], r1[1]}; OUT = __builtin_bit_cast(bf16x8, w); } while (0)
  PK4(p0, 0, pa0); PK4(p0, 8, pa1); PK4(p1, 0, pa2); PK4(p1, 8, pa3);
#undef PK4
}

__device__ __forceinline__ void finishSM_noexp(f32x16& p0, f32x16& p1, float& l_reg, bf16x8& pa0, bf16x8& pa1, bf16x8& pa2, bf16x8& pa3) {
  float ps = 0;
#pragma unroll
  for (int r = 0; r < 16; ++r) ps += p0[r];
#pragma unroll
  for (int r = 0; r < 16; ++r) ps += p1[r];
  { auto rr = __builtin_amdgcn_permlane32_swap(__float_as_uint(ps), __float_as_uint(ps), false, false); ps = __uint_as_float(rr[0]) + __uint_as_float(rr[1]); }
  l_reg += ps;
#define PK4(P, BASE, OUT) do { unsigned a0 = cvtpk(P[BASE + 0], P[BASE + 1]), a1 = cvtpk(P[BASE + 2], P[BASE + 3]);   \
    unsigned b0 = cvtpk(P[BASE + 4], P[BASE + 5]), b1 = cvtpk(P[BASE + 6], P[BASE + 7]);                              \
    auto r0 = __builtin_amdgcn_permlane32_swap(a0, b0, false, false); auto r1 = __builtin_amdgcn_permlane32_swap(a1, b1, false, false); \
    u32x4 w = {r0[0], r1[0], r0[1], r1[1]}; OUT = __builtin_bit_cast(bf16x8, w); } while (0)
  PK4(p0, 0, pa0); PK4(p0, 8, pa1); PK4(p1, 0, pa2); PK4(p1, 8, pa3);
#undef PK4
}

__device__ __forceinline__ void finish_T(const f32x16& p0, const f32x16& p1, float& l_reg, bf16x8& pa0, bf16x8& pa1, bf16x8& pa2, bf16x8& pa3) {
  float ps = 0;
#pragma unroll
  for (int r = 0; r < 16; ++r) ps += p0[r];
#pragma unroll
  for (int r = 0; r < 16; ++r) ps += p1[r];
  l_reg += ps;
#define PK8(P, BASE, OUT) do { u32x4 w = {cvtpk(P[BASE + 0], P[BASE + 1]), cvtpk(P[BASE + 2], P[BASE + 3]), cvtpk(P[BASE + 4], P[BASE + 5]), cvtpk(P[BASE + 6], P[BASE + 7])}; OUT = __builtin_bit_cast(bf16x8, w); } while (0)
  PK8(p0, 0, pa0); PK8(p0, 8, pa1); PK8(p1, 0, pa2); PK8(p1, 8, pa3);
#undef PK8
}

constexpr int DA_SHM_V = 16384, DA_SHM_K = 8192, DA_LDS_V = 0, DA_LDS_K = 2 * DA_SHM_V, DA_LDS_WS = DA_LDS_K + 2 * DA_SHM_K, DA_LDS_BYTES = DA_LDS_WS + 8 * 256;
__device__ __forceinline__ void da_pass(const bf16_t* __restrict__ Qw, const bf16_t* __restrict__ Kh, const bf16_t* __restrict__ Vh, int NT, lptr lds, int tid, int wid, int lane,
                                        f32x16 (&o)[4], float& l_out) {
  const int r32 = lane & 31, hi = lane >> 5;
  const lptr V_lds = lds + DA_LDS_V, K_lds = lds + DA_LDS_K;
  ATT_LAS float* al_l = (ATT_LAS float*)(lds + DA_LDS_WS) + wid * 64 + 32;
  float m_reg = -1e30f, l_reg = 0.f;
#pragma unroll
  for (int d = 0; d < 4; ++d) o[d] = f32x16{};
  bf16x8 qr[4];
#pragma unroll
  for (int d0 = 0; d0 < 4; ++d0) qr[d0] = *(const bf16x8*)(Qw + d0 * 16);
  const int sr = tid >> 4, sc = (tid & 15) * 8, vst0 = v_st(sr, sc), vst1 = v_st(32 + sr, sc);
  const int kr = tid >> 3, kc = tid & 7, kst = koff(kr, kc);
  const int vb0 = (int)(unsigned)(uintptr_t)V_lds + v_rd_base(lane);
  bf16x8 sv0[2], sv1[2], sk[2];
#define SLOAD(i, k0) do { sv0[i] = *(const bf16x8*)(Vh + (size_t)((k0) + sr) * PITCH + sc); sv1[i] = *(const bf16x8*)(Vh + (size_t)((k0) + 32 + sr) * PITCH + sc); \
    sk[i] = *(const bf16x8*)(Kh + (size_t)((k0) + kr) * PITCH + kc * 8); } while (0)
#define SWRITE(b, i) do { *(ATT_LAS bf16x8*)(V_lds + (b) * DA_SHM_V + vst0) = sv0[i]; *(ATT_LAS bf16x8*)(V_lds + (b) * DA_SHM_V + vst1) = sv1[i]; \
    *(ATT_LAS bf16x8*)(K_lds + (b) * DA_SHM_K + kst) = sk[i]; } while (0)
#define SWAIT() asm volatile("s_waitcnt vmcnt(3)" ::: "memory")
#define RESC(a) do { if (__any((a) < 1.f)) { if (hi == 0) al_l[r32] = (a); asm volatile("s_waitcnt lgkmcnt(0)" ::: "memory"); \
    _Pragma("unroll") for (int d = 0; d < 4; ++d) _Pragma("unroll") for (int r = 0; r < 16; ++r) o[d][r] *= al_l[crow(r, hi)]; } } while (0)
#define PVALL(vb) do { pv_one<0>(o[0], (vb), pa0, pa1, pa2, pa3); pv_one<1>(o[1], (vb), pa0, pa1, pa2, pa3); pv_one<2>(o[2], (vb), pa0, pa1, pa2, pa3); pv_one<3>(o[3], (vb), pa0, pa1, pa2, pa3); } while (0)
  f32x16 pA0, pA1, pB0, pB1; float mnA, mnB, alA, alB; bf16x8 pa0, pa1, pa2, pa3;
  SLOAD(0, 0); asm volatile("s_waitcnt vmcnt(0)" ::: "memory"); SWRITE(0, 0); __syncthreads();
  qkt(pA0, pA1, K_lds, qr, r32, hi); partialSM(pA0, pA1, m_reg, mnA, alA);
  SLOAD(1, 64); if (2 < NT) SLOAD(0, 128);
  SWAIT(); SWRITE(1, 1); __syncthreads();
  for (int j = 1; j + 1 < NT; j += 2) {
    SBAR(); qkt(pB0, pB1, K_lds + DA_SHM_K, qr, r32, hi);
    finishSM(pA0, pA1, alA, l_reg, pa0, pa1, pa2, pa3); SBAR();
    SLOAD(1, (j + 2) * 64); SBAR();
    PVALL(vb0); partialSM(pB0, pB1, m_reg, mnB, alB);
    __syncthreads(); SWAIT(); SWRITE(0, 0);
    RESC(alB); __syncthreads();
    SBAR(); qkt(pA0, pA1, K_lds, qr, r32, hi);
    finishSM(pB0, pB1, alB, l_reg, pa0, pa1, pa2, pa3); SBAR();
    if (j + 3 < NT) SLOAD(0, (j + 3) * 64); SBAR();
    PVALL(vb0 + DA_SHM_V); partialSM(pA0, pA1, m_reg, mnA, alA);
    __syncthreads(); SWAIT(); SWRITE(1, 1);
    RESC(alA); __syncthreads();
  }
  SBAR(); qkt(pB0, pB1, K_lds + DA_SHM_K, qr, r32, hi);
  finishSM(pA0, pA1, alA, l_reg, pa0, pa1, pa2, pa3); SBAR();
  PVALL(vb0); partialSM(pB0, pB1, m_reg, mnB, alB);
  __syncthreads(); RESC(alB);
  finishSM(pB0, pB1, alB, l_reg, pa0, pa1, pa2, pa3); SBAR();
  PVALL(vb0 + DA_SHM_V);
  l_out = l_reg;
  __syncthreads();
#undef SLOAD
#undef SWRITE
#undef SWAIT
#undef RESC
#undef PVALL
}
#ifndef PP_PREF
#define PP_PREF 0
#endif
#ifndef PP_DMA_LATE
#define PP_DMA_LATE 0
#endif
#ifndef PP_DMA_IN_M
#define PP_DMA_IN_M 1
#endif
#ifndef PP_PRIO
#define PP_PRIO 1
#endif
#ifndef PP_NS
#define PP_NS 3
#endif
constexpr int PP_K = 0, PP_V = PP_NS * 8192, PP_WS = PP_V + PP_NS * 16384, PP_BYTES = PP_WS + 8 * 256;
typedef short v4i16_t __attribute__((ext_vector_type(4)));
__device__ __forceinline__ short qr_raw(const bf16x8& v, int e) { return v[e]; }
__device__ __forceinline__ s16x4 vtr(lptr p) { return __builtin_bit_cast(s16x4, __builtin_amdgcn_ds_read_tr16_b64_v4i16((ATT_LAS v4i16_t*)p)); }
#define PP_BAR() do { __builtin_amdgcn_sched_barrier(0); asm volatile("s_waitcnt lgkmcnt(0)" ::: "memory"); __builtin_amdgcn_s_barrier(); __builtin_amdgcn_sched_barrier(0); } while (0)
template <int GRP>
__device__ __forceinline__ void da_pass_pp(const bf16_t* __restrict__ Qw, const bf16_t* __restrict__ Kh, const bf16_t* __restrict__ Vh, int NT, lptr lds, int wid, int lane,
                                           float kmax2, f32x16 (&o)[4], float& l_out, unsigned* dbg = nullptr, int variant = 0) {
  const int r32 = lane & 31, hi = lane >> 5;
  const lptr Kr = lds + PP_K, Vr = lds + PP_V;
  ATT_LAS float* al_l = (ATT_LAS float*)(lds + PP_WS) + wid * 64 + 32;
  const bf16_t* ksrc = Kh + (size_t)(lane ^ wid) * PITCH + wid * 8;
  const bf16_t* vsrc0;
  { const int j = lane & 31, sidx = 2 * (2 * wid) + (lane >> 5), kk = (sidx >> 2) * 8 + (j >> 2), col = (sidx & 3) * 32 + (j & 3) * 8; vsrc0 = Vh + (size_t)kk * PITCH + col; }
#define DMA_K(t, slot) __builtin_amdgcn_global_load_lds((const unsigned*)(ksrc + (size_t)(t) * 64 * PITCH), (ATT_LAS unsigned*)(Kr + (slot) * 8192 + wid * 1024), 16, 0, 0)
#define DMA_V0(t, slot) __builtin_amdgcn_global_load_lds((const unsigned*)(vsrc0 + (size_t)(t) * 64 * PITCH), (ATT_LAS unsigned*)(Vr + (slot) * 16384 + (2 * wid) * 1024), 16, 0, 0)
#define DMA_V1(t, slot) __builtin_amdgcn_global_load_lds((const unsigned*)(vsrc0 + 64 + (size_t)(t) * 64 * PITCH), (ATT_LAS unsigned*)(Vr + (slot) * 16384 + (2 * wid + 1) * 1024), 16, 0, 0)
#define DMA_V(t, slot) do { DMA_V0(t, slot); DMA_V1(t, slot); } while (0)
  bf16x8 qr[4];
#pragma unroll
  for (int d0 = 0; d0 < 4; ++d0) qr[d0] = *(const bf16x8*)(Qw + d0 * 16);
  DMA_K(0, 0); DMA_V(0, 0); DMA_K(1, 1); if (PP_NS == 4) { DMA_K(2, 2); DMA_V(1, 1); }
  bool fast;
  { float qn = 0.f;
#pragma unroll
    for (int d0 = 0; d0 < 4; ++d0) {
#pragma unroll
      for (int e = 0; e < 8; ++e) { const float v = __uint_as_float(((unsigned)(unsigned short)qr_raw(qr[d0], e)) << 16); qn += v * v; } }
    { auto rr = __builtin_amdgcn_permlane32_swap(__float_as_uint(qn), __float_as_uint(qn), false, false); qn = __uint_as_float(rr[0]) + __uint_as_float(rr[1]); }
#ifdef PROBE_FORCE_FAST
    fast = true; }
#elif defined(PROBE_FORCE_SLOW)
    fast = false; }
#else
    fast = __all(qn * kmax2 * 1.05f < 10000.f) != 0; }
#endif
#pragma unroll
  for (int d = 0; d < 4; ++d) o[d] = f32x16{};
  float mref = 0.f, l_reg = 0.f;
  f32x16 S0, S1; bf16x8 pa0, pa1, pa2, pa3; const f32x16 zero16 = f32x16{};
  const int kq0 = koff(r32, hi), kq1 = koff(32 + r32, hi);
  const int vbase = v_rd_base(lane);
  asm volatile("s_waitcnt vmcnt(0)" ::: "memory");
  PP_BAR();
  int ks_cur = 0, vs_prev = PP_NS - 1, vs_new = PP_NS - 2;
#define SB0() __builtin_amdgcn_sched_barrier(0)
#define VRD8(d0, L0, H0, L1, H1, L2, H2, L3, H3) do { L0 = vtr(Vt + v_rd_off(d0, 0, 0)); H0 = vtr(Vt + v_rd_off(d0, 0, 1)); L1 = vtr(Vt + v_rd_off(d0, 1, 0)); H1 = vtr(Vt + v_rd_off(d0, 1, 1)); \
    L2 = vtr(Vt + v_rd_off(d0, 2, 0)); H2 = vtr(Vt + v_rd_off(d0, 2, 1)); L3 = vtr(Vt + v_rd_off(d0, 3, 0)); H3 = vtr(Vt + v_rd_off(d0, 3, 1)); } while (0)
#define PV4(d0, L0, H0, L1, H1, L2, H2, L3, H3) do { \
    o[d0] = __builtin_amdgcn_mfma_f32_32x32x16_bf16((bf16x8){L0[0], L0[1], L0[2], L0[3], H0[0], H0[1], H0[2], H0[3]}, pa0, o[d0], 0, 0, 0); \
    o[d0] = __builtin_amdgcn_mfma_f32_32x32x16_bf16((bf16x8){L1[0], L1[1], L1[2], L1[3], H1[0], H1[1], H1[2], H1[3]}, pa1, o[d0], 0, 0, 0); \
    o[d0] = __builtin_amdgcn_mfma_f32_32x32x16_bf16((bf16x8){L2[0], L2[1], L2[2], L2[3], H2[0], H2[1], H2[2], H2[3]}, pa2, o[d0], 0, 0, 0); \
    o[d0] = __builtin_amdgcn_mfma_f32_32x32x16_bf16((bf16x8){L3[0], L3[1], L3[2], L3[3], H3[0], H3[1], H3[2], H3[3]}, pa3, o[d0], 0, 0, 0); } while (0)
#define KRD8(KS) do { const lptr Kt = Kr + (KS) * 8192; \
    kf[0] = *(const ATT_LAS bf16x8*)(Kt + koff(r32, hi)); kf[1] = *(const ATT_LAS bf16x8*)(Kt + koff(32 + r32, hi)); \
    kf[2] = *(const ATT_LAS bf16x8*)(Kt + koff(r32, 2 + hi)); kf[3] = *(const ATT_LAS bf16x8*)(Kt + koff(32 + r32, 2 + hi)); \
    kf[4] = *(const ATT_LAS bf16x8*)(Kt + koff(r32, 4 + hi)); kf[5] = *(const ATT_LAS bf16x8*)(Kt + koff(32 + r32, 4 + hi)); \
    kf[6] = *(const ATT_LAS bf16x8*)(Kt + koff(r32, 6 + hi)); kf[7] = *(const ATT_LAS bf16x8*)(Kt + koff(32 + r32, 6 + hi)); } while (0)
#define KRD4A(KS) do { const lptr Kt = Kr + (KS) * 8192; \
    kf[0] = *(const ATT_LAS bf16x8*)(Kt + koff(r32, hi)); kf[1] = *(const ATT_LAS bf16x8*)(Kt + koff(32 + r32, hi)); } while (0)
#define KRD4B(KS) do { const lptr Kt = Kr + (KS) * 8192; \
    kf[2] = *(const ATT_LAS bf16x8*)(Kt + koff(r32, 2 + hi)); kf[3] = *(const ATT_LAS bf16x8*)(Kt + koff(32 + r32, 2 + hi)); \
    kf[4] = *(const ATT_LAS bf16x8*)(Kt + koff(r32, 4 + hi)); kf[5] = *(const ATT_LAS bf16x8*)(Kt + koff(32 + r32, 4 + hi)); \
    kf[6] = *(const ATT_LAS bf16x8*)(Kt + koff(r32, 6 + hi)); kf[7] = *(const ATT_LAS bf16x8*)(Kt + koff(32 + r32, 6 + hi)); } while (0)
#define QK8() do { \
    S0 = __builtin_amdgcn_mfma_f32_32x32x16_bf16(kf[0], qr[0], zero16, 0, 0, 0); S1 = __builtin_amdgcn_mfma_f32_32x32x16_bf16(kf[1], qr[0], zero16, 0, 0, 0); \
    S0 = __builtin_amdgcn_mfma_f32_32x32x16_bf16(kf[2], qr[1], S0, 0, 0, 0);   S1 = __builtin_amdgcn_mfma_f32_32x32x16_bf16(kf[3], qr[1], S1, 0, 0, 0); \
    S0 = __builtin_amdgcn_mfma_f32_32x32x16_bf16(kf[4], qr[2], S0, 0, 0, 0);   S1 = __builtin_amdgcn_mfma_f32_32x32x16_bf16(kf[5], qr[2], S1, 0, 0, 0); \
    S0 = __builtin_amdgcn_mfma_f32_32x32x16_bf16(kf[6], qr[3], S0, 0, 0, 0);   S1 = __builtin_amdgcn_mfma_f32_32x32x16_bf16(kf[7], qr[3], S1, 0, 0, 0); } while (0)
  bf16x8 kf[8]; s16x4 a0, a1, a2, a3, a4, a5, a6, a7, b0_, b1_, b2_, b3_, b4_, b5_, b6_, b7_;
#define NXT3(x) ((x) == PP_NS - 1 ? 0 : (x) + 1)
#define PREF(DO_K, DO_V, kslot, vslot) do { if (DO_V) { const lptr Vt = Vr + (vslot) * 16384 + vbase; VRD8(0, a0, a1, a2, a3, a4, a5, a6, a7); } \
    if (DO_K) { const int ks_cur_ = (kslot); KRD8(ks_cur_); } } while (0)
#define MB_DMA_K(tt) do { if (PP_DMA_IN_M && (tt) + PP_NS - 1 < NT) { DMA_K((tt) + PP_NS - 1, vs_prev); SB0(); } } while (0)
#define MB_DMA_V0(tt) do { if (PP_DMA_IN_M && (tt) + PP_NS - 2 < NT) { DMA_V0((tt) + PP_NS - 2, vs_new); SB0(); } } while (0)
#define MB_DMA_V1(tt) do { if (PP_DMA_IN_M && (tt) + PP_NS - 2 < NT) { DMA_V1((tt) + PP_NS - 2, vs_new); SB0(); } } while (0)
#define MBLOCK(DO_QK, DO_PV, tt) do { if (PP_PRIO == 1) __builtin_amdgcn_s_setprio(1); const lptr Vt = Vr + vs_prev * 16384 + vbase; \
    if (PP_PREF == 0) { if (DO_QK) { KRD8(ks_cur); SB0(); } else if (DO_PV) { VRD8(0, a0, a1, a2, a3, a4, a5, a6, a7); SB0(); } } \
    if (PP_PREF == 3) { if (DO_QK) KRD4B(ks_cur); if (DO_PV) VRD8(0, a0, a1, a2, a3, a4, a5, a6, a7); SB0(); } \
    if (DO_QK && variant != 2) { QK8(); SB0(); if (PP_PREF == 0 && DO_PV) { VRD8(0, a0, a1, a2, a3, a4, a5, a6, a7); SB0(); } } \
    if (DO_PV && variant != 2) { VRD8(1, b0_, b1_, b2_, b3_, b4_, b5_, b6_, b7_); SB0(); PV4(0, a0, a1, a2, a3, a4, a5, a6, a7); SB0(); MB_DMA_K(tt); VRD8(2, a0, a1, a2, a3, a4, a5, a6, a7); SB0(); \
                 PV4(1, b0_, b1_, b2_, b3_, b4_, b5_, b6_, b7_); SB0(); MB_DMA_V0(tt); VRD8(3, b0_, b1_, b2_, b3_, b4_, b5_, b6_, b7_); SB0(); \
                 PV4(2, a0, a1, a2, a3, a4, a5, a6, a7); SB0(); MB_DMA_V1(tt); \
                 PV4(3, b0_, b1_, b2_, b3_, b4_, b5_, b6_, b7_); SB0(); \
                 if (PP_PREF == 3 && (tt) + 1 < NT) { KRD4A(NXT3(ks_cur)); SB0(); } } \
    else { MB_DMA_K(tt); MB_DMA_V0(tt); MB_DMA_V1(tt); if (PP_PREF == 3 && (tt) + 1 < NT) { KRD4A(NXT3(ks_cur)); SB0(); } } \
    if (PP_PRIO == 1) __builtin_amdgcn_s_setprio(0); } while (0)
#define VBLOCK(t) do { if ((t) >= 0 && (t) < NT && variant != 1) { if (PP_PRIO == 2) __builtin_amdgcn_s_setprio(1); \
    if (!fast) { const float rm = rowmax32(S0, S1); \
      if ((t) == 0 || __any(rm - mref > THRL)) { const float mn = (t) == 0 ? rm : fmaxf(rm, mref); \
        if ((t) != 0) { const float f = __builtin_amdgcn_exp2f(mref - mn); l_reg *= f; \
          _Pragma("unroll") for (int d = 0; d < 4; ++d) _Pragma("unroll") for (int r = 0; r < 16; ++r) o[d][r] *= f; } \
        mref = mn; } \
      _Pragma("unroll") for (int r = 0; r < 16; ++r) { S0[r] -= mref; S1[r] -= mref; } } \
    _Pragma("unroll") for (int r = 0; r < 16; ++r) { S0[r] = __builtin_amdgcn_exp2f(S0[r]); S1[r] = __builtin_amdgcn_exp2f(S1[r]); } \
    finish_T(S0, S1, l_reg, pa0, pa1, pa2, pa3); if (PP_PRIO == 2) __builtin_amdgcn_s_setprio(0); } } while (0)
#define ROT3() do { vs_new = vs_prev; vs_prev = ks_cur; ks_cur = ks_cur == PP_NS - 1 ? 0 : ks_cur + 1; } while (0)
#define TAILWAIT(t) do { if (PP_PREF == 3) { if ((t) + 3 < NT) asm volatile("s_waitcnt vmcnt(3)" ::: "memory"); else if ((t) + 2 < NT) asm volatile("s_waitcnt vmcnt(2)" ::: "memory"); else asm volatile("s_waitcnt vmcnt(0)" ::: "memory"); } \
    else if (PP_NS == 3) { if ((t) + 2 < NT) asm volatile("s_waitcnt vmcnt(3)" ::: "memory"); else if ((t) + 1 < NT) asm volatile("s_waitcnt vmcnt(2)" ::: "memory"); else asm volatile("s_waitcnt vmcnt(0)" ::: "memory"); } \
    else { if ((t) + 3 < NT) asm volatile("s_waitcnt vmcnt(6)" ::: "memory"); else if ((t) + 2 < NT) asm volatile("s_waitcnt vmcnt(5)" ::: "memory"); else if ((t) + 1 < NT) asm volatile("s_waitcnt vmcnt(2)" ::: "memory"); else asm volatile("s_waitcnt vmcnt(0)" ::: "memory"); } } while (0)
#if defined(DPROBE)
  unsigned long long dp_acc = 0, dp_prev = 0; const bool dp_on = dbg != nullptr && blockIdx.x == 0 && wid == (DPROBE_GRP ? 4 : 0) && GRP == DPROBE_GRP;
#define DP_T(i) do { if (dp_on) { const unsigned long long now_ = __builtin_amdgcn_s_memtime(); if ((i) == DPROBE) dp_acc += now_ - dp_prev; dp_prev = now_; } } while (0)
#else
#define DP_T(i) do {} while (0)
#endif
#define DMA_ISSUE(t) do { if ((t) + PP_NS - 1 < NT) DMA_K((t) + PP_NS - 1, vs_prev); if ((t) + PP_NS - 2 < NT) DMA_V((t) + PP_NS - 2, vs_new); } while (0)
  { if (!PP_DMA_IN_M && !(PP_DMA_LATE && GRP == 0)) { DMA_ISSUE(0); SB0(); }
    if (PP_PREF == 3) { KRD4A(ks_cur); SB0(); } else if (PP_PREF != 0) { PREF(true, false, ks_cur, 0); SB0(); }
    if (GRP == 0) MBLOCK(true, false, 0);
    if (!PP_DMA_IN_M && PP_DMA_LATE && GRP == 0) { SB0(); DMA_ISSUE(0); }
    SB0(); if (PP_PREF == 1 || PP_PREF == 2) TAILWAIT(0); PP_BAR();
    if (GRP == 0) { if (PP_PREF == 1) { PREF(1 < NT, true, NXT3(ks_cur), NXT3(vs_prev)); SB0(); } VBLOCK(0); if (PP_PREF == 2) { SB0(); PREF(1 < NT, true, NXT3(ks_cur), NXT3(vs_prev)); } } else MBLOCK(true, false, 0);
    SB0(); if (PP_PREF == 0 || PP_PREF == 3) TAILWAIT(0); PP_BAR(); ROT3(); }
#pragma clang loop unroll(disable)
  for (int t = 1; t < NT; ++t) {
    DP_T(0);
    if (!PP_DMA_IN_M && !(PP_DMA_LATE && GRP == 0)) { DMA_ISSUE(t); SB0(); }
    if (GRP == 0) MBLOCK(true, true, t); else { if (PP_PREF == 1) { PREF(true, true, ks_cur, vs_prev); SB0(); } VBLOCK(t - 1); if (PP_PREF == 2) { SB0(); PREF(true, true, ks_cur, vs_prev); } }
    if (!PP_DMA_IN_M && PP_DMA_LATE && GRP == 0) { SB0(); DMA_ISSUE(t); }
    SB0(); if (PP_PREF == 1 || PP_PREF == 2) TAILWAIT(t); DP_T(1); PP_BAR(); DP_T(2);
    if (GRP == 0) { if (PP_PREF == 1) { PREF(t + 1 < NT, true, NXT3(ks_cur), NXT3(vs_prev)); SB0(); } VBLOCK(t); if (PP_PREF == 2) { SB0(); PREF(t + 1 < NT, true, NXT3(ks_cur), NXT3(vs_prev)); } } else MBLOCK(true, true, t);
    SB0(); if (PP_PREF == 0 || PP_PREF == 3) TAILWAIT(t); DP_T(3); PP_BAR(); DP_T(4); ROT3();
  }
  { if (GRP == 0) MBLOCK(false, true, NT); else { if (PP_PREF == 1) { PREF(false, true, 0, vs_prev); SB0(); } VBLOCK(NT - 1); if (PP_PREF == 2) { SB0(); PREF(false, true, 0, vs_prev); } }
    PP_BAR();
    if (GRP == 1) MBLOCK(false, true, NT);
    PP_BAR(); }
#if defined(DPROBE)
  if (dp_on && lane == 0) atomicAdd(dbg, (unsigned)(dp_acc >> 4));
#endif
  l_out = l_reg;
#undef DMA_K
#undef DMA_V
#undef MBLOCK
#undef MB_DMA_K
#undef MB_DMA_V0
#undef MB_DMA_V1
#undef VBLOCK
#undef SB0
#undef VRD8
#undef PV4
#undef KRD8
#undef KRD4A
#undef KRD4B
#undef QK8
#undef ROT3
#undef TAILWAIT
#undef PREF
#undef NXT3
#undef DMA_ISSUE
}
constexpr int DA_LDS_OST = 0, DA_LDS_TOTAL = PP_BYTES;
__device__ __forceinline__ void da_unit(size_t rowbase, int T, int h, int qb, const bf16_t* Q, const bf16_t* K, const bf16_t* V, bf16_t* O, float* park, unsigned lam_bits, float outscale,
                                        const float* __restrict__ subg, const unsigned* kmaxp, lptr lds, int tid, int wid, int lane, unsigned* dbg = nullptr, int variant = 0) {
  const int NT = T / 64;
  const size_t qrow = rowbase + (size_t)qb * 256 + wid * 32;
  f32x16 o[4]; float l_reg;
#pragma clang loop unroll(disable)
  for (int sub = 0; sub < 2; ++sub) {
    asm volatile("" : "+v"(tid)); lane = tid & 63;
    const int r32 = lane & 31, hi = lane >> 5;
    ATT_LAS float* li_l = (ATT_LAS float*)(lds + PP_WS) + wid * 64;
    const float kmax2 = __uint_as_float(__builtin_nontemporal_load(kmaxp + 2 * h + sub));
    if (wid < 4) da_pass_pp<0>(Q + (qrow + r32) * PITCH + (2 * h + sub) * 64 + hi * 8, K + rowbase * PITCH + (2 * h + sub) * 64, V + rowbase * PITCH + h * 128, NT, lds, wid, lane, kmax2, o, l_reg, dbg, variant);
    else da_pass_pp<1>(Q + (qrow + r32) * PITCH + (2 * h + sub) * 64 + hi * 8, K + rowbase * PITCH + (2 * h + sub) * 64, V + rowbase * PITCH + h * 128, NT, lds, wid, lane, kmax2, o, l_reg, dbg, variant);
    { auto rr = __builtin_amdgcn_permlane32_swap(__float_as_uint(l_reg), __float_as_uint(l_reg), false, false); l_reg = __uint_as_float(rr[0]) + __uint_as_float(rr[1]); }
    const float rl = __builtin_amdgcn_rcpf(l_reg);
    f32x4* pk = (f32x4*)(park + ((size_t)wid * 64 + lane) * 64);
    if (sub == 0) {
#pragma unroll
      for (int d0 = 0; d0 < 4; ++d0)
#pragma unroll
        for (int q = 0; q < 4; ++q) { f32x4 v; v[0] = o[d0][4 * q] * rl; v[1] = o[d0][4 * q + 1] * rl; v[2] = o[d0][4 * q + 2] * rl; v[3] = o[d0][4 * q + 3] * rl; pk[d0 * 4 + q] = v; }
    } else {
      const float rll = rl * __uint_as_float(lam_bits); float ss = 0.f;
#pragma unroll
      for (int d0 = 0; d0 < 4; ++d0)
#pragma unroll
        for (int q = 0; q < 4; ++q) { const f32x4 p = pk[d0 * 4 + q];
#pragma unroll
          for (int j = 0; j < 4; ++j) { const float v = p[j] - o[d0][4 * q + j] * rll; o[d0][4 * q + j] = v; ss += v * v; } }
      { auto rr = __builtin_amdgcn_permlane32_swap(__float_as_uint(ss), __float_as_uint(ss), false, false); ss = __uint_as_float(rr[0]) + __uint_as_float(rr[1]); }
      const float rstd = __builtin_amdgcn_rsqf(ss * (1.0f / 128.0f) + 1e-5f) * outscale;
      ATT_LAS bf16_t* stg = (ATT_LAS bf16_t*)(lds + DA_LDS_OST) + wid * 4096;
#pragma unroll
      for (int d0 = 0; d0 < 4; ++d0)
#pragma unroll
        for (int q = 0; q < 4; ++q) { const f32x4 gv = *(const f32x4*)(subg + d0 * 32 + 8 * q + 4 * hi);
          typedef unsigned u32x2v __attribute__((ext_vector_type(2))); u32x2v w;
          w.x = cvtpk(o[d0][4 * q] * rstd * gv[0], o[d0][4 * q + 1] * rstd * gv[1]); w.y = cvtpk(o[d0][4 * q + 2] * rstd * gv[2], o[d0][4 * q + 3] * rstd * gv[3]);
          *(ATT_LAS u32x2v*)(stg + r32 * 128 + d0 * 32 + 8 * q + 4 * hi) = w; }
      asm volatile("s_waitcnt lgkmcnt(0)" ::: "memory");
      bf16_t* Ow = O + qrow * PITCH + h * 128;
#pragma unroll
      for (int i = 0; i < 8; ++i) { const int row = i * 4 + (lane >> 4), ch = lane & 15; const u32x4 v = *(const ATT_LAS u32x4*)(stg + row * 128 + ch * 8); *(u32x4*)(Ow + (size_t)row * PITCH + ch * 8) = v; }
      asm volatile("s_waitcnt lgkmcnt(0)" ::: "memory"); __builtin_amdgcn_s_barrier();
    }
  }
}

constexpr int NA_NS = 4, NA_SLOT = 16384, NA_LDS_B = NA_NS * NA_SLOT, NA_LDS_WS = NA_LDS_B + 2560, NA_LDS_OST = NA_LDS_WS + 8 * 256, NA_LDS_BYTES = NA_LDS_OST + 8 * 4096, NA_BPAD = 64;
template <int D0, int KS0, int KS1> __device__ __forceinline__ void pv_ks(f32x16& od, int vb, bf16x8 pa0, bf16x8 pa1, bf16x8 pa2, bf16x8 pa3) {
  s16x4 l[4], h[4];
#pragma unroll
  for (int ks = 0; ks < 4; ++ks) if (ks >= KS0 && ks <= KS1) {
      asm volatile("ds_read_b64_tr_b16 %0, %1 offset:%2" : "=&v"(l[ks]) : "v"(vb), "i"(D0 * 512 + ks * 2048) : "memory");
      asm volatile("ds_read_b64_tr_b16 %0, %1 offset:%2" : "=&v"(h[ks]) : "v"(vb), "i"(D0 * 512 + ks * 2048 + 1024) : "memory"); }
  asm volatile("s_waitcnt lgkmcnt(0)" ::: "memory"); SBAR();
#define PK(L, H) (bf16x8){L[0], L[1], L[2], L[3], H[0], H[1], H[2], H[3]}
  if (0 >= KS0 && 0 <= KS1) od = __builtin_amdgcn_mfma_f32_32x32x16_bf16(pa0, PK(l[0], h[0]), od, 0, 0, 0);
  if (1 >= KS0 && 1 <= KS1) od = __builtin_amdgcn_mfma_f32_32x32x16_bf16(pa1, PK(l[1], h[1]), od, 0, 0, 0);
  if (2 >= KS0 && 2 <= KS1) od = __builtin_amdgcn_mfma_f32_32x32x16_bf16(pa2, PK(l[2], h[2]), od, 0, 0, 0);
  if (3 >= KS0 && 3 <= KS1) od = __builtin_amdgcn_mfma_f32_32x32x16_bf16(pa3, PK(l[3], h[3]), od, 0, 0, 0);
#undef PK
}
template <int H>
__device__ __forceinline__ void na_tiles(size_t tok0, int rows, int h, int R, int qrow, const bf16_t* Q, const bf16_t* K, const bf16_t* V, bf16_t* O, lptr lds, int tid, int wid, int lane) {
  const int r32 = lane & 31, hi = lane >> 5;
  ATT_LAS float* bias = (ATT_LAS float*)(lds + NA_LDS_B);
  ATT_LAS float* li_l = (ATT_LAS float*)(lds + NA_LDS_WS) + wid * 64; ATT_LAS float* al_l = li_l + 32;
  const int c = 32 * H + r32;
  const int c0 = min(max(c - 8, 0), 48), tmask = 4 * hi - c0;
  const int rlo_w = min(max(qrow - 4, 0), rows - 8);
  const int kr_lo = min(max(R - 4, 0), rows - 8), kr_hi = min(max(R + 3 - 4, 0), rows - 8) + 7, nt = kr_hi - kr_lo + 1;
  const size_t qtok = tok0 + (size_t)qrow * 64 + c;
  bf16x8 qr[4];
#pragma unroll
  for (int d0 = 0; d0 < 4; ++d0) qr[d0] = *(const bf16x8*)(Q + qtok * PITCH + h * 64 + d0 * 16 + hi * 8);
  const int vb0 = (int)(unsigned)(uintptr_t)lds + v_rd_base(lane);
  const bf16_t* ksrc = K + (tok0 + (size_t)(lane ^ wid)) * PITCH + h * 64 + wid * 8;
  const bf16_t* vsrc;
  { const int j = lane & 31, kk = wid * 8 + (j >> 2), col = (lane >> 5) * 32 + (j & 3) * 8, k = (kk & ~0xC) | ((kk & 4) << 1) | ((kk & 8) >> 1); vsrc = V + (tok0 + (size_t)k) * PITCH + h * 64 + col; }
#define NDMA(row, slot) do { __builtin_amdgcn_global_load_lds((const unsigned*)(vsrc + (size_t)(row) * 64 * PITCH), (ATT_LAS unsigned*)(lds + (slot) * NA_SLOT + wid * 1024), 16, 0, 0); \
                             __builtin_amdgcn_global_load_lds((const unsigned*)(ksrc + (size_t)(row) * 64 * PITCH), (ATT_LAS unsigned*)(lds + (slot) * NA_SLOT + 8192 + wid * 1024), 16, 0, 0); } while (0)
#define NBAR() do { __builtin_amdgcn_sched_barrier(0); asm volatile("s_waitcnt lgkmcnt(0)" ::: "memory"); __builtin_amdgcn_s_barrier(); __builtin_amdgcn_sched_barrier(0); } while (0)
  float mref = 0.f, l_reg = 0.f; f32x16 o[2]; o[0] = f32x16{}; o[1] = f32x16{};
  asm volatile("" :: "v"(qr[0]), "v"(qr[1]), "v"(qr[2]), "v"(qr[3]));
  NDMA(kr_lo, 0); if (1 < nt) NDMA(kr_lo + 1, 1); if (2 < nt) NDMA(kr_lo + 2, 2);
  int slot = 0;
  for (int t = 0; t < nt; ++t) {
    const int krow = kr_lo + t;
    if (t + 2 < nt) asm volatile("s_waitcnt vmcnt(4)" ::: "memory"); else if (t + 1 < nt) asm volatile("s_waitcnt vmcnt(2)" ::: "memory"); else asm volatile("s_waitcnt vmcnt(0)" ::: "memory");
    NBAR();
    if (t + 3 < nt) NDMA(krow + 3, (slot + 3) & 3);
    __builtin_amdgcn_sched_barrier(0);
    if (krow >= rlo_w && krow < rlo_w + 8) {
      f32x16 p0, p1; qkt(p0, p1, lds + slot * NA_SLOT + 8192, qr, r32, hi);
      const int bofs = NA_BPAD + (krow - qrow + 7) * 31 + 15 - c + 4 * hi;
#define BM(P, r, koffc) do { const int kcol = ((r) & 3) + 8 * ((r) >> 2) + (koffc); float bv_ = bias[bofs + kcol]; asm volatile("" : "+v"(bv_));   \
        P[r] = ((unsigned)(kcol + tmask) < 16u) ? P[r] + bv_ : -INFINITY; } while (0)
      float pm;
      if (H == 0) {
#pragma unroll
        for (int r = 0; r < 16; ++r) BM(p0, r, 0);
#pragma unroll
        for (int r = 0; r < 4; ++r) BM(p1, r, 32);
        pm = p0[0];
#pragma unroll
        for (int r = 1; r < 16; ++r) pm = fmaxf(pm, p0[r]);
#pragma unroll
        for (int r = 0; r < 4; ++r) pm = fmaxf(pm, p1[r]);
      } else {
#pragma unroll
        for (int r = 12; r < 16; ++r) BM(p0, r, 0);
#pragma unroll
        for (int r = 0; r < 16; ++r) BM(p1, r, 32);
        pm = p1[0];
#pragma unroll
        for (int r = 1; r < 16; ++r) pm = fmaxf(pm, p1[r]);
#pragma unroll
        for (int r = 12; r < 16; ++r) pm = fmaxf(pm, p0[r]);
      }
#undef BM
      { auto rr = __builtin_amdgcn_permlane32_swap(__float_as_uint(pm), __float_as_uint(pm), false, false); pm = fmaxf(__uint_as_float(rr[0]), __uint_as_float(rr[1])); }
      const bool first = krow == rlo_w;
      if (first || __any(pm - mref > THRL)) { const float mn = first ? pm : fmaxf(pm, mref);
        if (!first) { const float f = __builtin_amdgcn_exp2f(mref - mn); l_reg *= f; if (hi == 0) al_l[r32] = f; asm volatile("s_waitcnt lgkmcnt(0)" ::: "memory");
#pragma unroll
          for (int r = 0; r < 16; ++r) { const float a = al_l[crow(r, hi)]; o[0][r] *= a; o[1][r] *= a; } }
        mref = mn; }
      float ps = 0.f;
      if (H == 0) {
#pragma unroll
        for (int r = 0; r < 16; ++r) { p0[r] = __builtin_amdgcn_exp2f(p0[r] - mref); ps += p0[r]; }
#pragma unroll
        for (int r = 0; r < 4; ++r) { p1[r] = __builtin_amdgcn_exp2f(p1[r] - mref); ps += p1[r]; }
#pragma unroll
        for (int r = 4; r < 8; ++r) p1[r] = 0.f;
      } else {
#pragma unroll
        for (int r = 12; r < 16; ++r) { p0[r] = __builtin_amdgcn_exp2f(p0[r] - mref); ps += p0[r]; }
#pragma unroll
        for (int r = 0; r < 16; ++r) { p1[r] = __builtin_amdgcn_exp2f(p1[r] - mref); ps += p1[r]; }
#pragma unroll
        for (int r = 8; r < 12; ++r) p0[r] = 0.f;
      }
      { auto rr = __builtin_amdgcn_permlane32_swap(__float_as_uint(ps), __float_as_uint(ps), false, false); ps = __uint_as_float(rr[0]) + __uint_as_float(rr[1]); }
      l_reg += ps;
      bf16x8 pa0 = bf16x8{}, pa1, pa2, pa3 = bf16x8{};
#define PK4(P, BASE, OUT) do { unsigned a0 = cvtpk(P[BASE + 0], P[BASE + 1]), a1 = cvtpk(P[BASE + 2], P[BASE + 3]);   \
    unsigned b0 = cvtpk(P[BASE + 4], P[BASE + 5]), b1 = cvtpk(P[BASE + 6], P[BASE + 7]);                              \
    auto r0 = __builtin_amdgcn_permlane32_swap(a0, b0, false, false); auto r1 = __builtin_amdgcn_permlane32_swap(a1, b1, false, false); \
    u32x4 w = {r0[0], r1[0], r0[1], r1[1]}; OUT = __builtin_bit_cast(bf16x8, w); } while (0)
      const int vb = vb0 + slot * NA_SLOT;
      if (H == 0) { PK4(p0, 0, pa0); PK4(p0, 8, pa1); PK4(p1, 0, pa2); pv_ks<0, 0, 2>(o[0], vb, pa0, pa1, pa2, pa3); pv_ks<1, 0, 2>(o[1], vb, pa0, pa1, pa2, pa3); }
      else        { PK4(p0, 8, pa1); PK4(p1, 0, pa2); PK4(p1, 8, pa3); pv_ks<0, 1, 3>(o[0], vb, pa0, pa1, pa2, pa3); pv_ks<1, 1, 3>(o[1], vb, pa0, pa1, pa2, pa3); }
#undef PK4
    }
    slot = (slot + 1) & 3;
  }
#undef NDMA
  if (hi == 0) li_l[r32] = l_reg; asm volatile("s_waitcnt lgkmcnt(0)" ::: "memory");
  ATT_LAS bf16_t* stg = (ATT_LAS bf16_t*)(lds + NA_LDS_OST) + wid * 2048;
#pragma unroll
  for (int r = 0; r < 16; ++r) { const int orow = crow(r, hi); const float rl = __builtin_amdgcn_rcpf(li_l[orow]);
#pragma unroll
    for (int d0 = 0; d0 < 2; ++d0) { const unsigned w = cvtpk(o[d0][r] * rl, 0.f); stg[orow * 64 + d0 * 32 + r32] = (bf16_t)(w & 0xffffu); } }
  asm volatile("s_waitcnt lgkmcnt(0)" ::: "memory");
  bf16_t* Ow = O + (tok0 + (size_t)qrow * 64 + 32 * H) * PITCH + h * 64;
#pragma unroll
  for (int i = 0; i < 4; ++i) { const int row = i * 8 + (lane >> 3), ch = lane & 7; const u32x4 v = *(const ATT_LAS u32x4*)(stg + row * 64 + ch * 8); *(u32x4*)(Ow + (size_t)row * PITCH + ch * 8) = v; }
  NBAR();
#undef NBAR
}
__device__ __forceinline__ void na_unit(size_t tok0, int rows, int h, int R, const bf16_t* Q, const bf16_t* K, const bf16_t* V, bf16_t* O, const float* __restrict__ rpb_h,
                                        lptr lds, int tid, int wid, int lane) {
  asm volatile("" : "+v"(tid)); lane = tid & 63;
  ATT_LAS float* bias = (ATT_LAS float*)(lds + NA_LDS_B);
  for (int i = tid; i < 465; i += 512) bias[NA_BPAD + i] = rpb_h[i] * 1.4426950408889634f;
  const int qrow = R + (wid >> 1);
  if ((wid & 1) == 0) na_tiles<0>(tok0, rows, h, R, qrow, Q, K, V, O, lds, tid, wid, lane);
  else                na_tiles<1>(tok0, rows, h, R, qrow, Q, K, V, O, lds, tid, wid, lane);
}
#undef SBAR
}

#define XB_TMO      128
#define XB_XCNT(j)  (256  + 64 * (j))
#define XB_XSUB(j)  (1280 + 64 * (j))
#define XB_XGEN(j)  (2304 + 64 * (j))
#define XB_TOP      3328
#define XB_TOPGEN   3392
#define XCD_BAR_WORDS 3456
#define XB_SPIN_CAP (1u << 18)

__device__ __forceinline__ unsigned xb_ld(unsigned* p)              { return __hip_atomic_load(p, __ATOMIC_RELAXED, __HIP_MEMORY_SCOPE_AGENT); }
__device__ __forceinline__ unsigned xb_add(unsigned* p, unsigned v) { return __hip_atomic_fetch_add(p, v, __ATOMIC_RELAXED, __HIP_MEMORY_SCOPE_AGENT); }
__device__ __forceinline__ unsigned xb_xcc_id() { return (unsigned)__builtin_amdgcn_s_getreg((3 << 11) | 20) & 0xFu; }
#define XB_SPIN(cond, bar) do { unsigned _sp = 0; while (cond) { __builtin_amdgcn_s_sleep(1); \
    if ((++_sp & 255u) == 0u) { if (xb_ld(&(bar)[XB_TMO])) break; if (_sp > XB_SPIN_CAP) { atomicAdd(&(bar)[XB_TMO], 1u); break; } } } } while (0)

struct XcdBarrier {
    unsigned* bar; unsigned x; int w;
    volatile LAS unsigned* st;
};

__device__ __forceinline__ XcdBarrier xcd_barrier_post(unsigned* bar, volatile LAS unsigned* st) {
    XcdBarrier b; b.bar = bar; b.x = xb_xcc_id(); b.st = st; b.w = __builtin_amdgcn_readfirstlane((int)threadIdx.x >> 6);
    if (threadIdx.x == 0) (void)xb_add(&bar[XB_XCNT(b.x)], 1u);
    return b;
}
__device__ __forceinline__ void xcd_barrier_complete(unsigned* bar, unsigned x, unsigned& nloc, unsigned& nx) {
    const unsigned G = gridDim.x * gridDim.y * gridDim.z;
    unsigned sum, cnt, mine, sp = 0u;
    for (;;) {
        sum = 0u; cnt = 0u; mine = 0u;
#pragma unroll
        for (unsigned j = 0; j < 16; ++j) { const unsigned c = xb_ld(&bar[XB_XCNT(j)]); sum += c; cnt += (c > 0u) ? 1u : 0u; mine = (j == x) ? c : mine; }
        if (sum == G) break;
        __builtin_amdgcn_s_sleep(1);
        if ((++sp & 255u) == 0u) { if (xb_ld(&bar[XB_TMO])) break; if (sp > XB_SPIN_CAP) { atomicAdd(&bar[XB_TMO], 1u); break; } }
    }
    nloc = mine > 0u ? mine : 1u; nx = cnt > 0u ? cnt : 1u;
}

__device__ __forceinline__ void xcd_barrier(const XcdBarrier& b) {
    asm volatile("s_waitcnt vmcnt(0)" ::: "memory");
    __syncthreads();
    if (b.w == 0 && LANE_ID() == 0) {
        unsigned* bar = b.bar;
        __builtin_amdgcn_s_waitcnt(0);
        unsigned nloc = b.st[0], nx = b.st[1];
        if (nloc == 0u) { xcd_barrier_complete(bar, b.x, nloc, nx); b.st[0] = nloc; b.st[1] = nx; }
        const unsigned old = xb_add(&bar[XB_XSUB(b.x)], 1u);
        const unsigned gen = old / nloc;
        if (old + 1u == (gen + 1u) * nloc) {
            __builtin_amdgcn_fence(__ATOMIC_RELEASE, "agent");
            asm volatile("s_waitcnt vmcnt(0)" ::: "memory");
            const unsigned og = xb_add(&bar[XB_TOP], 1u);
            const unsigned tg = og / nx;
            if (og + 1u == (tg + 1u) * nx) xb_add(&bar[XB_TOPGEN], 1u);
            else XB_SPIN(xb_ld(&bar[XB_TOPGEN]) == tg, bar);
            __builtin_amdgcn_fence(__ATOMIC_ACQUIRE, "agent");
            xb_add(&bar[XB_XGEN(b.x)], 1u);
            asm volatile("s_waitcnt vmcnt(0)" ::: "memory");
        } else {
            XB_SPIN(xb_ld(&bar[XB_XGEN(b.x)]) == gen, bar);
            __builtin_amdgcn_fence(__ATOMIC_ACQUIRE, "agent");
            asm volatile("s_waitcnt vmcnt(0)" ::: "memory");
        }
    }
    __syncthreads();
}

constexpr int NWAVES = 8;
#ifndef FUSE_THIN
#define FUSE_THIN 0
#endif
#ifndef MK_PER_PHASE
#define MK_PER_PHASE 0
#endif
constexpr int NPH = 15;

constexpr size_t MiB = 1u << 20;
constexpr size_t WS_CTL = 0, CTL_ZERO_BYTES = 1 * MiB;
constexpr size_t WS_ROPE_C = 1 * MiB, WS_ROPE_S = 2 * MiB, WS_RS = 3 * MiB;
constexpr size_t WS_WQKV0 = 4 * MiB, WS_WO0 = 10 * MiB, WS_WIN0 = 12 * MiB, WS_WOUT0 = 23 * MiB;
constexpr size_t WS_WQKV1 = 29 * MiB, WS_WO1 = 35 * MiB, WS_WIN1 = 37 * MiB, WS_WOUT1 = 48 * MiB;
constexpr size_t WS_XN = 56 * MiB;
constexpr size_t WS_Q = 218 * MiB, WS_K = 378 * MiB, WS_V = 538 * MiB;
constexpr size_t WS_G = 218 * MiB;
constexpr size_t WS_MB = 698 * MiB;
constexpr size_t WS_PARK = 858 * MiB;
constexpr size_t WS_END = 896 * MiB;
static_assert(WS_WOUT1 + (size_t)D * FF * 2 <= WS_XN - 4096 && WS_XN + (size_t)(NMT_CONV * 254 + 2) * D * 2 <= WS_Q && WS_G + (size_t)M * FF * 2 <= WS_MB && WS_MB + (size_t)M * D * 2 <= WS_PARK, "d_ws map");
constexpr int CW_PANEL = 16384, PANEL_BANK = 320 * 64;
constexpr int CW_TP = 8000;
constexpr int CW_KMAX = 8192;
constexpr int CW_BAR = 4096;

constexpr int RING_OFF = 0, RING_BYTES = 131072;
constexpr int LDSCTL_OFF = RING_BYTES, MISC_OFF = LDSCTL_OFF + 320;
constexpr int XCH_OFF = RING_BYTES + 1024;
constexpr int LDS_BYTES = 147456;
static_assert(XCH_OFF + 8192 + 4096 <= LDS_BYTES && att::DA_LDS_TOTAL <= RING_BYTES && att::NA_LDS_BYTES <= RING_BYTES, "LDS map");

__device__ __forceinline__ void p0_transpose_item(const float* W, int K, int N, bf16* WT, int k0, int n0, int drow0, const float* gk, LAS float* scr, int lane) {
#pragma unroll 8
    for (int i = 0; i < 32; ++i) { const int kk = 2 * i + (lane >> 5); float w = W[(size_t)(k0 + kk) * N + n0 + (lane & 31)]; if (gk) w *= gk[k0 + kk]; scr[kk * 33 + (lane & 31)] = w; }
    LDS_WAIT(); asm volatile("" ::: "memory");
    const int c = lane & 7;
#pragma unroll
    for (int j = 0; j < 4; ++j) { const int n = (lane >> 3) + 8 * j; const LAS float* s = scr + (8 * c) * 33 + n;
        v4u o; o.x = pk2(s[0 * 33], s[1 * 33]); o.y = pk2(s[2 * 33], s[3 * 33]); o.z = pk2(s[4 * 33], s[5 * 33]); o.w = pk2(s[6 * 33], s[7 * 33]);
        *(GAS v4u*)(WT + (size_t)(drow0 + n) * K + k0 + 8 * c) = o; }
    LDS_WAIT(); asm volatile("" ::: "memory");
}
__device__ __forceinline__ void p0_matrix(const float* W, int K, int N, bf16* WT, const float* gk, int mode, int roff, LAS float* scr, int gw, int NGW, int lane) {
    const int nblk = N / 32, nitems = (K / 64) * nblk;
    for (int it = gw; it < nitems; it += NGW) {
        const int kb = it / nblk, nb = it % nblk, n0 = 32 * nb; int drow0;
        if (mode == 0) drow0 = roff + n0;
        else if (mode == 1) { const int bj = n0 >= FF ? 1 : 0, ch = n0 - bj * FF; drow0 = (ch >> 7) * 256 + bj * 128 + (ch & 127); }
        else { const int s = n0 >> 6, half = (n0 >> 5) & 1; drow0 = roff + (s >> 2) * 256 + half * 128 + (s & 3) * 32; }
        p0_transpose_item(W, K, N, WT, 64 * kb, n0, drow0, gk, scr, lane);
    }
}
__device__ __forceinline__ void sincos_small(double x, double& s, double& c) {
    const double x2 = x * x;
    double a = -1.0 / 25852016738884976640000.0;
    a = a * x2 + 1.0 / 51090942171709440000.0;
    a = a * x2 - 1.0 / 121645100408832000.0;
    a = a * x2 + 1.0 / 355687428096000.0;
    a = a * x2 - 1.0 / 1307674368000.0;
    a = a * x2 + 1.0 / 6227020800.0;
    a = a * x2 - 1.0 / 39916800.0;
    a = a * x2 + 1.0 / 362880.0;
    a = a * x2 - 1.0 / 5040.0;
    a = a * x2 + 1.0 / 120.0;
    a = a * x2 - 1.0 / 6.0;
    a = a * x2 + 1.0;
    s = a * x;
    double b = 1.0 / 620448401733239439360000.0;
    b = b * x2 - 1.0 / 1124000727777607680000.0;
    b = b * x2 + 1.0 / 2432902008176640000.0;
    b = b * x2 - 1.0 / 6402373705728000.0;
    b = b * x2 + 1.0 / 20922789888000.0;
    b = b * x2 - 1.0 / 87178291200.0;
    b = b * x2 + 1.0 / 479001600.0;
    b = b * x2 - 1.0 / 3628800.0;
    b = b * x2 + 1.0 / 40320.0;
    b = b * x2 - 1.0 / 720.0;
    b = b * x2 + 1.0 / 24.0;
    b = b * x2 - 0.5;
    b = b * x2 + 1.0;
    c = b;
}
struct Args { const float* in[22]; float* out; unsigned char* ws; int ph_lo, ph_hi; };
__global__ void __launch_bounds__(NWAVES * 64, 2) mega_fwd(Args args) {
    extern __shared__ __attribute__((aligned(16))) unsigned char lds_raw[];
    LAS unsigned char* lds = (LAS unsigned char*)lds_raw;
    volatile LAS unsigned* MISC = (volatile LAS unsigned*)(lds + MISC_OFF);
    const int wave = __builtin_amdgcn_readfirstlane((int)threadIdx.x >> 6);
#define lane LANE_ID()
#define tid (wave * 64 + LANE_ID())
    const int G = gridDim.x, bx = blockIdx.x, vcu = (G % 8 == 0) ? (bx % 8) * (G / 8) + bx / 8 : bx;
    const int gw = vcu * NWAVES + wave, NGW = G * NWAVES;
    unsigned char* ws = args.ws;
    gu32* ctl = (gu32*)(ws + WS_CTL);
    for (int u = tid; u < (LDS_BYTES - LDSCTL_OFF) / 4; u += NWAVES * 64) ((LAS unsigned*)(lds + LDSCTL_OFF))[u] = 0u;
    __syncthreads();
    XcdBarrier bar; bar.bar = (unsigned*)(ctl + CW_BAR); bar.x = 0; bar.st = nullptr; bar.w = wave;
    if (!MK_PER_PHASE) bar = xcd_barrier_post((unsigned*)(ctl + CW_BAR), MISC + 8);
#if defined(BPROBE)
    unsigned long long bp_acc = 0; int bp_k = 0;
#define GRID_BAR() do { const unsigned long long t_ = __builtin_amdgcn_s_memrealtime(); xcd_barrier(bar); if (bp_k >= BPROBE_LO && bp_k < BPROBE_HI) bp_acc += __builtin_amdgcn_s_memrealtime() - t_; ++bp_k; } while (0)
#else
#define GRID_BAR() do { if (!MK_PER_PHASE) xcd_barrier(bar); } while (0)
#endif
    const int lo = args.ph_lo, hi = args.ph_hi;
#ifndef PH_MASK
#define PH_MASK 0x7fff
#endif
#define IN(k) (((PH_MASK >> (k)) & 1) && lo <= (k) && (k) < hi)
#define BOTH(k) (IN(k) && IN((k) + 1))
#ifndef PROBE_DUP
#define PROBE_DUP -1
#endif
#define REPS(k) (((k) == PROBE_DUP) ? 2 : 1)

#if defined(GPROBE)
#define GP_ARG(k) ((k) == GPROBE_PHASE ? (unsigned*)(ctl + CW_TP) : (unsigned*)nullptr)
#else
#define GP_ARG(k) ((unsigned*)nullptr)
#endif
#if defined(DPROBE)
#define DP_ARG ((unsigned*)(ctl + CW_TP))
#else
#define DP_ARG ((unsigned*)nullptr)
#endif
#if defined(PPROBE)
    unsigned long long pp_t0 = 0, pp_t1 = 0;
#define PP_BEGIN(k) do { if ((k) == PPROBE) pp_t0 = __builtin_amdgcn_s_memrealtime(); } while (0)
#define PP_END(k) do { if ((k) == PPROBE) pp_t1 = __builtin_amdgcn_s_memrealtime(); } while (0)
#else
#define PP_BEGIN(k) do {} while (0)
#define PP_END(k) do {} while (0)
#endif
#if defined(TPROBE)
    unsigned long long tp_c0 = 0, tp_r0 = 0, tp_c1 = 0, tp_r1 = 0;
#define TP_BEGIN(k) do { if ((k) == TPROBE) { tp_c0 = __builtin_amdgcn_s_memtime(); tp_r0 = __builtin_amdgcn_s_memrealtime(); } } while (0)
#define TP_END(k) do { if ((k) == TPROBE) { tp_c1 = __builtin_amdgcn_s_memtime(); tp_r1 = __builtin_amdgcn_s_memrealtime(); } } while (0)
#else
#define TP_BEGIN(k) do {} while (0)
#define TP_END(k) do {} while (0)
#endif
    const float* x_p = args.in[0]; const float* x_s = args.in[1];
    const float* attn_pre_g = args.in[2]; const float* attn_post_g = args.in[3]; const float* ffn_pre_g = args.in[4]; const float* ffn_post_g = args.in[5];
    float* out = args.out;
    bf16* XN = (bf16*)(ws + WS_XN); bf16* QB = (bf16*)(ws + WS_Q); bf16* KB = (bf16*)(ws + WS_K); bf16* VB = (bf16*)(ws + WS_V); bf16* GB = (bf16*)(ws + WS_G); bf16* MB = (bf16*)(ws + WS_MB);
    float* ROPE_C = (float*)(ws + WS_ROPE_C); float* ROPE_S = (float*)(ws + WS_ROPE_S); float* RS = (float*)(ws + WS_RS);
    constexpr size_t TSTEP_D = (size_t)256 * D * 2, TSTEP_FF = (size_t)256 * FF * 2, TSTEP_CONV = (size_t)254 * D * 2;

    if (IN(0)) for (int rep_ = 0; rep_ < REPS(0); ++rep_) { PP_BEGIN(0);
        LAS float* scr = (LAS float*)(lds + RING_OFF + wave * 16384);
        p0_matrix(args.in[6], D, 3 * D, (bf16*)(ws + WS_WQKV0), attn_pre_g, 0, 0, scr, gw, NGW, lane);
        p0_matrix(args.in[8], D, D, (bf16*)(ws + WS_WO0), nullptr, 0, 0, scr, gw, NGW, lane);
        p0_matrix(args.in[18], D, FF2, (bf16*)(ws + WS_WIN0), ffn_pre_g, 1, 0, scr, gw, NGW, lane);
        p0_matrix(args.in[21], FF, D, (bf16*)(ws + WS_WOUT0), nullptr, 0, 0, scr, gw, NGW, lane);
        p0_matrix(args.in[9], D, D, (bf16*)(ws + WS_WQKV1), attn_pre_g + D, 2, 0, scr, gw, NGW, lane);
        p0_matrix(args.in[10], D, D, (bf16*)(ws + WS_WQKV1), attn_pre_g + D, 2, D, scr, gw, NGW, lane);
        p0_matrix(args.in[11], D, D, (bf16*)(ws + WS_WQKV1), attn_pre_g + D, 0, 2 * D, scr, gw, NGW, lane);
        p0_matrix(args.in[17], D, D, (bf16*)(ws + WS_WO1), nullptr, 0, 0, scr, gw, NGW, lane);
        p0_matrix(args.in[18] + (size_t)D * FF2, D, FF2, (bf16*)(ws + WS_WIN1), ffn_pre_g + D, 1, 0, scr, gw, NGW, lane);
        p0_matrix(args.in[21] + (size_t)FF * D, FF, D, (bf16*)(ws + WS_WOUT1), nullptr, 0, 0, scr, gw, NGW, lane);
        for (int i = gw * 64 + lane; i < T_S * 32; i += NGW * 64) {
            const int t = i >> 5, d = i & 31;
            double inv = 1.0; for (int q = 0; q < d; ++q) inv *= 0.7498942093324559;
            const double ang = (double)t * inv;
            const double k = __builtin_rint(ang * 0.15915494309189535);
            double xr = __builtin_fma(-k, 6.283185307179586, ang); xr = __builtin_fma(-k, 2.4492935982947064e-16, xr);
            double s, c; sincos_small(xr, s, c);
            ROPE_C[i] = (float)c; ROPE_S[i] = (float)s;
        }
        thin_pass<0>(x_p, x_s, XN, nullptr, nullptr, RS, nullptr, gw, NGW, lane);
        PP_END(0); if (BOTH(0)) GRID_BAR();
    }
    if (IN(1)) for (int rep_ = 0; rep_ < REPS(1); ++rep_) { PP_BEGIN(1);
        pg8::Gemm g{XN, (const bf16*)(ws + WS_WQKV0), M, 3 * D, D, TSTEP_D}; pg8::StaticOrder S; S.init(M, 3 * D, G, bx);
        pg8::EpiBf16<0> E{QB, D, RS, D, (size_t)(WS_K - WS_Q) / 2, att::QSCALE};
        pg8::gemm_phase<pg8::EpiBf16<0>, pg8::StaticOrder, true, true>(lds + RING_OFF, g, S, E, wave, GP_ARG(1));
        PP_END(1); if (BOTH(1)) GRID_BAR();
    }
    if (IN(2)) for (int rep_ = 0; rep_ < REPS(2); ++rep_) { PP_BEGIN(2);
        constexpr int NU_P = 4 * 16 * 16, NU = NU_P + 8 * 16 * 32;
        const int per = (NU + G - 1) / G, u0 = vcu * per, u1 = (u0 + per < NU) ? u0 + per : NU;
        for (int u = u0; u < u1; ++u) {
            size_t tok0; int rows, h, R;
            if (u < NU_P) { const int b = u >> 8, r = u & 255; tok0 = (size_t)b * T_P; rows = 64; h = r >> 4; R = (r & 15) * 4; }
            else { const int v = u - NU_P, b = v >> 9, r = v & 511; tok0 = (size_t)M_P + (size_t)b * T_S; rows = 128; h = r >> 5; R = (r & 31) * 4; }
            __syncthreads();
            att::na_unit(tok0, rows, h, R, QB, KB, VB, MB, args.in[7] + h * 465, (att::lptr)(lds + RING_OFF), tid, wave, lane);
        }
        __syncthreads();
        PP_END(2); if (BOTH(2)) GRID_BAR();
    }
    if (IN(3)) for (int rep_ = 0; rep_ < REPS(3); ++rep_) { PP_BEGIN(3);
        pg8::Gemm g{MB, (const bf16*)(ws + WS_WO0), M, D, D, TSTEP_D}; pg8::StaticOrder S; S.init(M, D, G, bx);
        #if FUSE_THIN
        pg8::EpiThin<1> E{QB, XN, attn_post_g, RS, nullptr, (unsigned*)(ctl + CW_PANEL + 0 * PANEL_BANK), (PG8_LAS unsigned*)(lds + MISC_OFF + 64), D / 256};
        pg8::gemm_phase<pg8::EpiThin<1>, pg8::StaticOrder, true, true>(lds + RING_OFF, g, S, E, wave);
#else
        pg8::EpiBf16<0> E{QB, D, nullptr, 0, 0, 1.f};
        pg8::gemm_phase<pg8::EpiBf16<0>, pg8::StaticOrder, true, true>(lds + RING_OFF, g, S, E, wave);
#endif
        PP_END(3); if (BOTH(3)) GRID_BAR();
    }
    if (!FUSE_THIN && IN(4)) for (int rep_ = 0; rep_ < REPS(4); ++rep_) { PP_BEGIN(4); thin_pass<1>(nullptr, nullptr, XN, QB, attn_post_g, RS, nullptr, gw, NGW, lane); PP_END(4); if (BOTH(4)) GRID_BAR(); }
#if defined(PROBE_NULL5)
    if (IN(5)) {
        pg8::Gemm g{XN - D, (const bf16*)(ws + WS_WIN0), M, FF2, D, TSTEP_CONV}; pg8::StaticOrder S; S.init_tiles(NMT_CONV, FF2 / 256, G, bx);
        pg8::EpiNull E{(float*)(ws + WS_PARK)};
        pg8::gemm_phase<pg8::EpiNull, pg8::StaticOrder, true, true>(lds + RING_OFF, g, S, E, wave);
        GRID_BAR();
    }
#endif
    if (IN(5)) for (int rep_ = 0; rep_ < REPS(5); ++rep_) { PP_BEGIN(5); TP_BEGIN(5);
        pg8::Gemm g{XN - D, (const bf16*)(ws + WS_WIN0), M, FF2, D, TSTEP_CONV}; pg8::StaticOrder S; S.init_tiles(NMT_CONV, FF2 / 256, G, bx);
        pg8::EpiConvGlu E{GB, args.in[19], args.in[20], (PG8_LAS float*)(lds + XCH_OFF), M, RS, (PG8_LAS float*)(lds + XCH_OFF + 8192)};
        pg8::gemm_phase<pg8::EpiConvGlu, pg8::StaticOrder, true, true>(lds + RING_OFF, g, S, E, wave, GP_ARG(5));
        TP_END(5); PP_END(5); if (BOTH(5)) GRID_BAR();
    }
    if (IN(6)) for (int rep_ = 0; rep_ < REPS(6); ++rep_) { PP_BEGIN(6); TP_BEGIN(6);
        pg8::Gemm g{GB, (const bf16*)(ws + WS_WOUT0), M, D, FF, TSTEP_FF}; pg8::StaticOrder S; S.init(M, D, G, bx);
        #if FUSE_THIN
        pg8::EpiThin<1> E{MB, XN, ffn_post_g, RS, nullptr, (unsigned*)(ctl + CW_PANEL + 1 * PANEL_BANK), (PG8_LAS unsigned*)(lds + MISC_OFF + 64), D / 256};
        pg8::gemm_phase<pg8::EpiThin<1>, pg8::StaticOrder, true, true>(lds + RING_OFF, g, S, E, wave);
#else
        pg8::EpiBf16<0> E{MB, D, nullptr, 0, 0, 1.f};
        pg8::gemm_phase<pg8::EpiBf16<0>, pg8::StaticOrder, true, true>(lds + RING_OFF, g, S, E, wave);
#endif
        TP_END(6); PP_END(6); if (BOTH(6)) GRID_BAR();
    }
    if (!FUSE_THIN && IN(7)) for (int rep_ = 0; rep_ < REPS(7); ++rep_) { PP_BEGIN(7); thin_pass<1>(nullptr, nullptr, XN, MB, ffn_post_g, RS, nullptr, gw, NGW, lane); PP_END(7); if (BOTH(7)) GRID_BAR(); }
    if (IN(8)) for (int rep_ = 0; rep_ < REPS(8); ++rep_) { PP_BEGIN(8);
        pg8::Gemm g{XN, (const bf16*)(ws + WS_WQKV1), M, 3 * D, D, TSTEP_D}; pg8::StaticOrder S; S.init(M, 3 * D, G, bx);
        pg8::EpiRope E{QB, KB, VB, ROPE_C, ROPE_S, att::QSCALE, RS, (unsigned*)(ctl + CW_KMAX)};
        pg8::gemm_phase<pg8::EpiRope, pg8::StaticOrder, true, true>(lds + RING_OFF, g, S, E, wave, GP_ARG(8));
        PP_END(8); if (BOTH(8)) GRID_BAR();
    }
#if defined(PROBE_DAV)
    if (IN(9)) for (int vrep_ = 0; vrep_ < 2; ++vrep_) { const int variant_ = vrep_ == 0 ? PROBE_DAV : 0;
#else
    if (IN(9)) { const int variant_ = 0;
#endif
    for (int rep_ = 0; rep_ < REPS(9); ++rep_) { PP_BEGIN(9); TP_BEGIN(9);
        float lam;
        { const float a = wave_sum(args.in[12][lane] * args.in[13][lane]), b = wave_sum(args.in[14][lane] * args.in[15][lane]); lam = __expf(a) - __expf(b) + LAMBDA_INIT; }
        asm volatile("" : "+v"(lam));
        const unsigned lam_bits = __builtin_amdgcn_readfirstlane(__float_as_uint(lam));
        float* park = (float*)(ws + WS_PARK) + (size_t)bx * 32768;
        constexpr int NP = 4 * 8 * 16, NS = 8 * 8 * 32;
#pragma clang loop unroll(disable)
        for (int id = vcu; id < NP + NS; id += G) {
            size_t rowbase; int T, h, qb, bidx;
            if (id < NP) { const int bh = id >> 4; qb = id & 15; bidx = bh >> 3; rowbase = (size_t)bidx * T_P; T = T_P; h = bh & 7; }
            else { const int bh = (id - NP) >> 5; qb = (id - NP) & 31; bidx = 4 + (bh >> 3); rowbase = (size_t)M_P + (size_t)(bh >> 3) * T_S; T = T_S; h = bh & 7; }
            att::da_unit(rowbase, T, h, qb, QB, KB, VB, MB, park, lam_bits, 1.0f - LAMBDA_INIT, args.in[16], (const unsigned*)(ctl + CW_KMAX) + bidx * 16, (att::lptr)(lds + RING_OFF), tid, wave, lane, DP_ARG, variant_);
        }
        TP_END(9); PP_END(9); if (BOTH(9)) GRID_BAR();
    } }
    if (IN(10)) for (int rep_ = 0; rep_ < REPS(10); ++rep_) { PP_BEGIN(10);
        pg8::Gemm g{MB, (const bf16*)(ws + WS_WO1), M, D, D, TSTEP_D}; pg8::StaticOrder S; S.init(M, D, G, bx);
        #if FUSE_THIN
        pg8::EpiThin<1> E{QB, XN, attn_post_g + D, RS, nullptr, (unsigned*)(ctl + CW_PANEL + 2 * PANEL_BANK), (PG8_LAS unsigned*)(lds + MISC_OFF + 64), D / 256};
        pg8::gemm_phase<pg8::EpiThin<1>, pg8::StaticOrder, true, true>(lds + RING_OFF, g, S, E, wave);
#else
        pg8::EpiBf16<0> E{QB, D, nullptr, 0, 0, 1.f};
        pg8::gemm_phase<pg8::EpiBf16<0>, pg8::StaticOrder, true, true>(lds + RING_OFF, g, S, E, wave);
#endif
        PP_END(10); if (BOTH(10)) GRID_BAR();
    }
    if (!FUSE_THIN && IN(11)) for (int rep_ = 0; rep_ < REPS(11); ++rep_) { PP_BEGIN(11); thin_pass<1>(nullptr, nullptr, XN, QB, attn_post_g + D, RS, nullptr, gw, NGW, lane); PP_END(11); if (BOTH(11)) GRID_BAR(); }
    if (IN(12)) for (int rep_ = 0; rep_ < REPS(12); ++rep_) { PP_BEGIN(12);
        pg8::Gemm g{XN - D, (const bf16*)(ws + WS_WIN1), M, FF2, D, TSTEP_CONV}; pg8::StaticOrder S; S.init_tiles(NMT_CONV, FF2 / 256, G, bx);
        pg8::EpiConvGlu E{GB, args.in[19] + 3 * FF2, args.in[20] + FF2, (PG8_LAS float*)(lds + XCH_OFF), M, RS, (PG8_LAS float*)(lds + XCH_OFF + 8192)};
        pg8::gemm_phase<pg8::EpiConvGlu, pg8::StaticOrder, true, true>(lds + RING_OFF, g, S, E, wave);
        PP_END(12); if (BOTH(12)) GRID_BAR();
    }
    if (IN(13)) for (int rep_ = 0; rep_ < REPS(13); ++rep_) { PP_BEGIN(13);
        pg8::Gemm g{GB, (const bf16*)(ws + WS_WOUT1), M, D, FF, TSTEP_FF}; pg8::StaticOrder S; S.init(M, D, G, bx);
        #if FUSE_THIN
        pg8::EpiThin<2> E{MB, XN, ffn_post_g + D, RS, out, (unsigned*)(ctl + CW_PANEL + 3 * PANEL_BANK), (PG8_LAS unsigned*)(lds + MISC_OFF + 64), D / 256};
        pg8::gemm_phase<pg8::EpiThin<2>, pg8::StaticOrder, true, true>(lds + RING_OFF, g, S, E, wave);
#else
        pg8::EpiBf16<0> E{MB, D, nullptr, 0, 0, 1.f};
        pg8::gemm_phase<pg8::EpiBf16<0>, pg8::StaticOrder, true, true>(lds + RING_OFF, g, S, E, wave);
#endif
        PP_END(13); if (BOTH(13)) GRID_BAR();
    }
    if (!FUSE_THIN && IN(14)) for (int rep_ = 0; rep_ < REPS(14); ++rep_) { PP_BEGIN(14); thin_pass<2>(nullptr, nullptr, XN, MB, ffn_post_g + D, nullptr, out, gw, NGW, lane); }
#if defined(DPROBE)
    if (bx == 0 && hi > 14) {
        const unsigned long long tk = (unsigned long long)__hip_atomic_load(ctl + CW_TP, __ATOMIC_RELAXED, __HIP_MEMORY_SCOPE_AGENT);
        const unsigned long long t0_ = __builtin_amdgcn_s_memrealtime(); while (__builtin_amdgcn_s_memrealtime() - t0_ < tk) __builtin_amdgcn_s_sleep(16); }
#endif
#if defined(PPROBE)
    if (hi > 14) {
        const unsigned dur = (unsigned)(pp_t1 - pp_t0);
        if (tid == 0) { if (PPROBE_STAT == 1) atomicMax((unsigned*)(ctl + CW_TP), dur); else if (PPROBE_STAT == 2) atomicMax((unsigned*)(ctl + CW_TP), 0x40000000u - dur); else if (bx == 0) __hip_atomic_store(ctl + CW_TP, dur, __ATOMIC_RELAXED, __HIP_MEMORY_SCOPE_AGENT); }
        xcd_barrier(bar);
        if (bx == 0) { unsigned v = __hip_atomic_load(ctl + CW_TP, __ATOMIC_RELAXED, __HIP_MEMORY_SCOPE_AGENT); if (PPROBE_STAT == 2) v = 0x40000000u - v;
            const unsigned long long tk = (unsigned long long)v * PPROBE_SCALE;
            const unsigned long long t0_ = __builtin_amdgcn_s_memrealtime(); while (__builtin_amdgcn_s_memrealtime() - t0_ < tk) __builtin_amdgcn_s_sleep(16); }
    }
#endif
#if defined(BPROBE)
    if (hi > 14) {
        if (bx == BPROBE_BLOCK && tid == 0) __hip_atomic_store(ctl + CW_TP, (unsigned)bp_acc, __ATOMIC_RELAXED, __HIP_MEMORY_SCOPE_AGENT);
        xcd_barrier(bar);
        if (bx == 0) { const unsigned long long tk = (unsigned long long)__hip_atomic_load(ctl + CW_TP, __ATOMIC_RELAXED, __HIP_MEMORY_SCOPE_AGENT);
            const unsigned long long t0_ = __builtin_amdgcn_s_memrealtime(); while (__builtin_amdgcn_s_memrealtime() - t0_ < tk) __builtin_amdgcn_s_sleep(16); }
    }
#endif
#if defined(GPROBE)
    if (bx == 0 && hi > 14) {
        const unsigned long long tk = (unsigned long long)__hip_atomic_load(ctl + CW_TP, __ATOMIC_RELAXED, __HIP_MEMORY_SCOPE_AGENT) * GPROBE_SCALE;
        const unsigned long long t0_ = __builtin_amdgcn_s_memrealtime(); while (__builtin_amdgcn_s_memrealtime() - t0_ < tk) __builtin_amdgcn_s_sleep(16);
    }
#endif
#if defined(TPROBE)
    if (bx == 0 && hi > 14) {
        const unsigned long long mhz = (tp_c1 - tp_c0) * 100ull / (tp_r1 - tp_r0 + 1ull);
        const unsigned long long t0_ = __builtin_amdgcn_s_memrealtime(); while (__builtin_amdgcn_s_memrealtime() - t0_ < mhz * 100ull) __builtin_amdgcn_s_sleep(16);
    }
#endif
#undef IN
#undef BOTH
#undef GRID_BAR
#undef lane
#undef tid
}

extern "C" void kernel_launch(void* const* d_in, const int* in_sizes, int n_in, void* d_out, int out_size, void* d_ws, size_t ws_size, hipStream_t stream) {
    static int grid = 0;
    if (grid == 0) {
        if (n_in != 22 || in_sizes[0] != M_P * D || in_sizes[1] != M_S * D || out_size != M * D || ws_size < WS_END) {
            fprintf(stderr, "kernel_launch: unexpected shapes (n_in %d, in0 %d, in1 %d, out %d, ws %zu); nothing launched\n", n_in, n_in > 0 ? in_sizes[0] : -1, n_in > 1 ? in_sizes[1] : -1, out_size, ws_size); grid = -1; return; }
        int dev = 0, cus = 0, per_cu = 0;
        if (hipGetDevice(&dev) != hipSuccess || hipDeviceGetAttribute(&cus, hipDeviceAttributeMultiprocessorCount, dev) != hipSuccess) { fprintf(stderr, "kernel_launch: device query failed\n"); grid = -1; return; }
        if (hipFuncSetAttribute((const void*)mega_fwd, hipFuncAttributeMaxDynamicSharedMemorySize, LDS_BYTES) != hipSuccess) { fprintf(stderr, "kernel_launch: hipFuncSetAttribute failed\n"); grid = -1; return; }
        if (hipOccupancyMaxActiveBlocksPerMultiprocessor(&per_cu, (const void*)mega_fwd, NWAVES * 64, LDS_BYTES) != hipSuccess || per_cu < 1) { fprintf(stderr, "kernel_launch: occupancy query says %d blocks per CU\n", per_cu); }
        (void)hipGetLastError();
        grid = cus;
    }
    if (grid < 0) return;
    if (hipMemsetAsync((char*)d_ws + WS_CTL, 0, CTL_ZERO_BYTES, stream) != hipSuccess) { fprintf(stderr, "kernel_launch: memset failed\n"); return; }
    Args a{};
    for (int i = 0; i < 22; ++i) a.in[i] = (const float*)d_in[i];
    a.out = (float*)d_out; a.ws = (unsigned char*)d_ws;
#if MK_PER_PHASE
    for (int p = 0; p < NPH; ++p) { a.ph_lo = p; a.ph_hi = p + 1; hipLaunchKernelGGL(mega_fwd, dim3(grid), dim3(NWAVES * 64), LDS_BYTES, stream, a); }
#else
    a.ph_lo = 0; a.ph_hi = NPH;
    hipLaunchKernelGGL(mega_fwd, dim3(grid), dim3(NWAVES * 64), LDS_BYTES, stream, a);
#endif
    const hipError_t le = hipPeekAtLastError();
    if (le != hipSuccess) fprintf(stderr, "kernel_launch: launch failed: %s\n", hipGetErrorName(le));
}
```

```cpp
#include <hip/hip_runtime.h>
#include <cstdio>
#include <cstdint>
#include <cmath>
#define GAS __attribute__((address_space(1)))
#define LAS __attribute__((address_space(3)))
typedef unsigned short bf16;
typedef unsigned v4u __attribute__((ext_vector_type(4)));
typedef float f32x4 __attribute__((ext_vector_type(4)));
typedef short bf16x8 __attribute__((ext_vector_type(8)));
typedef GAS unsigned gu32;
typedef GAS unsigned long long gu64;
__device__ __forceinline__ int lane_id_fresh() { int x; asm volatile("v_mbcnt_lo_u32_b32 %0, -1, 0\n\tv_mbcnt_hi_u32_b32 %0, -1, %0" : "=v"(x)); return x; }
#define LANE_ID() lane_id_fresh()
#define RLX_AGENT __ATOMIC_RELAXED, __HIP_MEMORY_SCOPE_AGENT
#define LDS_WAIT() asm volatile("s_waitcnt lgkmcnt(0)" ::: "memory")
#define VM_WAIT() asm volatile("s_waitcnt vmcnt(0)" ::: "memory")
__device__ __forceinline__ unsigned long long rt() { return __builtin_amdgcn_s_memrealtime(); }
__device__ __forceinline__ unsigned f2bf(float f) { unsigned u = __builtin_bit_cast(unsigned, f); return (u + 0x7fffu + ((u >> 16) & 1u)) >> 16; }
__device__ __forceinline__ unsigned pk2(float lo, float hi) { return f2bf(lo) | (f2bf(hi) << 16); }
constexpr int D = 1024, M_P = 4 * 4096, M_S = 8 * 8192, M = M_P + M_S, T_P = 4096, T_S = 8192, FF = 2816, FF2 = 2 * FF;
constexpr int NMT_CONV = (M + 253) / 254;
constexpr float NORM_EPS = 1e-6f;
constexpr float LAMBDA_INIT = 0.35550907f;

__device__ __forceinline__ float wave_sum(float v) {
#pragma unroll
    for (int o = 1; o < 64; o <<= 1) v += __shfl_xor(v, o);
    return v;
}
__device__ __forceinline__ f32x4 bf4_to_f32(unsigned long long w) {
    f32x4 v; v.x = __uint_as_float((unsigned)(w & 0xffffull) << 16); v.y = __uint_as_float((unsigned)((w >> 16) & 0xffffull) << 16);
    v.z = __uint_as_float((unsigned)((w >> 32) & 0xffffull) << 16); v.w = __uint_as_float((unsigned)(w >> 48) << 16); return v;
}
__device__ __forceinline__ void bf8_to_f32(v4u w, f32x4& a, f32x4& b) {
    a.x = __uint_as_float(w.x << 16); a.y = __uint_as_float(w.x & 0xffff0000u); a.z = __uint_as_float(w.y << 16); a.w = __uint_as_float(w.y & 0xffff0000u);
    b.x = __uint_as_float(w.z << 16); b.y = __uint_as_float(w.z & 0xffff0000u); b.z = __uint_as_float(w.w << 16); b.w = __uint_as_float(w.w & 0xffff0000u);
}
__device__ __forceinline__ float sq4(f32x4 v) { return (v.x * v.x + v.y * v.y) + (v.z * v.z + v.w * v.w); }
template <int MODE, int R = 4>
__device__ __forceinline__ void thin_rows(const float* xp, const float* xs, bf16* xb, const bf16* mb, const float* gpost, float* rs, float* out, int row0, int row1, int rstep, int lane) {
    f32x4 g[2][2];
    if (MODE != 0) {
#pragma unroll
        for (int j = 0; j < 2; ++j) { g[j][0] = *(const f32x4*)(gpost + 8 * lane + 512 * j); g[j][1] = *(const f32x4*)(gpost + 8 * lane + 512 * j + 4); }
    }
    for (int rb = row0; rb < row1; rb += rstep) {
        f32x4 x[R][2][2];
        if (MODE == 0) { const float* xr = rb < M_P ? xp + (size_t)rb * D : xs + (size_t)(rb - M_P) * D;
#pragma unroll
            for (int r = 0; r < R; ++r)
#pragma unroll
                for (int j = 0; j < 2; ++j) { x[r][j][0] = *(const GAS f32x4*)(xr + (size_t)r * D + 8 * lane + 512 * j); x[r][j][1] = *(const GAS f32x4*)(xr + (size_t)r * D + 8 * lane + 512 * j + 4); }
        } else {
            v4u xw[R][2], mw[R][2];
#pragma unroll
            for (int r = 0; r < R; ++r)
#pragma unroll
                for (int j = 0; j < 2; ++j) { xw[r][j] = *(const GAS v4u*)(xb + (size_t)(rb + r) * D + 8 * lane + 512 * j); mw[r][j] = *(const GAS v4u*)(mb + (size_t)(rb + r) * D + 8 * lane + 512 * j); }
            f32x4 mv[R][2][2]; float ss[R];
#pragma unroll
            for (int r = 0; r < R; ++r) { ss[r] = 0.f;
#pragma unroll
                for (int j = 0; j < 2; ++j) { bf8_to_f32(xw[r][j], x[r][j][0], x[r][j][1]); bf8_to_f32(mw[r][j], mv[r][j][0], mv[r][j][1]); ss[r] += sq4(mv[r][j][0]) + sq4(mv[r][j][1]); } }
#pragma unroll
            for (int o = 1; o < 64; o <<= 1) {
#pragma unroll
                for (int r = 0; r < R; ++r) ss[r] += __shfl_xor(ss[r], o); }
#pragma unroll
            for (int r = 0; r < R; ++r) { const float rm = __builtin_amdgcn_rsqf(ss[r] * (1.f / D) + NORM_EPS);
#pragma unroll
                for (int j = 0; j < 2; ++j) { x[r][j][0] = x[r][j][0] + mv[r][j][0] * g[j][0] * rm; x[r][j][1] = x[r][j][1] + mv[r][j][1] * g[j][1] * rm; } }
        }
        if (MODE == 2) {
#pragma unroll
            for (int r = 0; r < R; ++r)
#pragma unroll
                for (int j = 0; j < 2; ++j) { *(GAS f32x4*)(out + (size_t)(rb + r) * D + 8 * lane + 512 * j) = x[r][j][0]; *(GAS f32x4*)(out + (size_t)(rb + r) * D + 8 * lane + 512 * j + 4) = x[r][j][1]; }
        } else {
            float s2[R];
#pragma unroll
            for (int r = 0; r < R; ++r) { s2[r] = 0.f;
#pragma unroll
                for (int j = 0; j < 2; ++j) { s2[r] += sq4(x[r][j][0]) + sq4(x[r][j][1]);
                    v4u w; w.x = pk2(x[r][j][0].x, x[r][j][0].y); w.y = pk2(x[r][j][0].z, x[r][j][0].w); w.z = pk2(x[r][j][1].x, x[r][j][1].y); w.w = pk2(x[r][j][1].z, x[r][j][1].w);
                    *(GAS v4u*)(xb + (size_t)(rb + r) * D + 8 * lane + 512 * j) = w; } }
#pragma unroll
            for (int o = 1; o < 64; o <<= 1) {
#pragma unroll
                for (int r = 0; r < R; ++r) s2[r] += __shfl_xor(s2[r], o); }
            if (lane < R) { float v = s2[0];
#pragma unroll
                for (int r = 1; r < R; ++r) v = lane == r ? s2[r] : v;
                rs[rb + lane] = __builtin_amdgcn_rsqf(v * (1.f / D) + NORM_EPS); }
        }
    }
}

template <int MODE, int R>
__device__ __forceinline__ void thin_rows_lean(bf16* xb, const bf16* mb, const float* gpost, float* rs, float* out, int row0, int row1, int lane) {
    for (int rb = row0; rb < row1; rb += R) {
        v4u xw[R][2], mw[R][2]; float ss[R], s2[R];
#pragma unroll
        for (int r = 0; r < R; ++r)
#pragma unroll
            for (int j = 0; j < 2; ++j) { xw[r][j] = *(const GAS v4u*)(xb + (size_t)(rb + r) * D + 8 * lane + 512 * j); mw[r][j] = *(const GAS v4u*)(mb + (size_t)(rb + r) * D + 8 * lane + 512 * j); }
#pragma unroll
        for (int r = 0; r < R; ++r) { ss[r] = 0.f;
#pragma unroll
            for (int j = 0; j < 2; ++j) { f32x4 a, b; bf8_to_f32(mw[r][j], a, b); ss[r] += sq4(a) + sq4(b); } }
#pragma unroll
        for (int o = 1; o < 64; o <<= 1) {
#pragma unroll
            for (int r = 0; r < R; ++r) ss[r] += __shfl_xor(ss[r], o); }
#pragma unroll
        for (int r = 0; r < R; ++r) { const float rm = __builtin_amdgcn_rsqf(ss[r] * (1.f / D) + NORM_EPS); s2[r] = 0.f;
#pragma unroll
            for (int j = 0; j < 2; ++j) { f32x4 xa, xb2, ma, mb2; bf8_to_f32(xw[r][j], xa, xb2); bf8_to_f32(mw[r][j], ma, mb2);
                const f32x4 g0 = *(const f32x4*)(gpost + 8 * lane + 512 * j), g1 = *(const f32x4*)(gpost + 8 * lane + 512 * j + 4);
                xa = xa + ma * g0 * rm; xb2 = xb2 + mb2 * g1 * rm;
                if (MODE == 2) { *(GAS f32x4*)(out + (size_t)(rb + r) * D + 8 * lane + 512 * j) = xa; *(GAS f32x4*)(out + (size_t)(rb + r) * D + 8 * lane + 512 * j + 4) = xb2; }
                else { s2[r] += sq4(xa) + sq4(xb2);
                    v4u w; w.x = pk2(xa.x, xa.y); w.y = pk2(xa.z, xa.w); w.z = pk2(xb2.x, xb2.y); w.w = pk2(xb2.z, xb2.w);
                    *(GAS v4u*)(xb + (size_t)(rb + r) * D + 8 * lane + 512 * j) = w; } } }
        if (MODE != 2) {
#pragma unroll
            for (int o = 1; o < 64; o <<= 1) {
#pragma unroll
                for (int r = 0; r < R; ++r) s2[r] += __shfl_xor(s2[r], o); }
            if (lane < R) { float v = s2[0];
#pragma unroll
                for (int r = 1; r < R; ++r) v = lane == r ? s2[r] : v;
                rs[rb + lane] = __builtin_amdgcn_rsqf(v * (1.f / D) + NORM_EPS); }
        }
    }
}
template <int MODE>
__device__ __forceinline__ void thin_pass(const float* xp, const float* xs, bf16* xb, const bf16* mb, const float* gpost, float* rs, float* out, int gw, int NGW, int lane) {
    thin_rows<MODE>(xp, xs, xb, mb, gpost, rs, out, gw * 4, M, NGW * 4, lane);
}

namespace pg8 {
#define PG8_LAS __attribute__((address_space(3)))
typedef unsigned short bf16_t;
typedef short bf16x8 __attribute__((ext_vector_type(8)));
typedef float f32x4 __attribute__((ext_vector_type(4)));
typedef unsigned u32x4 __attribute__((ext_vector_type(4)));
constexpr int BM = 256, BK = 64, HALF = 128, HTB = HALF * BK * 2  , STAGE_BYTES = 8 * HTB, NXCD = 8, WGM = 8;

__host__ __device__ __forceinline__ int lds_byte(int r, int c) { const int st = (r >> 4) * 2 + (c >> 5), rr = r & 15, cc = c & 31, ob = rr * 64 + cc * 2; return st * 1024 + (ob ^ (((ob >> 9) & 1) << 5)); }
__host__ __device__ __forceinline__ void stage_rc(int b, int& R, int& C) { const int st = b / 1024, sb = b % 1024, swz = sb ^ (((sb >> 9) & 1) << 5); R = (st >> 1) * 16 + swz / 64; C = (st & 1) * 32 + (swz % 64) / 2; }
__host__ __device__ __forceinline__ int perm32(int rho) { const int n = rho >> 4, i = rho & 15; return 8 * (i >> 2) + 4 * n + (i & 3); }

struct Unit { int pm, pn; };
struct Gemm { const bf16_t* A; const bf16_t* Bt; int M, N, K; size_t tstepA; };

struct StaticOrder {
    int nM, nN, nwg, G, c;
    __host__ __device__ void init(int M, int N, int G_, int c_) { nM = M / BM; nN = N / BM; nwg = nM * nN; G = G_; c = c_; }
    __host__ __device__ void init_tiles(int nM_, int nN_, int G_, int c_) { nM = nM_; nN = nN_; nwg = nM * nN; G = G_; c = c_; }
    __host__ __device__ bool next(int i, Unit& u) const {
        const long L = (long)i * G + c; if (L >= nwg) return false;
        int wgid = (int)L; { const int q = nwg / NXCD, r = nwg % NXCD, xcd = wgid % NXCD, off = wgid / NXCD; wgid = (xcd < r ? xcd * (q + 1) : r * (q + 1) + (xcd - r) * q) + off; }
        const int nig = WGM * nN, gid = wgid / nig, fm = gid * WGM, gsz = (nM - fm) < WGM ? (nM - fm) : WGM;
        u.pm = fm + ((wgid % nig) % gsz); u.pn = (wgid % nig) / gsz; return true;
    }
    __device__ __forceinline__ void a_ready(const Unit&) const {}
    __device__ __forceinline__ void done(const Unit&) const {}
};

__device__ __forceinline__ unsigned cvt_pk_bf16(float lo, float hi) { unsigned r; asm volatile("v_cvt_pk_bf16_f32 %0, %1, %2" : "=v"(r) : "v"(lo), "v"(hi)); return r; }
typedef float f32x2 __attribute__((ext_vector_type(2)));
__device__ __forceinline__ f32x2 gelu_pk(f32x2 v) {
    const f32x2 av = __builtin_elementwise_abs(v), d = av * 0.2316418882f + 1.0f;
    f32x2 t; t.x = __builtin_amdgcn_rcpf(d.x); t.y = __builtin_amdgcn_rcpf(d.y);
    f32x2 q = t * 0.5307027145f + (-0.7265760135f); q = q * t + 0.7107068705f; q = q * t + (-0.142248368f); q = q * t + 0.127414796f; q = q * t;
    const f32x2 s = (v * v) * (-0.72134752044f);
    f32x2 e; e.x = __builtin_amdgcn_exp2f(s.x); e.y = __builtin_amdgcn_exp2f(s.y);
    const f32x2 m = v * (q * e), r = v - m;
    f32x2 o; o.x = v.x < 0.f ? m.x : r.x; o.y = v.y < 0.f ? m.y : r.y; return o;
}

template <int ACT  > struct EpiBf16 {
    static constexpr bool PERM = true, AFTER_DRAIN = false, HAS_FLUSH = false; static_assert(ACT == 0 || ACT == 1, "EpiBf16: ACT is 0 (none) or 1 (gelu_pk)");
    bf16_t* O; int ldc; const float* rs; int split_cols; size_t split_stride; float scale0;
    __device__ __forceinline__ void operator()(const f32x4 (&acc)[2][2][4][2], const Unit& u, int wr, int wc, int fr, int fq) const {
        const int row0 = u.pm * BM + wr * 64 + fr; int colt = u.pn * BM; bf16_t* base = O;
        float sc = 1.f; if (split_cols) { const int t = colt / split_cols; base += (size_t)t * split_stride; colt -= t * split_cols; if (t == 0) sc = scale0; }
        const int col0 = colt + wc * 32 + 8 * fq;
#pragma unroll
        for (int ai = 0; ai < 2; ++ai)
#pragma unroll
            for (int m = 0; m < 4; ++m) { bf16_t* rowp = base + (size_t)(row0 + ai * HALF + m * 16) * ldc + col0; const float rsc = rs ? rs[row0 + ai * HALF + m * 16] * sc : sc;
#pragma unroll
                for (int bj = 0; bj < 2; ++bj) { f32x4 v0 = acc[ai][bj][m][0], v1 = acc[ai][bj][m][1];
                    if (ACT == 1) { f32x2 a = gelu_pk((f32x2){v0[0], v0[1]}), b = gelu_pk((f32x2){v0[2], v0[3]}), c = gelu_pk((f32x2){v1[0], v1[1]}), d = gelu_pk((f32x2){v1[2], v1[3]});
                        v0 = (f32x4){a.x, a.y, b.x, b.y}; v1 = (f32x4){c.x, c.y, d.x, d.y}; }
                    v0 = v0 * rsc; v1 = v1 * rsc; u32x4 w; w.x = cvt_pk_bf16(v0[0], v0[1]); w.y = cvt_pk_bf16(v0[2], v0[3]); w.z = cvt_pk_bf16(v1[0], v1[1]); w.w = cvt_pk_bf16(v1[2], v1[3]);
#if defined(EPI_NT_STORE)
                    __builtin_nontemporal_store(w, (u32x4*)(rowp + bj * HALF)); } }
#else
                    *(u32x4*)(rowp + bj * HALF) = w; } }
#endif
    }
};

struct EpiRope {
    static constexpr bool PERM = true, AFTER_DRAIN = false, HAS_FLUSH = false;
    bf16_t* Q; bf16_t* Kk; bf16_t* V; const float* cs; const float* sn; float qscale; const float* rs; unsigned* kmax;
    __device__ __forceinline__ void operator()(const f32x4 (&acc)[2][2][4][2], const Unit& u, int wr, int wc, int fr, int fq) const {
        const int which = u.pn >> 2;
        const int row0 = u.pm * BM + wr * 64 + fr;
        if (which == 2) {
            const int col0 = (u.pn - 8) * BM + wc * 32 + 8 * fq;
#pragma unroll
            for (int ai = 0; ai < 2; ++ai)
#pragma unroll
                for (int m = 0; m < 4; ++m) { bf16_t* rowp = V + (size_t)(row0 + ai * HALF + m * 16) * 1024 + col0; const float r = rs[row0 + ai * HALF + m * 16];
#pragma unroll
                    for (int bj = 0; bj < 2; ++bj) { const f32x4 v0 = acc[ai][bj][m][0] * r, v1 = acc[ai][bj][m][1] * r;
                        u32x4 w; w.x = cvt_pk_bf16(v0[0], v0[1]); w.y = cvt_pk_bf16(v0[2], v0[3]); w.z = cvt_pk_bf16(v1[0], v1[1]); w.w = cvt_pk_bf16(v1[2], v1[3]);
                        *(u32x4*)(rowp + bj * HALF) = w; } }
        } else {
            bf16_t* base = which == 0 ? Q : Kk; const float sc = which == 0 ? qscale : 1.f;
            const int colb = ((u.pn & 3) * 4 + wc) * 64 + 8 * fq; float kn2 = 0.f;
#pragma unroll
            for (int ai = 0; ai < 2; ++ai)
#pragma unroll
                for (int m = 0; m < 4; ++m) { const int row = row0 + ai * HALF + m * 16; const int t = row < 16384 ? (row & 4095) : (row & 8191); const float scr = sc * rs[row];
                    const f32x4 c0 = *(const f32x4*)(cs + t * 32 + 8 * fq), c1 = *(const f32x4*)(cs + t * 32 + 8 * fq + 4);
                    const f32x4 s0 = *(const f32x4*)(sn + t * 32 + 8 * fq), s1 = *(const f32x4*)(sn + t * 32 + 8 * fq + 4);
                    const f32x4 x1a = acc[ai][0][m][0], x1b = acc[ai][0][m][1], x2a = acc[ai][1][m][0], x2b = acc[ai][1][m][1];
                    const f32x4 o1a = (x1a * c0 - x2a * s0) * scr, o1b = (x1b * c1 - x2b * s1) * scr, o2a = (x2a * c0 + x1a * s0) * scr, o2b = (x2b * c1 + x1b * s1) * scr;
                    u32x4 w1, w2; w1.x = cvt_pk_bf16(o1a[0], o1a[1]); w1.y = cvt_pk_bf16(o1a[2], o1a[3]); w1.z = cvt_pk_bf16(o1b[0], o1b[1]); w1.w = cvt_pk_bf16(o1b[2], o1b[3]);
                    w2.x = cvt_pk_bf16(o2a[0], o2a[1]); w2.y = cvt_pk_bf16(o2a[2], o2a[3]); w2.z = cvt_pk_bf16(o2b[0], o2b[1]); w2.w = cvt_pk_bf16(o2b[2], o2b[3]);
                    bf16_t* rowp = base + (size_t)row * 1024 + colb;
                    *(u32x4*)(rowp) = w1; *(u32x4*)(rowp + 32) = w2;
                    if (which == 1) { const f32x4 q4 = o1a * o1a + o1b * o1b + o2a * o2a + o2b * o2b; float ss = (q4[0] + q4[1]) + (q4[2] + q4[3]); ss += __shfl_xor(ss, 16); ss += __shfl_xor(ss, 32); kn2 = fmaxf(kn2, ss); } }
            if (which == 1) { kn2 = fmaxf(kn2, __shfl_xor(kn2, 1)); kn2 = fmaxf(kn2, __shfl_xor(kn2, 2)); kn2 = fmaxf(kn2, __shfl_xor(kn2, 4)); kn2 = fmaxf(kn2, __shfl_xor(kn2, 8));
                const int r0 = u.pm * BM; const int batch = r0 < 16384 ? (r0 >> 12) : 4 + ((r0 - 16384) >> 13);
                if (fr == 0 && fq == 0) atomicMax(kmax + batch * 16 + (u.pn & 3) * 4 + wc, __float_as_uint(kn2)); }
        }
    }
};

template <int CTRL> __device__ __forceinline__ float dpp_f(float old, float src) { return __int_as_float(__builtin_amdgcn_update_dpp(__float_as_int(old), __float_as_int(src), CTRL, 0xf, 0xf, false)); }
__device__ __forceinline__ float gelu_tanh(float x) {
    const float u = 0.7978845608028654f * (x + 0.044715f * x * x * x);
    const float e = __builtin_amdgcn_exp2f(-2.8853900817779268f * u);
    return x * __builtin_amdgcn_rcpf(1.0f + e);
}
struct EpiConvGlu {
    static constexpr bool PERM = true, AFTER_DRAIN = false, HAS_FLUSH = false;
    bf16_t* G; const float* cw; const float* cb; PG8_LAS float* X; int Mrows; const float* rs; PG8_LAS float* WT;
    __device__ __forceinline__ void operator()(f32x4 (&acc)[2][2][4][2], const Unit& u, int wr, int wc, int fr, int fq) const {
        const int xcol = wc * 32 + 8 * fq;
        const int gc0 = u.pn * 128 + xcol;
        float rsv[2][4];
#pragma unroll
        for (int ai = 0; ai < 2; ++ai)
#pragma unroll
            for (int m = 0; m < 4; ++m) { int tr = u.pm * 254 - 1 + ai * HALF + wr * 64 + m * 16 + fr; tr = tr < 0 ? 0 : (tr >= Mrows ? Mrows - 1 : tr); rsv[ai][m] = rs[tr]; }
        { const int tidx = (wr * 4 + wc) * 64 + fq * 16 + fr, e0 = 2 * tidx, t = e0 >> 8, c = e0 & 255;
          const float* src = (t < 3 ? cw + t * 5632 : cb) + (c < 128 ? u.pn * 128 + c : 2816 + u.pn * 128 + c - 128);
          typedef float f32x2v __attribute__((ext_vector_type(2)));
          *(PG8_LAS f32x2v*)(WT + e0) = *(const f32x2v*)src; }
#pragma unroll
        for (int ai = 0; ai < 2; ++ai)
#pragma unroll
            for (int m = 0; m < 4; ++m) {
#pragma unroll
                for (int bj = 0; bj < 2; ++bj)
#pragma unroll
                    for (int n = 0; n < 2; ++n) acc[ai][bj][m][n] = acc[ai][bj][m][n] * rsv[ai][m]; }
#pragma unroll
        for (int ai = 0; ai < 2; ++ai) { const int ch = 2 * ai + wr;
            if (fr == 0) {
#pragma unroll
                for (int bj = 0; bj < 2; ++bj)
#pragma unroll
                    for (int n = 0; n < 2; ++n) *(PG8_LAS f32x4*)(X + ((ch * 2 + 0) * 256 + bj * 128 + xcol + 4 * n)) = acc[ai][bj][0][n]; }
            if (fr == 15) {
#pragma unroll
                for (int bj = 0; bj < 2; ++bj)
#pragma unroll
                    for (int n = 0; n < 2; ++n) *(PG8_LAS f32x4*)(X + ((ch * 2 + 1) * 256 + bj * 128 + xcol + 4 * n)) = acc[ai][bj][3][n]; } }
        asm volatile("s_waitcnt lgkmcnt(0)" ::: "memory"); __builtin_amdgcn_s_barrier(); asm volatile("" ::: "memory");
        const int tg0 = u.pm * 254 - 1 + wr * 64 + fr;
        const int tb = u.pm * 254 - 1; const bool bnd = ((tb + 4096 + 257) >> 12) != ((tb + 4096 - 1) >> 12);
        if (bnd) body<true>(acc, u, wr, wc, fr, fq, xcol, gc0, tg0); else body<false>(acc, u, wr, wc, fr, fq, xcol, gc0, tg0);
    }
    template <bool bnd>
    __device__ __forceinline__ void body(f32x4 (&acc)[2][2][4][2], const Unit& u, int wr, int wc, int fr, int fq, int xcol, int gc0, int tg0) const {
#pragma unroll
        for (int ai = 0; ai < 2; ++ai) { const int ch = 2 * ai + wr;
#pragma unroll
            for (int m = 0; m < 4; ++m) {
                const int row = ai * HALF + wr * 64 + m * 16 + fr; const int tg = tg0 + ai * HALF + m * 16;
                const int ps = tg < 16384 ? (tg & 4095) : (tg & 8191); const int ps1 = (tg + 1) < 16384 ? ((tg + 1) & 4095) : ((tg + 1) & 8191);
                const bool first = bnd && ps == 0, last = bnd && ps1 == 0;
                u32x4 w;
#pragma unroll
                for (int n = 0; n < 2; ++n) {
                    f32x4 wgv[3], wuv[3];
#pragma unroll
                    for (int t = 0; t < 3; ++t) { wgv[t] = *(const PG8_LAS f32x4*)(WT + t * 256 + xcol + 4 * n); wuv[t] = *(const PG8_LAS f32x4*)(WT + t * 256 + 128 + xcol + 4 * n); }
                    const f32x4 bgv = *(const PG8_LAS f32x4*)(WT + 768 + xcol + 4 * n), buv = *(const PG8_LAS f32x4*)(WT + 768 + 128 + xcol + 4 * n);
                    f32x4 pg = (f32x4){0.f, 0.f, 0.f, 0.f}, pu = pg, ng = pg, nu = pg;
                    if (m == 0 && ch > 0) { pg = *(const PG8_LAS f32x4*)(X + (((ch - 1) * 2 + 1) * 256 + xcol + 4 * n)); pu = *(const PG8_LAS f32x4*)(X + (((ch - 1) * 2 + 1) * 256 + 128 + xcol + 4 * n)); }
                    if (m == 3 && ch < 3) { ng = *(const PG8_LAS f32x4*)(X + (((ch + 1) * 2 + 0) * 256 + xcol + 4 * n)); nu = *(const PG8_LAS f32x4*)(X + (((ch + 1) * 2 + 0) * 256 + 128 + xcol + 4 * n)); }
                    float o[4];
#pragma unroll
                    for (int j = 0; j < 4; ++j) {
                        const float cg = acc[ai][0][m][n][j], cu = acc[ai][1][m][n][j];
                        float p0g, p0u, n15g, n15u;
                        if (m > 0) { p0g = dpp_f<0x121>(0.f, acc[ai][0][m > 0 ? m - 1 : 0][n][j]); p0u = dpp_f<0x121>(0.f, acc[ai][1][m > 0 ? m - 1 : 0][n][j]); } else { p0g = pg[j]; p0u = pu[j]; }
                        if (m < 3) { n15g = dpp_f<0x12F>(0.f, acc[ai][0][m < 3 ? m + 1 : 3][n][j]); n15u = dpp_f<0x12F>(0.f, acc[ai][1][m < 3 ? m + 1 : 3][n][j]); } else { n15g = ng[j]; n15u = nu[j]; }
                        float prg = dpp_f<0x111>(p0g, cg), pru = dpp_f<0x111>(p0u, cu);
                        float nxg = dpp_f<0x101>(n15g, cg), nxu = dpp_f<0x101>(n15u, cu);
                        if (first) { prg = 0.f; pru = 0.f; }
                        if (last) { nxg = 0.f; nxu = 0.f; }
                        const float yg = wgv[0][j] * prg + (wgv[1][j] * cg + (wgv[2][j] * nxg + bgv[j]));
                        const float yu = wuv[0][j] * pru + (wuv[1][j] * cu + (wuv[2][j] * nxu + buv[j]));
                        o[j] = gelu_tanh(yg) * yu;
                    }
                    if (n == 0) { w.x = cvt_pk_bf16(o[0], o[1]); w.y = cvt_pk_bf16(o[2], o[3]); } else { w.z = cvt_pk_bf16(o[0], o[1]); w.w = cvt_pk_bf16(o[2], o[3]); }
                }
                if (row >= 1 && row <= 254 && tg < Mrows) *(u32x4*)(G + (size_t)tg * 2816 + gc0) = w;
            }
        }
    }
};

template <int MODE>
struct EpiThin {
    static constexpr bool PERM = true, AFTER_DRAIN = false, HAS_FLUSH = true;
    bf16_t* mb; bf16_t* xb; const float* g; float* rs; float* out; unsigned* cnt; PG8_LAS unsigned* flag; int ntn;
    __device__ __forceinline__ void publish(int wid, int lane) const {
        asm volatile("s_waitcnt vmcnt(0)" ::: "memory"); __builtin_amdgcn_s_barrier(); asm volatile("" ::: "memory");
        const int ppm = (int)flag[1] - 1;
        if (ppm >= 0) {
            if (wid == 0 && lane == 0) { const unsigned old = __hip_atomic_fetch_add(cnt + 64 * ppm, 1u, __ATOMIC_RELAXED, __HIP_MEMORY_SCOPE_AGENT); flag[0] = (old == (unsigned)(ntn - 1)) ? 1u : 0u; }
            asm volatile("s_waitcnt vmcnt(0) lgkmcnt(0)" ::: "memory"); __builtin_amdgcn_s_barrier(); asm volatile("" ::: "memory");
            if (flag[0] != 0u) {
                if (wid == 0) { __builtin_amdgcn_fence(__ATOMIC_ACQUIRE, "agent"); asm volatile("s_waitcnt vmcnt(0)" ::: "memory"); }
                asm volatile("s_waitcnt lgkmcnt(0)" ::: "memory"); __builtin_amdgcn_s_barrier(); asm volatile("" ::: "memory");
                thin_rows_lean<MODE, 4>(xb, mb, g, rs, out, ppm * BM + wid * 32, ppm * BM + wid * 32 + 32, lane);
            }
        }
    }
    __device__ __forceinline__ void operator()(const f32x4 (&acc)[2][2][4][2], const Unit& u, int wr, int wc, int fr, int fq) const {
        const int wid = wr * 4 + wc, lane = fq * 16 + fr;
        u32x4 w[2][4][2];
#pragma unroll
        for (int ai = 0; ai < 2; ++ai)
#pragma unroll
            for (int m = 0; m < 4; ++m)
#pragma unroll
                for (int bj = 0; bj < 2; ++bj) { const f32x4 v0 = acc[ai][bj][m][0], v1 = acc[ai][bj][m][1];
                    w[ai][m][bj].x = cvt_pk_bf16(v0[0], v0[1]); w[ai][m][bj].y = cvt_pk_bf16(v0[2], v0[3]); w[ai][m][bj].z = cvt_pk_bf16(v1[0], v1[1]); w[ai][m][bj].w = cvt_pk_bf16(v1[2], v1[3]); }
        publish(wid, lane);
        asm volatile("s_waitcnt lgkmcnt(0)" ::: "memory"); __builtin_amdgcn_s_barrier(); asm volatile("" ::: "memory");
        if (wid == 0 && lane == 0) flag[1] = (unsigned)(u.pm + 1);
        const __amdgpu_buffer_rsrc_t rsrc = __builtin_amdgcn_make_buffer_rsrc((void*)mb, 0, M * 1024 * 2, 0x00020000);
        const int row0 = u.pm * BM + wr * 64 + fr, col0 = u.pn * BM + wc * 32 + 8 * fq;
#pragma unroll
        for (int ai = 0; ai < 2; ++ai)
#pragma unroll
            for (int m = 0; m < 4; ++m)
#pragma unroll
                for (int bj = 0; bj < 2; ++bj) __builtin_amdgcn_raw_buffer_store_b128(w[ai][m][bj], rsrc, ((row0 + ai * HALF + m * 16) * 1024 + col0 + bj * HALF) * 2, 0, 16);
    }
    __device__ __forceinline__ void flush(const Unit&, int wr, int wc, int fr, int fq) const {
        const int wid = wr * 4 + wc, lane = fq * 16 + fr;
        publish(wid, lane);
        asm volatile("s_waitcnt lgkmcnt(0)" ::: "memory"); __builtin_amdgcn_s_barrier(); asm volatile("" ::: "memory");
        if (wid == 0 && lane == 0) flag[1] = 0u;
        asm volatile("s_waitcnt lgkmcnt(0)" ::: "memory"); __builtin_amdgcn_s_barrier(); asm volatile("" ::: "memory");
    }
};

struct EpiNull {
    static constexpr bool PERM = true, AFTER_DRAIN = false, HAS_FLUSH = false;
    float* sink;
    __device__ __forceinline__ void operator()(const f32x4 (&acc)[2][2][4][2], const Unit& u, int wr, int wc, int fr, int fq) const {
        float s = 0.f;
#pragma unroll
        for (int ai = 0; ai < 2; ++ai)
#pragma unroll
            for (int bj = 0; bj < 2; ++bj)
#pragma unroll
                for (int m = 0; m < 4; ++m)
#pragma unroll
                    for (int n = 0; n < 2; ++n) s += acc[ai][bj][m][n][0] + acc[ai][bj][m][n][1] + acc[ai][bj][m][n][2] + acc[ai][bj][m][n][3];
        if (s == 123456.789f) sink[0] = s;
    }
};
template <class Epi, class Sched, bool ALIGN_EPI = false, bool SP2 = false>
__device__ __forceinline__ void gemm_phase(PG8_LAS unsigned char* lds, const Gemm g, const Sched& S, const Epi& E, int wave_arg, unsigned* tpw = nullptr) {
    const int wid = wave_arg, lane = LANE_ID(), tid = wid * 64 + lane, wr = wid >> 2, wc = wid & 3, fr = lane & 15, fq = lane >> 4;
    const int K = g.K, nt = K / BK;
    unsigned voffA[2], voffB[2];
#pragma unroll
    for (int i = 0; i < 2; ++i) { int R, C; stage_rc(tid * 16 + i * 8192, R, C); const int Rb = Epi::PERM ? ((R & ~31) + perm32(R & 31)) : R;
        voffA[i] = (unsigned)(R * K + C) * 2u; voffB[i] = (unsigned)(Rb * K + C) * 2u; }
    const size_t kstep = (size_t)(BK * 2);
    const size_t hstep = (size_t)HALF * K * 2;
    const size_t tstep = 2 * hstep;
    const unsigned ldsw = (unsigned)wid * 1024u;
    const int aoff = lds_byte(wr * 64 + fr, fq * 8), boff = lds_byte(wc * 32 + fr, fq * 8);
#define PG8_SA(b, h) (((b) * 2 + (h)) * HTB)
#define PG8_SB(b, h) ((4 + (b) * 2 + (h)) * HTB)
#define PG8_STAGE(bufoff, gbase, voff) do { _Pragma("unroll") for (int _i = 0; _i < 2; ++_i) \
        __builtin_amdgcn_global_load_lds((const unsigned*)((const char*)(gbase) + (voff)[_i]), (PG8_LAS unsigned*)(lds + (bufoff) + ldsw + _i * 8192), 16, 0, 0); } while (0)
#define PG8_LDA(dst, b, h) do { _Pragma("unroll") for (int m = 0; m < 4; ++m) _Pragma("unroll") for (int k = 0; k < 2; ++k) dst[m][k] = *(const PG8_LAS bf16x8*)(lds + PG8_SA(b, h) + aoff + m * 2048 + k * 1024); } while (0)
#define PG8_LDB(dst, b, h) do { _Pragma("unroll") for (int n = 0; n < 2; ++n) _Pragma("unroll") for (int k = 0; k < 2; ++k) dst[n][k] = *(const PG8_LAS bf16x8*)(lds + PG8_SB(b, h) + boff + n * 2048 + k * 1024); } while (0)
#define PG8_MMA(ai, bj, At, Bt) do { __builtin_amdgcn_s_setprio(1); _Pragma("unroll") for (int m = 0; m < 4; ++m) _Pragma("unroll") for (int n = 0; n < 2; ++n) _Pragma("unroll") for (int k = 0; k < 2; ++k) \
        acc[ai][bj][m][n] = __builtin_amdgcn_mfma_f32_16x16x32_bf16(Bt[n][k], At[m][k], acc[ai][bj][m][n], 0, 0, 0); __builtin_amdgcn_s_setprio(0); } while (0)
#define PG8_WAIT_V(n) asm volatile("s_waitcnt vmcnt(" #n ")" ::: "memory")
#define PG8_WAIT_L(n) asm volatile("s_waitcnt lgkmcnt(" #n ")" ::: "memory")
#define PG8_BAR __builtin_amdgcn_s_barrier()
#define PG8_SCHED __builtin_amdgcn_sched_barrier(0)
    Unit cur, nxt; int ui = 0;
    if (!S.next(0, cur)) return;
#if defined(GPROBE)
    unsigned long long gp_acc = 0, gp_t = 0; const bool gp_on = tpw != nullptr && blockIdx.x == 0 && wid == 0;
#define GP_MARK() do { if (gp_on) gp_t = __builtin_amdgcn_s_memrealtime(); } while (0)
#define GP_ADD() do { if (gp_on) gp_acc += __builtin_amdgcn_s_memrealtime() - gp_t; } while (0)
#else
#define GP_MARK() do {} while (0)
#define GP_ADD() do {} while (0)
#endif
#if defined(GEMM_STAGGER_TICKS)
    { const unsigned long long t0_ = __builtin_amdgcn_s_memrealtime(); const unsigned long long dly_ = (unsigned long long)((blockIdx.x >> 3) & 3) * GEMM_STAGGER_TICKS;
      while (__builtin_amdgcn_s_memrealtime() - t0_ < dly_) __builtin_amdgcn_s_sleep(8); }
#endif
    f32x4 acc[2][2][4][2];
#pragma unroll
    for (int a = 0; a < 2; ++a)
#pragma unroll
        for (int b = 0; b < 2; ++b)
#pragma unroll
            for (int m = 0; m < 4; ++m)
#pragma unroll
                for (int n = 0; n < 2; ++n) acc[a][b][m][n] = (f32x4){0.f, 0.f, 0.f, 0.f};
    bf16x8 At[4][2], B0[2][2], B1[2][2];
    const char* cA = (const char*)g.A + (size_t)cur.pm * g.tstepA; const char* cB = (const char*)g.Bt + (size_t)cur.pn * tstep;
    S.a_ready(cur);
    if constexpr (SP2) {
        PG8_STAGE(PG8_SB(0, 0), cB, voffB); PG8_STAGE(PG8_SB(0, 1), cB + hstep, voffB); PG8_STAGE(PG8_SA(0, 0), cA, voffA); PG8_STAGE(PG8_SA(0, 1), cA + hstep, voffA);
        if (wr == 1) PG8_BAR;
        PG8_WAIT_V(2); PG8_BAR;
        PG8_STAGE(PG8_SB(1, 0), cB + kstep, voffB); PG8_STAGE(PG8_SA(1, 0), cA + kstep, voffA); PG8_STAGE(PG8_SB(1, 1), cB + hstep + kstep, voffB);
        PG8_WAIT_V(6); PG8_BAR;
    } else {
        PG8_STAGE(PG8_SB(0, 0), cB, voffB); PG8_STAGE(PG8_SA(0, 0), cA, voffA); PG8_STAGE(PG8_SB(0, 1), cB + hstep, voffB); PG8_STAGE(PG8_SA(0, 1), cA + hstep, voffA);
        if (wr == 1) PG8_BAR;
        PG8_WAIT_V(4); PG8_BAR;
        PG8_STAGE(PG8_SB(1, 0), cB + kstep, voffB); PG8_STAGE(PG8_SA(1, 0), cA + kstep, voffA); PG8_STAGE(PG8_SB(1, 1), cB + hstep + kstep, voffB);
        PG8_WAIT_V(6); PG8_BAR;
    }
    for (;;) {
        const bool has_next = S.next(ui + 1, nxt);
        const char* nA = has_next ? (const char*)g.A + (size_t)nxt.pm * g.tstepA : cA; const char* nB = has_next ? (const char*)g.Bt + (size_t)nxt.pn * tstep : cB;
        for (int t = 0; t < nt; t += 2) {
            const bool last = (t == nt - 2);
#if defined(GPROBE) && GPROBE == 2
            if (t == 0) GP_MARK(); if (t == 4) GP_ADD();
#elif defined(GPROBE) && GPROBE == 3
            if (t == 4) GP_MARK(); if (t == 6) GP_ADD();
#elif defined(GPROBE) && GPROBE == 4
            if (t == nt - 2) GP_MARK();
#endif
            const char* a1 = cA + (size_t)(t + 1) * kstep;
            const char* a2 = last ? nA : cA + (size_t)(t + 2) * kstep; const char* b2 = last ? nB : cB + (size_t)(t + 2) * kstep;
            const char* a3 = a2 + kstep; const char* b3 = b2 + kstep;
            if (last && has_next) S.a_ready(nxt);
            if constexpr (SP2) {
            PG8_LDB(B0, 0, 0); PG8_LDB(B1, 0, 1); PG8_SCHED; PG8_LDA(At, 0, 0); PG8_STAGE(PG8_SA(1, 1), a1 + hstep, voffA);
            PG8_WAIT_V(8); PG8_WAIT_L(0); PG8_BAR; PG8_MMA(0, 0, At, B0); PG8_MMA(0, 1, At, B1); PG8_BAR; PG8_SCHED;
            PG8_LDA(At, 0, 1); PG8_STAGE(PG8_SB(0, 0), b2, voffB); PG8_STAGE(PG8_SB(0, 1), b2 + hstep, voffB); PG8_STAGE(PG8_SA(0, 0), a2, voffA);
            PG8_WAIT_V(8); PG8_WAIT_L(0); PG8_BAR; PG8_MMA(1, 0, At, B0); PG8_MMA(1, 1, At, B1); PG8_BAR; PG8_SCHED;
            PG8_LDB(B0, 1, 0); PG8_LDB(B1, 1, 1); PG8_SCHED; PG8_LDA(At, 1, 0); PG8_STAGE(PG8_SA(0, 1), a2 + hstep, voffA);
            PG8_WAIT_V(8); PG8_WAIT_L(0); PG8_BAR; PG8_MMA(0, 0, At, B0); PG8_MMA(0, 1, At, B1); PG8_BAR; PG8_SCHED;
            PG8_LDA(At, 1, 1); PG8_STAGE(PG8_SB(1, 0), b3, voffB); PG8_STAGE(PG8_SB(1, 1), b3 + hstep, voffB); PG8_STAGE(PG8_SA(1, 0), a3, voffA);
            PG8_WAIT_V(8); PG8_WAIT_L(0); PG8_BAR; PG8_MMA(1, 0, At, B0); PG8_MMA(1, 1, At, B1); PG8_BAR; PG8_SCHED;
            } else {
            PG8_LDB(B0, 0, 0); PG8_SCHED; PG8_LDA(At, 0, 0); PG8_STAGE(PG8_SA(1, 1), a1 + hstep, voffA);
            PG8_WAIT_L(8); PG8_BAR; PG8_WAIT_L(0); PG8_MMA(0, 0, At, B0); PG8_BAR; PG8_SCHED;
            PG8_LDB(B1, 0, 1); PG8_STAGE(PG8_SB(0, 0), b2, voffB);
            PG8_BAR; PG8_WAIT_L(0); PG8_MMA(0, 1, At, B1); PG8_BAR;
            PG8_LDA(At, 0, 1); PG8_STAGE(PG8_SA(0, 0), a2, voffA);
            PG8_BAR; PG8_WAIT_L(0); PG8_MMA(1, 0, At, B0); PG8_BAR; PG8_SCHED;
            PG8_STAGE(PG8_SB(0, 1), b2 + hstep, voffB);
            PG8_WAIT_V(6); PG8_BAR; PG8_MMA(1, 1, At, B1); PG8_BAR;
            PG8_LDB(B0, 1, 0); PG8_SCHED; PG8_LDA(At, 1, 0); PG8_STAGE(PG8_SA(0, 1), a2 + hstep, voffA);
            PG8_WAIT_L(8); PG8_BAR; PG8_WAIT_L(0); PG8_MMA(0, 0, At, B0); PG8_BAR; PG8_SCHED;
            PG8_LDB(B1, 1, 1); PG8_STAGE(PG8_SB(1, 0), b3, voffB);
            PG8_BAR; PG8_WAIT_L(0); PG8_MMA(0, 1, At, B1); PG8_BAR;
            PG8_LDA(At, 1, 1); PG8_STAGE(PG8_SA(1, 0), a3, voffA);
            PG8_BAR; PG8_WAIT_L(0); PG8_MMA(1, 0, At, B0); PG8_BAR; PG8_SCHED;
            PG8_STAGE(PG8_SB(1, 1), b3 + hstep, voffB);
            PG8_WAIT_V(6); PG8_BAR; PG8_MMA(1, 1, At, B1); PG8_BAR;
            }
        }
#if defined(GPROBE) && GPROBE == 4
        GP_ADD();
#endif
        if constexpr (ALIGN_EPI) { if (wr == 0) PG8_BAR; }
#if defined(GPROBE) && GPROBE == 1
        GP_MARK();
#elif defined(GPROBE) && GPROBE == 6
        if (ui > 0) GP_ADD();
#endif
        if constexpr (!Epi::AFTER_DRAIN) { E(acc, cur, wr, wc, fr, fq); S.done(cur); }
#if defined(GPROBE) && GPROBE == 1
        GP_ADD();
#elif defined(GPROBE) && GPROBE == 6
        GP_MARK();
#endif
        if (!has_next) break;
#pragma unroll
        for (int a = 0; a < 2; ++a)
#pragma unroll
            for (int b = 0; b < 2; ++b)
#pragma unroll
                for (int m = 0; m < 4; ++m)
#pragma unroll
                    for (int n = 0; n < 2; ++n) acc[a][b][m][n] = (f32x4){0.f, 0.f, 0.f, 0.f};
        cur = nxt; cA = nA; cB = nB; ++ui;
        if constexpr (ALIGN_EPI) { if (wr == 1) PG8_BAR; }
    }
#if defined(GPROBE)
    if (gp_on && lane == 0) tpw[0] = (unsigned)gp_acc;
#endif
    PG8_WAIT_V(0);
    if constexpr (!ALIGN_EPI) { if (wr == 0) PG8_BAR; }
    PG8_BAR;
    if constexpr (Epi::AFTER_DRAIN) { E.fused(acc, cur, wr, wc, fr, fq, lds, wid, lane); S.done(cur); }
    if constexpr (Epi::HAS_FLUSH) E.flush(cur, wr, wc, fr, fq);
#undef PG8_SA
#undef PG8_SB
#undef PG8_STAGE
#undef PG8_LDA
#undef PG8_LDB
#undef PG8_MMA
#undef PG8_WAIT_V
#undef PG8_WAIT_L
#undef PG8_BAR
#undef PG8_SCHED
}
}

namespace att {
#define ATT_LAS __attribute__((address_space(3)))
typedef unsigned short bf16_t;
using bf16x8 = __attribute__((ext_vector_type(8))) short;
using s16x4  = __attribute__((ext_vector_type(4))) short;
using f32x16 = __attribute__((ext_vector_type(16))) float;
using f32x4  = __attribute__((ext_vector_type(4))) float;
using u32x4  = __attribute__((ext_vector_type(4))) unsigned;
typedef ATT_LAS char* lptr;
#define SBAR() __builtin_amdgcn_sched_barrier(0)
constexpr int PITCH = 1024;
constexpr float QSCALE = 0.125f * 1.4426950408889634f;
constexpr float THRL = 8.0f * 1.4426950408889634f;
__device__ __forceinline__ int crow(int r, int hi) { return (r & 3) + 8 * (r >> 2) + 4 * hi; }
__device__ __forceinline__ unsigned cvtpk(float lo, float hi) { unsigned r; asm volatile("v_cvt_pk_bf16_f32 %0, %1, %2" : "=v"(r) : "v"(lo), "v"(hi)); return r; }
__device__ __forceinline__ int koff(int row, int c) { return c * 1024 + ((row ^ c) << 4); }
__device__ __forceinline__ int v_st(int k, int c) { const int kk = (k & ~0xC) | ((k & 4) << 1) | ((k & 8) >> 1); return ((kk >> 3) * 4 + (c >> 5)) * 512 + ((kk & 7) * 32 + (c & 31)) * 2; }
__device__ __forceinline__ int v_rd_base(int lane) { return ((lane & 3) << 3) | (((lane >> 2) & 3) << 6) | (((lane >> 4) & 1) << 5) | (((lane >> 5) & 1) << 8); }
constexpr int v_rd_off(int d0, int ks, int half) { return d0 * 512 + ks * 4096 + half * 2048; }
template <int OFF> __device__ __forceinline__ s16x4 tr_read(int vb) { s16x4 r; asm volatile("ds_read_b64_tr_b16 %0, %1 offset:%2" : "=&v"(r) : "v"(vb), "i"(OFF) : "memory"); return r; }
template <int D0> __device__ __forceinline__ void pv_one(f32x16& od, int vb, bf16x8 pa0, bf16x8 pa1, bf16x8 pa2, bf16x8 pa3) {
  const s16x4 l0 = tr_read<v_rd_off(D0, 0, 0)>(vb), h0 = tr_read<v_rd_off(D0, 0, 1)>(vb), l1 = tr_read<v_rd_off(D0, 1, 0)>(vb), h1 = tr_read<v_rd_off(D0, 1, 1)>(vb);
  const s16x4 l2 = tr_read<v_rd_off(D0, 2, 0)>(vb), h2 = tr_read<v_rd_off(D0, 2, 1)>(vb), l3 = tr_read<v_rd_off(D0, 3, 0)>(vb), h3 = tr_read<v_rd_off(D0, 3, 1)>(vb);
  asm volatile("s_waitcnt lgkmcnt(0)" ::: "memory"); SBAR();
#define PK(L, H) (bf16x8){L[0], L[1], L[2], L[3], H[0], H[1], H[2], H[3]}
  od = __builtin_amdgcn_mfma_f32_32x32x16_bf16(pa0, PK(l0, h0), od, 0, 0, 0);
  od = __builtin_amdgcn_mfma_f32_32x32x16_bf16(pa1, PK(l1, h1), od, 0, 0, 0);
  od = __builtin_amdgcn_mfma_f32_32x32x16_bf16(pa2, PK(l2, h2), od, 0, 0, 0);
  od = __builtin_amdgcn_mfma_f32_32x32x16_bf16(pa3, PK(l3, h3), od, 0, 0, 0);
#undef PK
}
__device__ __forceinline__ void qkt(f32x16& p0, f32x16& p1, lptr Ks, const bf16x8* qr, int r32, int hi) {
  p0 = f32x16{}; p1 = f32x16{};
#pragma unroll
  for (int d0 = 0; d0 < 4; ++d0) { const int c = 2 * d0 + hi;
    const bf16x8 b0 = *(const ATT_LAS bf16x8*)(Ks + koff(r32, c));
    const bf16x8 b1 = *(const ATT_LAS bf16x8*)(Ks + koff(32 + r32, c));
    p0 = __builtin_amdgcn_mfma_f32_32x32x16_bf16(b0, qr[d0], p0, 0, 0, 0);
    p1 = __builtin_amdgcn_mfma_f32_32x32x16_bf16(b1, qr[d0], p1, 0, 0, 0); }
}
__device__ __forceinline__ float rowmax32(const f32x16& p0, const f32x16& p1) {
  float pmax = p0[0];
#pragma unroll
  for (int r = 1; r < 16; ++r) pmax = fmaxf(pmax, p0[r]);
#pragma unroll
  for (int r = 0; r < 16; ++r) pmax = fmaxf(pmax, p1[r]);
  auto rr = __builtin_amdgcn_permlane32_swap(__float_as_uint(pmax), __float_as_uint(pmax), false, false);
  return fmaxf(__uint_as_float(rr[0]), __uint_as_float(rr[1]));
}
__device__ __forceinline__ void partialSM(f32x16& p0, f32x16& p1, float& m_reg, float& mn, float& alpha) {
  const float pmax = rowmax32(p0, p1);
  if (__builtin_expect(__all(pmax - m_reg <= THRL), 1)) { mn = m_reg; alpha = 1.f; }
  else { mn = fmaxf(m_reg, pmax); alpha = __builtin_amdgcn_exp2f(m_reg - mn); m_reg = mn; }
#pragma unroll
  for (int r = 0; r < 16; ++r) p0[r] = p0[r] - mn;
#pragma unroll
  for (int r = 0; r < 16; ++r) p1[r] = p1[r] - mn;
#pragma unroll
  for (int r = 0; r < 16; ++r) p0[r] = __builtin_amdgcn_exp2f(p0[r]);
}
__device__ __forceinline__ void finishSM(f32x16& p0, f32x16& p1, float alpha, float& l_reg, bf16x8& pa0, bf16x8& pa1, bf16x8& pa2, bf16x8& pa3) {
#pragma unroll
  for (int r = 0; r < 16; ++r) p1[r] = __builtin_amdgcn_exp2f(p1[r]);
  float ps = 0;
#pragma unroll
  for (int r = 0; r < 16; ++r) ps += p0[r];
#pragma unroll
  for (int r = 0; r < 16; ++r) ps += p1[r];
  { auto rr = __builtin_amdgcn_permlane32_swap(__float_as_uint(ps), __float_as_uint(ps), false, false); ps = __uint_as_float(rr[0]) + __uint_as_float(rr[1]); }
  l_reg = l_reg * alpha + ps;
#define PK4(P, BASE, OUT) do { unsigned a0 = cvtpk(P[BASE + 0], P[BASE + 1]), a1 = cvtpk(P[BASE + 2], P[BASE + 3]);   \
    unsigned b0 = cvtpk(P[BASE + 4], P[BASE + 5]), b1 = cvtpk(P[BASE + 6], P[BASE + 7]);                              \
    auto r0 = __builtin_amdgcn_permlane32_swap(a0, b0, false, false); auto r1 = __builtin_amdgcn_permlane32_swap(a1, b1, false, false); \
    u32x4 w = {r0[0], r1[0], r0[1], r1[1]}; OUT = __builtin_bit_cast(bf16x8, w); } while (0)
  PK4(p0, 0, pa0); PK4(p0, 8, pa1); PK4(p1, 0, pa2); PK4(p1, 8, pa3);
#undef PK4
}

__device__ __forceinline__ void finishSM_noexp(f32x16& p0, f32x16& p1, float& l_reg, bf16x8& pa0, bf16x8& pa1, bf16x8& pa2, bf16x8& pa3) {
  float ps = 0;
#pragma unroll
  for (int r = 0; r < 16; ++r) ps += p0[r];
#pragma unroll
  for (int r = 0; r < 16; ++r) ps += p1[r];
  { auto rr = __builtin_amdgcn_permlane32_swap(__float_as_uint(ps), __float_as_uint(ps), false, false); ps = __uint_as_float(rr[0]) + __uint_as_float(rr[1]); }
  l_reg += ps;
#define PK4(P, BASE, OUT) do { unsigned a0 = cvtpk(P[BASE + 0], P[BASE + 1]), a1 = cvtpk(P[BASE + 2], P[BASE + 3]);   \
    unsigned b0 = cvtpk(P[BASE + 4], P[BASE + 5]), b1 = cvtpk(P[BASE + 6], P[BASE + 7]);                              \
    auto r0 = __builtin_amdgcn_permlane32_swap(a0, b0, false, false); auto r1 = __builtin_amdgcn_permlane32_swap(a1, b1, false, false); \
    u32x4 w = {r0[0], r1[0], r0[1], r1[1]}; OUT = __builtin_bit_cast(bf16x8, w); } while (0)
  PK4(p0, 0, pa0); PK4(p0, 8, pa1); PK4(p1, 0, pa2); PK4(p1, 8, pa3);
#undef PK4
}

__device__ __forceinline__ void finish_T(const f32x16& p0, const f32x16& p1, float& l_reg, bf16x8& pa0, bf16x8& pa1, bf16x8& pa2, bf16x8& pa3) {
  float ps = 0;
#pragma unroll
  for (int r = 0; r < 16; ++r) ps += p0[r];
#pragma unroll
  for (int r = 0; r < 16; ++r) ps += p1[r];
  l_reg += ps;
#define PK8(P, BASE, OUT) do { u32x4 w = {cvtpk(P[BASE + 0], P[BASE + 1]), cvtpk(P[BASE + 2], P[BASE + 3]), cvtpk(P[BASE + 4], P[BASE + 5]), cvtpk(P[BASE + 6], P[BASE + 7])}; OUT = __builtin_bit_cast(bf16x8, w); } while (0)
  PK8(p0, 0, pa0); PK8(p0, 8, pa1); PK8(p1, 0, pa2); PK8(p1, 8, pa3);
#undef PK8
}

constexpr int DA_SHM_V = 16384, DA_SHM_K = 8192, DA_LDS_V = 0, DA_LDS_K = 2 * DA_SHM_V, DA_LDS_WS = DA_LDS_K + 2 * DA_SHM_K, DA_LDS_BYTES = DA_LDS_WS + 8 * 256;
__device__ __forceinline__ void da_pass(const bf16_t* __restrict__ Qw, const bf16_t* __restrict__ Kh, const bf16_t* __restrict__ Vh, int NT, lptr lds, int tid, int wid, int lane,
                                        f32x16 (&o)[4], float& l_out) {
  const int r32 = lane & 31, hi = lane >> 5;
  const lptr V_lds = lds + DA_LDS_V, K_lds = lds + DA_LDS_K;
  ATT_LAS float* al_l = (ATT_LAS float*)(lds + DA_LDS_WS) + wid * 64 + 32;
  float m_reg = -1e30f, l_reg = 0.f;
#pragma unroll
  for (int d = 0; d < 4; ++d) o[d] = f32x16{};
  bf16x8 qr[4];
#pragma unroll
  for (int d0 = 0; d0 < 4; ++d0) qr[d0] = *(const bf16x8*)(Qw + d0 * 16);
  const int sr = tid >> 4, sc = (tid & 15) * 8, vst0 = v_st(sr, sc), vst1 = v_st(32 + sr, sc);
  const int kr = tid >> 3, kc = tid & 7, kst = koff(kr, kc);
  const int vb0 = (int)(unsigned)(uintptr_t)V_lds + v_rd_base(lane);
  bf16x8 sv0[2], sv1[2], sk[2];
#define SLOAD(i, k0) do { sv0[i] = *(const bf16x8*)(Vh + (size_t)((k0) + sr) * PITCH + sc); sv1[i] = *(const bf16x8*)(Vh + (size_t)((k0) + 32 + sr) * PITCH + sc); \
    sk[i] = *(const bf16x8*)(Kh + (size_t)((k0) + kr) * PITCH + kc * 8); } while (0)
#define SWRITE(b, i) do { *(ATT_LAS bf16x8*)(V_lds + (b) * DA_SHM_V + vst0) = sv0[i]; *(ATT_LAS bf16x8*)(V_lds + (b) * DA_SHM_V + vst1) = sv1[i]; \
    *(ATT_LAS bf16x8*)(K_lds + (b) * DA_SHM_K + kst) = sk[i]; } while (0)
#define SWAIT() asm volatile("s_waitcnt vmcnt(3)" ::: "memory")
#define RESC(a) do { if (__any((a) < 1.f)) { if (hi == 0) al_l[r32] = (a); asm volatile("s_waitcnt lgkmcnt(0)" ::: "memory"); \
    _Pragma("unroll") for (int d = 0; d < 4; ++d) _Pragma("unroll") for (int r = 0; r < 16; ++r) o[d][r] *= al_l[crow(r, hi)]; } } while (0)
#define PVALL(vb) do { pv_one<0>(o[0], (vb), pa0, pa1, pa2, pa3); pv_one<1>(o[1], (vb), pa0, pa1, pa2, pa3); pv_one<2>(o[2], (vb), pa0, pa1, pa2, pa3); pv_one<3>(o[3], (vb), pa0, pa1, pa2, pa3); } while (0)
  f32x16 pA0, pA1, pB0, pB1; float mnA, mnB, alA, alB; bf16x8 pa0, pa1, pa2, pa3;
  SLOAD(0, 0); asm volatile("s_waitcnt vmcnt(0)" ::: "memory"); SWRITE(0, 0); __syncthreads();
  qkt(pA0, pA1, K_lds, qr, r32, hi); partialSM(pA0, pA1, m_reg, mnA, alA);
  SLOAD(1, 64); if (2 < NT) SLOAD(0, 128);
  SWAIT(); SWRITE(1, 1); __syncthreads();
  for (int j = 1; j + 1 < NT; j += 2) {
    SBAR(); qkt(pB0, pB1, K_lds + DA_SHM_K, qr, r32, hi);
    finishSM(pA0, pA1, alA, l_reg, pa0, pa1, pa2, pa3); SBAR();
    SLOAD(1, (j + 2) * 64); SBAR();
    PVALL(vb0); partialSM(pB0, pB1, m_reg, mnB, alB);
    __syncthreads(); SWAIT(); SWRITE(0, 0);
    RESC(alB); __syncthreads();
    SBAR(); qkt(pA0, pA1, K_lds, qr, r32, hi);
    finishSM(pB0, pB1, alB, l_reg, pa0, pa1, pa2, pa3); SBAR();
    if (j + 3 < NT) SLOAD(0, (j + 3) * 64); SBAR();
    PVALL(vb0 + DA_SHM_V); partialSM(pA0, pA1, m_reg, mnA, alA);
    __syncthreads(); SWAIT(); SWRITE(1, 1);
    RESC(alA); __syncthreads();
  }
  SBAR(); qkt(pB0, pB1, K_lds + DA_SHM_K, qr, r32, hi);
  finishSM(pA0, pA1, alA, l_reg, pa0, pa1, pa2, pa3); SBAR();
  PVALL(vb0); partialSM(pB0, pB1, m_reg, mnB, alB);
  __syncthreads(); RESC(alB);
  finishSM(pB0, pB1, alB, l_reg, pa0, pa1, pa2, pa3); SBAR();
  PVALL(vb0 + DA_SHM_V);
  l_out = l_reg;
  __syncthreads();
#undef SLOAD
#undef SWRITE
#undef SWAIT
#undef RESC
#undef PVALL
}
#ifndef PP_PREF
#define PP_PREF 0
#endif
#ifndef PP_DMA_LATE
#define PP_DMA_LATE 0
#endif
#ifndef PP_DMA_IN_M
#define PP_DMA_IN_M 1
#endif
#ifndef PP_PRIO
#define PP_PRIO 1
#endif
#ifndef PP_NS
#define PP_NS 3
#endif
#ifndef PP_MIDBAR
#define PP_MIDBAR 0
#endif
#define PP_MID() do { if (PP_MIDBAR) PP_BAR(); else __builtin_amdgcn_sched_barrier(0); } while (0)
constexpr int PP_K = 0, PP_V = PP_NS * 8192, PP_WS = PP_V + PP_NS * 16384, PP_BYTES = PP_WS + 8 * 256;
typedef short v4i16_t __attribute__((ext_vector_type(4)));
__device__ __forceinline__ short qr_raw(const bf16x8& v, int e) { return v[e]; }
__device__ __forceinline__ s16x4 vtr(lptr p) { return __builtin_bit_cast(s16x4, __builtin_amdgcn_ds_read_tr16_b64_v4i16((ATT_LAS v4i16_t*)p)); }
#define PP_BAR() do { __builtin_amdgcn_sched_barrier(0); asm volatile("s_waitcnt lgkmcnt(0)" ::: "memory"); __builtin_amdgcn_s_barrier(); __builtin_amdgcn_sched_barrier(0); } while (0)
template <int GRP>
__device__ __forceinline__ void da_pass_pp(const bf16_t* __restrict__ Qw, const bf16_t* __restrict__ Kh, const bf16_t* __restrict__ Vh, int NT, lptr lds, int wid, int lane,
                                           float kmax2, f32x16 (&o)[4], float& l_out, unsigned* dbg = nullptr, int variant = 0) {
  const int r32 = lane & 31, hi = lane >> 5;
  const lptr Kr = lds + PP_K, Vr = lds + PP_V;
  ATT_LAS float* al_l = (ATT_LAS float*)(lds + PP_WS) + wid * 64 + 32;
  const bf16_t* ksrc = Kh + (size_t)(lane ^ wid) * PITCH + wid * 8;
  const bf16_t* vsrc0;
  { const int j = lane & 31, sidx = 2 * (2 * wid) + (lane >> 5), kk = (sidx >> 2) * 8 + (j >> 2), col = (sidx & 3) * 32 + (j & 3) * 8; vsrc0 = Vh + (size_t)kk * PITCH + col; }
#define DMA_K(t, slot) __builtin_amdgcn_global_load_lds((const unsigned*)(ksrc + (size_t)(t) * 64 * PITCH), (ATT_LAS unsigned*)(Kr + (slot) * 8192 + wid * 1024), 16, 0, 0)
#define DMA_V0(t, slot) __builtin_amdgcn_global_load_lds((const unsigned*)(vsrc0 + (size_t)(t) * 64 * PITCH), (ATT_LAS unsigned*)(Vr + (slot) * 16384 + (2 * wid) * 1024), 16, 0, 0)
#define DMA_V1(t, slot) __builtin_amdgcn_global_load_lds((const unsigned*)(vsrc0 + 64 + (size_t)(t) * 64 * PITCH), (ATT_LAS unsigned*)(Vr + (slot) * 16384 + (2 * wid + 1) * 1024), 16, 0, 0)
#define DMA_V(t, slot) do { DMA_V0(t, slot); DMA_V1(t, slot); } while (0)
  bf16x8 qr[4];
#pragma unroll
  for (int d0 = 0; d0 < 4; ++d0) qr[d0] = *(const bf16x8*)(Qw + d0 * 16);
  DMA_K(0, 0); DMA_V(0, 0); DMA_K(1, 1); if (PP_NS == 4) { DMA_K(2, 2); DMA_V(1, 1); }
  bool fast;
  { float qn = 0.f;
#pragma unroll
    for (int d0 = 0; d0 < 4; ++d0) {
#pragma unroll
      for (int e = 0; e < 8; ++e) { const float v = __uint_as_float(((unsigned)(unsigned short)qr_raw(qr[d0], e)) << 16); qn += v * v; } }
    { auto rr = __builtin_amdgcn_permlane32_swap(__float_as_uint(qn), __float_as_uint(qn), false, false); qn = __uint_as_float(rr[0]) + __uint_as_float(rr[1]); }
#ifdef PROBE_FORCE_FAST
    fast = true; }
#elif defined(PROBE_FORCE_SLOW)
    fast = false; }
#else
    fast = __all(qn * kmax2 * 1.05f < 10000.f) != 0; }
#endif
#pragma unroll
  for (int d = 0; d < 4; ++d) o[d] = f32x16{};
  float mref = 0.f, l_reg = 0.f;
  f32x16 S0, S1; bf16x8 pa0, pa1, pa2, pa3; const f32x16 zero16 = f32x16{};
  const int kq0 = koff(r32, hi), kq1 = koff(32 + r32, hi);
  const int vbase = v_rd_base(lane);
  asm volatile("s_waitcnt vmcnt(0)" ::: "memory");
  PP_BAR();
  int ks_cur = 0, vs_prev = PP_NS - 1, vs_new = PP_NS - 2;
#define SB0() __builtin_amdgcn_sched_barrier(0)
#define VRD8(d0, L0, H0, L1, H1, L2, H2, L3, H3) do { L0 = vtr(Vt + v_rd_off(d0, 0, 0)); H0 = vtr(Vt + v_rd_off(d0, 0, 1)); L1 = vtr(Vt + v_rd_off(d0, 1, 0)); H1 = vtr(Vt + v_rd_off(d0, 1, 1)); \
    L2 = vtr(Vt + v_rd_off(d0, 2, 0)); H2 = vtr(Vt + v_rd_off(d0, 2, 1)); L3 = vtr(Vt + v_rd_off(d0, 3, 0)); H3 = vtr(Vt + v_rd_off(d0, 3, 1)); } while (0)
#define PV4(d0, L0, H0, L1, H1, L2, H2, L3, H3) do { \
    o[d0] = __builtin_amdgcn_mfma_f32_32x32x16_bf16((bf16x8){L0[0], L0[1], L0[2], L0[3], H0[0], H0[1], H0[2], H0[3]}, pa0, o[d0], 0, 0, 0); \
    o[d0] = __builtin_amdgcn_mfma_f32_32x32x16_bf16((bf16x8){L1[0], L1[1], L1[2], L1[3], H1[0], H1[1], H1[2], H1[3]}, pa1, o[d0], 0, 0, 0); \
    o[d0] = __builtin_amdgcn_mfma_f32_32x32x16_bf16((bf16x8){L2[0], L2[1], L2[2], L2[3], H2[0], H2[1], H2[2], H2[3]}, pa2, o[d0], 0, 0, 0); \
    o[d0] = __builtin_amdgcn_mfma_f32_32x32x16_bf16((bf16x8){L3[0], L3[1], L3[2], L3[3], H3[0], H3[1], H3[2], H3[3]}, pa3, o[d0], 0, 0, 0); } while (0)
#define KRD8(KS) do { const lptr Kt = Kr + (KS) * 8192; \
    kf[0] = *(const ATT_LAS bf16x8*)(Kt + koff(r32, hi)); kf[1] = *(const ATT_LAS bf16x8*)(Kt + koff(32 + r32, hi)); \
    kf[2] = *(const ATT_LAS bf16x8*)(Kt + koff(r32, 2 + hi)); kf[3] = *(const ATT_LAS bf16x8*)(Kt + koff(32 + r32, 2 + hi)); \
    kf[4] = *(const ATT_LAS bf16x8*)(Kt + koff(r32, 4 + hi)); kf[5] = *(const ATT_LAS bf16x8*)(Kt + koff(32 + r32, 4 + hi)); \
    kf[6] = *(const ATT_LAS bf16x8*)(Kt + koff(r32, 6 + hi)); kf[7] = *(const ATT_LAS bf16x8*)(Kt + koff(32 + r32, 6 + hi)); } while (0)
#define KRD4A(KS) do { const lptr Kt = Kr + (KS) * 8192; \
    kf[0] = *(const ATT_LAS bf16x8*)(Kt + koff(r32, hi)); kf[1] = *(const ATT_LAS bf16x8*)(Kt + koff(32 + r32, hi)); } while (0)
#define KRD4B(KS) do { const lptr Kt = Kr + (KS) * 8192; \
    kf[2] = *(const ATT_LAS bf16x8*)(Kt + koff(r32, 2 + hi)); kf[3] = *(const ATT_LAS bf16x8*)(Kt + koff(32 + r32, 2 + hi)); \
    kf[4] = *(const ATT_LAS bf16x8*)(Kt + koff(r32, 4 + hi)); kf[5] = *(const ATT_LAS bf16x8*)(Kt + koff(32 + r32, 4 + hi)); \
    kf[6] = *(const ATT_LAS bf16x8*)(Kt + koff(r32, 6 + hi)); kf[7] = *(const ATT_LAS bf16x8*)(Kt + koff(32 + r32, 6 + hi)); } while (0)
#define QK8() do { \
    S0 = __builtin_amdgcn_mfma_f32_32x32x16_bf16(kf[0], qr[0], zero16, 0, 0, 0); S1 = __builtin_amdgcn_mfma_f32_32x32x16_bf16(kf[1], qr[0], zero16, 0, 0, 0); \
    S0 = __builtin_amdgcn_mfma_f32_32x32x16_bf16(kf[2], qr[1], S0, 0, 0, 0);   S1 = __builtin_amdgcn_mfma_f32_32x32x16_bf16(kf[3], qr[1], S1, 0, 0, 0); \
    S0 = __builtin_amdgcn_mfma_f32_32x32x16_bf16(kf[4], qr[2], S0, 0, 0, 0);   S1 = __builtin_amdgcn_mfma_f32_32x32x16_bf16(kf[5], qr[2], S1, 0, 0, 0); \
    S0 = __builtin_amdgcn_mfma_f32_32x32x16_bf16(kf[6], qr[3], S0, 0, 0, 0);   S1 = __builtin_amdgcn_mfma_f32_32x32x16_bf16(kf[7], qr[3], S1, 0, 0, 0); } while (0)
  bf16x8 kf[8]; s16x4 a0, a1, a2, a3, a4, a5, a6, a7, b0_, b1_, b2_, b3_, b4_, b5_, b6_, b7_;
#define NXT3(x) ((x) == PP_NS - 1 ? 0 : (x) + 1)
#define PREF(DO_K, DO_V, kslot, vslot) do { if (DO_V) { const lptr Vt = Vr + (vslot) * 16384 + vbase; VRD8(0, a0, a1, a2, a3, a4, a5, a6, a7); } \
    if (DO_K) { const int ks_cur_ = (kslot); KRD8(ks_cur_); } } while (0)
#define MB_DMA_K(tt) do { if (PP_DMA_IN_M && (tt) + PP_NS - 1 < NT) { DMA_K((tt) + PP_NS - 1, vs_prev); SB0(); } } while (0)
#define MB_DMA_V0(tt) do { if (PP_DMA_IN_M && (tt) + PP_NS - 2 < NT) { DMA_V0((tt) + PP_NS - 2, vs_new); SB0(); } } while (0)
#define MB_DMA_V1(tt) do { if (PP_DMA_IN_M && (tt) + PP_NS - 2 < NT) { DMA_V1((tt) + PP_NS - 2, vs_new); SB0(); } } while (0)
#define MBLOCK(DO_QK, DO_PV, tt) do { if (PP_PRIO == 1) __builtin_amdgcn_s_setprio(1); const lptr Vt = Vr + vs_prev * 16384 + vbase; \
    if (PP_PREF == 0 || PP_PREF == 4) { if (DO_QK) { if (PP_PREF == 0 || GRP == 0) { KRD8(ks_cur); SB0(); } } else if (DO_PV) { VRD8(0, a0, a1, a2, a3, a4, a5, a6, a7); SB0(); } } \
    if (PP_PREF == 3) { if (DO_QK) KRD4B(ks_cur); if (DO_PV) VRD8(0, a0, a1, a2, a3, a4, a5, a6, a7); SB0(); } \
    if (DO_QK && variant != 2) { QK8(); SB0(); if ((PP_PREF == 0 || PP_PREF == 4) && DO_PV) { VRD8(0, a0, a1, a2, a3, a4, a5, a6, a7); SB0(); } } \
    if (DO_PV && variant != 2) { VRD8(1, b0_, b1_, b2_, b3_, b4_, b5_, b6_, b7_); SB0(); PV4(0, a0, a1, a2, a3, a4, a5, a6, a7); SB0(); MB_DMA_K(tt); VRD8(2, a0, a1, a2, a3, a4, a5, a6, a7); SB0(); \
                 PV4(1, b0_, b1_, b2_, b3_, b4_, b5_, b6_, b7_); SB0(); MB_DMA_V0(tt); VRD8(3, b0_, b1_, b2_, b3_, b4_, b5_, b6_, b7_); SB0(); \
                 PV4(2, a0, a1, a2, a3, a4, a5, a6, a7); SB0(); MB_DMA_V1(tt); \
                 PV4(3, b0_, b1_, b2_, b3_, b4_, b5_, b6_, b7_); SB0(); \
                 if (PP_PREF == 3 && (tt) + 1 < NT) { KRD4A(NXT3(ks_cur)); SB0(); } } \
    else { MB_DMA_K(tt); MB_DMA_V0(tt); MB_DMA_V1(tt); if (PP_PREF == 3 && (tt) + 1 < NT) { KRD4A(NXT3(ks_cur)); SB0(); } } \
    if (PP_PRIO == 1) __builtin_amdgcn_s_setprio(0); } while (0)
#define VBLOCK(t) do { if ((t) >= 0 && (t) < NT && variant != 1) { if (PP_PRIO == 2) __builtin_amdgcn_s_setprio(1); \
    if (!fast) { const float rm = rowmax32(S0, S1); \
      if ((t) == 0 || __any(rm - mref > THRL)) { const float mn = (t) == 0 ? rm : fmaxf(rm, mref); \
        if ((t) != 0) { const float f = __builtin_amdgcn_exp2f(mref - mn); l_reg *= f; \
          _Pragma("unroll") for (int d = 0; d < 4; ++d) _Pragma("unroll") for (int r = 0; r < 16; ++r) o[d][r] *= f; } \
        mref = mn; } \
      _Pragma("unroll") for (int r = 0; r < 16; ++r) { S0[r] -= mref; S1[r] -= mref; } } \
    _Pragma("unroll") for (int r = 0; r < 16; ++r) { S0[r] = __builtin_amdgcn_exp2f(S0[r]); S1[r] = __builtin_amdgcn_exp2f(S1[r]); } \
    finish_T(S0, S1, l_reg, pa0, pa1, pa2, pa3); if (PP_PRIO == 2) __builtin_amdgcn_s_setprio(0); } } while (0)
#define ROT3() do { vs_new = vs_prev; vs_prev = ks_cur; ks_cur = ks_cur == PP_NS - 1 ? 0 : ks_cur + 1; } while (0)
#define TAILWAIT(t) do { if (PP_PREF == 3) { if ((t) + 3 < NT) asm volatile("s_waitcnt vmcnt(3)" ::: "memory"); else if ((t) + 2 < NT) asm volatile("s_waitcnt vmcnt(2)" ::: "memory"); else asm volatile("s_waitcnt vmcnt(0)" ::: "memory"); } \
    else if (PP_NS == 3) { if ((t) + 2 < NT) asm volatile("s_waitcnt vmcnt(3)" ::: "memory"); else if ((t) + 1 < NT) asm volatile("s_waitcnt vmcnt(2)" ::: "memory"); else asm volatile("s_waitcnt vmcnt(0)" ::: "memory"); } \
    else { if ((t) + 3 < NT) asm volatile("s_waitcnt vmcnt(6)" ::: "memory"); else if ((t) + 2 < NT) asm volatile("s_waitcnt vmcnt(5)" ::: "memory"); else if ((t) + 1 < NT) asm volatile("s_waitcnt vmcnt(2)" ::: "memory"); else asm volatile("s_waitcnt vmcnt(0)" ::: "memory"); } } while (0)
#if defined(DPROBE)
  unsigned long long dp_acc = 0, dp_prev = 0; const bool dp_on = dbg != nullptr && blockIdx.x == 0 && wid == (DPROBE_GRP ? 4 : 0) && GRP == DPROBE_GRP;
#define DP_T(i) do { if (dp_on) { const unsigned long long now_ = __builtin_amdgcn_s_memtime(); if ((i) == DPROBE) dp_acc += now_ - dp_prev; dp_prev = now_; } } while (0)
#else
#define DP_T(i) do {} while (0)
#endif
#define DMA_ISSUE(t) do { if ((t) + PP_NS - 1 < NT) DMA_K((t) + PP_NS - 1, vs_prev); if ((t) + PP_NS - 2 < NT) DMA_V((t) + PP_NS - 2, vs_new); } while (0)
  { if (!PP_DMA_IN_M && !(PP_DMA_LATE && GRP == 0)) { DMA_ISSUE(0); SB0(); }
    if (PP_PREF == 3) { KRD4A(ks_cur); SB0(); } else if (PP_PREF != 0) { PREF(true, false, ks_cur, 0); SB0(); }
    if (GRP == 0) MBLOCK(true, false, 0);
    if (!PP_DMA_IN_M && PP_DMA_LATE && GRP == 0) { SB0(); DMA_ISSUE(0); }
    SB0(); if (PP_PREF == 1 || PP_PREF == 2) TAILWAIT(0); PP_MID();
    if (GRP == 0) { if (PP_PREF == 1) { PREF(1 < NT, true, NXT3(ks_cur), NXT3(vs_prev)); SB0(); } VBLOCK(0); if (PP_PREF == 2) { SB0(); PREF(1 < NT, true, NXT3(ks_cur), NXT3(vs_prev)); } } else { if (PP_PREF == 4) { KRD8(ks_cur); SB0(); } MBLOCK(true, false, 0); }
    SB0(); if (PP_PREF == 0 || PP_PREF == 3 || PP_PREF == 4) TAILWAIT(0); PP_BAR(); ROT3(); }
#pragma clang loop unroll(disable)
  for (int t = 1; t < NT; ++t) {
    DP_T(0);
    if (!PP_DMA_IN_M && !(PP_DMA_LATE && GRP == 0)) { DMA_ISSUE(t); SB0(); }
    if (GRP == 0) MBLOCK(true, true, t); else { if (PP_PREF == 4) { KRD8(ks_cur); SB0(); } if (PP_PREF == 1) { PREF(true, true, ks_cur, vs_prev); SB0(); } VBLOCK(t - 1); if (PP_PREF == 2) { SB0(); PREF(true, true, ks_cur, vs_prev); } }
    if (!PP_DMA_IN_M && PP_DMA_LATE && GRP == 0) { SB0(); DMA_ISSUE(t); }
    SB0(); if (PP_PREF == 1 || PP_PREF == 2) TAILWAIT(t); DP_T(1); PP_MID(); DP_T(2);
    if (GRP == 0) { if (PP_PREF == 1) { PREF(t + 1 < NT, true, NXT3(ks_cur), NXT3(vs_prev)); SB0(); } VBLOCK(t); if (PP_PREF == 2) { SB0(); PREF(t + 1 < NT, true, NXT3(ks_cur), NXT3(vs_prev)); } } else MBLOCK(true, true, t);
    SB0(); if (PP_PREF == 0 || PP_PREF == 3 || PP_PREF == 4) TAILWAIT(t); DP_T(3); PP_BAR(); DP_T(4); ROT3();
  }
  { if (GRP == 0) MBLOCK(false, true, NT); else { if (PP_PREF == 1) { PREF(false, true, 0, vs_prev); SB0(); } VBLOCK(NT - 1); if (PP_PREF == 2) { SB0(); PREF(false, true, 0, vs_prev); } }
    PP_MID();
    if (GRP == 1) MBLOCK(false, true, NT);
    PP_BAR(); }
#if defined(DPROBE)
  if (dp_on && lane == 0) atomicAdd(dbg, (unsigned)(dp_acc >> 4));
#endif
  l_out = l_reg;
#undef DMA_K
#undef DMA_V
#undef MBLOCK
#undef MB_DMA_K
#undef MB_DMA_V0
#undef MB_DMA_V1
#undef VBLOCK
#undef SB0
#undef VRD8
#undef PV4
#undef KRD8
#undef KRD4A
#undef KRD4B
#undef QK8
#undef ROT3
#undef TAILWAIT
#undef PREF
#undef NXT3
#undef DMA_ISSUE
}
constexpr int DA_LDS_OST = 0, DA_LDS_TOTAL = PP_BYTES;
__device__ __forceinline__ void da_unit(size_t rowbase, int T, int h, int qb, const bf16_t* Q, const bf16_t* K, const bf16_t* V, bf16_t* O, float* park, unsigned lam_bits, float outscale,
                                        const float* __restrict__ subg, const unsigned* kmaxp, lptr lds, int tid, int wid, int lane, unsigned* dbg = nullptr, int variant = 0) {
  const int NT = T / 64;
  const size_t qrow = rowbase + (size_t)qb * 256 + wid * 32;
  f32x16 o[4]; float l_reg;
#pragma clang loop unroll(disable)
  for (int sub = 0; sub < 2; ++sub) {
    asm volatile("" : "+v"(tid)); lane = tid & 63;
    const int r32 = lane & 31, hi = lane >> 5;
    ATT_LAS float* li_l = (ATT_LAS float*)(lds + PP_WS) + wid * 64;
    const float kmax2 = __uint_as_float(__builtin_nontemporal_load(kmaxp + 2 * h + sub));
    if (wid < 4) da_pass_pp<0>(Q + (qrow + r32) * PITCH + (2 * h + sub) * 64 + hi * 8, K + rowbase * PITCH + (2 * h + sub) * 64, V + rowbase * PITCH + h * 128, NT, lds, wid, lane, kmax2, o, l_reg, dbg, variant);
    else da_pass_pp<1>(Q + (qrow + r32) * PITCH + (2 * h + sub) * 64 + hi * 8, K + rowbase * PITCH + (2 * h + sub) * 64, V + rowbase * PITCH + h * 128, NT, lds, wid, lane, kmax2, o, l_reg, dbg, variant);
    { auto rr = __builtin_amdgcn_permlane32_swap(__float_as_uint(l_reg), __float_as_uint(l_reg), false, false); l_reg = __uint_as_float(rr[0]) + __uint_as_float(rr[1]); }
    const float rl = __builtin_amdgcn_rcpf(l_reg);
    f32x4* pk = (f32x4*)(park + ((size_t)wid * 64 + lane) * 64);
    if (sub == 0) {
#pragma unroll
      for (int d0 = 0; d0 < 4; ++d0)
#pragma unroll
        for (int q = 0; q < 4; ++q) { f32x4 v; v[0] = o[d0][4 * q] * rl; v[1] = o[d0][4 * q + 1] * rl; v[2] = o[d0][4 * q + 2] * rl; v[3] = o[d0][4 * q + 3] * rl; pk[d0 * 4 + q] = v; }
    } else {
      const float rll = rl * __uint_as_float(lam_bits); float ss = 0.f;
#pragma unroll
      for (int d0 = 0; d0 < 4; ++d0)
#pragma unroll
        for (int q = 0; q < 4; ++q) { const f32x4 p = pk[d0 * 4 + q];
#pragma unroll
          for (int j = 0; j < 4; ++j) { const float v = p[j] - o[d0][4 * q + j] * rll; o[d0][4 * q + j] = v; ss += v * v; } }
      { auto rr = __builtin_amdgcn_permlane32_swap(__float_as_uint(ss), __float_as_uint(ss), false, false); ss = __uint_as_float(rr[0]) + __uint_as_float(rr[1]); }
      const float rstd = __builtin_amdgcn_rsqf(ss * (1.0f / 128.0f) + 1e-5f) * outscale;
      ATT_LAS bf16_t* stg = (ATT_LAS bf16_t*)(lds + DA_LDS_OST) + wid * 4096;
#pragma unroll
      for (int d0 = 0; d0 < 4; ++d0)
#pragma unroll
        for (int q = 0; q < 4; ++q) { const f32x4 gv = *(const f32x4*)(subg + d0 * 32 + 8 * q + 4 * hi);
          typedef unsigned u32x2v __attribute__((ext_vector_type(2))); u32x2v w;
          w.x = cvtpk(o[d0][4 * q] * rstd * gv[0], o[d0][4 * q + 1] * rstd * gv[1]); w.y = cvtpk(o[d0][4 * q + 2] * rstd * gv[2], o[d0][4 * q + 3] * rstd * gv[3]);
          *(ATT_LAS u32x2v*)(stg + r32 * 128 + d0 * 32 + 8 * q + 4 * hi) = w; }
      asm volatile("s_waitcnt lgkmcnt(0)" ::: "memory");
      bf16_t* Ow = O + qrow * PITCH + h * 128;
#pragma unroll
      for (int i = 0; i < 8; ++i) { const int row = i * 4 + (lane >> 4), ch = lane & 15; const u32x4 v = *(const ATT_LAS u32x4*)(stg + row * 128 + ch * 8); *(u32x4*)(Ow + (size_t)row * PITCH + ch * 8) = v; }
      asm volatile("s_waitcnt lgkmcnt(0)" ::: "memory"); __builtin_amdgcn_s_barrier();
    }
  }
}

constexpr int NA_NS = 4, NA_SLOT = 16384, NA_LDS_B = NA_NS * NA_SLOT, NA_LDS_WS = NA_LDS_B + 2560, NA_LDS_OST = NA_LDS_WS + 8 * 256, NA_LDS_BYTES = NA_LDS_OST + 8 * 4096, NA_BPAD = 64;
template <int D0, int KS0, int KS1> __device__ __forceinline__ void pv_ks(f32x16& od, int vb, bf16x8 pa0, bf16x8 pa1, bf16x8 pa2, bf16x8 pa3) {
  s16x4 l[4], h[4];
#pragma unroll
  for (int ks = 0; ks < 4; ++ks) if (ks >= KS0 && ks <= KS1) {
      asm volatile("ds_read_b64_tr_b16 %0, %1 offset:%2" : "=&v"(l[ks]) : "v"(vb), "i"(D0 * 512 + ks * 2048) : "memory");
      asm volatile("ds_read_b64_tr_b16 %0, %1 offset:%2" : "=&v"(h[ks]) : "v"(vb), "i"(D0 * 512 + ks * 2048 + 1024) : "memory"); }
  asm volatile("s_waitcnt lgkmcnt(0)" ::: "memory"); SBAR();
#define PK(L, H) (bf16x8){L[0], L[1], L[2], L[3], H[0], H[1], H[2], H[3]}
  if (0 >= KS0 && 0 <= KS1) od = __builtin_amdgcn_mfma_f32_32x32x16_bf16(pa0, PK(l[0], h[0]), od, 0, 0, 0);
  if (1 >= KS0 && 1 <= KS1) od = __builtin_amdgcn_mfma_f32_32x32x16_bf16(pa1, PK(l[1], h[1]), od, 0, 0, 0);
  if (2 >= KS0 && 2 <= KS1) od = __builtin_amdgcn_mfma_f32_32x32x16_bf16(pa2, PK(l[2], h[2]), od, 0, 0, 0);
  if (3 >= KS0 && 3 <= KS1) od = __builtin_amdgcn_mfma_f32_32x32x16_bf16(pa3, PK(l[3], h[3]), od, 0, 0, 0);
#undef PK
}
template <int H>
__device__ __forceinline__ void na_tiles(size_t tok0, int rows, int h, int R, int qrow, const bf16_t* Q, const bf16_t* K, const bf16_t* V, bf16_t* O, lptr lds, int tid, int wid, int lane) {
  const int r32 = lane & 31, hi = lane >> 5;
  ATT_LAS float* bias = (ATT_LAS float*)(lds + NA_LDS_B);
  ATT_LAS float* li_l = (ATT_LAS float*)(lds + NA_LDS_WS) + wid * 64; ATT_LAS float* al_l = li_l + 32;
  const int c = 32 * H + r32;
  const int c0 = min(max(c - 8, 0), 48), tmask = 4 * hi - c0;
  const int rlo_w = min(max(qrow - 4, 0), rows - 8);
  const int kr_lo = min(max(R - 4, 0), rows - 8), kr_hi = min(max(R + 3 - 4, 0), rows - 8) + 7, nt = kr_hi - kr_lo + 1;
  const size_t qtok = tok0 + (size_t)qrow * 64 + c;
  bf16x8 qr[4];
#pragma unroll
  for (int d0 = 0; d0 < 4; ++d0) qr[d0] = *(const bf16x8*)(Q + qtok * PITCH + h * 64 + d0 * 16 + hi * 8);
  const int vb0 = (int)(unsigned)(uintptr_t)lds + v_rd_base(lane);
  const bf16_t* ksrc = K + (tok0 + (size_t)(lane ^ wid)) * PITCH + h * 64 + wid * 8;
  const bf16_t* vsrc;
  { const int j = lane & 31, kk = wid * 8 + (j >> 2), col = (lane >> 5) * 32 + (j & 3) * 8, k = (kk & ~0xC) | ((kk & 4) << 1) | ((kk & 8) >> 1); vsrc = V + (tok0 + (size_t)k) * PITCH + h * 64 + col; }
#define NDMA(row, slot) do { __builtin_amdgcn_global_load_lds((const unsigned*)(vsrc + (size_t)(row) * 64 * PITCH), (ATT_LAS unsigned*)(lds + (slot) * NA_SLOT + wid * 1024), 16, 0, 0); \
                             __builtin_amdgcn_global_load_lds((const unsigned*)(ksrc + (size_t)(row) * 64 * PITCH), (ATT_LAS unsigned*)(lds + (slot) * NA_SLOT + 8192 + wid * 1024), 16, 0, 0); } while (0)
#define NBAR() do { __builtin_amdgcn_sched_barrier(0); asm volatile("s_waitcnt lgkmcnt(0)" ::: "memory"); __builtin_amdgcn_s_barrier(); __builtin_amdgcn_sched_barrier(0); } while (0)
  float mref = 0.f, l_reg = 0.f; f32x16 o[2]; o[0] = f32x16{}; o[1] = f32x16{};
  asm volatile("" :: "v"(qr[0]), "v"(qr[1]), "v"(qr[2]), "v"(qr[3]));
  NDMA(kr_lo, 0); if (1 < nt) NDMA(kr_lo + 1, 1); if (2 < nt) NDMA(kr_lo + 2, 2);
  int slot = 0;
  for (int t = 0; t < nt; ++t) {
    const int krow = kr_lo + t;
    if (t + 2 < nt) asm volatile("s_waitcnt vmcnt(4)" ::: "memory"); else if (t + 1 < nt) asm volatile("s_waitcnt vmcnt(2)" ::: "memory"); else asm volatile("s_waitcnt vmcnt(0)" ::: "memory");
    NBAR();
    if (t + 3 < nt) NDMA(krow + 3, (slot + 3) & 3);
    __builtin_amdgcn_sched_barrier(0);
    if (krow >= rlo_w && krow < rlo_w + 8) {
      f32x16 p0, p1; qkt(p0, p1, lds + slot * NA_SLOT + 8192, qr, r32, hi);
      const int bofs = NA_BPAD + (krow - qrow + 7) * 31 + 15 - c + 4 * hi;
#define BM(P, r, koffc) do { const int kcol = ((r) & 3) + 8 * ((r) >> 2) + (koffc); float bv_ = bias[bofs + kcol]; asm volatile("" : "+v"(bv_));   \
        P[r] = ((unsigned)(kcol + tmask) < 16u) ? P[r] + bv_ : -INFINITY; } while (0)
      float pm;
      if (H == 0) {
#pragma unroll
        for (int r = 0; r < 16; ++r) BM(p0, r, 0);
#pragma unroll
        for (int r = 0; r < 4; ++r) BM(p1, r, 32);
        pm = p0[0];
#pragma unroll
        for (int r = 1; r < 16; ++r) pm = fmaxf(pm, p0[r]);
#pragma unroll
        for (int r = 0; r < 4; ++r) pm = fmaxf(pm, p1[r]);
      } else {
#pragma unroll
        for (int r = 12; r < 16; ++r) BM(p0, r, 0);
#pragma unroll
        for (int r = 0; r < 16; ++r) BM(p1, r, 32);
        pm = p1[0];
#pragma unroll
        for (int r = 1; r < 16; ++r) pm = fmaxf(pm, p1[r]);
#pragma unroll
        for (int r = 12; r < 16; ++r) pm = fmaxf(pm, p0[r]);
      }
#undef BM
      { auto rr = __builtin_amdgcn_permlane32_swap(__float_as_uint(pm), __float_as_uint(pm), false, false); pm = fmaxf(__uint_as_float(rr[0]), __uint_as_float(rr[1])); }
      const bool first = krow == rlo_w;
      if (first || __any(pm - mref > THRL)) { const float mn = first ? pm : fmaxf(pm, mref);
        if (!first) { const float f = __builtin_amdgcn_exp2f(mref - mn); l_reg *= f; if (hi == 0) al_l[r32] = f; asm volatile("s_waitcnt lgkmcnt(0)" ::: "memory");
#pragma unroll
          for (int r = 0; r < 16; ++r) { const float a = al_l[crow(r, hi)]; o[0][r] *= a; o[1][r] *= a; } }
        mref = mn; }
      float ps = 0.f;
      if (H == 0) {
#pragma unroll
        for (int r = 0; r < 16; ++r) { p0[r] = __builtin_amdgcn_exp2f(p0[r] - mref); ps += p0[r]; }
#pragma unroll
        for (int r = 0; r < 4; ++r) { p1[r] = __builtin_amdgcn_exp2f(p1[r] - mref); ps += p1[r]; }
#pragma unroll
        for (int r = 4; r < 8; ++r) p1[r] = 0.f;
      } else {
#pragma unroll
        for (int r = 12; r < 16; ++r) { p0[r] = __builtin_amdgcn_exp2f(p0[r] - mref); ps += p0[r]; }
#pragma unroll
        for (int r = 0; r < 16; ++r) { p1[r] = __builtin_amdgcn_exp2f(p1[r] - mref); ps += p1[r]; }
#pragma unroll
        for (int r = 8; r < 12; ++r) p0[r] = 0.f;
      }
      { auto rr = __builtin_amdgcn_permlane32_swap(__float_as_uint(ps), __float_as_uint(ps), false, false); ps = __uint_as_float(rr[0]) + __uint_as_float(rr[1]); }
      l_reg += ps;
      bf16x8 pa0 = bf16x8{}, pa1, pa2, pa3 = bf16x8{};
#define PK4(P, BASE, OUT) do { unsigned a0 = cvtpk(P[BASE + 0], P[BASE + 1]), a1 = cvtpk(P[BASE + 2], P[BASE + 3]);   \
    unsigned b0 = cvtpk(P[BASE + 4], P[BASE + 5]), b1 = cvtpk(P[BASE + 6], P[BASE + 7]);                              \
    auto r0 = __builtin_amdgcn_permlane32_swap(a0, b0, false, false); auto r1 = __builtin_amdgcn_permlane32_swap(a1, b1, false, false); \
    u32x4 w = {r0[0], r1[0], r0[1], r1[1]}; OUT = __builtin_bit_cast(bf16x8, w); } while (0)
      const int vb = vb0 + slot * NA_SLOT;
      if (H == 0) { PK4(p0, 0, pa0); PK4(p0, 8, pa1); PK4(p1, 0, pa2); pv_ks<0, 0, 2>(o[0], vb, pa0, pa1, pa2, pa3); pv_ks<1, 0, 2>(o[1], vb, pa0, pa1, pa2, pa3); }
      else        { PK4(p0, 8, pa1); PK4(p1, 0, pa2); PK4(p1, 8, pa3); pv_ks<0, 1, 3>(o[0], vb, pa0, pa1, pa2, pa3); pv_ks<1, 1, 3>(o[1], vb, pa0, pa1, pa2, pa3); }
#undef PK4
    }
    slot = (slot + 1) & 3;
  }
#undef NDMA
  if (hi == 0) li_l[r32] = l_reg; asm volatile("s_waitcnt lgkmcnt(0)" ::: "memory");
  ATT_LAS bf16_t* stg = (ATT_LAS bf16_t*)(lds + NA_LDS_OST) + wid * 2048;
#pragma unroll
  for (int r = 0; r < 16; ++r) { const int orow = crow(r, hi); const float rl = __builtin_amdgcn_rcpf(li_l[orow]);
#pragma unroll
    for (int d0 = 0; d0 < 2; ++d0) { const unsigned w = cvtpk(o[d0][r] * rl, 0.f); stg[orow * 64 + d0 * 32 + r32] = (bf16_t)(w & 0xffffu); } }
  asm volatile("s_waitcnt lgkmcnt(0)" ::: "memory");
  bf16_t* Ow = O + (tok0 + (size_t)qrow * 64 + 32 * H) * PITCH + h * 64;
#pragma unroll
  for (int i = 0; i < 4; ++i) { const int row = i * 8 + (lane >> 3), ch = lane & 7; const u32x4 v = *(const ATT_LAS u32x4*)(stg + row * 64 + ch * 8); *(u32x4*)(Ow + (size_t)row * PITCH + ch * 8) = v; }
  NBAR();
#undef NBAR
}
__device__ __forceinline__ void na_unit(size_t tok0, int rows, int h, int R, const bf16_t* Q, const bf16_t* K, const bf16_t* V, bf16_t* O, const float* __restrict__ rpb_h,
                                        lptr lds, int tid, int wid, int lane) {
  asm volatile("" : "+v"(tid)); lane = tid & 63;
  ATT_LAS float* bias = (ATT_LAS float*)(lds + NA_LDS_B);
  for (int i = tid; i < 465; i += 512) bias[NA_BPAD + i] = rpb_h[i] * 1.4426950408889634f;
  const int qrow = R + (wid >> 1);
  if ((wid & 1) == 0) na_tiles<0>(tok0, rows, h, R, qrow, Q, K, V, O, lds, tid, wid, lane);
  else                na_tiles<1>(tok0, rows, h, R, qrow, Q, K, V, O, lds, tid, wid, lane);
}
#undef SBAR
}

#define XB_TMO      128
#define XB_XCNT(j)  (256  + 64 * (j))
#define XB_XSUB(j)  (1280 + 64 * (j))
#define XB_XGEN(j)  (2304 + 64 * (j))
#define XB_TOP      3328
#define XB_TOPGEN   3392
#define XCD_BAR_WORDS 3456
#define XB_SPIN_CAP (1u << 18)

__device__ __forceinline__ unsigned xb_ld(unsigned* p)              { return __hip_atomic_load(p, __ATOMIC_RELAXED, __HIP_MEMORY_SCOPE_AGENT); }
__device__ __forceinline__ unsigned xb_add(unsigned* p, unsigned v) { return __hip_atomic_fetch_add(p, v, __ATOMIC_RELAXED, __HIP_MEMORY_SCOPE_AGENT); }
__device__ __forceinline__ unsigned xb_xcc_id() { return (unsigned)__builtin_amdgcn_s_getreg((3 << 11) | 20) & 0xFu; }
#define XB_SPIN(cond, bar) do { unsigned _sp = 0; while (cond) { __builtin_amdgcn_s_sleep(1); \
    if ((++_sp & 255u) == 0u) { if (xb_ld(&(bar)[XB_TMO])) break; if (_sp > XB_SPIN_CAP) { atomicAdd(&(bar)[XB_TMO], 1u); break; } } } } while (0)

struct XcdBarrier {
    unsigned* bar; unsigned x; int w;
    volatile LAS unsigned* st;
};

__device__ __forceinline__ XcdBarrier xcd_barrier_post(unsigned* bar, volatile LAS unsigned* st) {
    XcdBarrier b; b.bar = bar; b.x = xb_xcc_id(); b.st = st; b.w = __builtin_amdgcn_readfirstlane((int)threadIdx.x >> 6);
    if (threadIdx.x == 0) (void)xb_add(&bar[XB_XCNT(b.x)], 1u);
    return b;
}
__device__ __forceinline__ void xcd_barrier_complete(unsigned* bar, unsigned x, unsigned& nloc, unsigned& nx) {
    const unsigned G = gridDim.x * gridDim.y * gridDim.z;
    unsigned sum, cnt, mine, sp = 0u;
    for (;;) {
        sum = 0u; cnt = 0u; mine = 0u;
#pragma unroll
        for (unsigned j = 0; j < 16; ++j) { const unsigned c = xb_ld(&bar[XB_XCNT(j)]); sum += c; cnt += (c > 0u) ? 1u : 0u; mine = (j == x) ? c : mine; }
        if (sum == G) break;
        __builtin_amdgcn_s_sleep(1);
        if ((++sp & 255u) == 0u) { if (xb_ld(&bar[XB_TMO])) break; if (sp > XB_SPIN_CAP) { atomicAdd(&bar[XB_TMO], 1u); break; } }
    }
    nloc = mine > 0u ? mine : 1u; nx = cnt > 0u ? cnt : 1u;
}

__device__ __forceinline__ void xcd_barrier(const XcdBarrier& b) {
    asm volatile("s_waitcnt vmcnt(0)" ::: "memory");
    __syncthreads();
    if (b.w == 0 && LANE_ID() == 0) {
        unsigned* bar = b.bar;
        __builtin_amdgcn_s_waitcnt(0);
        unsigned nloc = b.st[0], nx = b.st[1];
        if (nloc == 0u) { xcd_barrier_complete(bar, b.x, nloc, nx); b.st[0] = nloc; b.st[1] = nx; }
        const unsigned old = xb_add(&bar[XB_XSUB(b.x)], 1u);
        const unsigned gen = old / nloc;
        if (old + 1u == (gen + 1u) * nloc) {
            __builtin_amdgcn_fence(__ATOMIC_RELEASE, "agent");
            asm volatile("s_waitcnt vmcnt(0)" ::: "memory");
            const unsigned og = xb_add(&bar[XB_TOP], 1u);
            const unsigned tg = og / nx;
            if (og + 1u == (tg + 1u) * nx) xb_add(&bar[XB_TOPGEN], 1u);
            else XB_SPIN(xb_ld(&bar[XB_TOPGEN]) == tg, bar);
            __builtin_amdgcn_fence(__ATOMIC_ACQUIRE, "agent");
            xb_add(&bar[XB_XGEN(b.x)], 1u);
            asm volatile("s_waitcnt vmcnt(0)" ::: "memory");
        } else {
            XB_SPIN(xb_ld(&bar[XB_XGEN(b.x)]) == gen, bar);
            __builtin_amdgcn_fence(__ATOMIC_ACQUIRE, "agent");
            asm volatile("s_waitcnt vmcnt(0)" ::: "memory");
        }
    }
    __syncthreads();
}

constexpr int NWAVES = 8;
#ifndef PG8_ALIGN_PLAIN
#define PG8_ALIGN_PLAIN true
#endif
#ifndef FUSE_THIN
#define FUSE_THIN 0
#endif
#ifndef MK_PER_PHASE
#define MK_PER_PHASE 0
#endif
constexpr int NPH = 15;

constexpr size_t MiB = 1u << 20;
constexpr size_t WS_CTL = 0, CTL_ZERO_BYTES = 1 * MiB;
constexpr size_t WS_ROPE_C = 1 * MiB, WS_ROPE_S = 2 * MiB, WS_RS = 3 * MiB;
constexpr size_t WS_WQKV0 = 4 * MiB, WS_WO0 = 10 * MiB, WS_WIN0 = 12 * MiB, WS_WOUT0 = 23 * MiB;
constexpr size_t WS_WQKV1 = 29 * MiB, WS_WO1 = 35 * MiB, WS_WIN1 = 37 * MiB, WS_WOUT1 = 48 * MiB;
constexpr size_t WS_XN = 56 * MiB;
constexpr size_t WS_Q = 218 * MiB, WS_K = 378 * MiB, WS_V = 538 * MiB;
constexpr size_t WS_G = 218 * MiB;
constexpr size_t WS_MB = 698 * MiB;
constexpr size_t WS_PARK = 858 * MiB;
constexpr size_t WS_END = 896 * MiB;
static_assert(WS_WOUT1 + (size_t)D * FF * 2 <= WS_XN - 4096 && WS_XN + (size_t)(NMT_CONV * 254 + 2) * D * 2 <= WS_Q && WS_G + (size_t)M * FF * 2 <= WS_MB && WS_MB + (size_t)M * D * 2 <= WS_PARK, "d_ws map");
constexpr int CW_PANEL = 16384, PANEL_BANK = 320 * 64;
constexpr int CW_TP = 8000;
constexpr int CW_KMAX = 8192;
constexpr int CW_BAR = 4096;

constexpr int RING_OFF = 0, RING_BYTES = 131072;
constexpr int LDSCTL_OFF = RING_BYTES, MISC_OFF = LDSCTL_OFF + 320;
constexpr int XCH_OFF = RING_BYTES + 1024;
constexpr int LDS_BYTES = 147456;
static_assert(XCH_OFF + 8192 + 4096 <= LDS_BYTES && att::DA_LDS_TOTAL <= RING_BYTES && att::NA_LDS_BYTES <= RING_BYTES, "LDS map");

__device__ __forceinline__ void p0_transpose_item(const float* W, int K, int N, bf16* WT, int k0, int n0, int drow0, const float* gk, LAS float* scr, int lane) {
#pragma unroll 8
    for (int i = 0; i < 32; ++i) { const int kk = 2 * i + (lane >> 5); float w = W[(size_t)(k0 + kk) * N + n0 + (lane & 31)]; if (gk) w *= gk[k0 + kk]; scr[kk * 33 + (lane & 31)] = w; }
    LDS_WAIT(); asm volatile("" ::: "memory");
    const int c = lane & 7;
#pragma unroll
    for (int j = 0; j < 4; ++j) { const int n = (lane >> 3) + 8 * j; const LAS float* s = scr + (8 * c) * 33 + n;
        v4u o; o.x = pk2(s[0 * 33], s[1 * 33]); o.y = pk2(s[2 * 33], s[3 * 33]); o.z = pk2(s[4 * 33], s[5 * 33]); o.w = pk2(s[6 * 33], s[7 * 33]);
        *(GAS v4u*)(WT + (size_t)(drow0 + n) * K + k0 + 8 * c) = o; }
    LDS_WAIT(); asm volatile("" ::: "memory");
}
__device__ __forceinline__ void p0_matrix(const float* W, int K, int N, bf16* WT, const float* gk, int mode, int roff, LAS float* scr, int gw, int NGW, int lane) {
    const int nblk = N / 32, nitems = (K / 64) * nblk;
    for (int it = gw; it < nitems; it += NGW) {
        const int kb = it / nblk, nb = it % nblk, n0 = 32 * nb; int drow0;
        if (mode == 0) drow0 = roff + n0;
        else if (mode == 1) { const int bj = n0 >= FF ? 1 : 0, ch = n0 - bj * FF; drow0 = (ch >> 7) * 256 + bj * 128 + (ch & 127); }
        else { const int s = n0 >> 6, half = (n0 >> 5) & 1; drow0 = roff + (s >> 2) * 256 + half * 128 + (s & 3) * 32; }
        p0_transpose_item(W, K, N, WT, 64 * kb, n0, drow0, gk, scr, lane);
    }
}
__device__ __forceinline__ void sincos_small(double x, double& s, double& c) {
    const double x2 = x * x;
    double a = -1.0 / 25852016738884976640000.0;
    a = a * x2 + 1.0 / 51090942171709440000.0;
    a = a * x2 - 1.0 / 121645100408832000.0;
    a = a * x2 + 1.0 / 355687428096000.0;
    a = a * x2 - 1.0 / 1307674368000.0;
    a = a * x2 + 1.0 / 6227020800.0;
    a = a * x2 - 1.0 / 39916800.0;
    a = a * x2 + 1.0 / 362880.0;
    a = a * x2 - 1.0 / 5040.0;
    a = a * x2 + 1.0 / 120.0;
    a = a * x2 - 1.0 / 6.0;
    a = a * x2 + 1.0;
    s = a * x;
    double b = 1.0 / 620448401733239439360000.0;
    b = b * x2 - 1.0 / 1124000727777607680000.0;
    b = b * x2 + 1.0 / 2432902008176640000.0;
    b = b * x2 - 1.0 / 6402373705728000.0;
    b = b * x2 + 1.0 / 20922789888000.0;
    b = b * x2 - 1.0 / 87178291200.0;
    b = b * x2 + 1.0 / 479001600.0;
    b = b * x2 - 1.0 / 3628800.0;
    b = b * x2 + 1.0 / 40320.0;
    b = b * x2 - 1.0 / 720.0;
    b = b * x2 + 1.0 / 24.0;
    b = b * x2 - 0.5;
    b = b * x2 + 1.0;
    c = b;
}
struct Args { const float* in[22]; float* out; unsigned char* ws; int ph_lo, ph_hi; };
__global__ void __launch_bounds__(NWAVES * 64, 2) mega_fwd(Args args) {
    extern __shared__ __attribute__((aligned(16))) unsigned char lds_raw[];
    LAS unsigned char* lds = (LAS unsigned char*)lds_raw;
    volatile LAS unsigned* MISC = (volatile LAS unsigned*)(lds + MISC_OFF);
    const int wave = __builtin_amdgcn_readfirstlane((int)threadIdx.x >> 6);
#define lane LANE_ID()
#define tid (wave * 64 + LANE_ID())
    const int G = gridDim.x, bx = blockIdx.x, vcu = (G % 8 == 0) ? (bx % 8) * (G / 8) + bx / 8 : bx;
    const int gw = vcu * NWAVES + wave, NGW = G * NWAVES;
    unsigned char* ws = args.ws;
    gu32* ctl = (gu32*)(ws + WS_CTL);
    for (int u = tid; u < (LDS_BYTES - LDSCTL_OFF) / 4; u += NWAVES * 64) ((LAS unsigned*)(lds + LDSCTL_OFF))[u] = 0u;
    __syncthreads();
    XcdBarrier bar; bar.bar = (unsigned*)(ctl + CW_BAR); bar.x = 0; bar.st = nullptr; bar.w = wave;
    if (!MK_PER_PHASE) bar = xcd_barrier_post((unsigned*)(ctl + CW_BAR), MISC + 8);
#if defined(BPROBE)
    unsigned long long bp_acc = 0; int bp_k = 0;
#define GRID_BAR() do { const unsigned long long t_ = __builtin_amdgcn_s_memrealtime(); xcd_barrier(bar); if (bp_k >= BPROBE_LO && bp_k < BPROBE_HI) bp_acc += __builtin_amdgcn_s_memrealtime() - t_; ++bp_k; } while (0)
#else
#define GRID_BAR() do { if (!MK_PER_PHASE) xcd_barrier(bar); } while (0)
#endif
    const int lo = args.ph_lo, hi = args.ph_hi;
#ifndef PH_MASK
#define PH_MASK 0x7fff
#endif
#define IN(k) (((PH_MASK >> (k)) & 1) && lo <= (k) && (k) < hi)
#define BOTH(k) (IN(k) && IN((k) + 1))
#ifndef PROBE_DUP
#define PROBE_DUP -1
#endif
#define REPS(k) (((k) == PROBE_DUP) ? 2 : 1)

#if defined(GPROBE)
#define GP_ARG(k) ((k) == GPROBE_PHASE ? (unsigned*)(ctl + CW_TP) : (unsigned*)nullptr)
#else
#define GP_ARG(k) ((unsigned*)nullptr)
#endif
#if defined(DPROBE)
#define DP_ARG ((unsigned*)(ctl + CW_TP))
#else
#define DP_ARG ((unsigned*)nullptr)
#endif
#if defined(PPROBE)
    unsigned long long pp_t0 = 0, pp_t1 = 0;
#define PP_BEGIN(k) do { if ((k) == PPROBE) pp_t0 = __builtin_amdgcn_s_memrealtime(); } while (0)
#define PP_END(k) do { if ((k) == PPROBE) pp_t1 = __builtin_amdgcn_s_memrealtime(); } while (0)
#else
#define PP_BEGIN(k) do {} while (0)
#define PP_END(k) do {} while (0)
#endif
#if defined(TPROBE)
    unsigned long long tp_c0 = 0, tp_r0 = 0, tp_c1 = 0, tp_r1 = 0;
#define TP_BEGIN(k) do { if ((k) == TPROBE) { tp_c0 = __builtin_amdgcn_s_memtime(); tp_r0 = __builtin_amdgcn_s_memrealtime(); } } while (0)
#define TP_END(k) do { if ((k) == TPROBE) { tp_c1 = __builtin_amdgcn_s_memtime(); tp_r1 = __builtin_amdgcn_s_memrealtime(); } } while (0)
#else
#define TP_BEGIN(k) do {} while (0)
#define TP_END(k) do {} while (0)
#endif
    const float* x_p = args.in[0]; const float* x_s = args.in[1];
    const float* attn_pre_g = args.in[2]; const float* attn_post_g = args.in[3]; const float* ffn_pre_g = args.in[4]; const float* ffn_post_g = args.in[5];
    float* out = args.out;
    bf16* XN = (bf16*)(ws + WS_XN); bf16* QB = (bf16*)(ws + WS_Q); bf16* KB = (bf16*)(ws + WS_K); bf16* VB = (bf16*)(ws + WS_V); bf16* GB = (bf16*)(ws + WS_G); bf16* MB = (bf16*)(ws + WS_MB);
    float* ROPE_C = (float*)(ws + WS_ROPE_C); float* ROPE_S = (float*)(ws + WS_ROPE_S); float* RS = (float*)(ws + WS_RS);
    constexpr size_t TSTEP_D = (size_t)256 * D * 2, TSTEP_FF = (size_t)256 * FF * 2, TSTEP_CONV = (size_t)254 * D * 2;

    if (IN(0)) for (int rep_ = 0; rep_ < REPS(0); ++rep_) { PP_BEGIN(0);
        LAS float* scr = (LAS float*)(lds + RING_OFF + wave * 16384);
        p0_matrix(args.in[6], D, 3 * D, (bf16*)(ws + WS_WQKV0), attn_pre_g, 0, 0, scr, gw, NGW, lane);
        p0_matrix(args.in[8], D, D, (bf16*)(ws + WS_WO0), nullptr, 0, 0, scr, gw, NGW, lane);
        p0_matrix(args.in[18], D, FF2, (bf16*)(ws + WS_WIN0), ffn_pre_g, 1, 0, scr, gw, NGW, lane);
        p0_matrix(args.in[21], FF, D, (bf16*)(ws + WS_WOUT0), nullptr, 0, 0, scr, gw, NGW, lane);
        p0_matrix(args.in[9], D, D, (bf16*)(ws + WS_WQKV1), attn_pre_g + D, 2, 0, scr, gw, NGW, lane);
        p0_matrix(args.in[10], D, D, (bf16*)(ws + WS_WQKV1), attn_pre_g + D, 2, D, scr, gw, NGW, lane);
        p0_matrix(args.in[11], D, D, (bf16*)(ws + WS_WQKV1), attn_pre_g + D, 0, 2 * D, scr, gw, NGW, lane);
        p0_matrix(args.in[17], D, D, (bf16*)(ws + WS_WO1), nullptr, 0, 0, scr, gw, NGW, lane);
        p0_matrix(args.in[18] + (size_t)D * FF2, D, FF2, (bf16*)(ws + WS_WIN1), ffn_pre_g + D, 1, 0, scr, gw, NGW, lane);
        p0_matrix(args.in[21] + (size_t)FF * D, FF, D, (bf16*)(ws + WS_WOUT1), nullptr, 0, 0, scr, gw, NGW, lane);
        for (int i = gw * 64 + lane; i < T_S * 32; i += NGW * 64) {
            const int t = i >> 5, d = i & 31;
            double inv = 1.0; for (int q = 0; q < d; ++q) inv *= 0.7498942093324559;
            const double ang = (double)t * inv;
            const double k = __builtin_rint(ang * 0.15915494309189535);
            double xr = __builtin_fma(-k, 6.283185307179586, ang); xr = __builtin_fma(-k, 2.4492935982947064e-16, xr);
            double s, c; sincos_small(xr, s, c);
            ROPE_C[i] = (float)c; ROPE_S[i] = (float)s;
        }
        thin_pass<0>(x_p, x_s, XN, nullptr, nullptr, RS, nullptr, gw, NGW, lane);
        PP_END(0); if (BOTH(0)) GRID_BAR();
    }
    if (IN(1)) for (int rep_ = 0; rep_ < REPS(1); ++rep_) { PP_BEGIN(1);
        pg8::Gemm g{XN, (const bf16*)(ws + WS_WQKV0), M, 3 * D, D, TSTEP_D}; pg8::StaticOrder S; S.init(M, 3 * D, G, bx);
        pg8::EpiBf16<0> E{QB, D, RS, D, (size_t)(WS_K - WS_Q) / 2, att::QSCALE};
        pg8::gemm_phase<pg8::EpiBf16<0>, pg8::StaticOrder, PG8_ALIGN_PLAIN, true>(lds + RING_OFF, g, S, E, wave, GP_ARG(1));
        PP_END(1); if (BOTH(1)) GRID_BAR();
    }
    if (IN(2)) for (int rep_ = 0; rep_ < REPS(2); ++rep_) { PP_BEGIN(2);
        constexpr int NU_P = 4 * 16 * 16, NU = NU_P + 8 * 16 * 32;
        const int per = (NU + G - 1) / G, u0 = vcu * per, u1 = (u0 + per < NU) ? u0 + per : NU;
        for (int u = u0; u < u1; ++u) {
            size_t tok0; int rows, h, R;
            if (u < NU_P) { const int b = u >> 8, r = u & 255; tok0 = (size_t)b * T_P; rows = 64; h = r >> 4; R = (r & 15) * 4; }
            else { const int v = u - NU_P, b = v >> 9, r = v & 511; tok0 = (size_t)M_P + (size_t)b * T_S; rows = 128; h = r >> 5; R = (r & 31) * 4; }
            __syncthreads();
            att::na_unit(tok0, rows, h, R, QB, KB, VB, MB, args.in[7] + h * 465, (att::lptr)(lds + RING_OFF), tid, wave, lane);
        }
        __syncthreads();
        PP_END(2); if (BOTH(2)) GRID_BAR();
    }
    if (IN(3)) for (int rep_ = 0; rep_ < REPS(3); ++rep_) { PP_BEGIN(3);
        pg8::Gemm g{MB, (const bf16*)(ws + WS_WO0), M, D, D, TSTEP_D}; pg8::StaticOrder S; S.init(M, D, G, bx);
        #if FUSE_THIN
        pg8::EpiThin<1> E{QB, XN, attn_post_g, RS, nullptr, (unsigned*)(ctl + CW_PANEL + 0 * PANEL_BANK), (PG8_LAS unsigned*)(lds + MISC_OFF + 64), D / 256};
        pg8::gemm_phase<pg8::EpiThin<1>, pg8::StaticOrder, true, true>(lds + RING_OFF, g, S, E, wave);
#else
        pg8::EpiBf16<0> E{QB, D, nullptr, 0, 0, 1.f};
        pg8::gemm_phase<pg8::EpiBf16<0>, pg8::StaticOrder, PG8_ALIGN_PLAIN, true>(lds + RING_OFF, g, S, E, wave);
#endif
        PP_END(3); if (BOTH(3)) GRID_BAR();
    }
    if (!FUSE_THIN && IN(4)) for (int rep_ = 0; rep_ < REPS(4); ++rep_) { PP_BEGIN(4); thin_pass<1>(nullptr, nullptr, XN, QB, attn_post_g, RS, nullptr, gw, NGW, lane); PP_END(4); if (BOTH(4)) GRID_BAR(); }
#if defined(PROBE_NULL5)
    if (IN(5)) {
        pg8::Gemm g{XN - D, (const bf16*)(ws + WS_WIN0), M, FF2, D, TSTEP_CONV}; pg8::StaticOrder S; S.init_tiles(NMT_CONV, FF2 / 256, G, bx);
        pg8::EpiNull E{(float*)(ws + WS_PARK)};
        pg8::gemm_phase<pg8::EpiNull, pg8::StaticOrder, true, true>(lds + RING_OFF, g, S, E, wave);
        GRID_BAR();
    }
#endif
    if (IN(5)) for (int rep_ = 0; rep_ < REPS(5); ++rep_) { PP_BEGIN(5); TP_BEGIN(5);
        pg8::Gemm g{XN - D, (const bf16*)(ws + WS_WIN0), M, FF2, D, TSTEP_CONV}; pg8::StaticOrder S; S.init_tiles(NMT_CONV, FF2 / 256, G, bx);
        pg8::EpiConvGlu E{GB, args.in[19], args.in[20], (PG8_LAS float*)(lds + XCH_OFF), M, RS, (PG8_LAS float*)(lds + XCH_OFF + 8192)};
        pg8::gemm_phase<pg8::EpiConvGlu, pg8::StaticOrder, true, true>(lds + RING_OFF, g, S, E, wave, GP_ARG(5));
        TP_END(5); PP_END(5); if (BOTH(5)) GRID_BAR();
    }
    if (IN(6)) for (int rep_ = 0; rep_ < REPS(6); ++rep_) { PP_BEGIN(6); TP_BEGIN(6);
        pg8::Gemm g{GB, (const bf16*)(ws + WS_WOUT0), M, D, FF, TSTEP_FF}; pg8::StaticOrder S; S.init(M, D, G, bx);
        #if FUSE_THIN
        pg8::EpiThin<1> E{MB, XN, ffn_post_g, RS, nullptr, (unsigned*)(ctl + CW_PANEL + 1 * PANEL_BANK), (PG8_LAS unsigned*)(lds + MISC_OFF + 64), D / 256};
        pg8::gemm_phase<pg8::EpiThin<1>, pg8::StaticOrder, true, true>(lds + RING_OFF, g, S, E, wave);
#else
        pg8::EpiBf16<0> E{MB, D, nullptr, 0, 0, 1.f};
        pg8::gemm_phase<pg8::EpiBf16<0>, pg8::StaticOrder, PG8_ALIGN_PLAIN, true>(lds + RING_OFF, g, S, E, wave);
#endif
        TP_END(6); PP_END(6); if (BOTH(6)) GRID_BAR();
    }
    if (!FUSE_THIN && IN(7)) for (int rep_ = 0; rep_ < REPS(7); ++rep_) { PP_BEGIN(7); thin_pass<1>(nullptr, nullptr, XN, MB, ffn_post_g, RS, nullptr, gw, NGW, lane); PP_END(7); if (BOTH(7)) GRID_BAR(); }
    if (IN(8)) for (int rep_ = 0; rep_ < REPS(8); ++rep_) { PP_BEGIN(8);
        pg8::Gemm g{XN, (const bf16*)(ws + WS_WQKV1), M, 3 * D, D, TSTEP_D}; pg8::StaticOrder S; S.init(M, 3 * D, G, bx);
        pg8::EpiRope E{QB, KB, VB, ROPE_C, ROPE_S, att::QSCALE, RS, (unsigned*)(ctl + CW_KMAX)};
        pg8::gemm_phase<pg8::EpiRope, pg8::StaticOrder, true, true>(lds + RING_OFF, g, S, E, wave, GP_ARG(8));
        PP_END(8); if (BOTH(8)) GRID_BAR();
    }
#if defined(PROBE_DAV)
    if (IN(9)) for (int vrep_ = 0; vrep_ < 2; ++vrep_) { const int variant_ = vrep_ == 0 ? PROBE_DAV : 0;
#else
    if (IN(9)) { const int variant_ = 0;
#endif
    for (int rep_ = 0; rep_ < REPS(9); ++rep_) { PP_BEGIN(9); TP_BEGIN(9);
        float lam;
        { const float a = wave_sum(args.in[12][lane] * args.in[13][lane]), b = wave_sum(args.in[14][lane] * args.in[15][lane]); lam = __expf(a) - __expf(b) + LAMBDA_INIT; }
        asm volatile("" : "+v"(lam));
        const unsigned lam_bits = __builtin_amdgcn_readfirstlane(__float_as_uint(lam));
        float* park = (float*)(ws + WS_PARK) + (size_t)bx * 32768;
        constexpr int NP = 4 * 8 * 16, NS = 8 * 8 * 32;
#pragma clang loop unroll(disable)
        for (int id = vcu; id < NP + NS; id += G) {
            size_t rowbase; int T, h, qb, bidx;
            if (id < NP) { const int bh = id >> 4; qb = id & 15; bidx = bh >> 3; rowbase = (size_t)bidx * T_P; T = T_P; h = bh & 7; }
            else { const int bh = (id - NP) >> 5; qb = (id - NP) & 31; bidx = 4 + (bh >> 3); rowbase = (size_t)M_P + (size_t)(bh >> 3) * T_S; T = T_S; h = bh & 7; }
            att::da_unit(rowbase, T, h, qb, QB, KB, VB, MB, park, lam_bits, 1.0f - LAMBDA_INIT, args.in[16], (const unsigned*)(ctl + CW_KMAX) + bidx * 16, (att::lptr)(lds + RING_OFF), tid, wave, lane, DP_ARG, variant_);
        }
        TP_END(9); PP_END(9); if (BOTH(9)) GRID_BAR();
    } }
    if (IN(10)) for (int rep_ = 0; rep_ < REPS(10); ++rep_) { PP_BEGIN(10);
        pg8::Gemm g{MB, (const bf16*)(ws + WS_WO1), M, D, D, TSTEP_D}; pg8::StaticOrder S; S.init(M, D, G, bx);
        #if FUSE_THIN
        pg8::EpiThin<1> E{QB, XN, attn_post_g + D, RS, nullptr, (unsigned*)(ctl + CW_PANEL + 2 * PANEL_BANK), (PG8_LAS unsigned*)(lds + MISC_OFF + 64), D / 256};
        pg8::gemm_phase<pg8::EpiThin<1>, pg8::StaticOrder, true, true>(lds + RING_OFF, g, S, E, wave);
#else
        pg8::EpiBf16<0> E{QB, D, nullptr, 0, 0, 1.f};
        pg8::gemm_phase<pg8::EpiBf16<0>, pg8::StaticOrder, PG8_ALIGN_PLAIN, true>(lds + RING_OFF, g, S, E, wave);
#endif
        PP_END(10); if (BOTH(10)) GRID_BAR();
    }
    if (!FUSE_THIN && IN(11)) for (int rep_ = 0; rep_ < REPS(11); ++rep_) { PP_BEGIN(11); thin_pass<1>(nullptr, nullptr, XN, QB, attn_post_g + D, RS, nullptr, gw, NGW, lane); PP_END(11); if (BOTH(11)) GRID_BAR(); }
    if (IN(12)) for (int rep_ = 0; rep_ < REPS(12); ++rep_) { PP_BEGIN(12);
        pg8::Gemm g{XN - D, (const bf16*)(ws + WS_WIN1), M, FF2, D, TSTEP_CONV}; pg8::StaticOrder S; S.init_tiles(NMT_CONV, FF2 / 256, G, bx);
        pg8::EpiConvGlu E{GB, args.in[19] + 3 * FF2, args.in[20] + FF2, (PG8_LAS float*)(lds + XCH_OFF), M, RS, (PG8_LAS float*)(lds + XCH_OFF + 8192)};
        pg8::gemm_phase<pg8::EpiConvGlu, pg8::StaticOrder, true, true>(lds + RING_OFF, g, S, E, wave);
        PP_END(12); if (BOTH(12)) GRID_BAR();
    }
    if (IN(13)) for (int rep_ = 0; rep_ < REPS(13); ++rep_) { PP_BEGIN(13);
        pg8::Gemm g{GB, (const bf16*)(ws + WS_WOUT1), M, D, FF, TSTEP_FF}; pg8::StaticOrder S; S.init(M, D, G, bx);
        #if FUSE_THIN
        pg8::EpiThin<2> E{MB, XN, ffn_post_g + D, RS, out, (unsigned*)(ctl + CW_PANEL + 3 * PANEL_BANK), (PG8_LAS unsigned*)(lds + MISC_OFF + 64), D / 256};
        pg8::gemm_phase<pg8::EpiThin<2>, pg8::StaticOrder, true, true>(lds + RING_OFF, g, S, E, wave);
#else
        pg8::EpiBf16<0> E{MB, D, nullptr, 0, 0, 1.f};
        pg8::gemm_phase<pg8::EpiBf16<0>, pg8::StaticOrder, PG8_ALIGN_PLAIN, true>(lds + RING_OFF, g, S, E, wave);
#endif
        PP_END(13); if (BOTH(13)) GRID_BAR();
    }
    if (!FUSE_THIN && IN(14)) for (int rep_ = 0; rep_ < REPS(14); ++rep_) { PP_BEGIN(14); thin_pass<2>(nullptr, nullptr, XN, MB, ffn_post_g + D, nullptr, out, gw, NGW, lane); }
#if defined(DPROBE)
    if (bx == 0 && hi > 14) {
        const unsigned long long tk = (unsigned long long)__hip_atomic_load(ctl + CW_TP, __ATOMIC_RELAXED, __HIP_MEMORY_SCOPE_AGENT);
        const unsigned long long t0_ = __builtin_amdgcn_s_memrealtime(); while (__builtin_amdgcn_s_memrealtime() - t0_ < tk) __builtin_amdgcn_s_sleep(16); }
#endif
#if defined(PPROBE)
    if (hi > 14) {
        const unsigned dur = (unsigned)(pp_t1 - pp_t0);
        if (tid == 0) { if (PPROBE_STAT == 1) atomicMax((unsigned*)(ctl + CW_TP), dur); else if (PPROBE_STAT == 2) atomicMax((unsigned*)(ctl + CW_TP), 0x40000000u - dur); else if (bx == 0) __hip_atomic_store(ctl + CW_TP, dur, __ATOMIC_RELAXED, __HIP_MEMORY_SCOPE_AGENT); }
        xcd_barrier(bar);
        if (bx == 0) { unsigned v = __hip_atomic_load(ctl + CW_TP, __ATOMIC_RELAXED, __HIP_MEMORY_SCOPE_AGENT); if (PPROBE_STAT == 2) v = 0x40000000u - v;
            const unsigned long long tk = (unsigned long long)v * PPROBE_SCALE;
            const unsigned long long t0_ = __builtin_amdgcn_s_memrealtime(); while (__builtin_amdgcn_s_memrealtime() - t0_ < tk) __builtin_amdgcn_s_sleep(16); }
    }
#endif
#if defined(BPROBE)
    if (hi > 14) {
        if (bx == BPROBE_BLOCK && tid == 0) __hip_atomic_store(ctl + CW_TP, (unsigned)bp_acc, __ATOMIC_RELAXED, __HIP_MEMORY_SCOPE_AGENT);
        xcd_barrier(bar);
        if (bx == 0) { const unsigned long long tk = (unsigned long long)__hip_atomic_load(ctl + CW_TP, __ATOMIC_RELAXED, __HIP_MEMORY_SCOPE_AGENT);
            const unsigned long long t0_ = __builtin_amdgcn_s_memrealtime(); while (__builtin_amdgcn_s_memrealtime() - t0_ < tk) __builtin_amdgcn_s_sleep(16); }
    }
#endif
#if defined(GPROBE)
    if (bx == 0 && hi > 14) {
        const unsigned long long tk = (unsigned long long)__hip_atomic_load(ctl + CW_TP, __ATOMIC_RELAXED, __HIP_MEMORY_SCOPE_AGENT) * GPROBE_SCALE;
        const unsigned long long t0_ = __builtin_amdgcn_s_memrealtime(); while (__builtin_amdgcn_s_memrealtime() - t0_ < tk) __builtin_amdgcn_s_sleep(16);
    }
#endif
#if defined(TPROBE)
    if (bx == 0 && hi > 14) {
        const unsigned long long mhz = (tp_c1 - tp_c0) * 100ull / (tp_r1 - tp_r0 + 1ull);
        const unsigned long long t0_ = __builtin_amdgcn_s_memrealtime(); while (__builtin_amdgcn_s_memrealtime() - t0_ < mhz * 100ull) __builtin_amdgcn_s_sleep(16);
    }
#endif
#undef IN
#undef BOTH
#undef GRID_BAR
#undef lane
#undef tid
}

extern "C" void kernel_launch(void* const* d_in, const int* in_sizes, int n_in, void* d_out, int out_size, void* d_ws, size_t ws_size, hipStream_t stream) {
    static int grid = 0;
    if (grid == 0) {
        if (n_in != 22 || in_sizes[0] != M_P * D || in_sizes[1] != M_S * D || out_size != M * D || ws_size < WS_END) {
            fprintf(stderr, "kernel_launch: unexpected shapes (n_in %d, in0 %d, in1 %d, out %d, ws %zu); nothing launched\n", n_in, n_in > 0 ? in_sizes[0] : -1, n_in > 1 ? in_sizes[1] : -1, out_size, ws_size); grid = -1; return; }
        int dev = 0, cus = 0, per_cu = 0;
        if (hipGetDevice(&dev) != hipSuccess || hipDeviceGetAttribute(&cus, hipDeviceAttributeMultiprocessorCount, dev) != hipSuccess) { fprintf(stderr, "kernel_launch: device query failed\n"); grid = -1; return; }
        if (hipFuncSetAttribute((const void*)mega_fwd, hipFuncAttributeMaxDynamicSharedMemorySize, LDS_BYTES) != hipSuccess) { fprintf(stderr, "kernel_launch: hipFuncSetAttribute failed\n"); grid = -1; return; }
        if (hipOccupancyMaxActiveBlocksPerMultiprocessor(&per_cu, (const void*)mega_fwd, NWAVES * 64, LDS_BYTES) != hipSuccess || per_cu < 1) { fprintf(stderr, "kernel_launch: occupancy query says %d blocks per CU\n", per_cu); }
        (void)hipGetLastError();
        grid = cus;
    }
    if (grid < 0) return;
    if (hipMemsetAsync((char*)d_ws + WS_CTL, 0, CTL_ZERO_BYTES, stream) != hipSuccess) { fprintf(stderr, "kernel_launch: memset failed\n"); return; }
    Args a{};
    for (int i = 0; i < 22; ++i) a.in[i] = (const float*)d_in[i];
    a.out = (float*)d_out; a.ws = (unsigned char*)d_ws;
#if MK_PER_PHASE
    for (int p = 0; p < NPH; ++p) { a.ph_lo = p; a.ph_hi = p + 1; hipLaunchKernelGGL(mega_fwd, dim3(grid), dim3(NWAVES * 64), LDS_BYTES, stream, a); }
#else
    a.ph_lo = 0; a.ph_hi = NPH;
    hipLaunchKernelGGL(mega_fwd, dim3(grid), dim3(NWAVES * 64), LDS_BYTES, stream, a);
#endif
    const hipError_t le = hipPeekAtLastError();
    if (le != hipSuccess) fprintf(stderr, "kernel_launch: launch failed: %s\n", hipGetErrorName(le));
}
```

```cpp
#include <hip/hip_runtime.h>
#include <cstdio>
#include <cstdint>
#include <cmath>
#define GAS __attribute__((address_space(1)))
#define LAS __attribute__((address_space(3)))
typedef unsigned short bf16;
typedef unsigned v4u __attribute__((ext_vector_type(4)));
typedef float f32x4 __attribute__((ext_vector_type(4)));
typedef short bf16x8 __attribute__((ext_vector_type(8)));
typedef GAS unsigned gu32;
typedef GAS unsigned long long gu64;
__device__ __forceinline__ int lane_id_fresh() { int x; asm volatile("v_mbcnt_lo_u32_b32 %0, -1, 0\n\tv_mbcnt_hi_u32_b32 %0, -1, %0" : "=v"(x)); return x; }
#define LANE_ID() lane_id_fresh()
#define RLX_AGENT __ATOMIC_RELAXED, __HIP_MEMORY_SCOPE_AGENT
#define LDS_WAIT() asm volatile("s_waitcnt lgkmcnt(0)" ::: "memory")
#define VM_WAIT() asm volatile("s_waitcnt vmcnt(0)" ::: "memory")
__device__ __forceinline__ unsigned long long rt() { return __builtin_amdgcn_s_memrealtime(); }
__device__ __forceinline__ unsigned f2bf(float f) { unsigned u = __builtin_bit_cast(unsigned, f); return (u + 0x7fffu + ((u >> 16) & 1u)) >> 16; }
__device__ __forceinline__ unsigned pk2(float lo, float hi) { return f2bf(lo) | (f2bf(hi) << 16); }
constexpr int D = 1024, M_P = 4 * 4096, M_S = 8 * 8192, M = M_P + M_S, T_P = 4096, T_S = 8192, FF = 2816, FF2 = 2 * FF;
constexpr int NMT_CONV = (M + 253) / 254;
constexpr float NORM_EPS = 1e-6f;
constexpr float LAMBDA_INIT = 0.35550907f;

__device__ __forceinline__ float wave_sum(float v) {
#pragma unroll
    for (int o = 1; o < 64; o <<= 1) v += __shfl_xor(v, o);
    return v;
}
__device__ __forceinline__ f32x4 bf4_to_f32(unsigned long long w) {
    f32x4 v; v.x = __uint_as_float((unsigned)(w & 0xffffull) << 16); v.y = __uint_as_float((unsigned)((w >> 16) & 0xffffull) << 16);
    v.z = __uint_as_float((unsigned)((w >> 32) & 0xffffull) << 16); v.w = __uint_as_float((unsigned)(w >> 48) << 16); return v;
}
__device__ __forceinline__ void bf8_to_f32(v4u w, f32x4& a, f32x4& b) {
    a.x = __uint_as_float(w.x << 16); a.y = __uint_as_float(w.x & 0xffff0000u); a.z = __uint_as_float(w.y << 16); a.w = __uint_as_float(w.y & 0xffff0000u);
    b.x = __uint_as_float(w.z << 16); b.y = __uint_as_float(w.z & 0xffff0000u); b.z = __uint_as_float(w.w << 16); b.w = __uint_as_float(w.w & 0xffff0000u);
}
__device__ __forceinline__ float sq4(f32x4 v) { return (v.x * v.x + v.y * v.y) + (v.z * v.z + v.w * v.w); }
template <int MODE, int R = 4>
__device__ __forceinline__ void thin_rows(const float* xp, const float* xs, bf16* xb, const bf16* mb, const float* gpost, float* rs, float* out, int row0, int row1, int rstep, int lane) {
    f32x4 g[2][2];
    if (MODE != 0) {
#pragma unroll
        for (int j = 0; j < 2; ++j) { g[j][0] = *(const f32x4*)(gpost + 8 * lane + 512 * j); g[j][1] = *(const f32x4*)(gpost + 8 * lane + 512 * j + 4); }
    }
    for (int rb = row0; rb < row1; rb += rstep) {
        f32x4 x[R][2][2];
        if (MODE == 0) { const float* xr = rb < M_P ? xp + (size_t)rb * D : xs + (size_t)(rb - M_P) * D;
#pragma unroll
            for (int r = 0; r < R; ++r)
#pragma unroll
                for (int j = 0; j < 2; ++j) { x[r][j][0] = *(const GAS f32x4*)(xr + (size_t)r * D + 8 * lane + 512 * j); x[r][j][1] = *(const GAS f32x4*)(xr + (size_t)r * D + 8 * lane + 512 * j + 4); }
        } else {
            v4u xw[R][2], mw[R][2];
#pragma unroll
            for (int r = 0; r < R; ++r)
#pragma unroll
                for (int j = 0; j < 2; ++j) { xw[r][j] = *(const GAS v4u*)(xb + (size_t)(rb + r) * D + 8 * lane + 512 * j); mw[r][j] = *(const GAS v4u*)(mb + (size_t)(rb + r) * D + 8 * lane + 512 * j); }
            f32x4 mv[R][2][2]; float ss[R];
#pragma unroll
            for (int r = 0; r < R; ++r) { ss[r] = 0.f;
#pragma unroll
                for (int j = 0; j < 2; ++j) { bf8_to_f32(xw[r][j], x[r][j][0], x[r][j][1]); bf8_to_f32(mw[r][j], mv[r][j][0], mv[r][j][1]); ss[r] += sq4(mv[r][j][0]) + sq4(mv[r][j][1]); } }
#pragma unroll
            for (int o = 1; o < 64; o <<= 1) {
#pragma unroll
                for (int r = 0; r < R; ++r) ss[r] += __shfl_xor(ss[r], o); }
#pragma unroll
            for (int r = 0; r < R; ++r) { const float rm = __builtin_amdgcn_rsqf(ss[r] * (1.f / D) + NORM_EPS);
#pragma unroll
                for (int j = 0; j < 2; ++j) { x[r][j][0] = x[r][j][0] + mv[r][j][0] * g[j][0] * rm; x[r][j][1] = x[r][j][1] + mv[r][j][1] * g[j][1] * rm; } }
        }
        if (MODE == 2) {
#pragma unroll
            for (int r = 0; r < R; ++r)
#pragma unroll
                for (int j = 0; j < 2; ++j) { *(GAS f32x4*)(out + (size_t)(rb + r) * D + 8 * lane + 512 * j) = x[r][j][0]; *(GAS f32x4*)(out + (size_t)(rb + r) * D + 8 * lane + 512 * j + 4) = x[r][j][1]; }
        } else {
            float s2[R];
#pragma unroll
            for (int r = 0; r < R; ++r) { s2[r] = 0.f;
#pragma unroll
                for (int j = 0; j < 2; ++j) { s2[r] += sq4(x[r][j][0]) + sq4(x[r][j][1]);
                    v4u w; w.x = pk2(x[r][j][0].x, x[r][j][0].y); w.y = pk2(x[r][j][0].z, x[r][j][0].w); w.z = pk2(x[r][j][1].x, x[r][j][1].y); w.w = pk2(x[r][j][1].z, x[r][j][1].w);
                    *(GAS v4u*)(xb + (size_t)(rb + r) * D + 8 * lane + 512 * j) = w; } }
#pragma unroll
            for (int o = 1; o < 64; o <<= 1) {
#pragma unroll
                for (int r = 0; r < R; ++r) s2[r] += __shfl_xor(s2[r], o); }
            if (lane < R) { float v = s2[0];
#pragma unroll
                for (int r = 1; r < R; ++r) v = lane == r ? s2[r] : v;
                rs[rb + lane] = __builtin_amdgcn_rsqf(v * (1.f / D) + NORM_EPS); }
        }
    }
}

template <int MODE, int R>
__device__ __forceinline__ void thin_rows_lean(bf16* xb, const bf16* mb, const float* gpost, float* rs, float* out, int row0, int row1, int lane) {
    for (int rb = row0; rb < row1; rb += R) {
        v4u xw[R][2], mw[R][2]; float ss[R], s2[R];
#pragma unroll
        for (int r = 0; r < R; ++r)
#pragma unroll
            for (int j = 0; j < 2; ++j) { xw[r][j] = *(const GAS v4u*)(xb + (size_t)(rb + r) * D + 8 * lane + 512 * j); mw[r][j] = *(const GAS v4u*)(mb + (size_t)(rb + r) * D + 8 * lane + 512 * j); }
#pragma unroll
        for (int r = 0; r < R; ++r) { ss[r] = 0.f;
#pragma unroll
            for (int j = 0; j < 2; ++j) { f32x4 a, b; bf8_to_f32(mw[r][j], a, b); ss[r] += sq4(a) + sq4(b); } }
#pragma unroll
        for (int o = 1; o < 64; o <<= 1) {
#pragma unroll
            for (int r = 0; r < R; ++r) ss[r] += __shfl_xor(ss[r], o); }
#pragma unroll
        for (int r = 0; r < R; ++r) { const float rm = __builtin_amdgcn_rsqf(ss[r] * (1.f / D) + NORM_EPS); s2[r] = 0.f;
#pragma unroll
            for (int j = 0; j < 2; ++j) { f32x4 xa, xb2, ma, mb2; bf8_to_f32(xw[r][j], xa, xb2); bf8_to_f32(mw[r][j], ma, mb2);
                const f32x4 g0 = *(const f32x4*)(gpost + 8 * lane + 512 * j), g1 = *(const f32x4*)(gpost + 8 * lane + 512 * j + 4);
                xa = xa + ma * g0 * rm; xb2 = xb2 + mb2 * g1 * rm;
                if (MODE == 2) { *(GAS f32x4*)(out + (size_t)(rb + r) * D + 8 * lane + 512 * j) = xa; *(GAS f32x4*)(out + (size_t)(rb + r) * D + 8 * lane + 512 * j + 4) = xb2; }
                else { s2[r] += sq4(xa) + sq4(xb2);
                    v4u w; w.x = pk2(xa.x, xa.y); w.y = pk2(xa.z, xa.w); w.z = pk2(xb2.x, xb2.y); w.w = pk2(xb2.z, xb2.w);
                    *(GAS v4u*)(xb + (size_t)(rb + r) * D + 8 * lane + 512 * j) = w; } } }
        if (MODE != 2) {
#pragma unroll
            for (int o = 1; o < 64; o <<= 1) {
#pragma unroll
                for (int r = 0; r < R; ++r) s2[r] += __shfl_xor(s2[r], o); }
            if (lane < R) { float v = s2[0];
#pragma unroll
                for (int r = 1; r < R; ++r) v = lane == r ? s2[r] : v;
                rs[rb + lane] = __builtin_amdgcn_rsqf(v * (1.f / D) + NORM_EPS); }
        }
    }
}
template <int MODE>
__device__ __forceinline__ void thin_pass(const float* xp, const float* xs, bf16* xb, const bf16* mb, const float* gpost, float* rs, float* out, int gw, int NGW, int lane) {
    thin_rows<MODE>(xp, xs, xb, mb, gpost, rs, out, gw * 4, M, NGW * 4, lane);
}

namespace pg8 {
#define PG8_LAS __attribute__((address_space(3)))
typedef unsigned short bf16_t;
typedef short bf16x8 __attribute__((ext_vector_type(8)));
typedef float f32x4 __attribute__((ext_vector_type(4)));
typedef unsigned u32x4 __attribute__((ext_vector_type(4)));
constexpr int BM = 256, BK = 64, HALF = 128, HTB = HALF * BK * 2  , STAGE_BYTES = 8 * HTB, NXCD = 8, WGM = 8;

__host__ __device__ __forceinline__ int lds_byte(int r, int c) { const int st = (r >> 4) * 2 + (c >> 5), rr = r & 15, cc = c & 31, ob = rr * 64 + cc * 2; return st * 1024 + (ob ^ (((ob >> 9) & 1) << 5)); }
__host__ __device__ __forceinline__ void stage_rc(int b, int& R, int& C) { const int st = b / 1024, sb = b % 1024, swz = sb ^ (((sb >> 9) & 1) << 5); R = (st >> 1) * 16 + swz / 64; C = (st & 1) * 32 + (swz % 64) / 2; }
__host__ __device__ __forceinline__ int perm32(int rho) { const int n = rho >> 4, i = rho & 15; return 8 * (i >> 2) + 4 * n + (i & 3); }

struct Unit { int pm, pn; };
struct Gemm { const bf16_t* A; const bf16_t* Bt; int M, N, K; size_t tstepA; };

struct StaticOrder {
    int nM, nN, nwg, G, c;
    __host__ __device__ void init(int M, int N, int G_, int c_) { nM = M / BM; nN = N / BM; nwg = nM * nN; G = G_; c = c_; }
    __host__ __device__ void init_tiles(int nM_, int nN_, int G_, int c_) { nM = nM_; nN = nN_; nwg = nM * nN; G = G_; c = c_; }
    __host__ __device__ bool next(int i, Unit& u) const {
        const long L = (long)i * G + c; if (L >= nwg) return false;
        int wgid = (int)L; { const int q = nwg / NXCD, r = nwg % NXCD, xcd = wgid % NXCD, off = wgid / NXCD; wgid = (xcd < r ? xcd * (q + 1) : r * (q + 1) + (xcd - r) * q) + off; }
        const int nig = WGM * nN, gid = wgid / nig, fm = gid * WGM, gsz = (nM - fm) < WGM ? (nM - fm) : WGM;
        u.pm = fm + ((wgid % nig) % gsz); u.pn = (wgid % nig) / gsz; return true;
    }
    __device__ __forceinline__ void a_ready(const Unit&) const {}
    __device__ __forceinline__ void done(const Unit&) const {}
};

__device__ __forceinline__ unsigned cvt_pk_bf16(float lo, float hi) { unsigned r; asm volatile("v_cvt_pk_bf16_f32 %0, %1, %2" : "=v"(r) : "v"(lo), "v"(hi)); return r; }
typedef float f32x2 __attribute__((ext_vector_type(2)));
__device__ __forceinline__ f32x2 gelu_pk(f32x2 v) {
    const f32x2 av = __builtin_elementwise_abs(v), d = av * 0.2316418882f + 1.0f;
    f32x2 t; t.x = __builtin_amdgcn_rcpf(d.x); t.y = __builtin_amdgcn_rcpf(d.y);
    f32x2 q = t * 0.5307027145f + (-0.7265760135f); q = q * t + 0.7107068705f; q = q * t + (-0.142248368f); q = q * t + 0.127414796f; q = q * t;
    const f32x2 s = (v * v) * (-0.72134752044f);
    f32x2 e; e.x = __builtin_amdgcn_exp2f(s.x); e.y = __builtin_amdgcn_exp2f(s.y);
    const f32x2 m = v * (q * e), r = v - m;
    f32x2 o; o.x = v.x < 0.f ? m.x : r.x; o.y = v.y < 0.f ? m.y : r.y; return o;
}

template <int ACT  > struct EpiBf16 {
    static constexpr bool PERM = true, AFTER_DRAIN = false, HAS_FLUSH = false; static_assert(ACT == 0 || ACT == 1, "EpiBf16: ACT is 0 (none) or 1 (gelu_pk)");
    bf16_t* O; int ldc; const float* rs; int split_cols; size_t split_stride; float scale0;
    __device__ __forceinline__ void operator()(const f32x4 (&acc)[2][2][4][2], const Unit& u, int wr, int wc, int fr, int fq) const {
        const int row0 = u.pm * BM + wr * 64 + fr; int colt = u.pn * BM; bf16_t* base = O;
        float sc = 1.f; if (split_cols) { const int t = colt / split_cols; base += (size_t)t * split_stride; colt -= t * split_cols; if (t == 0) sc = scale0; }
        const int col0 = colt + wc * 32 + 8 * fq;
#pragma unroll
        for (int ai = 0; ai < 2; ++ai)
#pragma unroll
            for (int m = 0; m < 4; ++m) { bf16_t* rowp = base + (size_t)(row0 + ai * HALF + m * 16) * ldc + col0; const float rsc = rs ? rs[row0 + ai * HALF + m * 16] * sc : sc;
#pragma unroll
                for (int bj = 0; bj < 2; ++bj) { f32x4 v0 = acc[ai][bj][m][0], v1 = acc[ai][bj][m][1];
                    if (ACT == 1) { f32x2 a = gelu_pk((f32x2){v0[0], v0[1]}), b = gelu_pk((f32x2){v0[2], v0[3]}), c = gelu_pk((f32x2){v1[0], v1[1]}), d = gelu_pk((f32x2){v1[2], v1[3]});
                        v0 = (f32x4){a.x, a.y, b.x, b.y}; v1 = (f32x4){c.x, c.y, d.x, d.y}; }
                    v0 = v0 * rsc; v1 = v1 * rsc; u32x4 w; w.x = cvt_pk_bf16(v0[0], v0[1]); w.y = cvt_pk_bf16(v0[2], v0[3]); w.z = cvt_pk_bf16(v1[0], v1[1]); w.w = cvt_pk_bf16(v1[2], v1[3]);
#if defined(EPI_NT_STORE)
                    __builtin_nontemporal_store(w, (u32x4*)(rowp + bj * HALF)); } }
#else
                    *(u32x4*)(rowp + bj * HALF) = w; } }
#endif
    }
};

struct EpiRope {
    static constexpr bool PERM = true, AFTER_DRAIN = false, HAS_FLUSH = false;
    bf16_t* Q; bf16_t* Kk; bf16_t* V; const float* cs; const float* sn; float qscale; const float* rs; unsigned* kmax;
    __device__ __forceinline__ void operator()(const f32x4 (&acc)[2][2][4][2], const Unit& u, int wr, int wc, int fr, int fq) const {
        const int which = u.pn >> 2;
        const int row0 = u.pm * BM + wr * 64 + fr;
        if (which == 2) {
            const int col0 = (u.pn - 8) * BM + wc * 32 + 8 * fq;
#pragma unroll
            for (int ai = 0; ai < 2; ++ai)
#pragma unroll
                for (int m = 0; m < 4; ++m) { bf16_t* rowp = V + (size_t)(row0 + ai * HALF + m * 16) * 1024 + col0; const float r = rs[row0 + ai * HALF + m * 16];
#pragma unroll
                    for (int bj = 0; bj < 2; ++bj) { const f32x4 v0 = acc[ai][bj][m][0] * r, v1 = acc[ai][bj][m][1] * r;
                        u32x4 w; w.x = cvt_pk_bf16(v0[0], v0[1]); w.y = cvt_pk_bf16(v0[2], v0[3]); w.z = cvt_pk_bf16(v1[0], v1[1]); w.w = cvt_pk_bf16(v1[2], v1[3]);
                        *(u32x4*)(rowp + bj * HALF) = w; } }
        } else {
            bf16_t* base = which == 0 ? Q : Kk; const float sc = which == 0 ? qscale : 1.f;
            const int colb = ((u.pn & 3) * 4 + wc) * 64 + 8 * fq; float kn2 = 0.f;
#pragma unroll
            for (int ai = 0; ai < 2; ++ai)
#pragma unroll
                for (int m = 0; m < 4; ++m) { const int row = row0 + ai * HALF + m * 16; const int t = row < 16384 ? (row & 4095) : (row & 8191); const float scr = sc * rs[row];
                    const f32x4 c0 = *(const f32x4*)(cs + t * 32 + 8 * fq), c1 = *(const f32x4*)(cs + t * 32 + 8 * fq + 4);
                    const f32x4 s0 = *(const f32x4*)(sn + t * 32 + 8 * fq), s1 = *(const f32x4*)(sn + t * 32 + 8 * fq + 4);
                    const f32x4 x1a = acc[ai][0][m][0], x1b = acc[ai][0][m][1], x2a = acc[ai][1][m][0], x2b = acc[ai][1][m][1];
                    const f32x4 o1a = (x1a * c0 - x2a * s0) * scr, o1b = (x1b * c1 - x2b * s1) * scr, o2a = (x2a * c0 + x1a * s0) * scr, o2b = (x2b * c1 + x1b * s1) * scr;
                    u32x4 w1, w2; w1.x = cvt_pk_bf16(o1a[0], o1a[1]); w1.y = cvt_pk_bf16(o1a[2], o1a[3]); w1.z = cvt_pk_bf16(o1b[0], o1b[1]); w1.w = cvt_pk_bf16(o1b[2], o1b[3]);
                    w2.x = cvt_pk_bf16(o2a[0], o2a[1]); w2.y = cvt_pk_bf16(o2a[2], o2a[3]); w2.z = cvt_pk_bf16(o2b[0], o2b[1]); w2.w = cvt_pk_bf16(o2b[2], o2b[3]);
                    bf16_t* rowp = base + (size_t)row * 1024 + colb;
                    *(u32x4*)(rowp) = w1; *(u32x4*)(rowp + 32) = w2;
                    if (which == 1) { const f32x4 q4 = o1a * o1a + o1b * o1b + o2a * o2a + o2b * o2b; float ss = (q4[0] + q4[1]) + (q4[2] + q4[3]); ss += __shfl_xor(ss, 16); ss += __shfl_xor(ss, 32); kn2 = fmaxf(kn2, ss); } }
            if (which == 1) { kn2 = fmaxf(kn2, __shfl_xor(kn2, 1)); kn2 = fmaxf(kn2, __shfl_xor(kn2, 2)); kn2 = fmaxf(kn2, __shfl_xor(kn2, 4)); kn2 = fmaxf(kn2, __shfl_xor(kn2, 8));
                const int r0 = u.pm * BM; const int batch = r0 < 16384 ? (r0 >> 12) : 4 + ((r0 - 16384) >> 13);
                if (fr == 0 && fq == 0) atomicMax(kmax + batch * 16 + (u.pn & 3) * 4 + wc, __float_as_uint(kn2)); }
        }
    }
};

template <int CTRL> __device__ __forceinline__ float dpp_f(float old, float src) { return __int_as_float(__builtin_amdgcn_update_dpp(__float_as_int(old), __float_as_int(src), CTRL, 0xf, 0xf, false)); }
__device__ __forceinline__ float gelu_tanh(float x) {
    const float u = 0.7978845608028654f * (x + 0.044715f * x * x * x);
    const float e = __builtin_amdgcn_exp2f(-2.8853900817779268f * u);
    return x * __builtin_amdgcn_rcpf(1.0f + e);
}
struct EpiConvGlu {
    static constexpr bool PERM = true, AFTER_DRAIN = false, HAS_FLUSH = false;
    bf16_t* G; const float* cw; const float* cb; PG8_LAS float* X; int Mrows; const float* rs; PG8_LAS float* WT;
    __device__ __forceinline__ void operator()(f32x4 (&acc)[2][2][4][2], const Unit& u, int wr, int wc, int fr, int fq) const {
        const int xcol = wc * 32 + 8 * fq;
        const int gc0 = u.pn * 128 + xcol;
        float rsv[2][4];
#pragma unroll
        for (int ai = 0; ai < 2; ++ai)
#pragma unroll
            for (int m = 0; m < 4; ++m) { int tr = u.pm * 254 - 1 + ai * HALF + wr * 64 + m * 16 + fr; tr = tr < 0 ? 0 : (tr >= Mrows ? Mrows - 1 : tr); rsv[ai][m] = rs[tr]; }
        { const int tidx = (wr * 4 + wc) * 64 + fq * 16 + fr, e0 = 2 * tidx, t = e0 >> 8, c = e0 & 255;
          const float* src = (t < 3 ? cw + t * 5632 : cb) + (c < 128 ? u.pn * 128 + c : 2816 + u.pn * 128 + c - 128);
          typedef float f32x2v __attribute__((ext_vector_type(2)));
          *(PG8_LAS f32x2v*)(WT + e0) = *(const f32x2v*)src; }
#pragma unroll
        for (int ai = 0; ai < 2; ++ai)
#pragma unroll
            for (int m = 0; m < 4; ++m) {
#pragma unroll
                for (int bj = 0; bj < 2; ++bj)
#pragma unroll
                    for (int n = 0; n < 2; ++n) acc[ai][bj][m][n] = acc[ai][bj][m][n] * rsv[ai][m]; }
#pragma unroll
        for (int ai = 0; ai < 2; ++ai) { const int ch = 2 * ai + wr;
            if (fr == 0) {
#pragma unroll
                for (int bj = 0; bj < 2; ++bj)
#pragma unroll
                    for (int n = 0; n < 2; ++n) *(PG8_LAS f32x4*)(X + ((ch * 2 + 0) * 256 + bj * 128 + xcol + 4 * n)) = acc[ai][bj][0][n]; }
            if (fr == 15) {
#pragma unroll
                for (int bj = 0; bj < 2; ++bj)
#pragma unroll
                    for (int n = 0; n < 2; ++n) *(PG8_LAS f32x4*)(X + ((ch * 2 + 1) * 256 + bj * 128 + xcol + 4 * n)) = acc[ai][bj][3][n]; } }
        asm volatile("s_waitcnt lgkmcnt(0)" ::: "memory"); __builtin_amdgcn_s_barrier(); asm volatile("" ::: "memory");
        const int tg0 = u.pm * 254 - 1 + wr * 64 + fr;
        const int tb = u.pm * 254 - 1; const bool bnd = ((tb + 4096 + 257) >> 12) != ((tb + 4096 - 1) >> 12);
        if (bnd) body<true>(acc, u, wr, wc, fr, fq, xcol, gc0, tg0); else body<false>(acc, u, wr, wc, fr, fq, xcol, gc0, tg0);
    }
    template <bool bnd>
    __device__ __forceinline__ void body(f32x4 (&acc)[2][2][4][2], const Unit& u, int wr, int wc, int fr, int fq, int xcol, int gc0, int tg0) const {
#pragma unroll
        for (int ai = 0; ai < 2; ++ai) { const int ch = 2 * ai + wr;
#pragma unroll
            for (int m = 0; m < 4; ++m) {
                const int row = ai * HALF + wr * 64 + m * 16 + fr; const int tg = tg0 + ai * HALF + m * 16;
                const int ps = tg < 16384 ? (tg & 4095) : (tg & 8191); const int ps1 = (tg + 1) < 16384 ? ((tg + 1) & 4095) : ((tg + 1) & 8191);
                const bool first = bnd && ps == 0, last = bnd && ps1 == 0;
                u32x4 w;
#pragma unroll
                for (int n = 0; n < 2; ++n) {
                    f32x4 wgv[3], wuv[3];
#pragma unroll
                    for (int t = 0; t < 3; ++t) { wgv[t] = *(const PG8_LAS f32x4*)(WT + t * 256 + xcol + 4 * n); wuv[t] = *(const PG8_LAS f32x4*)(WT + t * 256 + 128 + xcol + 4 * n); }
                    const f32x4 bgv = *(const PG8_LAS f32x4*)(WT + 768 + xcol + 4 * n), buv = *(const PG8_LAS f32x4*)(WT + 768 + 128 + xcol + 4 * n);
                    f32x4 pg = (f32x4){0.f, 0.f, 0.f, 0.f}, pu = pg, ng = pg, nu = pg;
                    if (m == 0 && ch > 0) { pg = *(const PG8_LAS f32x4*)(X + (((ch - 1) * 2 + 1) * 256 + xcol + 4 * n)); pu = *(const PG8_LAS f32x4*)(X + (((ch - 1) * 2 + 1) * 256 + 128 + xcol + 4 * n)); }
                    if (m == 3 && ch < 3) { ng = *(const PG8_LAS f32x4*)(X + (((ch + 1) * 2 + 0) * 256 + xcol + 4 * n)); nu = *(const PG8_LAS f32x4*)(X + (((ch + 1) * 2 + 0) * 256 + 128 + xcol + 4 * n)); }
                    float o[4];
#pragma unroll
                    for (int j = 0; j < 4; ++j) {
                        const float cg = acc[ai][0][m][n][j], cu = acc[ai][1][m][n][j];
                        float p0g, p0u, n15g, n15u;
                        if (m > 0) { p0g = dpp_f<0x121>(0.f, acc[ai][0][m > 0 ? m - 1 : 0][n][j]); p0u = dpp_f<0x121>(0.f, acc[ai][1][m > 0 ? m - 1 : 0][n][j]); } else { p0g = pg[j]; p0u = pu[j]; }
                        if (m < 3) { n15g = dpp_f<0x12F>(0.f, acc[ai][0][m < 3 ? m + 1 : 3][n][j]); n15u = dpp_f<0x12F>(0.f, acc[ai][1][m < 3 ? m + 1 : 3][n][j]); } else { n15g = ng[j]; n15u = nu[j]; }
                        float prg = dpp_f<0x111>(p0g, cg), pru = dpp_f<0x111>(p0u, cu);
                        float nxg = dpp_f<0x101>(n15g, cg), nxu = dpp_f<0x101>(n15u, cu);
                        if (first) { prg = 0.f; pru = 0.f; }
                        if (last) { nxg = 0.f; nxu = 0.f; }
                        const float yg = wgv[0][j] * prg + (wgv[1][j] * cg + (wgv[2][j] * nxg + bgv[j]));
                        const float yu = wuv[0][j] * pru + (wuv[1][j] * cu + (wuv[2][j] * nxu + buv[j]));
                        o[j] = gelu_tanh(yg) * yu;
                    }
                    if (n == 0) { w.x = cvt_pk_bf16(o[0], o[1]); w.y = cvt_pk_bf16(o[2], o[3]); } else { w.z = cvt_pk_bf16(o[0], o[1]); w.w = cvt_pk_bf16(o[2], o[3]); }
                }
                if (row >= 1 && row <= 254 && tg < Mrows) *(u32x4*)(G + (size_t)tg * 2816 + gc0) = w;
            }
        }
    }
};

template <int MODE>
struct EpiThin {
    static constexpr bool PERM = true, AFTER_DRAIN = false, HAS_FLUSH = true;
    bf16_t* mb; bf16_t* xb; const float* g; float* rs; float* out; unsigned* cnt; PG8_LAS unsigned* flag; int ntn;
    __device__ __forceinline__ void publish(int wid, int lane) const {
        asm volatile("s_waitcnt vmcnt(0)" ::: "memory"); __builtin_amdgcn_s_barrier(); asm volatile("" ::: "memory");
        const int ppm = (int)flag[1] - 1;
        if (ppm >= 0) {
            if (wid == 0 && lane == 0) { const unsigned old = __hip_atomic_fetch_add(cnt + 64 * ppm, 1u, __ATOMIC_RELAXED, __HIP_MEMORY_SCOPE_AGENT); flag[0] = (old == (unsigned)(ntn - 1)) ? 1u : 0u; }
            asm volatile("s_waitcnt vmcnt(0) lgkmcnt(0)" ::: "memory"); __builtin_amdgcn_s_barrier(); asm volatile("" ::: "memory");
            if (flag[0] != 0u) {
                if (wid == 0) { __builtin_amdgcn_fence(__ATOMIC_ACQUIRE, "agent"); asm volatile("s_waitcnt vmcnt(0)" ::: "memory"); }
                asm volatile("s_waitcnt lgkmcnt(0)" ::: "memory"); __builtin_amdgcn_s_barrier(); asm volatile("" ::: "memory");
                thin_rows_lean<MODE, 4>(xb, mb, g, rs, out, ppm * BM + wid * 32, ppm * BM + wid * 32 + 32, lane);
            }
        }
    }
    __device__ __forceinline__ void operator()(const f32x4 (&acc)[2][2][4][2], const Unit& u, int wr, int wc, int fr, int fq) const {
        const int wid = wr * 4 + wc, lane = fq * 16 + fr;
        u32x4 w[2][4][2];
#pragma unroll
        for (int ai = 0; ai < 2; ++ai)
#pragma unroll
            for (int m = 0; m < 4; ++m)
#pragma unroll
                for (int bj = 0; bj < 2; ++bj) { const f32x4 v0 = acc[ai][bj][m][0], v1 = acc[ai][bj][m][1];
                    w[ai][m][bj].x = cvt_pk_bf16(v0[0], v0[1]); w[ai][m][bj].y = cvt_pk_bf16(v0[2], v0[3]); w[ai][m][bj].z = cvt_pk_bf16(v1[0], v1[1]); w[ai][m][bj].w = cvt_pk_bf16(v1[2], v1[3]); }
        publish(wid, lane);
        asm volatile("s_waitcnt lgkmcnt(0)" ::: "memory"); __builtin_amdgcn_s_barrier(); asm volatile("" ::: "memory");
        if (wid == 0 && lane == 0) flag[1] = (unsigned)(u.pm + 1);
        const __amdgpu_buffer_rsrc_t rsrc = __builtin_amdgcn_make_buffer_rsrc((void*)mb, 0, M * 1024 * 2, 0x00020000);
        const int row0 = u.pm * BM + wr * 64 + fr, col0 = u.pn * BM + wc * 32 + 8 * fq;
#pragma unroll
        for (int ai = 0; ai < 2; ++ai)
#pragma unroll
            for (int m = 0; m < 4; ++m)
#pragma unroll
                for (int bj = 0; bj < 2; ++bj) __builtin_amdgcn_raw_buffer_store_b128(w[ai][m][bj], rsrc, ((row0 + ai * HALF + m * 16) * 1024 + col0 + bj * HALF) * 2, 0, 16);
    }
    __device__ __forceinline__ void flush(const Unit&, int wr, int wc, int fr, int fq) const {
        const int wid = wr * 4 + wc, lane = fq * 16 + fr;
        publish(wid, lane);
        asm volatile("s_waitcnt lgkmcnt(0)" ::: "memory"); __builtin_amdgcn_s_barrier(); asm volatile("" ::: "memory");
        if (wid == 0 && lane == 0) flag[1] = 0u;
        asm volatile("s_waitcnt lgkmcnt(0)" ::: "memory"); __builtin_amdgcn_s_barrier(); asm volatile("" ::: "memory");
    }
};

struct EpiNull {
    static constexpr bool PERM = true, AFTER_DRAIN = false, HAS_FLUSH = false;
    float* sink;
    __device__ __forceinline__ void operator()(const f32x4 (&acc)[2][2][4][2], const Unit& u, int wr, int wc, int fr, int fq) const {
        float s = 0.f;
#pragma unroll
        for (int ai = 0; ai < 2; ++ai)
#pragma unroll
            for (int bj = 0; bj < 2; ++bj)
#pragma unroll
                for (int m = 0; m < 4; ++m)
#pragma unroll
                    for (int n = 0; n < 2; ++n) s += acc[ai][bj][m][n][0] + acc[ai][bj][m][n][1] + acc[ai][bj][m][n][2] + acc[ai][bj][m][n][3];
        if (s == 123456.789f) sink[0] = s;
    }
};
template <class Epi, class Sched, bool ALIGN_EPI = false, bool SP2 = false>
__device__ __forceinline__ void gemm_phase(PG8_LAS unsigned char* lds, const Gemm g, const Sched& S, const Epi& E, int wave_arg, unsigned* tpw = nullptr) {
    const int wid = wave_arg, lane = LANE_ID(), tid = wid * 64 + lane, wr = wid >> 2, wc = wid & 3, fr = lane & 15, fq = lane >> 4;
    const int K = g.K, nt = K / BK;
    unsigned voffA[2], voffB[2];
#pragma unroll
    for (int i = 0; i < 2; ++i) { int R, C; stage_rc(tid * 16 + i * 8192, R, C); const int Rb = Epi::PERM ? ((R & ~31) + perm32(R & 31)) : R;
        voffA[i] = (unsigned)(R * K + C) * 2u; voffB[i] = (unsigned)(Rb * K + C) * 2u; }
    const size_t kstep = (size_t)(BK * 2);
    const size_t hstep = (size_t)HALF * K * 2;
    const size_t tstep = 2 * hstep;
    const unsigned ldsw = (unsigned)wid * 1024u;
    const int aoff = lds_byte(wr * 64 + fr, fq * 8), boff = lds_byte(wc * 32 + fr, fq * 8);
#define PG8_SA(b, h) (((b) * 2 + (h)) * HTB)
#define PG8_SB(b, h) ((4 + (b) * 2 + (h)) * HTB)
#define PG8_STAGE(bufoff, gbase, voff) do { _Pragma("unroll") for (int _i = 0; _i < 2; ++_i) \
        __builtin_amdgcn_global_load_lds((const unsigned*)((const char*)(gbase) + (voff)[_i]), (PG8_LAS unsigned*)(lds + (bufoff) + ldsw + _i * 8192), 16, 0, 0); } while (0)
#define PG8_LDA(dst, b, h) do { _Pragma("unroll") for (int m = 0; m < 4; ++m) _Pragma("unroll") for (int k = 0; k < 2; ++k) dst[m][k] = *(const PG8_LAS bf16x8*)(lds + PG8_SA(b, h) + aoff + m * 2048 + k * 1024); } while (0)
#define PG8_LDB(dst, b, h) do { _Pragma("unroll") for (int n = 0; n < 2; ++n) _Pragma("unroll") for (int k = 0; k < 2; ++k) dst[n][k] = *(const PG8_LAS bf16x8*)(lds + PG8_SB(b, h) + boff + n * 2048 + k * 1024); } while (0)
#define PG8_MMA(ai, bj, At, Bt) do { __builtin_amdgcn_s_setprio(1); _Pragma("unroll") for (int m = 0; m < 4; ++m) _Pragma("unroll") for (int n = 0; n < 2; ++n) _Pragma("unroll") for (int k = 0; k < 2; ++k) \
        acc[ai][bj][m][n] = __builtin_amdgcn_mfma_f32_16x16x32_bf16(Bt[n][k], At[m][k], acc[ai][bj][m][n], 0, 0, 0); __builtin_amdgcn_s_setprio(0); } while (0)
#define PG8_WAIT_V(n) asm volatile("s_waitcnt vmcnt(" #n ")" ::: "memory")
#define PG8_WAIT_L(n) asm volatile("s_waitcnt lgkmcnt(" #n ")" ::: "memory")
#define PG8_BAR __builtin_amdgcn_s_barrier()
#define PG8_SCHED __builtin_amdgcn_sched_barrier(0)
    Unit cur, nxt; int ui = 0;
    if (!S.next(0, cur)) return;
#if defined(GPROBE)
    unsigned long long gp_acc = 0, gp_t = 0; const bool gp_on = tpw != nullptr && blockIdx.x == 0 && wid == 0;
#define GP_MARK() do { if (gp_on) gp_t = __builtin_amdgcn_s_memrealtime(); } while (0)
#define GP_ADD() do { if (gp_on) gp_acc += __builtin_amdgcn_s_memrealtime() - gp_t; } while (0)
#else
#define GP_MARK() do {} while (0)
#define GP_ADD() do {} while (0)
#endif
#if defined(GEMM_STAGGER_TICKS)
    { const unsigned long long t0_ = __builtin_amdgcn_s_memrealtime(); const unsigned long long dly_ = (unsigned long long)((blockIdx.x >> 3) & 3) * GEMM_STAGGER_TICKS;
      while (__builtin_amdgcn_s_memrealtime() - t0_ < dly_) __builtin_amdgcn_s_sleep(8); }
#endif
    f32x4 acc[2][2][4][2];
#pragma unroll
    for (int a = 0; a < 2; ++a)
#pragma unroll
        for (int b = 0; b < 2; ++b)
#pragma unroll
            for (int m = 0; m < 4; ++m)
#pragma unroll
                for (int n = 0; n < 2; ++n) acc[a][b][m][n] = (f32x4){0.f, 0.f, 0.f, 0.f};
    bf16x8 At[4][2], B0[2][2], B1[2][2];
    const char* cA = (const char*)g.A + (size_t)cur.pm * g.tstepA; const char* cB = (const char*)g.Bt + (size_t)cur.pn * tstep;
    S.a_ready(cur);
    if constexpr (SP2) {
        PG8_STAGE(PG8_SB(0, 0), cB, voffB); PG8_STAGE(PG8_SB(0, 1), cB + hstep, voffB); PG8_STAGE(PG8_SA(0, 0), cA, voffA); PG8_STAGE(PG8_SA(0, 1), cA + hstep, voffA);
        if (wr == 1) PG8_BAR;
        PG8_WAIT_V(2); PG8_BAR;
        PG8_STAGE(PG8_SB(1, 0), cB + kstep, voffB); PG8_STAGE(PG8_SA(1, 0), cA + kstep, voffA); PG8_STAGE(PG8_SB(1, 1), cB + hstep + kstep, voffB);
        PG8_WAIT_V(6); PG8_BAR;
    } else {
        PG8_STAGE(PG8_SB(0, 0), cB, voffB); PG8_STAGE(PG8_SA(0, 0), cA, voffA); PG8_STAGE(PG8_SB(0, 1), cB + hstep, voffB); PG8_STAGE(PG8_SA(0, 1), cA + hstep, voffA);
        if (wr == 1) PG8_BAR;
        PG8_WAIT_V(4); PG8_BAR;
        PG8_STAGE(PG8_SB(1, 0), cB + kstep, voffB); PG8_STAGE(PG8_SA(1, 0), cA + kstep, voffA); PG8_STAGE(PG8_SB(1, 1), cB + hstep + kstep, voffB);
        PG8_WAIT_V(6); PG8_BAR;
    }
    for (;;) {
        const bool has_next = S.next(ui + 1, nxt);
        const char* nA = has_next ? (const char*)g.A + (size_t)nxt.pm * g.tstepA : cA; const char* nB = has_next ? (const char*)g.Bt + (size_t)nxt.pn * tstep : cB;
        for (int t = 0; t < nt; t += 2) {
            const bool last = (t == nt - 2);
#if defined(GPROBE) && GPROBE == 2
            if (t == 0) GP_MARK(); if (t == 4) GP_ADD();
#elif defined(GPROBE) && GPROBE == 3
            if (t == 4) GP_MARK(); if (t == 6) GP_ADD();
#elif defined(GPROBE) && GPROBE == 4
            if (t == nt - 2) GP_MARK();
#endif
            const char* a1 = cA + (size_t)(t + 1) * kstep;
            const char* a2 = last ? nA : cA + (size_t)(t + 2) * kstep; const char* b2 = last ? nB : cB + (size_t)(t + 2) * kstep;
            const char* a3 = a2 + kstep; const char* b3 = b2 + kstep;
            if (last && has_next) S.a_ready(nxt);
            if constexpr (SP2) {
            PG8_LDB(B0, 0, 0); PG8_LDB(B1, 0, 1); PG8_SCHED; PG8_LDA(At, 0, 0); PG8_STAGE(PG8_SA(1, 1), a1 + hstep, voffA);
            PG8_WAIT_V(8); PG8_WAIT_L(0); PG8_BAR; PG8_MMA(0, 0, At, B0); PG8_MMA(0, 1, At, B1); PG8_BAR; PG8_SCHED;
            PG8_LDA(At, 0, 1); PG8_STAGE(PG8_SB(0, 0), b2, voffB); PG8_STAGE(PG8_SB(0, 1), b2 + hstep, voffB); PG8_STAGE(PG8_SA(0, 0), a2, voffA);
            PG8_WAIT_V(8); PG8_WAIT_L(0); PG8_BAR; PG8_MMA(1, 0, At, B0); PG8_MMA(1, 1, At, B1); PG8_BAR; PG8_SCHED;
            PG8_LDB(B0, 1, 0); PG8_LDB(B1, 1, 1); PG8_SCHED; PG8_LDA(At, 1, 0); PG8_STAGE(PG8_SA(0, 1), a2 + hstep, voffA);
            PG8_WAIT_V(8); PG8_WAIT_L(0); PG8_BAR; PG8_MMA(0, 0, At, B0); PG8_MMA(0, 1, At, B1); PG8_BAR; PG8_SCHED;
            PG8_LDA(At, 1, 1); PG8_STAGE(PG8_SB(1, 0), b3, voffB); PG8_STAGE(PG8_SB(1, 1), b3 + hstep, voffB); PG8_STAGE(PG8_SA(1, 0), a3, voffA);
            PG8_WAIT_V(8); PG8_WAIT_L(0); PG8_BAR; PG8_MMA(1, 0, At, B0); PG8_MMA(1, 1, At, B1); PG8_BAR; PG8_SCHED;
            } else {
            PG8_LDB(B0, 0, 0); PG8_SCHED; PG8_LDA(At, 0, 0); PG8_STAGE(PG8_SA(1, 1), a1 + hstep, voffA);
            PG8_WAIT_L(8); PG8_BAR; PG8_WAIT_L(0); PG8_MMA(0, 0, At, B0); PG8_BAR; PG8_SCHED;
            PG8_LDB(B1, 0, 1); PG8_STAGE(PG8_SB(0, 0), b2, voffB);
            PG8_BAR; PG8_WAIT_L(0); PG8_MMA(0, 1, At, B1); PG8_BAR;
            PG8_LDA(At, 0, 1); PG8_STAGE(PG8_SA(0, 0), a2, voffA);
            PG8_BAR; PG8_WAIT_L(0); PG8_MMA(1, 0, At, B0); PG8_BAR; PG8_SCHED;
            PG8_STAGE(PG8_SB(0, 1), b2 + hstep, voffB);
            PG8_WAIT_V(6); PG8_BAR; PG8_MMA(1, 1, At, B1); PG8_BAR;
            PG8_LDB(B0, 1, 0); PG8_SCHED; PG8_LDA(At, 1, 0); PG8_STAGE(PG8_SA(0, 1), a2 + hstep, voffA);
            PG8_WAIT_L(8); PG8_BAR; PG8_WAIT_L(0); PG8_MMA(0, 0, At, B0); PG8_BAR; PG8_SCHED;
            PG8_LDB(B1, 1, 1); PG8_STAGE(PG8_SB(1, 0), b3, voffB);
            PG8_BAR; PG8_WAIT_L(0); PG8_MMA(0, 1, At, B1); PG8_BAR;
            PG8_LDA(At, 1, 1); PG8_STAGE(PG8_SA(1, 0), a3, voffA);
            PG8_BAR; PG8_WAIT_L(0); PG8_MMA(1, 0, At, B0); PG8_BAR; PG8_SCHED;
            PG8_STAGE(PG8_SB(1, 1), b3 + hstep, voffB);
            PG8_WAIT_V(6); PG8_BAR; PG8_MMA(1, 1, At, B1); PG8_BAR;
            }
        }
#if defined(GPROBE) && GPROBE == 4
        GP_ADD();
#endif
        if constexpr (ALIGN_EPI) { if (wr == 0) PG8_BAR; }
#if defined(GPROBE) && GPROBE == 1
        GP_MARK();
#elif defined(GPROBE) && GPROBE == 6
        if (ui > 0) GP_ADD();
#endif
        if constexpr (!Epi::AFTER_DRAIN) { E(acc, cur, wr, wc, fr, fq); S.done(cur); }
#if defined(GPROBE) && GPROBE == 1
        GP_ADD();
#elif defined(GPROBE) && GPROBE == 6
        GP_MARK();
#endif
        if (!has_next) break;
#pragma unroll
        for (int a = 0; a < 2; ++a)
#pragma unroll
            for (int b = 0; b < 2; ++b)
#pragma unroll
                for (int m = 0; m < 4; ++m)
#pragma unroll
                    for (int n = 0; n < 2; ++n) acc[a][b][m][n] = (f32x4){0.f, 0.f, 0.f, 0.f};
        cur = nxt; cA = nA; cB = nB; ++ui;
        if constexpr (ALIGN_EPI) { if (wr == 1) PG8_BAR; }
    }
#if defined(GPROBE)
    if (gp_on && lane == 0) tpw[0] = (unsigned)gp_acc;
#endif
    PG8_WAIT_V(0);
    if constexpr (!ALIGN_EPI) { if (wr == 0) PG8_BAR; }
    PG8_BAR;
    if constexpr (Epi::AFTER_DRAIN) { E.fused(acc, cur, wr, wc, fr, fq, lds, wid, lane); S.done(cur); }
    if constexpr (Epi::HAS_FLUSH) E.flush(cur, wr, wc, fr, fq);
#undef PG8_SA
#undef PG8_SB
#undef PG8_STAGE
#undef PG8_LDA
#undef PG8_LDB
#undef PG8_MMA
#undef PG8_WAIT_V
#undef PG8_WAIT_L
#undef PG8_BAR
#undef PG8_SCHED
}
}

namespace att {
#define ATT_LAS __attribute__((address_space(3)))
typedef unsigned short bf16_t;
using bf16x8 = __attribute__((ext_vector_type(8))) short;
using s16x4  = __attribute__((ext_vector_type(4))) short;
using f32x16 = __attribute__((ext_vector_type(16))) float;
using f32x4  = __attribute__((ext_vector_type(4))) float;
using u32x4  = __attribute__((ext_vector_type(4))) unsigned;
typedef ATT_LAS char* lptr;
#define SBAR() __builtin_amdgcn_sched_barrier(0)
constexpr int PITCH = 1024;
constexpr float QSCALE = 0.125f * 1.4426950408889634f;
constexpr float THRL = 8.0f * 1.4426950408889634f;
__device__ __forceinline__ int crow(int r, int hi) { return (r & 3) + 8 * (r >> 2) + 4 * hi; }
__device__ __forceinline__ unsigned cvtpk(float lo, float hi) { unsigned r; asm volatile("v_cvt_pk_bf16_f32 %0, %1, %2" : "=v"(r) : "v"(lo), "v"(hi)); return r; }
__device__ __forceinline__ int koff(int row, int c) { return c * 1024 + ((row ^ c) << 4); }
__device__ __forceinline__ int v_st(int k, int c) { const int kk = (k & ~0xC) | ((k & 4) << 1) | ((k & 8) >> 1); return ((kk >> 3) * 4 + (c >> 5)) * 512 + ((kk & 7) * 32 + (c & 31)) * 2; }
__device__ __forceinline__ int v_rd_base(int lane) { return ((lane & 3) << 3) | (((lane >> 2) & 3) << 6) | (((lane >> 4) & 1) << 5) | (((lane >> 5) & 1) << 8); }
constexpr int v_rd_off(int d0, int ks, int half) { return d0 * 512 + ks * 4096 + half * 2048; }
template <int OFF> __device__ __forceinline__ s16x4 tr_read(int vb) { s16x4 r; asm volatile("ds_read_b64_tr_b16 %0, %1 offset:%2" : "=&v"(r) : "v"(vb), "i"(OFF) : "memory"); return r; }
template <int D0> __device__ __forceinline__ void pv_one(f32x16& od, int vb, bf16x8 pa0, bf16x8 pa1, bf16x8 pa2, bf16x8 pa3) {
  const s16x4 l0 = tr_read<v_rd_off(D0, 0, 0)>(vb), h0 = tr_read<v_rd_off(D0, 0, 1)>(vb), l1 = tr_read<v_rd_off(D0, 1, 0)>(vb), h1 = tr_read<v_rd_off(D0, 1, 1)>(vb);
  const s16x4 l2 = tr_read<v_rd_off(D0, 2, 0)>(vb), h2 = tr_read<v_rd_off(D0, 2, 1)>(vb), l3 = tr_read<v_rd_off(D0, 3, 0)>(vb), h3 = tr_read<v_rd_off(D0, 3, 1)>(vb);
  asm volatile("s_waitcnt lgkmcnt(0)" ::: "memory"); SBAR();
#define PK(L, H) (bf16x8){L[0], L[1], L[2], L[3], H[0], H[1], H[2], H[3]}
  od = __builtin_amdgcn_mfma_f32_32x32x16_bf16(pa0, PK(l0, h0), od, 0, 0, 0);
  od = __builtin_amdgcn_mfma_f32_32x32x16_bf16(pa1, PK(l1, h1), od, 0, 0, 0);
  od = __builtin_amdgcn_mfma_f32_32x32x16_bf16(pa2, PK(l2, h2), od, 0, 0, 0);
  od = __builtin_amdgcn_mfma_f32_32x32x16_bf16(pa3, PK(l3, h3), od, 0, 0, 0);
#undef PK
}
__device__ __forceinline__ void qkt(f32x16& p0, f32x16& p1, lptr Ks, const bf16x8* qr, int r32, int hi) {
  p0 = f32x16{}; p1 = f32x16{};
#pragma unroll
  for (int d0 = 0; d0 < 4; ++d0) { const int c = 2 * d0 + hi;
    const bf16x8 b0 = *(const ATT_LAS bf16x8*)(Ks + koff(r32, c));
    const bf16x8 b1 = *(const ATT_LAS bf16x8*)(Ks + koff(32 + r32, c));
    p0 = __builtin_amdgcn_mfma_f32_32x32x16_bf16(b0, qr[d0], p0, 0, 0, 0);
    p1 = __builtin_amdgcn_mfma_f32_32x32x16_bf16(b1, qr[d0], p1, 0, 0, 0); }
}
__device__ __forceinline__ float rowmax32(const f32x16& p0, const f32x16& p1) {
  float pmax = p0[0];
#pragma unroll
  for (int r = 1; r < 16; ++r) pmax = fmaxf(pmax, p0[r]);
#pragma unroll
  for (int r = 0; r < 16; ++r) pmax = fmaxf(pmax, p1[r]);
  auto rr = __builtin_amdgcn_permlane32_swap(__float_as_uint(pmax), __float_as_uint(pmax), false, false);
  return fmaxf(__uint_as_float(rr[0]), __uint_as_float(rr[1]));
}
__device__ __forceinline__ void partialSM(f32x16& p0, f32x16& p1, float& m_reg, float& mn, float& alpha) {
  const float pmax = rowmax32(p0, p1);
  if (__builtin_expect(__all(pmax - m_reg <= THRL), 1)) { mn = m_reg; alpha = 1.f; }
  else { mn = fmaxf(m_reg, pmax); alpha = __builtin_amdgcn_exp2f(m_reg - mn); m_reg = mn; }
#pragma unroll
  for (int r = 0; r < 16; ++r) p0[r] = p0[r] - mn;
#pragma unroll
  for (int r = 0; r < 16; ++r) p1[r] = p1[r] - mn;
#pragma unroll
  for (int r = 0; r < 16; ++r) p0[r] = __builtin_amdgcn_exp2f(p0[r]);
}
__device__ __forceinline__ void finishSM(f32x16& p0, f32x16& p1, float alpha, float& l_reg, bf16x8& pa0, bf16x8& pa1, bf16x8& pa2, bf16x8& pa3) {
#pragma unroll
  for (int r = 0; r < 16; ++r) p1[r] = __builtin_amdgcn_exp2f(p1[r]);
  float ps = 0;
#pragma unroll
  for (int r = 0; r < 16; ++r) ps += p0[r];
#pragma unroll
  for (int r = 0; r < 16; ++r) ps += p1[r];
  { auto rr = __builtin_amdgcn_permlane32_swap(__float_as_uint(ps), __float_as_uint(ps), false, false); ps = __uint_as_float(rr[0]) + __uint_as_float(rr[1]); }
  l_reg = l_reg * alpha + ps;
#define PK4(P, BASE, OUT) do { unsigned a0 = cvtpk(P[BASE + 0], P[BASE + 1]), a1 = cvtpk(P[BASE + 2], P[BASE + 3]);   \
    unsigned b0 = cvtpk(P[BASE + 4], P[BASE + 5]), b1 = cvtpk(P[BASE + 6], P[BASE + 7]);                              \
    auto r0 = __builtin_amdgcn_permlane32_swap(a0, b0, false, false); auto r1 = __builtin_amdgcn_permlane32_swap(a1, b1, false, false); \
    u32x4 w = {r0[0], r1[0], r0[1], r1[1]}; OUT = __builtin_bit_cast(bf16x8, w); } while (0)
  PK4(p0, 0, pa0); PK4(p0, 8, pa1); PK4(p1, 0, pa2); PK4(p1, 8, pa3);
#undef PK4
}

__device__ __forceinline__ void finishSM_noexp(f32x16& p0, f32x16& p1, float& l_reg, bf16x8& pa0, bf16x8& pa1, bf16x8& pa2, bf16x8& pa3) {
  float ps = 0;
#pragma unroll
  for (int r = 0; r < 16; ++r) ps += p0[r];
#pragma unroll
  for (int r = 0; r < 16; ++r) ps += p1[r];
  { auto rr = __builtin_amdgcn_permlane32_swap(__float_as_uint(ps), __float_as_uint(ps), false, false); ps = __uint_as_float(rr[0]) + __uint_as_float(rr[1]); }
  l_reg += ps;
#define PK4(P, BASE, OUT) do { unsigned a0 = cvtpk(P[BASE + 0], P[BASE + 1]), a1 = cvtpk(P[BASE + 2], P[BASE + 3]);   \
    unsigned b0 = cvtpk(P[BASE + 4], P[BASE + 5]), b1 = cvtpk(P[BASE + 6], P[BASE + 7]);                              \
    auto r0 = __builtin_amdgcn_permlane32_swap(a0, b0, false, false); auto r1 = __builtin_amdgcn_permlane32_swap(a1, b1, false, false); \
    u32x4 w = {r0[0], r1[0], r0[1], r1[1]}; OUT = __builtin_bit_cast(bf16x8, w); } while (0)
  PK4(p0, 0, pa0); PK4(p0, 8, pa1); PK4(p1, 0, pa2); PK4(p1, 8, pa3);
#undef PK4
}

__device__ __forceinline__ void finish_T(const f32x16& p0, const f32x16& p1, float& l_reg, bf16x8& pa0, bf16x8& pa1, bf16x8& pa2, bf16x8& pa3) {
  float ps = 0;
#pragma unroll
  for (int r = 0; r < 16; ++r) ps += p0[r];
#pragma unroll
  for (int r = 0; r < 16; ++r) ps += p1[r];
  l_reg += ps;
#define PK8(P, BASE, OUT) do { u32x4 w = {cvtpk(P[BASE + 0], P[BASE + 1]), cvtpk(P[BASE + 2], P[BASE + 3]), cvtpk(P[BASE + 4], P[BASE + 5]), cvtpk(P[BASE + 6], P[BASE + 7])}; OUT = __builtin_bit_cast(bf16x8, w); } while (0)
  PK8(p0, 0, pa0); PK8(p0, 8, pa1); PK8(p1, 0, pa2); PK8(p1, 8, pa3);
#undef PK8
}

constexpr int DA_SHM_V = 16384, DA_SHM_K = 8192, DA_LDS_V = 0, DA_LDS_K = 2 * DA_SHM_V, DA_LDS_WS = DA_LDS_K + 2 * DA_SHM_K, DA_LDS_BYTES = DA_LDS_WS + 8 * 256;
__device__ __forceinline__ void da_pass(const bf16_t* __restrict__ Qw, const bf16_t* __restrict__ Kh, const bf16_t* __restrict__ Vh, int NT, lptr lds, int tid, int wid, int lane,
                                        f32x16 (&o)[4], float& l_out) {
  const int r32 = lane & 31, hi = lane >> 5;
  const lptr V_lds = lds + DA_LDS_V, K_lds = lds + DA_LDS_K;
  ATT_LAS float* al_l = (ATT_LAS float*)(lds + DA_LDS_WS) + wid * 64 + 32;
  float m_reg = -1e30f, l_reg = 0.f;
#pragma unroll
  for (int d = 0; d < 4; ++d) o[d] = f32x16{};
  bf16x8 qr[4];
#pragma unroll
  for (int d0 = 0; d0 < 4; ++d0) qr[d0] = *(const bf16x8*)(Qw + d0 * 16);
  const int sr = tid >> 4, sc = (tid & 15) * 8, vst0 = v_st(sr, sc), vst1 = v_st(32 + sr, sc);
  const int kr = tid >> 3, kc = tid & 7, kst = koff(kr, kc);
  const int vb0 = (int)(unsigned)(uintptr_t)V_lds + v_rd_base(lane);
  bf16x8 sv0[2], sv1[2], sk[2];
#define SLOAD(i, k0) do { sv0[i] = *(const bf16x8*)(Vh + (size_t)((k0) + sr) * PITCH + sc); sv1[i] = *(const bf16x8*)(Vh + (size_t)((k0) + 32 + sr) * PITCH + sc); \
    sk[i] = *(const bf16x8*)(Kh + (size_t)((k0) + kr) * PITCH + kc * 8); } while (0)
#define SWRITE(b, i) do { *(ATT_LAS bf16x8*)(V_lds + (b) * DA_SHM_V + vst0) = sv0[i]; *(ATT_LAS bf16x8*)(V_lds + (b) * DA_SHM_V + vst1) = sv1[i]; \
    *(ATT_LAS bf16x8*)(K_lds + (b) * DA_SHM_K + kst) = sk[i]; } while (0)
#define SWAIT() asm volatile("s_waitcnt vmcnt(3)" ::: "memory")
#define RESC(a) do { if (__any((a) < 1.f)) { if (hi == 0) al_l[r32] = (a); asm volatile("s_waitcnt lgkmcnt(0)" ::: "memory"); \
    _Pragma("unroll") for (int d = 0; d < 4; ++d) _Pragma("unroll") for (int r = 0; r < 16; ++r) o[d][r] *= al_l[crow(r, hi)]; } } while (0)
#define PVALL(vb) do { pv_one<0>(o[0], (vb), pa0, pa1, pa2, pa3); pv_one<1>(o[1], (vb), pa0, pa1, pa2, pa3); pv_one<2>(o[2], (vb), pa0, pa1, pa2, pa3); pv_one<3>(o[3], (vb), pa0, pa1, pa2, pa3); } while (0)
  f32x16 pA0, pA1, pB0, pB1; float mnA, mnB, alA, alB; bf16x8 pa0, pa1, pa2, pa3;
  SLOAD(0, 0); asm volatile("s_waitcnt vmcnt(0)" ::: "memory"); SWRITE(0, 0); __syncthreads();
  qkt(pA0, pA1, K_lds, qr, r32, hi); partialSM(pA0, pA1, m_reg, mnA, alA);
  SLOAD(1, 64); if (2 < NT) SLOAD(0, 128);
  SWAIT(); SWRITE(1, 1); __syncthreads();
  for (int j = 1; j + 1 < NT; j += 2) {
    SBAR(); qkt(pB0, pB1, K_lds + DA_SHM_K, qr, r32, hi);
    finishSM(pA0, pA1, alA, l_reg, pa0, pa1, pa2, pa3); SBAR();
    SLOAD(1, (j + 2) * 64); SBAR();
    PVALL(vb0); partialSM(pB0, pB1, m_reg, mnB, alB);
    __syncthreads(); SWAIT(); SWRITE(0, 0);
    RESC(alB); __syncthreads();
    SBAR(); qkt(pA0, pA1, K_lds, qr, r32, hi);
    finishSM(pB0, pB1, alB, l_reg, pa0, pa1, pa2, pa3); SBAR();
    if (j + 3 < NT) SLOAD(0, (j + 3) * 64); SBAR();
    PVALL(vb0 + DA_SHM_V); partialSM(pA0, pA1, m_reg, mnA, alA);
    __syncthreads(); SWAIT(); SWRITE(1, 1);
    RESC(alA); __syncthreads();
  }
  SBAR(); qkt(pB0, pB1, K_lds + DA_SHM_K, qr, r32, hi);
  finishSM(pA0, pA1, alA, l_reg, pa0, pa1, pa2, pa3); SBAR();
  PVALL(vb0); partialSM(pB0, pB1, m_reg, mnB, alB);
  __syncthreads(); RESC(alB);
  finishSM(pB0, pB1, alB, l_reg, pa0, pa1, pa2, pa3); SBAR();
  PVALL(vb0 + DA_SHM_V);
  l_out = l_reg;
  __syncthreads();
#undef SLOAD
#undef SWRITE
#undef SWAIT
#undef RESC
#undef PVALL
}
#ifndef DA_SP
#define DA_SP 0
#endif
#ifndef PP_PREF
#define PP_PREF 0
#endif
#ifndef PP_DMA_LATE
#define PP_DMA_LATE 0
#endif
#ifndef PP_DMA_IN_M
#define PP_DMA_IN_M 1
#endif
#ifndef PP_PRIO
#define PP_PRIO 1
#endif
#ifndef PP_NS
#define PP_NS 3
#endif
#ifndef PP_MIDBAR
#define PP_MIDBAR 0
#endif
#define PP_MID() do { if (PP_MIDBAR) PP_BAR(); else __builtin_amdgcn_sched_barrier(0); } while (0)
constexpr int PP_K = 0, PP_V = PP_NS * 8192, PP_WS = PP_V + PP_NS * 16384, PP_BYTES = PP_WS + 8 * 256;
typedef short v4i16_t __attribute__((ext_vector_type(4)));
__device__ __forceinline__ short qr_raw(const bf16x8& v, int e) { return v[e]; }
__device__ __forceinline__ s16x4 vtr(lptr p) { return __builtin_bit_cast(s16x4, __builtin_amdgcn_ds_read_tr16_b64_v4i16((ATT_LAS v4i16_t*)p)); }
#define PP_BAR() do { __builtin_amdgcn_sched_barrier(0); asm volatile("s_waitcnt lgkmcnt(0)" ::: "memory"); __builtin_amdgcn_s_barrier(); __builtin_amdgcn_sched_barrier(0); } while (0)
template <int GRP>
__device__ __forceinline__ void da_pass_pp(const bf16_t* __restrict__ Qw, const bf16_t* __restrict__ Kh, const bf16_t* __restrict__ Vh, int NT, lptr lds, int wid, int lane,
                                           float kmax2, f32x16 (&o)[4], float& l_out, unsigned* dbg = nullptr, int variant = 0) {
  const int r32 = lane & 31, hi = lane >> 5;
  const lptr Kr = lds + PP_K, Vr = lds + PP_V;
  ATT_LAS float* al_l = (ATT_LAS float*)(lds + PP_WS) + wid * 64 + 32;
  const bf16_t* ksrc = Kh + (size_t)(lane ^ wid) * PITCH + wid * 8;
  const bf16_t* vsrc0;
  { const int j = lane & 31, sidx = 2 * (2 * wid) + (lane >> 5), kk = (sidx >> 2) * 8 + (j >> 2), col = (sidx & 3) * 32 + (j & 3) * 8; vsrc0 = Vh + (size_t)kk * PITCH + col; }
#define DMA_K(t, slot) __builtin_amdgcn_global_load_lds((const unsigned*)(ksrc + (size_t)(t) * 64 * PITCH), (ATT_LAS unsigned*)(Kr + (slot) * 8192 + wid * 1024), 16, 0, 0)
#define DMA_V0(t, slot) __builtin_amdgcn_global_load_lds((const unsigned*)(vsrc0 + (size_t)(t) * 64 * PITCH), (ATT_LAS unsigned*)(Vr + (slot) * 16384 + (2 * wid) * 1024), 16, 0, 0)
#define DMA_V1(t, slot) __builtin_amdgcn_global_load_lds((const unsigned*)(vsrc0 + 64 + (size_t)(t) * 64 * PITCH), (ATT_LAS unsigned*)(Vr + (slot) * 16384 + (2 * wid + 1) * 1024), 16, 0, 0)
#define DMA_V(t, slot) do { DMA_V0(t, slot); DMA_V1(t, slot); } while (0)
  bf16x8 qr[4];
#pragma unroll
  for (int d0 = 0; d0 < 4; ++d0) qr[d0] = *(const bf16x8*)(Qw + d0 * 16);
  DMA_K(0, 0); DMA_V(0, 0); DMA_K(1, 1); if (PP_NS == 4) { DMA_K(2, 2); DMA_V(1, 1); }
  bool fast;
  { float qn = 0.f;
#pragma unroll
    for (int d0 = 0; d0 < 4; ++d0) {
#pragma unroll
      for (int e = 0; e < 8; ++e) { const float v = __uint_as_float(((unsigned)(unsigned short)qr_raw(qr[d0], e)) << 16); qn += v * v; } }
    { auto rr = __builtin_amdgcn_permlane32_swap(__float_as_uint(qn), __float_as_uint(qn), false, false); qn = __uint_as_float(rr[0]) + __uint_as_float(rr[1]); }
#ifdef PROBE_FORCE_FAST
    fast = true; }
#elif defined(PROBE_FORCE_SLOW)
    fast = false; }
#else
    fast = __all(qn * kmax2 * 1.05f < 10000.f) != 0; }
#endif
#pragma unroll
  for (int d = 0; d < 4; ++d) o[d] = f32x16{};
  float mref = 0.f, l_reg = 0.f;
  f32x16 S0, S1; bf16x8 pa0, pa1, pa2, pa3; const f32x16 zero16 = f32x16{};
  const int kq0 = koff(r32, hi), kq1 = koff(32 + r32, hi);
  const int vbase = v_rd_base(lane);
  asm volatile("s_waitcnt vmcnt(0)" ::: "memory");
  PP_BAR();
  int ks_cur = 0, vs_prev = PP_NS - 1, vs_new = PP_NS - 2;
#define SB0() __builtin_amdgcn_sched_barrier(0)
#define VRD8(d0, L0, H0, L1, H1, L2, H2, L3, H3) do { L0 = vtr(Vt + v_rd_off(d0, 0, 0)); H0 = vtr(Vt + v_rd_off(d0, 0, 1)); L1 = vtr(Vt + v_rd_off(d0, 1, 0)); H1 = vtr(Vt + v_rd_off(d0, 1, 1)); \
    L2 = vtr(Vt + v_rd_off(d0, 2, 0)); H2 = vtr(Vt + v_rd_off(d0, 2, 1)); L3 = vtr(Vt + v_rd_off(d0, 3, 0)); H3 = vtr(Vt + v_rd_off(d0, 3, 1)); } while (0)
#define PV4(d0, L0, H0, L1, H1, L2, H2, L3, H3) do { \
    o[d0] = __builtin_amdgcn_mfma_f32_32x32x16_bf16((bf16x8){L0[0], L0[1], L0[2], L0[3], H0[0], H0[1], H0[2], H0[3]}, pa0, o[d0], 0, 0, 0); \
    o[d0] = __builtin_amdgcn_mfma_f32_32x32x16_bf16((bf16x8){L1[0], L1[1], L1[2], L1[3], H1[0], H1[1], H1[2], H1[3]}, pa1, o[d0], 0, 0, 0); \
    o[d0] = __builtin_amdgcn_mfma_f32_32x32x16_bf16((bf16x8){L2[0], L2[1], L2[2], L2[3], H2[0], H2[1], H2[2], H2[3]}, pa2, o[d0], 0, 0, 0); \
    o[d0] = __builtin_amdgcn_mfma_f32_32x32x16_bf16((bf16x8){L3[0], L3[1], L3[2], L3[3], H3[0], H3[1], H3[2], H3[3]}, pa3, o[d0], 0, 0, 0); } while (0)
#define KRD8(KS) do { const lptr Kt = Kr + (KS) * 8192; \
    kf[0] = *(const ATT_LAS bf16x8*)(Kt + koff(r32, hi)); kf[1] = *(const ATT_LAS bf16x8*)(Kt + koff(32 + r32, hi)); \
    kf[2] = *(const ATT_LAS bf16x8*)(Kt + koff(r32, 2 + hi)); kf[3] = *(const ATT_LAS bf16x8*)(Kt + koff(32 + r32, 2 + hi)); \
    kf[4] = *(const ATT_LAS bf16x8*)(Kt + koff(r32, 4 + hi)); kf[5] = *(const ATT_LAS bf16x8*)(Kt + koff(32 + r32, 4 + hi)); \
    kf[6] = *(const ATT_LAS bf16x8*)(Kt + koff(r32, 6 + hi)); kf[7] = *(const ATT_LAS bf16x8*)(Kt + koff(32 + r32, 6 + hi)); } while (0)
#define KRD4A(KS) do { const lptr Kt = Kr + (KS) * 8192; \
    kf[0] = *(const ATT_LAS bf16x8*)(Kt + koff(r32, hi)); kf[1] = *(const ATT_LAS bf16x8*)(Kt + koff(32 + r32, hi)); } while (0)
#define KRD4B(KS) do { const lptr Kt = Kr + (KS) * 8192; \
    kf[2] = *(const ATT_LAS bf16x8*)(Kt + koff(r32, 2 + hi)); kf[3] = *(const ATT_LAS bf16x8*)(Kt + koff(32 + r32, 2 + hi)); \
    kf[4] = *(const ATT_LAS bf16x8*)(Kt + koff(r32, 4 + hi)); kf[5] = *(const ATT_LAS bf16x8*)(Kt + koff(32 + r32, 4 + hi)); \
    kf[6] = *(const ATT_LAS bf16x8*)(Kt + koff(r32, 6 + hi)); kf[7] = *(const ATT_LAS bf16x8*)(Kt + koff(32 + r32, 6 + hi)); } while (0)
#define QK8() do { \
    S0 = __builtin_amdgcn_mfma_f32_32x32x16_bf16(kf[0], qr[0], zero16, 0, 0, 0); S1 = __builtin_amdgcn_mfma_f32_32x32x16_bf16(kf[1], qr[0], zero16, 0, 0, 0); \
    S0 = __builtin_amdgcn_mfma_f32_32x32x16_bf16(kf[2], qr[1], S0, 0, 0, 0);   S1 = __builtin_amdgcn_mfma_f32_32x32x16_bf16(kf[3], qr[1], S1, 0, 0, 0); \
    S0 = __builtin_amdgcn_mfma_f32_32x32x16_bf16(kf[4], qr[2], S0, 0, 0, 0);   S1 = __builtin_amdgcn_mfma_f32_32x32x16_bf16(kf[5], qr[2], S1, 0, 0, 0); \
    S0 = __builtin_amdgcn_mfma_f32_32x32x16_bf16(kf[6], qr[3], S0, 0, 0, 0);   S1 = __builtin_amdgcn_mfma_f32_32x32x16_bf16(kf[7], qr[3], S1, 0, 0, 0); } while (0)
  bf16x8 kf[8]; s16x4 a0, a1, a2, a3, a4, a5, a6, a7, b0_, b1_, b2_, b3_, b4_, b5_, b6_, b7_;
#define NXT3(x) ((x) == PP_NS - 1 ? 0 : (x) + 1)
#define PREF(DO_K, DO_V, kslot, vslot) do { if (DO_V) { const lptr Vt = Vr + (vslot) * 16384 + vbase; VRD8(0, a0, a1, a2, a3, a4, a5, a6, a7); } \
    if (DO_K) { const int ks_cur_ = (kslot); KRD8(ks_cur_); } } while (0)
#define MB_DMA_K(tt) do { if (PP_DMA_IN_M && (tt) + PP_NS - 1 < NT) { DMA_K((tt) + PP_NS - 1, vs_prev); SB0(); } } while (0)
#define MB_DMA_V0(tt) do { if (PP_DMA_IN_M && (tt) + PP_NS - 2 < NT) { DMA_V0((tt) + PP_NS - 2, vs_new); SB0(); } } while (0)
#define MB_DMA_V1(tt) do { if (PP_DMA_IN_M && (tt) + PP_NS - 2 < NT) { DMA_V1((tt) + PP_NS - 2, vs_new); SB0(); } } while (0)
#define MBLOCK(DO_QK, DO_PV, tt) do { if (PP_PRIO == 1) __builtin_amdgcn_s_setprio(1); const lptr Vt = Vr + vs_prev * 16384 + vbase; \
    if (PP_PREF == 0 || PP_PREF == 4) { if (DO_QK) { if (PP_PREF == 0 || GRP == 0) { KRD8(ks_cur); SB0(); } } else if (DO_PV) { VRD8(0, a0, a1, a2, a3, a4, a5, a6, a7); SB0(); } } \
    if (PP_PREF == 3) { if (DO_QK) KRD4B(ks_cur); if (DO_PV) VRD8(0, a0, a1, a2, a3, a4, a5, a6, a7); SB0(); } \
    if (DO_QK && variant != 2) { QK8(); SB0(); if ((PP_PREF == 0 || PP_PREF == 4) && DO_PV) { VRD8(0, a0, a1, a2, a3, a4, a5, a6, a7); SB0(); } } \
    if (DO_PV && variant != 2) { VRD8(1, b0_, b1_, b2_, b3_, b4_, b5_, b6_, b7_); SB0(); PV4(0, a0, a1, a2, a3, a4, a5, a6, a7); SB0(); MB_DMA_K(tt); VRD8(2, a0, a1, a2, a3, a4, a5, a6, a7); SB0(); \
                 PV4(1, b0_, b1_, b2_, b3_, b4_, b5_, b6_, b7_); SB0(); MB_DMA_V0(tt); VRD8(3, b0_, b1_, b2_, b3_, b4_, b5_, b6_, b7_); SB0(); \
                 PV4(2, a0, a1, a2, a3, a4, a5, a6, a7); SB0(); MB_DMA_V1(tt); \
                 PV4(3, b0_, b1_, b2_, b3_, b4_, b5_, b6_, b7_); SB0(); \
                 if (PP_PREF == 3 && (tt) + 1 < NT) { KRD4A(NXT3(ks_cur)); SB0(); } } \
    else { MB_DMA_K(tt); MB_DMA_V0(tt); MB_DMA_V1(tt); if (PP_PREF == 3 && (tt) + 1 < NT) { KRD4A(NXT3(ks_cur)); SB0(); } } \
    if (PP_PRIO == 1) __builtin_amdgcn_s_setprio(0); } while (0)
#define VBLOCK(t) do { if ((t) >= 0 && (t) < NT && variant != 1) { if (PP_PRIO == 2) __builtin_amdgcn_s_setprio(1); \
    if (!fast) { const float rm = rowmax32(S0, S1); \
      if ((t) == 0 || __any(rm - mref > THRL)) { const float mn = (t) == 0 ? rm : fmaxf(rm, mref); \
        if ((t) != 0) { const float f = __builtin_amdgcn_exp2f(mref - mn); l_reg *= f; \
          _Pragma("unroll") for (int d = 0; d < 4; ++d) _Pragma("unroll") for (int r = 0; r < 16; ++r) o[d][r] *= f; } \
        mref = mn; } \
      _Pragma("unroll") for (int r = 0; r < 16; ++r) { S0[r] -= mref; S1[r] -= mref; } } \
    _Pragma("unroll") for (int r = 0; r < 16; ++r) { S0[r] = __builtin_amdgcn_exp2f(S0[r]); S1[r] = __builtin_amdgcn_exp2f(S1[r]); } \
    finish_T(S0, S1, l_reg, pa0, pa1, pa2, pa3); if (PP_PRIO == 2) __builtin_amdgcn_s_setprio(0); } } while (0)
#define ROT3() do { vs_new = vs_prev; vs_prev = ks_cur; ks_cur = ks_cur == PP_NS - 1 ? 0 : ks_cur + 1; } while (0)
#define TAILWAIT(t) do { if (PP_PREF == 3) { if ((t) + 3 < NT) asm volatile("s_waitcnt vmcnt(3)" ::: "memory"); else if ((t) + 2 < NT) asm volatile("s_waitcnt vmcnt(2)" ::: "memory"); else asm volatile("s_waitcnt vmcnt(0)" ::: "memory"); } \
    else if (PP_NS == 3) { if ((t) + 2 < NT) asm volatile("s_waitcnt vmcnt(3)" ::: "memory"); else if ((t) + 1 < NT) asm volatile("s_waitcnt vmcnt(2)" ::: "memory"); else asm volatile("s_waitcnt vmcnt(0)" ::: "memory"); } \
    else { if ((t) + 3 < NT) asm volatile("s_waitcnt vmcnt(6)" ::: "memory"); else if ((t) + 2 < NT) asm volatile("s_waitcnt vmcnt(5)" ::: "memory"); else if ((t) + 1 < NT) asm volatile("s_waitcnt vmcnt(2)" ::: "memory"); else asm volatile("s_waitcnt vmcnt(0)" ::: "memory"); } } while (0)
#if defined(DPROBE)
  unsigned long long dp_acc = 0, dp_prev = 0; const bool dp_on = dbg != nullptr && blockIdx.x == 0 && wid == (DPROBE_GRP ? 4 : 0) && GRP == DPROBE_GRP;
#define DP_T(i) do { if (dp_on) { const unsigned long long now_ = __builtin_amdgcn_s_memtime(); if ((i) == DPROBE) dp_acc += now_ - dp_prev; dp_prev = now_; } } while (0)
#else
#define DP_T(i) do {} while (0)
#endif
#define DMA_ISSUE(t) do { if ((t) + PP_NS - 1 < NT) DMA_K((t) + PP_NS - 1, vs_prev); if ((t) + PP_NS - 2 < NT) DMA_V((t) + PP_NS - 2, vs_new); } while (0)
#if DA_SP
  bf16x8 pb0, pb1, pb2, pb3; float resf = 1.f; bool resc = false;
#define SP_PRELUDE(t) do { resc = false; if (!fast) { const float rm = rowmax32(S0, S1); \
      if ((t) == 0 || __any(rm - mref > THRL)) { const float mn = (t) == 0 ? rm : fmaxf(rm, mref); resf = (t) == 0 ? 1.f : __builtin_amdgcn_exp2f(mref - mn); resc = (t) != 0; mref = mn; } \
      _Pragma("unroll") for (int r = 0; r < 16; ++r) { S0[r] -= mref; S1[r] -= mref; } } } while (0)
#define SP_EXP0() do { _Pragma("unroll") for (int r = 0; r < 16; ++r) S0[r] = __builtin_amdgcn_exp2f(S0[r]); } while (0)
#define SP_EXP1() do { _Pragma("unroll") for (int r = 0; r < 16; ++r) S1[r] = __builtin_amdgcn_exp2f(S1[r]); } while (0)
#define SP_SUM() do { float ps = 0.f; _Pragma("unroll") for (int r = 0; r < 16; ++r) ps += S0[r]; _Pragma("unroll") for (int r = 0; r < 16; ++r) ps += S1[r]; \
      l_reg = resc ? l_reg * resf + ps : l_reg + ps; } while (0)
#define SP_PACK() do { u32x4 w0_ = {cvtpk(S0[0], S0[1]), cvtpk(S0[2], S0[3]), cvtpk(S0[4], S0[5]), cvtpk(S0[6], S0[7])}; pb0 = __builtin_bit_cast(bf16x8, w0_); \
      u32x4 w1_ = {cvtpk(S0[8], S0[9]), cvtpk(S0[10], S0[11]), cvtpk(S0[12], S0[13]), cvtpk(S0[14], S0[15])}; pb1 = __builtin_bit_cast(bf16x8, w1_); \
      u32x4 w2_ = {cvtpk(S1[0], S1[1]), cvtpk(S1[2], S1[3]), cvtpk(S1[4], S1[5]), cvtpk(S1[6], S1[7])}; pb2 = __builtin_bit_cast(bf16x8, w2_); \
      u32x4 w3_ = {cvtpk(S1[8], S1[9]), cvtpk(S1[10], S1[11]), cvtpk(S1[12], S1[13]), cvtpk(S1[14], S1[15])}; pb3 = __builtin_bit_cast(bf16x8, w3_); } while (0)
#define SP_RESC() do { if (resc) { _Pragma("unroll") for (int d = 0; d < 4; ++d) _Pragma("unroll") for (int r = 0; r < 16; ++r) o[d][r] *= resf; } } while (0)
#define SP_ROLL() do { pa0 = pb0; pa1 = pb1; pa2 = pb2; pa3 = pb3; } while (0)
  { KRD8(ks_cur); SB0(); QK8(); SB0(); MB_DMA_K(0); MB_DMA_V0(0); MB_DMA_V1(0);
    SP_PRELUDE(0); SP_EXP0(); SP_EXP1(); SP_SUM(); SP_PACK(); SP_ROLL();
    SB0(); TAILWAIT(0); PP_BAR(); ROT3(); }
#pragma clang loop unroll(disable)
  for (int t = 1; t < NT; ++t) {
    const lptr Vt = Vr + vs_prev * 16384 + vbase;
    if (PP_PRIO == 1) __builtin_amdgcn_s_setprio(1);
    KRD8(ks_cur); VRD8(0, a0, a1, a2, a3, a4, a5, a6, a7); SB0();
    QK8(); SB0();
    PV4(0, a0, a1, a2, a3, a4, a5, a6, a7); SB0(); MB_DMA_K(t); VRD8(1, a0, a1, a2, a3, a4, a5, a6, a7); SB0();
    SP_PRELUDE(t); SP_EXP0(); SB0();
    PV4(1, a0, a1, a2, a3, a4, a5, a6, a7); SB0(); MB_DMA_V0(t); VRD8(2, a0, a1, a2, a3, a4, a5, a6, a7); SB0();
    SP_EXP1(); SB0();
    PV4(2, a0, a1, a2, a3, a4, a5, a6, a7); SB0(); MB_DMA_V1(t); VRD8(3, a0, a1, a2, a3, a4, a5, a6, a7); SB0();
    SP_SUM(); SB0();
    PV4(3, a0, a1, a2, a3, a4, a5, a6, a7); SB0();
    if (PP_PRIO == 1) __builtin_amdgcn_s_setprio(0);
    SP_PACK(); SP_RESC(); SP_ROLL();
    SB0(); TAILWAIT(t); PP_BAR(); ROT3();
  }
  { const lptr Vt = Vr + vs_prev * 16384 + vbase;
    VRD8(0, a0, a1, a2, a3, a4, a5, a6, a7); SB0(); PV4(0, a0, a1, a2, a3, a4, a5, a6, a7); SB0(); VRD8(1, a0, a1, a2, a3, a4, a5, a6, a7); SB0(); PV4(1, a0, a1, a2, a3, a4, a5, a6, a7); SB0();
    VRD8(2, a0, a1, a2, a3, a4, a5, a6, a7); SB0(); PV4(2, a0, a1, a2, a3, a4, a5, a6, a7); SB0(); VRD8(3, a0, a1, a2, a3, a4, a5, a6, a7); SB0(); PV4(3, a0, a1, a2, a3, a4, a5, a6, a7); SB0();
    PP_BAR(); }
#undef SP_PRELUDE
#undef SP_EXP0
#undef SP_EXP1
#undef SP_SUM
#undef SP_PACK
#undef SP_RESC
#undef SP_ROLL
#else
  { if (!PP_DMA_IN_M && !(PP_DMA_LATE && GRP == 0)) { DMA_ISSUE(0); SB0(); }
    if (PP_PREF == 3) { KRD4A(ks_cur); SB0(); } else if (PP_PREF != 0) { PREF(true, false, ks_cur, 0); SB0(); }
    if (GRP == 0) MBLOCK(true, false, 0);
    if (!PP_DMA_IN_M && PP_DMA_LATE && GRP == 0) { SB0(); DMA_ISSUE(0); }
    SB0(); if (PP_PREF == 1 || PP_PREF == 2) TAILWAIT(0); PP_MID();
    if (GRP == 0) { if (PP_PREF == 1) { PREF(1 < NT, true, NXT3(ks_cur), NXT3(vs_prev)); SB0(); } VBLOCK(0); if (PP_PREF == 2) { SB0(); PREF(1 < NT, true, NXT3(ks_cur), NXT3(vs_prev)); } } else { if (PP_PREF == 4) { KRD8(ks_cur); SB0(); } MBLOCK(true, false, 0); }
    SB0(); if (PP_PREF == 0 || PP_PREF == 3 || PP_PREF == 4) TAILWAIT(0); PP_BAR(); ROT3(); }
#pragma clang loop unroll(disable)
  for (int t = 1; t < NT; ++t) {
    DP_T(0);
    if (!PP_DMA_IN_M && !(PP_DMA_LATE && GRP == 0)) { DMA_ISSUE(t); SB0(); }
    if (GRP == 0) MBLOCK(true, true, t); else { if (PP_PREF == 4) { KRD8(ks_cur); SB0(); } if (PP_PREF == 1) { PREF(true, true, ks_cur, vs_prev); SB0(); } VBLOCK(t - 1); if (PP_PREF == 2) { SB0(); PREF(true, true, ks_cur, vs_prev); } }
    if (!PP_DMA_IN_M && PP_DMA_LATE && GRP == 0) { SB0(); DMA_ISSUE(t); }
    SB0(); if (PP_PREF == 1 || PP_PREF == 2) TAILWAIT(t); DP_T(1); PP_MID(); DP_T(2);
    if (GRP == 0) { if (PP_PREF == 1) { PREF(t + 1 < NT, true, NXT3(ks_cur), NXT3(vs_prev)); SB0(); } VBLOCK(t); if (PP_PREF == 2) { SB0(); PREF(t + 1 < NT, true, NXT3(ks_cur), NXT3(vs_prev)); } } else MBLOCK(true, true, t);
    SB0(); if (PP_PREF == 0 || PP_PREF == 3 || PP_PREF == 4) TAILWAIT(t); DP_T(3); PP_BAR(); DP_T(4); ROT3();
  }
  { if (GRP == 0) MBLOCK(false, true, NT); else { if (PP_PREF == 1) { PREF(false, true, 0, vs_prev); SB0(); } VBLOCK(NT - 1); if (PP_PREF == 2) { SB0(); PREF(false, true, 0, vs_prev); } }
    PP_MID();
    if (GRP == 1) MBLOCK(false, true, NT);
    PP_BAR(); }
#endif
#if defined(DPROBE)
  if (dp_on && lane == 0) atomicAdd(dbg, (unsigned)(dp_acc >> 4));
#endif
  l_out = l_reg;
#undef DMA_K
#undef DMA_V
#undef MBLOCK
#undef MB_DMA_K
#undef MB_DMA_V0
#undef MB_DMA_V1
#undef VBLOCK
#undef SB0
#undef VRD8
#undef PV4
#undef KRD8
#undef KRD4A
#undef KRD4B
#undef QK8
#undef ROT3
#undef TAILWAIT
#undef PREF
#undef NXT3
#undef DMA_ISSUE
}
constexpr int DA_LDS_OST = 0, DA_LDS_TOTAL = PP_BYTES;
__device__ __forceinline__ void da_unit(size_t rowbase, int T, int h, int qb, const bf16_t* Q, const bf16_t* K, const bf16_t* V, bf16_t* O, float* park, unsigned lam_bits, float outscale,
                                        const float* __restrict__ subg, const unsigned* kmaxp, lptr lds, int tid, int wid, int lane, unsigned* dbg = nullptr, int variant = 0) {
  const int NT = T / 64;
  const size_t qrow = rowbase + (size_t)qb * 256 + wid * 32;
  f32x16 o[4]; float l_reg;
#pragma clang loop unroll(disable)
  for (int sub = 0; sub < 2; ++sub) {
    asm volatile("" : "+v"(tid)); lane = tid & 63;
    const int r32 = lane & 31, hi = lane >> 5;
    ATT_LAS float* li_l = (ATT_LAS float*)(lds + PP_WS) + wid * 64;
    const float kmax2 = __uint_as_float(__builtin_nontemporal_load(kmaxp + 2 * h + sub));
    if (wid < 4) da_pass_pp<0>(Q + (qrow + r32) * PITCH + (2 * h + sub) * 64 + hi * 8, K + rowbase * PITCH + (2 * h + sub) * 64, V + rowbase * PITCH + h * 128, NT, lds, wid, lane, kmax2, o, l_reg, dbg, variant);
    else da_pass_pp<1>(Q + (qrow + r32) * PITCH + (2 * h + sub) * 64 + hi * 8, K + rowbase * PITCH + (2 * h + sub) * 64, V + rowbase * PITCH + h * 128, NT, lds, wid, lane, kmax2, o, l_reg, dbg, variant);
    { auto rr = __builtin_amdgcn_permlane32_swap(__float_as_uint(l_reg), __float_as_uint(l_reg), false, false); l_reg = __uint_as_float(rr[0]) + __uint_as_float(rr[1]); }
    const float rl = __builtin_amdgcn_rcpf(l_reg);
    f32x4* pk = (f32x4*)(park + ((size_t)wid * 64 + lane) * 64);
    if (sub == 0) {
#pragma unroll
      for (int d0 = 0; d0 < 4; ++d0)
#pragma unroll
        for (int q = 0; q < 4; ++q) { f32x4 v; v[0] = o[d0][4 * q] * rl; v[1] = o[d0][4 * q + 1] * rl; v[2] = o[d0][4 * q + 2] * rl; v[3] = o[d0][4 * q + 3] * rl; pk[d0 * 4 + q] = v; }
    } else {
      const float rll = rl * __uint_as_float(lam_bits); float ss = 0.f;
#pragma unroll
      for (int d0 = 0; d0 < 4; ++d0)
#pragma unroll
        for (int q = 0; q < 4; ++q) { const f32x4 p = pk[d0 * 4 + q];
#pragma unroll
          for (int j = 0; j < 4; ++j) { const float v = p[j] - o[d0][4 * q + j] * rll; o[d0][4 * q + j] = v; ss += v * v; } }
      { auto rr = __builtin_amdgcn_permlane32_swap(__float_as_uint(ss), __float_as_uint(ss), false, false); ss = __uint_as_float(rr[0]) + __uint_as_float(rr[1]); }
      const float rstd = __builtin_amdgcn_rsqf(ss * (1.0f / 128.0f) + 1e-5f) * outscale;
      ATT_LAS bf16_t* stg = (ATT_LAS bf16_t*)(lds + DA_LDS_OST) + wid * 4096;
#pragma unroll
      for (int d0 = 0; d0 < 4; ++d0)
#pragma unroll
        for (int q = 0; q < 4; ++q) { const f32x4 gv = *(const f32x4*)(subg + d0 * 32 + 8 * q + 4 * hi);
          typedef unsigned u32x2v __attribute__((ext_vector_type(2))); u32x2v w;
          w.x = cvtpk(o[d0][4 * q] * rstd * gv[0], o[d0][4 * q + 1] * rstd * gv[1]); w.y = cvtpk(o[d0][4 * q + 2] * rstd * gv[2], o[d0][4 * q + 3] * rstd * gv[3]);
          *(ATT_LAS u32x2v*)(stg + r32 * 128 + d0 * 32 + 8 * q + 4 * hi) = w; }
      asm volatile("s_waitcnt lgkmcnt(0)" ::: "memory");
      bf16_t* Ow = O + qrow * PITCH + h * 128;
#pragma unroll
      for (int i = 0; i < 8; ++i) { const int row = i * 4 + (lane >> 4), ch = lane & 15; const u32x4 v = *(const ATT_LAS u32x4*)(stg + row * 128 + ch * 8); *(u32x4*)(Ow + (size_t)row * PITCH + ch * 8) = v; }
      asm volatile("s_waitcnt lgkmcnt(0)" ::: "memory"); __builtin_amdgcn_s_barrier();
    }
  }
}

constexpr int NA_NS = 4, NA_SLOT = 16384, NA_LDS_B = NA_NS * NA_SLOT, NA_LDS_WS = NA_LDS_B + 2560, NA_LDS_OST = NA_LDS_WS + 8 * 256, NA_LDS_BYTES = NA_LDS_OST + 8 * 4096, NA_BPAD = 64;
template <int D0, int KS0, int KS1> __device__ __forceinline__ void pv_ks(f32x16& od, int vb, bf16x8 pa0, bf16x8 pa1, bf16x8 pa2, bf16x8 pa3) {
  s16x4 l[4], h[4];
#pragma unroll
  for (int ks = 0; ks < 4; ++ks) if (ks >= KS0 && ks <= KS1) {
      asm volatile("ds_read_b64_tr_b16 %0, %1 offset:%2" : "=&v"(l[ks]) : "v"(vb), "i"(D0 * 512 + ks * 2048) : "memory");
      asm volatile("ds_read_b64_tr_b16 %0, %1 offset:%2" : "=&v"(h[ks]) : "v"(vb), "i"(D0 * 512 + ks * 2048 + 1024) : "memory"); }
  asm volatile("s_waitcnt lgkmcnt(0)" ::: "memory"); SBAR();
#define PK(L, H) (bf16x8){L[0], L[1], L[2], L[3], H[0], H[1], H[2], H[3]}
  if (0 >= KS0 && 0 <= KS1) od = __builtin_amdgcn_mfma_f32_32x32x16_bf16(pa0, PK(l[0], h[0]), od, 0, 0, 0);
  if (1 >= KS0 && 1 <= KS1) od = __builtin_amdgcn_mfma_f32_32x32x16_bf16(pa1, PK(l[1], h[1]), od, 0, 0, 0);
  if (2 >= KS0 && 2 <= KS1) od = __builtin_amdgcn_mfma_f32_32x32x16_bf16(pa2, PK(l[2], h[2]), od, 0, 0, 0);
  if (3 >= KS0 && 3 <= KS1) od = __builtin_amdgcn_mfma_f32_32x32x16_bf16(pa3, PK(l[3], h[3]), od, 0, 0, 0);
#undef PK
}
template <int H>
__device__ __forceinline__ void na_tiles(size_t tok0, int rows, int h, int R, int qrow, const bf16_t* Q, const bf16_t* K, const bf16_t* V, bf16_t* O, lptr lds, int tid, int wid, int lane) {
  const int r32 = lane & 31, hi = lane >> 5;
  ATT_LAS float* bias = (ATT_LAS float*)(lds + NA_LDS_B);
  ATT_LAS float* li_l = (ATT_LAS float*)(lds + NA_LDS_WS) + wid * 64; ATT_LAS float* al_l = li_l + 32;
  const int c = 32 * H + r32;
  const int c0 = min(max(c - 8, 0), 48), tmask = 4 * hi - c0;
  const int rlo_w = min(max(qrow - 4, 0), rows - 8);
  const int kr_lo = min(max(R - 4, 0), rows - 8), kr_hi = min(max(R + 3 - 4, 0), rows - 8) + 7, nt = kr_hi - kr_lo + 1;
  const size_t qtok = tok0 + (size_t)qrow * 64 + c;
  bf16x8 qr[4];
#pragma unroll
  for (int d0 = 0; d0 < 4; ++d0) qr[d0] = *(const bf16x8*)(Q + qtok * PITCH + h * 64 + d0 * 16 + hi * 8);
  const int vb0 = (int)(unsigned)(uintptr_t)lds + v_rd_base(lane);
  const bf16_t* ksrc = K + (tok0 + (size_t)(lane ^ wid)) * PITCH + h * 64 + wid * 8;
  const bf16_t* vsrc;
  { const int j = lane & 31, kk = wid * 8 + (j >> 2), col = (lane >> 5) * 32 + (j & 3) * 8, k = (kk & ~0xC) | ((kk & 4) << 1) | ((kk & 8) >> 1); vsrc = V + (tok0 + (size_t)k) * PITCH + h * 64 + col; }
#define NDMA(row, slot) do { __builtin_amdgcn_global_load_lds((const unsigned*)(vsrc + (size_t)(row) * 64 * PITCH), (ATT_LAS unsigned*)(lds + (slot) * NA_SLOT + wid * 1024), 16, 0, 0); \
                             __builtin_amdgcn_global_load_lds((const unsigned*)(ksrc + (size_t)(row) * 64 * PITCH), (ATT_LAS unsigned*)(lds + (slot) * NA_SLOT + 8192 + wid * 1024), 16, 0, 0); } while (0)
#define NBAR() do { __builtin_amdgcn_sched_barrier(0); asm volatile("s_waitcnt lgkmcnt(0)" ::: "memory"); __builtin_amdgcn_s_barrier(); __builtin_amdgcn_sched_barrier(0); } while (0)
  float mref = 0.f, l_reg = 0.f; f32x16 o[2]; o[0] = f32x16{}; o[1] = f32x16{};
  asm volatile("" :: "v"(qr[0]), "v"(qr[1]), "v"(qr[2]), "v"(qr[3]));
  NDMA(kr_lo, 0); if (1 < nt) NDMA(kr_lo + 1, 1); if (2 < nt) NDMA(kr_lo + 2, 2);
  int slot = 0;
  for (int t = 0; t < nt; ++t) {
    const int krow = kr_lo + t;
    if (t + 2 < nt) asm volatile("s_waitcnt vmcnt(4)" ::: "memory"); else if (t + 1 < nt) asm volatile("s_waitcnt vmcnt(2)" ::: "memory"); else asm volatile("s_waitcnt vmcnt(0)" ::: "memory");
    NBAR();
    if (t + 3 < nt) NDMA(krow + 3, (slot + 3) & 3);
    __builtin_amdgcn_sched_barrier(0);
    if (krow >= rlo_w && krow < rlo_w + 8) {
      f32x16 p0, p1; qkt(p0, p1, lds + slot * NA_SLOT + 8192, qr, r32, hi);
      const int bofs = NA_BPAD + (krow - qrow + 7) * 31 + 15 - c + 4 * hi;
#define BM(P, r, koffc) do { const int kcol = ((r) & 3) + 8 * ((r) >> 2) + (koffc); float bv_ = bias[bofs + kcol]; asm volatile("" : "+v"(bv_));   \
        P[r] = ((unsigned)(kcol + tmask) < 16u) ? P[r] + bv_ : -INFINITY; } while (0)
      float pm;
      if (H == 0) {
#pragma unroll
        for (int r = 0; r < 16; ++r) BM(p0, r, 0);
#pragma unroll
        for (int r = 0; r < 4; ++r) BM(p1, r, 32);
        pm = p0[0];
#pragma unroll
        for (int r = 1; r < 16; ++r) pm = fmaxf(pm, p0[r]);
#pragma unroll
        for (int r = 0; r < 4; ++r) pm = fmaxf(pm, p1[r]);
      } else {
#pragma unroll
        for (int r = 12; r < 16; ++r) BM(p0, r, 0);
#pragma unroll
        for (int r = 0; r < 16; ++r) BM(p1, r, 32);
        pm = p1[0];
#pragma unroll
        for (int r = 1; r < 16; ++r) pm = fmaxf(pm, p1[r]);
#pragma unroll
        for (int r = 12; r < 16; ++r) pm = fmaxf(pm, p0[r]);
      }
#undef BM
      { auto rr = __builtin_amdgcn_permlane32_swap(__float_as_uint(pm), __float_as_uint(pm), false, false); pm = fmaxf(__uint_as_float(rr[0]), __uint_as_float(rr[1])); }
      const bool first = krow == rlo_w;
      if (first || __any(pm - mref > THRL)) { const float mn = first ? pm : fmaxf(pm, mref);
        if (!first) { const float f = __builtin_amdgcn_exp2f(mref - mn); l_reg *= f; if (hi == 0) al_l[r32] = f; asm volatile("s_waitcnt lgkmcnt(0)" ::: "memory");
#pragma unroll
          for (int r = 0; r < 16; ++r) { const float a = al_l[crow(r, hi)]; o[0][r] *= a; o[1][r] *= a; } }
        mref = mn; }
      float ps = 0.f;
      if (H == 0) {
#pragma unroll
        for (int r = 0; r < 16; ++r) { p0[r] = __builtin_amdgcn_exp2f(p0[r] - mref); ps += p0[r]; }
#pragma unroll
        for (int r = 0; r < 4; ++r) { p1[r] = __builtin_amdgcn_exp2f(p1[r] - mref); ps += p1[r]; }
#pragma unroll
        for (int r = 4; r < 8; ++r) p1[r] = 0.f;
      } else {
#pragma unroll
        for (int r = 12; r < 16; ++r) { p0[r] = __builtin_amdgcn_exp2f(p0[r] - mref); ps += p0[r]; }
#pragma unroll
        for (int r = 0; r < 16; ++r) { p1[r] = __builtin_amdgcn_exp2f(p1[r] - mref); ps += p1[r]; }
#pragma unroll
        for (int r = 8; r < 12; ++r) p0[r] = 0.f;
      }
      { auto rr = __builtin_amdgcn_permlane32_swap(__float_as_uint(ps), __float_as_uint(ps), false, false); ps = __uint_as_float(rr[0]) + __uint_as_float(rr[1]); }
      l_reg += ps;
      bf16x8 pa0 = bf16x8{}, pa1, pa2, pa3 = bf16x8{};
#define PK4(P, BASE, OUT) do { unsigned a0 = cvtpk(P[BASE + 0], P[BASE + 1]), a1 = cvtpk(P[BASE + 2], P[BASE + 3]);   \
    unsigned b0 = cvtpk(P[BASE + 4], P[BASE + 5]), b1 = cvtpk(P[BASE + 6], P[BASE + 7]);                              \
    auto r0 = __builtin_amdgcn_permlane32_swap(a0, b0, false, false); auto r1 = __builtin_amdgcn_permlane32_swap(a1, b1, false, false); \
    u32x4 w = {r0[0], r1[0], r0[1], r1[1]}; OUT = __builtin_bit_cast(bf16x8, w); } while (0)
      const int vb = vb0 + slot * NA_SLOT;
      if (H == 0) { PK4(p0, 0, pa0); PK4(p0, 8, pa1); PK4(p1, 0, pa2); pv_ks<0, 0, 2>(o[0], vb, pa0, pa1, pa2, pa3); pv_ks<1, 0, 2>(o[1], vb, pa0, pa1, pa2, pa3); }
      else        { PK4(p0, 8, pa1); PK4(p1, 0, pa2); PK4(p1, 8, pa3); pv_ks<0, 1, 3>(o[0], vb, pa0, pa1, pa2, pa3); pv_ks<1, 1, 3>(o[1], vb, pa0, pa1, pa2, pa3); }
#undef PK4
    }
    slot = (slot + 1) & 3;
  }
#undef NDMA
  if (hi == 0) li_l[r32] = l_reg; asm volatile("s_waitcnt lgkmcnt(0)" ::: "memory");
  ATT_LAS bf16_t* stg = (ATT_LAS bf16_t*)(lds + NA_LDS_OST) + wid * 2048;
#pragma unroll
  for (int r = 0; r < 16; ++r) { const int orow = crow(r, hi); const float rl = __builtin_amdgcn_rcpf(li_l[orow]);
#pragma unroll
    for (int d0 = 0; d0 < 2; ++d0) { const unsigned w = cvtpk(o[d0][r] * rl, 0.f); stg[orow * 64 + d0 * 32 + r32] = (bf16_t)(w & 0xffffu); } }
  asm volatile("s_waitcnt lgkmcnt(0)" ::: "memory");
  bf16_t* Ow = O + (tok0 + (size_t)qrow * 64 + 32 * H) * PITCH + h * 64;
#pragma unroll
  for (int i = 0; i < 4; ++i) { const int row = i * 8 + (lane >> 3), ch = lane & 7; const u32x4 v = *(const ATT_LAS u32x4*)(stg + row * 64 + ch * 8); *(u32x4*)(Ow + (size_t)row * PITCH + ch * 8) = v; }
  NBAR();
#undef NBAR
}
__device__ __forceinline__ void na_unit(size_t tok0, int rows, int h, int R, const bf16_t* Q, const bf16_t* K, const bf16_t* V, bf16_t* O, const float* __restrict__ rpb_h,
                                        lptr lds, int tid, int wid, int lane) {
  asm volatile("" : "+v"(tid)); lane = tid & 63;
  ATT_LAS float* bias = (ATT_LAS float*)(lds + NA_LDS_B);
  for (int i = tid; i < 465; i += 512) bias[NA_BPAD + i] = rpb_h[i] * 1.4426950408889634f;
  const int qrow = R + (wid >> 1);
  if ((wid & 1) == 0) na_tiles<0>(tok0, rows, h, R, qrow, Q, K, V, O, lds, tid, wid, lane);
  else                na_tiles<1>(tok0, rows, h, R, qrow, Q, K, V, O, lds, tid, wid, lane);
}
#undef SBAR
}

#define XB_TMO      128
#define XB_XCNT(j)  (256  + 64 * (j))
#define XB_XSUB(j)  (1280 + 64 * (j))
#define XB_XGEN(j)  (2304 + 64 * (j))
#define XB_TOP      3328
#define XB_TOPGEN   3392
#define XCD_BAR_WORDS 3456
#define XB_SPIN_CAP (1u << 18)

__device__ __forceinline__ unsigned xb_ld(unsigned* p)              { return __hip_atomic_load(p, __ATOMIC_RELAXED, __HIP_MEMORY_SCOPE_AGENT); }
__device__ __forceinline__ unsigned xb_add(unsigned* p, unsigned v) { return __hip_atomic_fetch_add(p, v, __ATOMIC_RELAXED, __HIP_MEMORY_SCOPE_AGENT); }
__device__ __forceinline__ unsigned xb_xcc_id() { return (unsigned)__builtin_amdgcn_s_getreg((3 << 11) | 20) & 0xFu; }
#define XB_SPIN(cond, bar) do { unsigned _sp = 0; while (cond) { __builtin_amdgcn_s_sleep(1); \
    if ((++_sp & 255u) == 0u) { if (xb_ld(&(bar)[XB_TMO])) break; if (_sp > XB_SPIN_CAP) { atomicAdd(&(bar)[XB_TMO], 1u); break; } } } } while (0)

struct XcdBarrier {
    unsigned* bar; unsigned x; int w;
    volatile LAS unsigned* st;
};

__device__ __forceinline__ XcdBarrier xcd_barrier_post(unsigned* bar, volatile LAS unsigned* st) {
    XcdBarrier b; b.bar = bar; b.x = xb_xcc_id(); b.st = st; b.w = __builtin_amdgcn_readfirstlane((int)threadIdx.x >> 6);
    if (threadIdx.x == 0) (void)xb_add(&bar[XB_XCNT(b.x)], 1u);
    return b;
}
__device__ __forceinline__ void xcd_barrier_complete(unsigned* bar, unsigned x, unsigned& nloc, unsigned& nx) {
    const unsigned G = gridDim.x * gridDim.y * gridDim.z;
    unsigned sum, cnt, mine, sp = 0u;
    for (;;) {
        sum = 0u; cnt = 0u; mine = 0u;
#pragma unroll
        for (unsigned j = 0; j < 16; ++j) { const unsigned c = xb_ld(&bar[XB_XCNT(j)]); sum += c; cnt += (c > 0u) ? 1u : 0u; mine = (j == x) ? c : mine; }
        if (sum == G) break;
        __builtin_amdgcn_s_sleep(1);
        if ((++sp & 255u) == 0u) { if (xb_ld(&bar[XB_TMO])) break; if (sp > XB_SPIN_CAP) { atomicAdd(&bar[XB_TMO], 1u); break; } }
    }
    nloc = mine > 0u ? mine : 1u; nx = cnt > 0u ? cnt : 1u;
}

__device__ __forceinline__ void xcd_barrier(const XcdBarrier& b) {
    asm volatile("s_waitcnt vmcnt(0)" ::: "memory");
    __syncthreads();
    if (b.w == 0 && LANE_ID() == 0) {
        unsigned* bar = b.bar;
        __builtin_amdgcn_s_waitcnt(0);
        unsigned nloc = b.st[0], nx = b.st[1];
        if (nloc == 0u) { xcd_barrier_complete(bar, b.x, nloc, nx); b.st[0] = nloc; b.st[1] = nx; }
        const unsigned old = xb_add(&bar[XB_XSUB(b.x)], 1u);
        const unsigned gen = old / nloc;
        if (old + 1u == (gen + 1u) * nloc) {
            __builtin_amdgcn_fence(__ATOMIC_RELEASE, "agent");
            asm volatile("s_waitcnt vmcnt(0)" ::: "memory");
            const unsigned og = xb_add(&bar[XB_TOP], 1u);
            const unsigned tg = og / nx;
            if (og + 1u == (tg + 1u) * nx) xb_add(&bar[XB_TOPGEN], 1u);
            else XB_SPIN(xb_ld(&bar[XB_TOPGEN]) == tg, bar);
            __builtin_amdgcn_fence(__ATOMIC_ACQUIRE, "agent");
            xb_add(&bar[XB_XGEN(b.x)], 1u);
            asm volatile("s_waitcnt vmcnt(0)" ::: "memory");
        } else {
            XB_SPIN(xb_ld(&bar[XB_XGEN(b.x)]) == gen, bar);
            __builtin_amdgcn_fence(__ATOMIC_ACQUIRE, "agent");
            asm volatile("s_waitcnt vmcnt(0)" ::: "memory");
        }
    }
    __syncthreads();
}

constexpr int NWAVES = 8;
#ifndef PG8_ALIGN_PLAIN
#define PG8_ALIGN_PLAIN true
#endif
#ifndef FUSE_THIN
#define FUSE_THIN 0
#endif
#ifndef MK_PER_PHASE
#define MK_PER_PHASE 0
#endif
constexpr int NPH = 15;

constexpr size_t MiB = 1u << 20;
constexpr size_t WS_CTL = 0, CTL_ZERO_BYTES = 1 * MiB;
constexpr size_t WS_ROPE_C = 1 * MiB, WS_ROPE_S = 2 * MiB, WS_RS = 3 * MiB;
constexpr size_t WS_WQKV0 = 4 * MiB, WS_WO0 = 10 * MiB, WS_WIN0 = 12 * MiB, WS_WOUT0 = 23 * MiB;
constexpr size_t WS_WQKV1 = 29 * MiB, WS_WO1 = 35 * MiB, WS_WIN1 = 37 * MiB, WS_WOUT1 = 48 * MiB;
constexpr size_t WS_XN = 56 * MiB;
constexpr size_t WS_Q = 218 * MiB, WS_K = 378 * MiB, WS_V = 538 * MiB;
constexpr size_t WS_G = 218 * MiB;
constexpr size_t WS_MB = 698 * MiB;
constexpr size_t WS_PARK = 858 * MiB;
constexpr size_t WS_END = 896 * MiB;
static_assert(WS_WOUT1 + (size_t)D * FF * 2 <= WS_XN - 4096 && WS_XN + (size_t)(NMT_CONV * 254 + 2) * D * 2 <= WS_Q && WS_G + (size_t)M * FF * 2 <= WS_MB && WS_MB + (size_t)M * D * 2 <= WS_PARK, "d_ws map");
constexpr int CW_PANEL = 16384, PANEL_BANK = 320 * 64;
constexpr int CW_TP = 8000;
constexpr int CW_KMAX = 8192;
constexpr int CW_BAR = 4096;

constexpr int RING_OFF = 0, RING_BYTES = 131072;
constexpr int LDSCTL_OFF = RING_BYTES, MISC_OFF = LDSCTL_OFF + 320;
constexpr int XCH_OFF = RING_BYTES + 1024;
constexpr int LDS_BYTES = 147456;
static_assert(XCH_OFF + 8192 + 4096 <= LDS_BYTES && att::DA_LDS_TOTAL <= RING_BYTES && att::NA_LDS_BYTES <= RING_BYTES, "LDS map");

__device__ __forceinline__ void p0_transpose_item(const float* W, int K, int N, bf16* WT, int k0, int n0, int drow0, const float* gk, LAS float* scr, int lane) {
#pragma unroll 8
    for (int i = 0; i < 32; ++i) { const int kk = 2 * i + (lane >> 5); float w = W[(size_t)(k0 + kk) * N + n0 + (lane & 31)]; if (gk) w *= gk[k0 + kk]; scr[kk * 33 + (lane & 31)] = w; }
    LDS_WAIT(); asm volatile("" ::: "memory");
    const int c = lane & 7;
#pragma unroll
    for (int j = 0; j < 4; ++j) { const int n = (lane >> 3) + 8 * j; const LAS float* s = scr + (8 * c) * 33 + n;
        v4u o; o.x = pk2(s[0 * 33], s[1 * 33]); o.y = pk2(s[2 * 33], s[3 * 33]); o.z = pk2(s[4 * 33], s[5 * 33]); o.w = pk2(s[6 * 33], s[7 * 33]);
        *(GAS v4u*)(WT + (size_t)(drow0 + n) * K + k0 + 8 * c) = o; }
    LDS_WAIT(); asm volatile("" ::: "memory");
}
__device__ __forceinline__ void p0_matrix(const float* W, int K, int N, bf16* WT, const float* gk, int mode, int roff, LAS float* scr, int gw, int NGW, int lane) {
    const int nblk = N / 32, nitems = (K / 64) * nblk;
    for (int it = gw; it < nitems; it += NGW) {
        const int kb = it / nblk, nb = it % nblk, n0 = 32 * nb; int drow0;
        if (mode == 0) drow0 = roff + n0;
        else if (mode == 1) { const int bj = n0 >= FF ? 1 : 0, ch = n0 - bj * FF; drow0 = (ch >> 7) * 256 + bj * 128 + (ch & 127); }
        else { const int s = n0 >> 6, half = (n0 >> 5) & 1; drow0 = roff + (s >> 2) * 256 + half * 128 + (s & 3) * 32; }
        p0_transpose_item(W, K, N, WT, 64 * kb, n0, drow0, gk, scr, lane);
    }
}
__device__ __forceinline__ void sincos_small(double x, double& s, double& c) {
    const double x2 = x * x;
    double a = -1.0 / 25852016738884976640000.0;
    a = a * x2 + 1.0 / 51090942171709440000.0;
    a = a * x2 - 1.0 / 121645100408832000.0;
    a = a * x2 + 1.0 / 355687428096000.0;
    a = a * x2 - 1.0 / 1307674368000.0;
    a = a * x2 + 1.0 / 6227020800.0;
    a = a * x2 - 1.0 / 39916800.0;
    a = a * x2 + 1.0 / 362880.0;
    a = a * x2 - 1.0 / 5040.0;
    a = a * x2 + 1.0 / 120.0;
    a = a * x2 - 1.0 / 6.0;
    a = a * x2 + 1.0;
    s = a * x;
    double b = 1.0 / 620448401733239439360000.0;
    b = b * x2 - 1.0 / 1124000727777607680000.0;
    b = b * x2 + 1.0 / 2432902008176640000.0;
    b = b * x2 - 1.0 / 6402373705728000.0;
    b = b * x2 + 1.0 / 20922789888000.0;
    b = b * x2 - 1.0 / 87178291200.0;
    b = b * x2 + 1.0 / 479001600.0;
    b = b * x2 - 1.0 / 3628800.0;
    b = b * x2 + 1.0 / 40320.0;
    b = b * x2 - 1.0 / 720.0;
    b = b * x2 + 1.0 / 24.0;
    b = b * x2 - 0.5;
    b = b * x2 + 1.0;
    c = b;
}
struct Args { const float* in[22]; float* out; unsigned char* ws; int ph_lo, ph_hi; };
__global__ void __launch_bounds__(NWAVES * 64, 2) mega_fwd(Args args) {
    extern __shared__ __attribute__((aligned(16))) unsigned char lds_raw[];
    LAS unsigned char* lds = (LAS unsigned char*)lds_raw;
    volatile LAS unsigned* MISC = (volatile LAS unsigned*)(lds + MISC_OFF);
    const int wave = __builtin_amdgcn_readfirstlane((int)threadIdx.x >> 6);
#define lane LANE_ID()
#define tid (wave * 64 + LANE_ID())
    const int G = gridDim.x, bx = blockIdx.x, vcu = (G % 8 == 0) ? (bx % 8) * (G / 8) + bx / 8 : bx;
    const int gw = vcu * NWAVES + wave, NGW = G * NWAVES;
    unsigned char* ws = args.ws;
    gu32* ctl = (gu32*)(ws + WS_CTL);
    for (int u = tid; u < (LDS_BYTES - LDSCTL_OFF) / 4; u += NWAVES * 64) ((LAS unsigned*)(lds + LDSCTL_OFF))[u] = 0u;
    __syncthreads();
    XcdBarrier bar; bar.bar = (unsigned*)(ctl + CW_BAR); bar.x = 0; bar.st = nullptr; bar.w = wave;
    if (!MK_PER_PHASE) bar = xcd_barrier_post((unsigned*)(ctl + CW_BAR), MISC + 8);
#if defined(BPROBE)
    unsigned long long bp_acc = 0; int bp_k = 0;
#define GRID_BAR() do { const unsigned long long t_ = __builtin_amdgcn_s_memrealtime(); xcd_barrier(bar); if (bp_k >= BPROBE_LO && bp_k < BPROBE_HI) bp_acc += __builtin_amdgcn_s_memrealtime() - t_; ++bp_k; } while (0)
#else
#define GRID_BAR() do { if (!MK_PER_PHASE) xcd_barrier(bar); } while (0)
#endif
    const int lo = args.ph_lo, hi = args.ph_hi;
#ifndef PH_MASK
#define PH_MASK 0x7fff
#endif
#define IN(k) (((PH_MASK >> (k)) & 1) && lo <= (k) && (k) < hi)
#define BOTH(k) (IN(k) && IN((k) + 1))
#ifndef PROBE_DUP
#define PROBE_DUP -1
#endif
#define REPS(k) (((k) == PROBE_DUP) ? 2 : 1)

#if defined(GPROBE)
#define GP_ARG(k) ((k) == GPROBE_PHASE ? (unsigned*)(ctl + CW_TP) : (unsigned*)nullptr)
#else
#define GP_ARG(k) ((unsigned*)nullptr)
#endif
#if defined(DPROBE)
#define DP_ARG ((unsigned*)(ctl + CW_TP))
#else
#define DP_ARG ((unsigned*)nullptr)
#endif
#if defined(PPROBE)
    unsigned long long pp_t0 = 0, pp_t1 = 0;
#define PP_BEGIN(k) do { if ((k) == PPROBE) pp_t0 = __builtin_amdgcn_s_memrealtime(); } while (0)
#define PP_END(k) do { if ((k) == PPROBE) pp_t1 = __builtin_amdgcn_s_memrealtime(); } while (0)
#else
#define PP_BEGIN(k) do {} while (0)
#define PP_END(k) do {} while (0)
#endif
#if defined(TPROBE)
    unsigned long long tp_c0 = 0, tp_r0 = 0, tp_c1 = 0, tp_r1 = 0;
#define TP_BEGIN(k) do { if ((k) == TPROBE) { tp_c0 = __builtin_amdgcn_s_memtime(); tp_r0 = __builtin_amdgcn_s_memrealtime(); } } while (0)
#define TP_END(k) do { if ((k) == TPROBE) { tp_c1 = __builtin_amdgcn_s_memtime(); tp_r1 = __builtin_amdgcn_s_memrealtime(); } } while (0)
#else
#define TP_BEGIN(k) do {} while (0)
#define TP_END(k) do {} while (0)
#endif
    const float* x_p = args.in[0]; const float* x_s = args.in[1];
    const float* attn_pre_g = args.in[2]; const float* attn_post_g = args.in[3]; const float* ffn_pre_g = args.in[4]; const float* ffn_post_g = args.in[5];
    float* out = args.out;
    bf16* XN = (bf16*)(ws + WS_XN); bf16* QB = (bf16*)(ws + WS_Q); bf16* KB = (bf16*)(ws + WS_K); bf16* VB = (bf16*)(ws + WS_V); bf16* GB = (bf16*)(ws + WS_G); bf16* MB = (bf16*)(ws + WS_MB);
    float* ROPE_C = (float*)(ws + WS_ROPE_C); float* ROPE_S = (float*)(ws + WS_ROPE_S); float* RS = (float*)(ws + WS_RS);
    constexpr size_t TSTEP_D = (size_t)256 * D * 2, TSTEP_FF = (size_t)256 * FF * 2, TSTEP_CONV = (size_t)254 * D * 2;

    if (IN(0)) for (int rep_ = 0; rep_ < REPS(0); ++rep_) { PP_BEGIN(0);
        LAS float* scr = (LAS float*)(lds + RING_OFF + wave * 16384);
        p0_matrix(args.in[6], D, 3 * D, (bf16*)(ws + WS_WQKV0), attn_pre_g, 0, 0, scr, gw, NGW, lane);
        p0_matrix(args.in[8], D, D, (bf16*)(ws + WS_WO0), nullptr, 0, 0, scr, gw, NGW, lane);
        p0_matrix(args.in[18], D, FF2, (bf16*)(ws + WS_WIN0), ffn_pre_g, 1, 0, scr, gw, NGW, lane);
        p0_matrix(args.in[21], FF, D, (bf16*)(ws + WS_WOUT0), nullptr, 0, 0, scr, gw, NGW, lane);
        p0_matrix(args.in[9], D, D, (bf16*)(ws + WS_WQKV1), attn_pre_g + D, 2, 0, scr, gw, NGW, lane);
        p0_matrix(args.in[10], D, D, (bf16*)(ws + WS_WQKV1), attn_pre_g + D, 2, D, scr, gw, NGW, lane);
        p0_matrix(args.in[11], D, D, (bf16*)(ws + WS_WQKV1), attn_pre_g + D, 0, 2 * D, scr, gw, NGW, lane);
        p0_matrix(args.in[17], D, D, (bf16*)(ws + WS_WO1), nullptr, 0, 0, scr, gw, NGW, lane);
        p0_matrix(args.in[18] + (size_t)D * FF2, D, FF2, (bf16*)(ws + WS_WIN1), ffn_pre_g + D, 1, 0, scr, gw, NGW, lane);
        p0_matrix(args.in[21] + (size_t)FF * D, FF, D, (bf16*)(ws + WS_WOUT1), nullptr, 0, 0, scr, gw, NGW, lane);
        for (int i = gw * 64 + lane; i < T_S * 32; i += NGW * 64) {
            const int t = i >> 5, d = i & 31;
            double inv = 1.0; for (int q = 0; q < d; ++q) inv *= 0.7498942093324559;
            const double ang = (double)t * inv;
            const double k = __builtin_rint(ang * 0.15915494309189535);
            double xr = __builtin_fma(-k, 6.283185307179586, ang); xr = __builtin_fma(-k, 2.4492935982947064e-16, xr);
            double s, c; sincos_small(xr, s, c);
            ROPE_C[i] = (float)c; ROPE_S[i] = (float)s;
        }
        thin_pass<0>(x_p, x_s, XN, nullptr, nullptr, RS, nullptr, gw, NGW, lane);
        PP_END(0); if (BOTH(0)) GRID_BAR();
    }
    if (IN(1)) for (int rep_ = 0; rep_ < REPS(1); ++rep_) { PP_BEGIN(1);
        pg8::Gemm g{XN, (const bf16*)(ws + WS_WQKV0), M, 3 * D, D, TSTEP_D}; pg8::StaticOrder S; S.init(M, 3 * D, G, bx);
        pg8::EpiBf16<0> E{QB, D, RS, D, (size_t)(WS_K - WS_Q) / 2, att::QSCALE};
        pg8::gemm_phase<pg8::EpiBf16<0>, pg8::StaticOrder, PG8_ALIGN_PLAIN, true>(lds + RING_OFF, g, S, E, wave, GP_ARG(1));
        PP_END(1); if (BOTH(1)) GRID_BAR();
    }
    if (IN(2)) for (int rep_ = 0; rep_ < REPS(2); ++rep_) { PP_BEGIN(2);
        constexpr int NU_P = 4 * 16 * 16, NU = NU_P + 8 * 16 * 32;
        const int per = (NU + G - 1) / G, u0 = vcu * per, u1 = (u0 + per < NU) ? u0 + per : NU;
        for (int u = u0; u < u1; ++u) {
            size_t tok0; int rows, h, R;
            if (u < NU_P) { const int b = u >> 8, r = u & 255; tok0 = (size_t)b * T_P; rows = 64; h = r >> 4; R = (r & 15) * 4; }
            else { const int v = u - NU_P, b = v >> 9, r = v & 511; tok0 = (size_t)M_P + (size_t)b * T_S; rows = 128; h = r >> 5; R = (r & 31) * 4; }
            __syncthreads();
            att::na_unit(tok0, rows, h, R, QB, KB, VB, MB, args.in[7] + h * 465, (att::lptr)(lds + RING_OFF), tid, wave, lane);
        }
        __syncthreads();
        PP_END(2); if (BOTH(2)) GRID_BAR();
    }
    if (IN(3)) for (int rep_ = 0; rep_ < REPS(3); ++rep_) { PP_BEGIN(3);
        pg8::Gemm g{MB, (const bf16*)(ws + WS_WO0), M, D, D, TSTEP_D}; pg8::StaticOrder S; S.init(M, D, G, bx);
        #if FUSE_THIN
        pg8::EpiThin<1> E{QB, XN, attn_post_g, RS, nullptr, (unsigned*)(ctl + CW_PANEL + 0 * PANEL_BANK), (PG8_LAS unsigned*)(lds + MISC_OFF + 64), D / 256};
        pg8::gemm_phase<pg8::EpiThin<1>, pg8::StaticOrder, true, true>(lds + RING_OFF, g, S, E, wave);
#else
        pg8::EpiBf16<0> E{QB, D, nullptr, 0, 0, 1.f};
        pg8::gemm_phase<pg8::EpiBf16<0>, pg8::StaticOrder, PG8_ALIGN_PLAIN, true>(lds + RING_OFF, g, S, E, wave);
#endif
        PP_END(3); if (BOTH(3)) GRID_BAR();
    }
    if (!FUSE_THIN && IN(4)) for (int rep_ = 0; rep_ < REPS(4); ++rep_) { PP_BEGIN(4); thin_pass<1>(nullptr, nullptr, XN, QB, attn_post_g, RS, nullptr, gw, NGW, lane); PP_END(4); if (BOTH(4)) GRID_BAR(); }
#if defined(PROBE_NULL5)
    if (IN(5)) {
        pg8::Gemm g{XN - D, (const bf16*)(ws + WS_WIN0), M, FF2, D, TSTEP_CONV}; pg8::StaticOrder S; S.init_tiles(NMT_CONV, FF2 / 256, G, bx);
        pg8::EpiNull E{(float*)(ws + WS_PARK)};
        pg8::gemm_phase<pg8::EpiNull, pg8::StaticOrder, true, true>(lds + RING_OFF, g, S, E, wave);
        GRID_BAR();
    }
#endif
    if (IN(5)) for (int rep_ = 0; rep_ < REPS(5); ++rep_) { PP_BEGIN(5); TP_BEGIN(5);
        pg8::Gemm g{XN - D, (const bf16*)(ws + WS_WIN0), M, FF2, D, TSTEP_CONV}; pg8::StaticOrder S; S.init_tiles(NMT_CONV, FF2 / 256, G, bx);
        pg8::EpiConvGlu E{GB, args.in[19], args.in[20], (PG8_LAS float*)(lds + XCH_OFF), M, RS, (PG8_LAS float*)(lds + XCH_OFF + 8192)};
        pg8::gemm_phase<pg8::EpiConvGlu, pg8::StaticOrder, true, true>(lds + RING_OFF, g, S, E, wave, GP_ARG(5));
        TP_END(5); PP_END(5); if (BOTH(5)) GRID_BAR();
    }
    if (IN(6)) for (int rep_ = 0; rep_ < REPS(6); ++rep_) { PP_BEGIN(6); TP_BEGIN(6);
        pg8::Gemm g{GB, (const bf16*)(ws + WS_WOUT0), M, D, FF, TSTEP_FF}; pg8::StaticOrder S; S.init(M, D, G, bx);
        #if FUSE_THIN
        pg8::EpiThin<1> E{MB, XN, ffn_post_g, RS, nullptr, (unsigned*)(ctl + CW_PANEL + 1 * PANEL_BANK), (PG8_LAS unsigned*)(lds + MISC_OFF + 64), D / 256};
        pg8::gemm_phase<pg8::EpiThin<1>, pg8::StaticOrder, true, true>(lds + RING_OFF, g, S, E, wave);
#else
        pg8::EpiBf16<0> E{MB, D, nullptr, 0, 0, 1.f};
        pg8::gemm_phase<pg8::EpiBf16<0>, pg8::StaticOrder, PG8_ALIGN_PLAIN, true>(lds + RING_OFF, g, S, E, wave);
#endif
        TP_END(6); PP_END(6); if (BOTH(6)) GRID_BAR();
    }
    if (!FUSE_THIN && IN(7)) for (int rep_ = 0; rep_ < REPS(7); ++rep_) { PP_BEGIN(7); thin_pass<1>(nullptr, nullptr, XN, MB, ffn_post_g, RS, nullptr, gw, NGW, lane); PP_END(7); if (BOTH(7)) GRID_BAR(); }
    if (IN(8)) for (int rep_ = 0; rep_ < REPS(8); ++rep_) { PP_BEGIN(8);
        pg8::Gemm g{XN, (const bf16*)(ws + WS_WQKV1), M, 3 * D, D, TSTEP_D}; pg8::StaticOrder S; S.init(M, 3 * D, G, bx);
        pg8::EpiRope E{QB, KB, VB, ROPE_C, ROPE_S, att::QSCALE, RS, (unsigned*)(ctl + CW_KMAX)};
        pg8::gemm_phase<pg8::EpiRope, pg8::StaticOrder, true, true>(lds + RING_OFF, g, S, E, wave, GP_ARG(8));
        PP_END(8); if (BOTH(8)) GRID_BAR();
    }
#if defined(PROBE_DAV)
    if (IN(9)) for (int vrep_ = 0; vrep_ < 2; ++vrep_) { const int variant_ = vrep_ == 0 ? PROBE_DAV : 0;
#else
    if (IN(9)) { const int variant_ = 0;
#endif
    for (int rep_ = 0; rep_ < REPS(9); ++rep_) { PP_BEGIN(9); TP_BEGIN(9);
        float lam;
        { const float a = wave_sum(args.in[12][lane] * args.in[13][lane]), b = wave_sum(args.in[14][lane] * args.in[15][lane]); lam = __expf(a) - __expf(b) + LAMBDA_INIT; }
        asm volatile("" : "+v"(lam));
        const unsigned lam_bits = __builtin_amdgcn_readfirstlane(__float_as_uint(lam));
        float* park = (float*)(ws + WS_PARK) + (size_t)bx * 32768;
        constexpr int NP = 4 * 8 * 16, NS = 8 * 8 * 32;
#pragma clang loop unroll(disable)
        for (int id = vcu; id < NP + NS; id += G) {
            size_t rowbase; int T, h, qb, bidx;
            if (id < NP) { const int bh = id >> 4; qb = id & 15; bidx = bh >> 3; rowbase = (size_t)bidx * T_P; T = T_P; h = bh & 7; }
            else { const int bh = (id - NP) >> 5; qb = (id - NP) & 31; bidx = 4 + (bh >> 3); rowbase = (size_t)M_P + (size_t)(bh >> 3) * T_S; T = T_S; h = bh & 7; }
            att::da_unit(rowbase, T, h, qb, QB, KB, VB, MB, park, lam_bits, 1.0f - LAMBDA_INIT, args.in[16], (const unsigned*)(ctl + CW_KMAX) + bidx * 16, (att::lptr)(lds + RING_OFF), tid, wave, lane, DP_ARG, variant_);
        }
        TP_END(9); PP_END(9); if (BOTH(9)) GRID_BAR();
    } }
    if (IN(10)) for (int rep_ = 0; rep_ < REPS(10); ++rep_) { PP_BEGIN(10);
        pg8::Gemm g{MB, (const bf16*)(ws + WS_WO1), M, D, D, TSTEP_D}; pg8::StaticOrder S; S.init(M, D, G, bx);
        #if FUSE_THIN
        pg8::EpiThin<1> E{QB, XN, attn_post_g + D, RS, nullptr, (unsigned*)(ctl + CW_PANEL + 2 * PANEL_BANK), (PG8_LAS unsigned*)(lds + MISC_OFF + 64), D / 256};
        pg8::gemm_phase<pg8::EpiThin<1>, pg8::StaticOrder, true, true>(lds + RING_OFF, g, S, E, wave);
#else
        pg8::EpiBf16<0> E{QB, D, nullptr, 0, 0, 1.f};
        pg8::gemm_phase<pg8::EpiBf16<0>, pg8::StaticOrder, PG8_ALIGN_PLAIN, true>(lds + RING_OFF, g, S, E, wave);
#endif
        PP_END(10); if (BOTH(10)) GRID_BAR();
    }
    if (!FUSE_THIN && IN(11)) for (int rep_ = 0; rep_ < REPS(11); ++rep_) { PP_BEGIN(11); thin_pass<1>(nullptr, nullptr, XN, QB, attn_post_g + D, RS, nullptr, gw, NGW, lane); PP_END(11); if (BOTH(11)) GRID_BAR(); }
    if (IN(12)) for (int rep_ = 0; rep_ < REPS(12); ++rep_) { PP_BEGIN(12);
        pg8::Gemm g{XN - D, (const bf16*)(ws + WS_WIN1), M, FF2, D, TSTEP_CONV}; pg8::StaticOrder S; S.init_tiles(NMT_CONV, FF2 / 256, G, bx);
        pg8::EpiConvGlu E{GB, args.in[19] + 3 * FF2, args.in[20] + FF2, (PG8_LAS float*)(lds + XCH_OFF), M, RS, (PG8_LAS float*)(lds + XCH_OFF + 8192)};
        pg8::gemm_phase<pg8::EpiConvGlu, pg8::StaticOrder, true, true>(lds + RING_OFF, g, S, E, wave);
        PP_END(12); if (BOTH(12)) GRID_BAR();
    }
    if (IN(13)) for (int rep_ = 0; rep_ < REPS(13); ++rep_) { PP_BEGIN(13);
        pg8::Gemm g{GB, (const bf16*)(ws + WS_WOUT1), M, D, FF, TSTEP_FF}; pg8::StaticOrder S; S.init(M, D, G, bx);
        #if FUSE_THIN
        pg8::EpiThin<2> E{MB, XN, ffn_post_g + D, RS, out, (unsigned*)(ctl + CW_PANEL + 3 * PANEL_BANK), (PG8_LAS unsigned*)(lds + MISC_OFF + 64), D / 256};
        pg8::gemm_phase<pg8::EpiThin<2>, pg8::StaticOrder, true, true>(lds + RING_OFF, g, S, E, wave);
#else
        pg8::EpiBf16<0> E{MB, D, nullptr, 0, 0, 1.f};
        pg8::gemm_phase<pg8::EpiBf16<0>, pg8::StaticOrder, PG8_ALIGN_PLAIN, true>(lds + RING_OFF, g, S, E, wave);
#endif
        PP_END(13); if (BOTH(13)) GRID_BAR();
    }
    if (!FUSE_THIN && IN(14)) for (int rep_ = 0; rep_ < REPS(14); ++rep_) { PP_BEGIN(14); thin_pass<2>(nullptr, nullptr, XN, MB, ffn_post_g + D, nullptr, out, gw, NGW, lane); }
#if defined(DPROBE)
    if (bx == 0 && hi > 14) {
        const unsigned long long tk = (unsigned long long)__hip_atomic_load(ctl + CW_TP, __ATOMIC_RELAXED, __HIP_MEMORY_SCOPE_AGENT);
        const unsigned long long t0_ = __builtin_amdgcn_s_memrealtime(); while (__builtin_amdgcn_s_memrealtime() - t0_ < tk) __builtin_amdgcn_s_sleep(16); }
#endif
#if defined(PPROBE)
    if (hi > 14) {
        const unsigned dur = (unsigned)(pp_t1 - pp_t0);
        if (tid == 0) { if (PPROBE_STAT == 1) atomicMax((unsigned*)(ctl + CW_TP), dur); else if (PPROBE_STAT == 2) atomicMax((unsigned*)(ctl + CW_TP), 0x40000000u - dur); else if (bx == 0) __hip_atomic_store(ctl + CW_TP, dur, __ATOMIC_RELAXED, __HIP_MEMORY_SCOPE_AGENT); }
        xcd_barrier(bar);
        if (bx == 0) { unsigned v = __hip_atomic_load(ctl + CW_TP, __ATOMIC_RELAXED, __HIP_MEMORY_SCOPE_AGENT); if (PPROBE_STAT == 2) v = 0x40000000u - v;
            const unsigned long long tk = (unsigned long long)v * PPROBE_SCALE;
            const unsigned long long t0_ = __builtin_amdgcn_s_memrealtime(); while (__builtin_amdgcn_s_memrealtime() - t0_ < tk) __builtin_amdgcn_s_sleep(16); }
    }
#endif
#if defined(BPROBE)
    if (hi > 14) {
        if (bx == BPROBE_BLOCK && tid == 0) __hip_atomic_store(ctl + CW_TP, (unsigned)bp_acc, __ATOMIC_RELAXED, __HIP_MEMORY_SCOPE_AGENT);
        xcd_barrier(bar);
        if (bx == 0) { const unsigned long long tk = (unsigned long long)__hip_atomic_load(ctl + CW_TP, __ATOMIC_RELAXED, __HIP_MEMORY_SCOPE_AGENT);
            const unsigned long long t0_ = __builtin_amdgcn_s_memrealtime(); while (__builtin_amdgcn_s_memrealtime() - t0_ < tk) __builtin_amdgcn_s_sleep(16); }
    }
#endif
#if defined(GPROBE)
    if (bx == 0 && hi > 14) {
        const unsigned long long tk = (unsigned long long)__hip_atomic_load(ctl + CW_TP, __ATOMIC_RELAXED, __HIP_MEMORY_SCOPE_AGENT) * GPROBE_SCALE;
        const unsigned long long t0_ = __builtin_amdgcn_s_memrealtime(); while (__builtin_amdgcn_s_memrealtime() - t0_ < tk) __builtin_amdgcn_s_sleep(16);
    }
#endif
#if defined(TPROBE)
    if (bx == 0 && hi > 14) {
        const unsigned long long mhz = (tp_c1 - tp_c0) * 100ull / (tp_r1 - tp_r0 + 1ull);
        const unsigned long long t0_ = __builtin_amdgcn_s_memrealtime(); while (__builtin_amdgcn_s_memrealtime() - t0_ < mhz * 100ull) __builtin_amdgcn_s_sleep(16);
    }
#endif
#undef IN
#undef BOTH
#undef GRID_BAR
#undef lane
#undef tid
}

extern "C" void kernel_launch(void* const* d_in, const int* in_sizes, int n_in, void* d_out, int out_size, void* d_ws, size_t ws_size, hipStream_t stream) {
    static int grid = 0;
    if (grid == 0) {
        if (n_in != 22 || in_sizes[0] != M_P * D || in_sizes[1] != M_S * D || out_size != M * D || ws_size < WS_END) {
            fprintf(stderr, "kernel_launch: unexpected shapes (n_in %d, in0 %d, in1 %d, out %d, ws %zu); nothing launched\n", n_in, n_in > 0 ? in_sizes[0] : -1, n_in > 1 ? in_sizes[1] : -1, out_size, ws_size); grid = -1; return; }
        int dev = 0, cus = 0, per_cu = 0;
        if (hipGetDevice(&dev) != hipSuccess || hipDeviceGetAttribute(&cus, hipDeviceAttributeMultiprocessorCount, dev) != hipSuccess) { fprintf(stderr, "kernel_launch: device query failed\n"); grid = -1; return; }
        if (hipFuncSetAttribute((const void*)mega_fwd, hipFuncAttributeMaxDynamicSharedMemorySize, LDS_BYTES) != hipSuccess) { fprintf(stderr, "kernel_launch: hipFuncSetAttribute failed\n"); grid = -1; return; }
        if (hipOccupancyMaxActiveBlocksPerMultiprocessor(&per_cu, (const void*)mega_fwd, NWAVES * 64, LDS_BYTES) != hipSuccess || per_cu < 1) { fprintf(stderr, "kernel_launch: occupancy query says %d blocks per CU\n", per_cu); }
        (void)hipGetLastError();
        grid = cus;
    }
    if (grid < 0) return;
    if (hipMemsetAsync((char*)d_ws + WS_CTL, 0, CTL_ZERO_BYTES, stream) != hipSuccess) { fprintf(stderr, "kernel_launch: memset failed\n"); return; }
    Args a{};
    for (int i = 0; i < 22; ++i) a.in[i] = (const float*)d_in[i];
    a.out = (float*)d_out; a.ws = (unsigned char*)d_ws;
#if MK_PER_PHASE
    for (int p = 0; p < NPH; ++p) { a.ph_lo = p; a.ph_hi = p + 1; hipLaunchKernelGGL(mega_fwd, dim3(grid), dim3(NWAVES * 64), LDS_BYTES, stream, a); }
#else
    a.ph_lo = 0; a.ph_hi = NPH;
    hipLaunchKernelGGL(mega_fwd, dim3(grid), dim3(NWAVES * 64), LDS_BYTES, stream, a);
#endif
    const hipError_t le = hipPeekAtLastError();
    if (le != hipSuccess) fprintf(stderr, "kernel_launch: launch failed: %s\n", hipGetErrorName(le));
}
```

```cpp
#define DA_WO_OVERLAP 1
#define GEMM_TAILQ 1
#include <hip/hip_runtime.h>
#include <cstdio>
#include <cstdint>
#include <cmath>
#define NA_KROW 1
#define NA_PP 1
#define NA_SP 1
#define NA_KEEP_BIAS 1
#define GAS __attribute__((address_space(1)))
#define LAS __attribute__((address_space(3)))
typedef unsigned short bf16;
typedef unsigned v4u __attribute__((ext_vector_type(4)));
typedef float f32x4 __attribute__((ext_vector_type(4)));
typedef short bf16x8 __attribute__((ext_vector_type(8)));
typedef GAS unsigned gu32;
typedef GAS unsigned long long gu64;
__device__ __forceinline__ int lane_id_fresh() { int x; asm volatile("v_mbcnt_lo_u32_b32 %0, -1, 0\n\tv_mbcnt_hi_u32_b32 %0, -1, %0" : "=v"(x)); return x; }
#define LANE_ID() lane_id_fresh()
#define RLX_AGENT __ATOMIC_RELAXED, __HIP_MEMORY_SCOPE_AGENT
#define LDS_WAIT() asm volatile("s_waitcnt lgkmcnt(0)" ::: "memory")
#define VM_WAIT() asm volatile("s_waitcnt vmcnt(0)" ::: "memory")
__device__ __forceinline__ unsigned long long rt() { return __builtin_amdgcn_s_memrealtime(); }
__device__ __forceinline__ unsigned f2bf(float f) { unsigned u = __builtin_bit_cast(unsigned, f); return (u + 0x7fffu + ((u >> 16) & 1u)) >> 16; }
__device__ __forceinline__ unsigned pk2(float lo, float hi) { return f2bf(lo) | (f2bf(hi) << 16); }
constexpr int D = 1024, M_P = 4 * 4096, M_S = 8 * 8192, M = M_P + M_S, T_P = 4096, T_S = 8192, FF = 2816, FF2 = 2 * FF;
constexpr int NMT_CONV = (M + 253) / 254;
constexpr float NORM_EPS = 1e-6f;
constexpr float LAMBDA_INIT = 0.35550907f;

__device__ __forceinline__ float wave_sum(float v) {
#pragma unroll
    for (int o = 1; o < 64; o <<= 1) v += __shfl_xor(v, o);
    return v;
}
__device__ __forceinline__ f32x4 bf4_to_f32(unsigned long long w) {
    f32x4 v; v.x = __uint_as_float((unsigned)(w & 0xffffull) << 16); v.y = __uint_as_float((unsigned)((w >> 16) & 0xffffull) << 16);
    v.z = __uint_as_float((unsigned)((w >> 32) & 0xffffull) << 16); v.w = __uint_as_float((unsigned)(w >> 48) << 16); return v;
}
__device__ __forceinline__ void bf8_to_f32(v4u w, f32x4& a, f32x4& b) {
    a.x = __uint_as_float(w.x << 16); a.y = __uint_as_float(w.x & 0xffff0000u); a.z = __uint_as_float(w.y << 16); a.w = __uint_as_float(w.y & 0xffff0000u);
    b.x = __uint_as_float(w.z << 16); b.y = __uint_as_float(w.z & 0xffff0000u); b.z = __uint_as_float(w.w << 16); b.w = __uint_as_float(w.w & 0xffff0000u);
}
__device__ __forceinline__ float sq4(f32x4 v) { return (v.x * v.x + v.y * v.y) + (v.z * v.z + v.w * v.w); }
template <int MODE, int R = 4>
__device__ __forceinline__ void thin_rows(const float* xp, const float* xs, bf16* xb, const bf16* mb, const float* gpost, float* rs, float* out, int row0, int row1, int rstep, int lane) {
    f32x4 g[2][2];
    if (MODE != 0) {
#pragma unroll
        for (int j = 0; j < 2; ++j) { g[j][0] = *(const f32x4*)(gpost + 8 * lane + 512 * j); g[j][1] = *(const f32x4*)(gpost + 8 * lane + 512 * j + 4); }
    }
    for (int rb = row0; rb < row1; rb += rstep) {
        f32x4 x[R][2][2];
        if (MODE == 0) { const float* xr = rb < M_P ? xp + (size_t)rb * D : xs + (size_t)(rb - M_P) * D;
#pragma unroll
            for (int r = 0; r < R; ++r)
#pragma unroll
                for (int j = 0; j < 2; ++j) { x[r][j][0] = *(const GAS f32x4*)(xr + (size_t)r * D + 8 * lane + 512 * j); x[r][j][1] = *(const GAS f32x4*)(xr + (size_t)r * D + 8 * lane + 512 * j + 4); }
        } else {
            v4u xw[R][2], mw[R][2];
#pragma unroll
            for (int r = 0; r < R; ++r)
#pragma unroll
                for (int j = 0; j < 2; ++j) { xw[r][j] = *(const GAS v4u*)(xb + (size_t)(rb + r) * D + 8 * lane + 512 * j); mw[r][j] = *(const GAS v4u*)(mb + (size_t)(rb + r) * D + 8 * lane + 512 * j); }
            f32x4 mv[R][2][2]; float ss[R];
#pragma unroll
            for (int r = 0; r < R; ++r) { ss[r] = 0.f;
#pragma unroll
                for (int j = 0; j < 2; ++j) { bf8_to_f32(xw[r][j], x[r][j][0], x[r][j][1]); bf8_to_f32(mw[r][j], mv[r][j][0], mv[r][j][1]); ss[r] += sq4(mv[r][j][0]) + sq4(mv[r][j][1]); } }
#pragma unroll
            for (int o = 1; o < 64; o <<= 1) {
#pragma unroll
                for (int r = 0; r < R; ++r) ss[r] += __shfl_xor(ss[r], o); }
#pragma unroll
            for (int r = 0; r < R; ++r) { const float rm = __builtin_amdgcn_rsqf(ss[r] * (1.f / D) + NORM_EPS);
#pragma unroll
                for (int j = 0; j < 2; ++j) { x[r][j][0] = x[r][j][0] + mv[r][j][0] * g[j][0] * rm; x[r][j][1] = x[r][j][1] + mv[r][j][1] * g[j][1] * rm; } }
        }
        if (MODE == 2) {
#pragma unroll
            for (int r = 0; r < R; ++r)
#pragma unroll
                for (int j = 0; j < 2; ++j) { *(GAS f32x4*)(out + (size_t)(rb + r) * D + 8 * lane + 512 * j) = x[r][j][0]; *(GAS f32x4*)(out + (size_t)(rb + r) * D + 8 * lane + 512 * j + 4) = x[r][j][1]; }
        } else {
            float s2[R];
#pragma unroll
            for (int r = 0; r < R; ++r) { s2[r] = 0.f;
#pragma unroll
                for (int j = 0; j < 2; ++j) { s2[r] += sq4(x[r][j][0]) + sq4(x[r][j][1]);
                    v4u w; w.x = pk2(x[r][j][0].x, x[r][j][0].y); w.y = pk2(x[r][j][0].z, x[r][j][0].w); w.z = pk2(x[r][j][1].x, x[r][j][1].y); w.w = pk2(x[r][j][1].z, x[r][j][1].w);
                    *(GAS v4u*)(xb + (size_t)(rb + r) * D + 8 * lane + 512 * j) = w; } }
#pragma unroll
            for (int o = 1; o < 64; o <<= 1) {
#pragma unroll
                for (int r = 0; r < R; ++r) s2[r] += __shfl_xor(s2[r], o); }
            if (lane < R) { float v = s2[0];
#pragma unroll
                for (int r = 1; r < R; ++r) v = lane == r ? s2[r] : v;
                rs[rb + lane] = __builtin_amdgcn_rsqf(v * (1.f / D) + NORM_EPS); }
        }
    }
}

template <int MODE, int R>
__device__ __forceinline__ void thin_rows_lean(bf16* xb, const bf16* mb, const float* gpost, float* rs, float* out, int row0, int row1, int lane) {
    for (int rb = row0; rb < row1; rb += R) {
        v4u xw[R][2], mw[R][2]; float ss[R], s2[R];
#pragma unroll
        for (int r = 0; r < R; ++r)
#pragma unroll
            for (int j = 0; j < 2; ++j) { xw[r][j] = *(const GAS v4u*)(xb + (size_t)(rb + r) * D + 8 * lane + 512 * j); mw[r][j] = *(const GAS v4u*)(mb + (size_t)(rb + r) * D + 8 * lane + 512 * j); }
#pragma unroll
        for (int r = 0; r < R; ++r) { ss[r] = 0.f;
#pragma unroll
            for (int j = 0; j < 2; ++j) { f32x4 a, b; bf8_to_f32(mw[r][j], a, b); ss[r] += sq4(a) + sq4(b); } }
#pragma unroll
        for (int o = 1; o < 64; o <<= 1) {
#pragma unroll
            for (int r = 0; r < R; ++r) ss[r] += __shfl_xor(ss[r], o); }
#pragma unroll
        for (int r = 0; r < R; ++r) { const float rm = __builtin_amdgcn_rsqf(ss[r] * (1.f / D) + NORM_EPS); s2[r] = 0.f;
#pragma unroll
            for (int j = 0; j < 2; ++j) { f32x4 xa, xb2, ma, mb2; bf8_to_f32(xw[r][j], xa, xb2); bf8_to_f32(mw[r][j], ma, mb2);
                const f32x4 g0 = *(const f32x4*)(gpost + 8 * lane + 512 * j), g1 = *(const f32x4*)(gpost + 8 * lane + 512 * j + 4);
                xa = xa + ma * g0 * rm; xb2 = xb2 + mb2 * g1 * rm;
                if (MODE == 2) { *(GAS f32x4*)(out + (size_t)(rb + r) * D + 8 * lane + 512 * j) = xa; *(GAS f32x4*)(out + (size_t)(rb + r) * D + 8 * lane + 512 * j + 4) = xb2; }
                else { s2[r] += sq4(xa) + sq4(xb2);
                    v4u w; w.x = pk2(xa.x, xa.y); w.y = pk2(xa.z, xa.w); w.z = pk2(xb2.x, xb2.y); w.w = pk2(xb2.z, xb2.w);
                    *(GAS v4u*)(xb + (size_t)(rb + r) * D + 8 * lane + 512 * j) = w; } } }
        if (MODE != 2) {
#pragma unroll
            for (int o = 1; o < 64; o <<= 1) {
#pragma unroll
                for (int r = 0; r < R; ++r) s2[r] += __shfl_xor(s2[r], o); }
            if (lane < R) { float v = s2[0];
#pragma unroll
                for (int r = 1; r < R; ++r) v = lane == r ? s2[r] : v;
                rs[rb + lane] = __builtin_amdgcn_rsqf(v * (1.f / D) + NORM_EPS); }
        }
    }
}
template <int MODE>
__device__ __forceinline__ void thin_pass(const float* xp, const float* xs, bf16* xb, const bf16* mb, const float* gpost, float* rs, float* out, int gw, int NGW, int lane) {
    thin_rows<MODE>(xp, xs, xb, mb, gpost, rs, out, gw * 4, M, NGW * 4, lane);
}

namespace pg8 {
#define PG8_LAS __attribute__((address_space(3)))
typedef unsigned short bf16_t;
typedef short bf16x8 __attribute__((ext_vector_type(8)));
typedef float f32x4 __attribute__((ext_vector_type(4)));
typedef unsigned u32x4 __attribute__((ext_vector_type(4)));
constexpr int BM = 256, BK = 64, HALF = 128, HTB = HALF * BK * 2  , STAGE_BYTES = 8 * HTB, NXCD = 8, WGM = 8;

__host__ __device__ __forceinline__ int lds_byte(int r, int c) { const int st = (r >> 4) * 2 + (c >> 5), rr = r & 15, cc = c & 31, ob = rr * 64 + cc * 2; return st * 1024 + (ob ^ (((ob >> 9) & 1) << 5)); }
__host__ __device__ __forceinline__ void stage_rc(int b, int& R, int& C) { const int st = b / 1024, sb = b % 1024, swz = sb ^ (((sb >> 9) & 1) << 5); R = (st >> 1) * 16 + swz / 64; C = (st & 1) * 32 + (swz % 64) / 2; }
__host__ __device__ __forceinline__ int perm32(int rho) { const int n = rho >> 4, i = rho & 15; return 8 * (i >> 2) + 4 * n + (i & 3); }

struct Unit { int pm, pn; };
struct Gemm { const bf16_t* A; const bf16_t* Bt; int M, N, K; size_t tstepA; };

struct StaticOrder {
    int nM, nN, nwg, G, c;
    __host__ __device__ void init(int M, int N, int G_, int c_) { nM = M / BM; nN = N / BM; nwg = nM * nN; G = G_; c = c_; }
    __host__ __device__ void init_tiles(int nM_, int nN_, int G_, int c_) { nM = nM_; nN = nN_; nwg = nM * nN; G = G_; c = c_; }
    __host__ __device__ bool next(int i, Unit& u) const {
        const long L = (long)i * G + c; if (L >= nwg) return false;
        int wgid = (int)L; { const int q = nwg / NXCD, r = nwg % NXCD, xcd = wgid % NXCD, off = wgid / NXCD; wgid = (xcd < r ? xcd * (q + 1) : r * (q + 1) + (xcd - r) * q) + off; }
        const int nig = WGM * nN, gid = wgid / nig, fm = gid * WGM, gsz = (nM - fm) < WGM ? (nM - fm) : WGM;
        u.pm = fm + ((wgid % nig) % gsz); u.pn = (wgid % nig) / gsz; return true;
    }
    __device__ __forceinline__ void a_ready(const Unit&) const {}
    __device__ __forceinline__ void done(const Unit&) const {}
};

struct QueueOrder {
    int nN, nwg; unsigned* ctr; unsigned* ready; unsigned need; volatile PG8_LAS unsigned* mbox; int wave;
    __device__ __forceinline__ bool next(int i, Unit& u) const {
        unsigned t;
        if (wave == 0) { unsigned v = 0; if (LANE_ID() == 0) v = __hip_atomic_fetch_add(ctr, 1u, __ATOMIC_RELAXED, __HIP_MEMORY_SCOPE_AGENT);
            t = (unsigned)__builtin_amdgcn_readfirstlane((int)v); t = t > 0xFFFFu ? 0xFFFFu : t; if (LANE_ID() == 0) mbox[i & 1] = ((unsigned)(i + 1) << 16) | t; }
        else { unsigned v, sp = 0; for (;;) { v = mbox[i & 1]; if ((v >> 16) == (unsigned)(i + 1) || ++sp > (1u << 24)) break; __builtin_amdgcn_s_sleep(1); } t = (unsigned)__builtin_amdgcn_readfirstlane((int)(v & 0xFFFFu)); }
        if ((int)t >= nwg) return false;
        u.pm = (int)t / nN; u.pn = (int)t % nN; return true;
    }
    __device__ __forceinline__ void a_ready(const Unit& u) const {
        unsigned* p = ready + 64 * u.pm; unsigned sp = 0;
        while (__hip_atomic_load(p, __ATOMIC_RELAXED, __HIP_MEMORY_SCOPE_AGENT) < need) { __builtin_amdgcn_s_sleep(32); if (++sp > (1u << 19)) break; }
        __builtin_amdgcn_fence(__ATOMIC_ACQUIRE, "agent");
    }
    __device__ __forceinline__ void done(const Unit&) const {}
};

struct TailOrder {
    StaticOrder so; unsigned* ctr; volatile PG8_LAS unsigned* mbox; int wave; unsigned tag;
    __device__ __forceinline__ bool next(int i, Unit& u) const {
        const int full = so.nwg / so.G;
        if (i < full) return so.next(i, u);
        if (i > full || full * so.G == so.nwg) return false;
        unsigned t; const unsigned want = (tag << 6) | (unsigned)((i & 31) + 1);
        if (wave == 0) { unsigned v = 0; if (LANE_ID() == 0) v = __hip_atomic_fetch_add(ctr, 1u, __ATOMIC_RELAXED, __HIP_MEMORY_SCOPE_AGENT);
            t = (unsigned)__builtin_amdgcn_readfirstlane((int)v); t = t > 0xFFFFu ? 0xFFFFu : t; if (LANE_ID() == 0) mbox[i & 1] = (want << 16) | t; }
        else { unsigned v, sp = 0; for (;;) { v = mbox[i & 1]; if ((v >> 16) == want || ++sp > (1u << 24)) break; __builtin_amdgcn_s_sleep(1); } t = (unsigned)__builtin_amdgcn_readfirstlane((int)(v & 0xFFFFu)); }
        StaticOrder s2 = so; s2.c = (int)t;
        if ((int)t >= so.G) return false;
        return s2.next(full, u);
    }
    __device__ __forceinline__ void a_ready(const Unit&) const {}
    __device__ __forceinline__ void done(const Unit&) const {}
};

__device__ __forceinline__ unsigned cvt_pk_bf16(float lo, float hi) { unsigned r; asm volatile("v_cvt_pk_bf16_f32 %0, %1, %2" : "=v"(r) : "v"(lo), "v"(hi)); return r; }
typedef float f32x2 __attribute__((ext_vector_type(2)));
__device__ __forceinline__ f32x2 gelu_pk(f32x2 v) {
    const f32x2 av = __builtin_elementwise_abs(v), d = av * 0.2316418882f + 1.0f;
    f32x2 t; t.x = __builtin_amdgcn_rcpf(d.x); t.y = __builtin_amdgcn_rcpf(d.y);
    f32x2 q = t * 0.5307027145f + (-0.7265760135f); q = q * t + 0.7107068705f; q = q * t + (-0.142248368f); q = q * t + 0.127414796f; q = q * t;
    const f32x2 s = (v * v) * (-0.72134752044f);
    f32x2 e; e.x = __builtin_amdgcn_exp2f(s.x); e.y = __builtin_amdgcn_exp2f(s.y);
    const f32x2 m = v * (q * e), r = v - m;
    f32x2 o; o.x = v.x < 0.f ? m.x : r.x; o.y = v.y < 0.f ? m.y : r.y; return o;
}

template <int ACT  > struct EpiBf16 {
    static constexpr bool PERM = true, AFTER_DRAIN = false, HAS_FLUSH = false, PERM_A = false; static_assert(ACT == 0 || ACT == 1, "EpiBf16: ACT is 0 (none) or 1 (gelu_pk)");
    bf16_t* O; int ldc; const float* rs; int split_cols; size_t split_stride; float scale0;
    __device__ __forceinline__ void operator()(const f32x4 (&acc)[2][2][4][2], const Unit& u, int wr, int wc, int fr, int fq) const {
        const int row0 = u.pm * BM + wr * 64 + fr; int colt = u.pn * BM; bf16_t* base = O;
        float sc = 1.f; if (split_cols) { const int t = colt / split_cols; base += (size_t)t * split_stride; colt -= t * split_cols; if (t == 0) sc = scale0; }
        const int col0 = colt + wc * 32 + 8 * fq;
        float rsv[2][4];
#pragma unroll
        for (int ai = 0; ai < 2; ++ai)
#pragma unroll
            for (int m = 0; m < 4; ++m) rsv[ai][m] = rs ? rs[row0 + ai * HALF + m * 16] * sc : sc;
#pragma unroll
        for (int ai = 0; ai < 2; ++ai)
#pragma unroll
            for (int m = 0; m < 4; ++m) { bf16_t* rowp = base + (size_t)(row0 + ai * HALF + m * 16) * ldc + col0; const float rsc = rsv[ai][m];
#pragma unroll
                for (int bj = 0; bj < 2; ++bj) { f32x4 v0 = acc[ai][bj][m][0], v1 = acc[ai][bj][m][1];
                    if (ACT == 1) { f32x2 a = gelu_pk((f32x2){v0[0], v0[1]}), b = gelu_pk((f32x2){v0[2], v0[3]}), c = gelu_pk((f32x2){v1[0], v1[1]}), d = gelu_pk((f32x2){v1[2], v1[3]});
                        v0 = (f32x4){a.x, a.y, b.x, b.y}; v1 = (f32x4){c.x, c.y, d.x, d.y}; }
                    v0 = v0 * rsc; v1 = v1 * rsc; u32x4 w; w.x = cvt_pk_bf16(v0[0], v0[1]); w.y = cvt_pk_bf16(v0[2], v0[3]); w.z = cvt_pk_bf16(v1[0], v1[1]); w.w = cvt_pk_bf16(v1[2], v1[3]);
#if defined(EPI_NT_STORE)
                    __builtin_nontemporal_store(w, (u32x4*)(rowp + bj * HALF)); } }
#else
                    *(u32x4*)(rowp + bj * HALF) = w; } }
#endif
    }
};

struct EpiRope {
    static constexpr bool PERM = true, AFTER_DRAIN = false, HAS_FLUSH = false, PERM_A = false;
    bf16_t* Q; bf16_t* Kk; bf16_t* V; const float* cs; const float* sn; float qscale; const float* rs; unsigned* kmax;
    __device__ __forceinline__ void operator()(const f32x4 (&acc)[2][2][4][2], const Unit& u, int wr, int wc, int fr, int fq) const {
        const int which = u.pn >> 2;
        const int row0 = u.pm * BM + wr * 64 + fr;
        float rsv[2][4];
#pragma unroll
        for (int ai = 0; ai < 2; ++ai)
#pragma unroll
            for (int m = 0; m < 4; ++m) rsv[ai][m] = rs[row0 + ai * HALF + m * 16];
        if (which == 2) {
            const int col0 = (u.pn - 8) * BM + wc * 32 + 8 * fq;
#pragma unroll
            for (int ai = 0; ai < 2; ++ai)
#pragma unroll
                for (int m = 0; m < 4; ++m) { bf16_t* rowp = V + (size_t)(row0 + ai * HALF + m * 16) * 1024 + col0; const float r = rsv[ai][m];
#pragma unroll
                    for (int bj = 0; bj < 2; ++bj) { const f32x4 v0 = acc[ai][bj][m][0] * r, v1 = acc[ai][bj][m][1] * r;
                        u32x4 w; w.x = cvt_pk_bf16(v0[0], v0[1]); w.y = cvt_pk_bf16(v0[2], v0[3]); w.z = cvt_pk_bf16(v1[0], v1[1]); w.w = cvt_pk_bf16(v1[2], v1[3]);
                        *(u32x4*)(rowp + bj * HALF) = w; } }
        } else {
            bf16_t* base = which == 0 ? Q : Kk; const float sc = which == 0 ? qscale : 1.f;
            const int colb = ((u.pn & 3) * 4 + wc) * 64 + 8 * fq; float kn2 = 0.f;
            f32x4 c0, c1, s0, s1;
            { const int t = row0 < 16384 ? (row0 & 4095) : (row0 & 8191);
              c0 = *(const f32x4*)(cs + t * 32 + 8 * fq); c1 = *(const f32x4*)(cs + t * 32 + 8 * fq + 4); s0 = *(const f32x4*)(sn + t * 32 + 8 * fq); s1 = *(const f32x4*)(sn + t * 32 + 8 * fq + 4); }
            const f32x4 C0 = *(const f32x4*)(cs + 16 * 32 + 8 * fq), C1 = *(const f32x4*)(cs + 16 * 32 + 8 * fq + 4), S0 = *(const f32x4*)(sn + 16 * 32 + 8 * fq), S1 = *(const f32x4*)(sn + 16 * 32 + 8 * fq + 4);
#pragma unroll
            for (int ai = 0; ai < 2; ++ai) {
#define ROPE_STEP() do { const f32x4 nc0 = c0 * C0 - s0 * S0, nc1 = c1 * C1 - s1 * S1, ns0 = s0 * C0 + c0 * S0, ns1 = s1 * C1 + c1 * S1; c0 = nc0; c1 = nc1; s0 = ns0; s1 = ns1; } while (0)
                if (ai == 1) { ROPE_STEP(); ROPE_STEP(); ROPE_STEP(); ROPE_STEP(); ROPE_STEP(); }
#pragma unroll
                for (int m = 0; m < 4; ++m) { const int row = row0 + ai * HALF + m * 16; const float scr = sc * rsv[ai][m];
                    if (m > 0) ROPE_STEP();
                    const f32x4 x1a = acc[ai][0][m][0], x1b = acc[ai][0][m][1], x2a = acc[ai][1][m][0], x2b = acc[ai][1][m][1];
                    const f32x4 o1a = (x1a * c0 - x2a * s0) * scr, o1b = (x1b * c1 - x2b * s1) * scr, o2a = (x2a * c0 + x1a * s0) * scr, o2b = (x2b * c1 + x1b * s1) * scr;
                    u32x4 w1, w2; w1.x = cvt_pk_bf16(o1a[0], o1a[1]); w1.y = cvt_pk_bf16(o1a[2], o1a[3]); w1.z = cvt_pk_bf16(o1b[0], o1b[1]); w1.w = cvt_pk_bf16(o1b[2], o1b[3]);
                    w2.x = cvt_pk_bf16(o2a[0], o2a[1]); w2.y = cvt_pk_bf16(o2a[2], o2a[3]); w2.z = cvt_pk_bf16(o2b[0], o2b[1]); w2.w = cvt_pk_bf16(o2b[2], o2b[3]);
                    bf16_t* rowp = base + (size_t)row * 1024 + colb;
                    *(u32x4*)(rowp) = w1; *(u32x4*)(rowp + 32) = w2;
                    if (which == 1) { const f32x4 q4 = o1a * o1a + o1b * o1b + o2a * o2a + o2b * o2b; float ss = (q4[0] + q4[1]) + (q4[2] + q4[3]); ss += __shfl_xor(ss, 16); ss += __shfl_xor(ss, 32); kn2 = fmaxf(kn2, ss); } } }
            if (which == 1) { kn2 = fmaxf(kn2, __shfl_xor(kn2, 1)); kn2 = fmaxf(kn2, __shfl_xor(kn2, 2)); kn2 = fmaxf(kn2, __shfl_xor(kn2, 4)); kn2 = fmaxf(kn2, __shfl_xor(kn2, 8));
                const int r0 = u.pm * BM; const int batch = r0 < 16384 ? (r0 >> 12) : 4 + ((r0 - 16384) >> 13);
                if (fr == 0 && fq == 0) atomicMax(kmax + batch * 16 + (u.pn & 3) * 4 + wc, __float_as_uint(kn2)); }
        }
    }
};

template <int CTRL> __device__ __forceinline__ float dpp_f(float old, float src) { return __int_as_float(__builtin_amdgcn_update_dpp(__float_as_int(old), __float_as_int(src), CTRL, 0xf, 0xf, false)); }
__device__ __forceinline__ float gelu_tanh(float x) {
    const float u = 0.7978845608028654f * (x + 0.044715f * x * x * x);
    const float e = __builtin_amdgcn_exp2f(-2.8853900817779268f * u);
    return x * __builtin_amdgcn_rcpf(1.0f + e);
}
struct EpiConvGlu {
    static constexpr bool PERM = true, AFTER_DRAIN = false, HAS_FLUSH = false, PERM_A = true;
    bf16_t* G; const float* cw; const float* cb; PG8_LAS float* X; int Mrows; const float* rs; PG8_LAS float* WT;
    __device__ __forceinline__ void operator()(f32x4 (&acc)[2][2][4][2], const Unit& u, int wr, int wc, int fr, int fq) const {
        const int xcol = wc * 32 + 8 * fq;
        const int gc0 = u.pn * 128 + xcol;
        float rsv[2][4];
#pragma unroll
        for (int ai = 0; ai < 2; ++ai)
#pragma unroll
            for (int m = 0; m < 4; ++m) { int tr = u.pm * 254 - 1 + ai * HALF + wr * 64 + 4 * fr + m; tr = tr < 0 ? 0 : (tr >= Mrows ? Mrows - 1 : tr); rsv[ai][m] = rs[tr]; }
        { const int tidx = (wr * 4 + wc) * 64 + fq * 16 + fr, e0 = 2 * tidx, t = e0 >> 8, c = e0 & 255;
          const float* src = (t < 3 ? cw + t * 5632 : cb) + (c < 128 ? u.pn * 128 + c : 2816 + u.pn * 128 + c - 128);
          typedef float f32x2v __attribute__((ext_vector_type(2)));
          *(PG8_LAS f32x2v*)(WT + e0) = *(const f32x2v*)src; }
#pragma unroll
        for (int ai = 0; ai < 2; ++ai)
#pragma unroll
            for (int m = 0; m < 4; ++m) {
#pragma unroll
                for (int bj = 0; bj < 2; ++bj)
#pragma unroll
                    for (int n = 0; n < 2; ++n) acc[ai][bj][m][n] = acc[ai][bj][m][n] * rsv[ai][m]; }
#pragma unroll
        for (int ai = 0; ai < 2; ++ai) { const int ch = 2 * ai + wr;
            if (fr == 0) {
#pragma unroll
                for (int bj = 0; bj < 2; ++bj)
#pragma unroll
                    for (int n = 0; n < 2; ++n) *(PG8_LAS f32x4*)(X + ((ch * 2 + 0) * 256 + bj * 128 + xcol + 4 * n)) = acc[ai][bj][0][n]; }
            if (fr == 15) {
#pragma unroll
                for (int bj = 0; bj < 2; ++bj)
#pragma unroll
                    for (int n = 0; n < 2; ++n) *(PG8_LAS f32x4*)(X + ((ch * 2 + 1) * 256 + bj * 128 + xcol + 4 * n)) = acc[ai][bj][3][n]; } }
        asm volatile("s_waitcnt lgkmcnt(0)" ::: "memory"); __builtin_amdgcn_s_barrier(); asm volatile("" ::: "memory");
        const int tg0 = u.pm * 254 - 1 + wr * 64 + 4 * fr;
        const int tb = u.pm * 254 - 1; const bool bnd = ((tb + 4096 + 257) >> 12) != ((tb + 4096 - 1) >> 12);
        if (bnd) body<true>(acc, u, wr, wc, fr, fq, xcol, gc0, tg0); else body<false>(acc, u, wr, wc, fr, fq, xcol, gc0, tg0);
    }
    template <bool bnd>
    __device__ __forceinline__ void body(f32x4 (&acc)[2][2][4][2], const Unit& u, int wr, int wc, int fr, int fq, int xcol, int gc0, int tg0) const {
#pragma unroll
        for (int ai = 0; ai < 2; ++ai) { const int ch = 2 * ai + wr;
#pragma unroll
            for (int m = 0; m < 4; ++m) {
                const int row = ai * HALF + wr * 64 + 4 * fr + m; const int tg = tg0 + ai * HALF + m;
                const int ps = tg < 16384 ? (tg & 4095) : (tg & 8191); const int ps1 = (tg + 1) < 16384 ? ((tg + 1) & 4095) : ((tg + 1) & 8191);
                const bool first = bnd && ps == 0, last = bnd && ps1 == 0;
                u32x4 w;
#pragma unroll
                for (int n = 0; n < 2; ++n) {
                    f32x4 wgv[3], wuv[3];
#pragma unroll
                    for (int t = 0; t < 3; ++t) { wgv[t] = *(const PG8_LAS f32x4*)(WT + t * 256 + xcol + 4 * n); wuv[t] = *(const PG8_LAS f32x4*)(WT + t * 256 + 128 + xcol + 4 * n); }
                    const f32x4 bgv = *(const PG8_LAS f32x4*)(WT + 768 + xcol + 4 * n), buv = *(const PG8_LAS f32x4*)(WT + 768 + 128 + xcol + 4 * n);
                    f32x4 pg = (f32x4){0.f, 0.f, 0.f, 0.f}, pu = pg, ng = pg, nu = pg;
                    if (m == 0 && ch > 0) { pg = *(const PG8_LAS f32x4*)(X + (((ch - 1) * 2 + 1) * 256 + xcol + 4 * n)); pu = *(const PG8_LAS f32x4*)(X + (((ch - 1) * 2 + 1) * 256 + 128 + xcol + 4 * n)); }
                    if (m == 3 && ch < 3) { ng = *(const PG8_LAS f32x4*)(X + (((ch + 1) * 2 + 0) * 256 + xcol + 4 * n)); nu = *(const PG8_LAS f32x4*)(X + (((ch + 1) * 2 + 0) * 256 + 128 + xcol + 4 * n)); }
                    const f32x4 cg = acc[ai][0][m][n], cu = acc[ai][1][m][n];
                    f32x4 prg, pru, nxg, nxu;
                    if (m > 0) { prg = acc[ai][0][m > 0 ? m - 1 : 0][n]; pru = acc[ai][1][m > 0 ? m - 1 : 0][n]; }
                    else {
#pragma unroll
                        for (int j = 0; j < 4; ++j) { prg[j] = dpp_f<0x111>(pg[j], acc[ai][0][3][n][j]); pru[j] = dpp_f<0x111>(pu[j], acc[ai][1][3][n][j]); } }
                    if (m < 3) { nxg = acc[ai][0][m < 3 ? m + 1 : 3][n]; nxu = acc[ai][1][m < 3 ? m + 1 : 3][n]; }
                    else {
#pragma unroll
                        for (int j = 0; j < 4; ++j) { nxg[j] = dpp_f<0x101>(ng[j], acc[ai][0][0][n][j]); nxu[j] = dpp_f<0x101>(nu[j], acc[ai][1][0][n][j]); } }
                    if (first) { prg = (f32x4){0.f, 0.f, 0.f, 0.f}; pru = prg; }
                    if (last) { nxg = (f32x4){0.f, 0.f, 0.f, 0.f}; nxu = nxg; }
                    const f32x4 yg = wgv[0] * prg + (wgv[1] * cg + (wgv[2] * nxg + bgv));
                    const f32x4 yu = wuv[0] * pru + (wuv[1] * cu + (wuv[2] * nxu + buv));
                    const f32x4 tt = yg * ((yg * yg) * (-0.10294324f) + (-2.3022082f));
                    f32x4 den; den[0] = __builtin_amdgcn_exp2f(tt[0]); den[1] = __builtin_amdgcn_exp2f(tt[1]); den[2] = __builtin_amdgcn_exp2f(tt[2]); den[3] = __builtin_amdgcn_exp2f(tt[3]);
                    den = den + 1.0f;
                    f32x4 rc; rc[0] = __builtin_amdgcn_rcpf(den[0]); rc[1] = __builtin_amdgcn_rcpf(den[1]); rc[2] = __builtin_amdgcn_rcpf(den[2]); rc[3] = __builtin_amdgcn_rcpf(den[3]);
                    const f32x4 o = (yg * rc) * yu;
                    if (n == 0) { w.x = cvt_pk_bf16(o[0], o[1]); w.y = cvt_pk_bf16(o[2], o[3]); } else { w.z = cvt_pk_bf16(o[0], o[1]); w.w = cvt_pk_bf16(o[2], o[3]); }
                }
                if (row >= 1 && row <= 254 && tg < Mrows) *(u32x4*)(G + (size_t)tg * 2816 + gc0) = w;
            }
        }
    }
};

template <int MODE>
struct EpiThin {
    static constexpr bool PERM = true, AFTER_DRAIN = false, HAS_FLUSH = true, PERM_A = false;
    bf16_t* mb; bf16_t* xb; const float* g; float* rs; float* out; unsigned* cnt; PG8_LAS unsigned* flag; int ntn;
    __device__ __forceinline__ void publish(int wid, int lane) const {
        asm volatile("s_waitcnt vmcnt(0)" ::: "memory"); __builtin_amdgcn_s_barrier(); asm volatile("" ::: "memory");
        const int ppm = (int)flag[1] - 1;
        if (ppm >= 0) {
            if (wid == 0 && lane == 0) { const unsigned old = __hip_atomic_fetch_add(cnt + 64 * ppm, 1u, __ATOMIC_RELAXED, __HIP_MEMORY_SCOPE_AGENT); flag[0] = (old == (unsigned)(ntn - 1)) ? 1u : 0u; }
            asm volatile("s_waitcnt vmcnt(0) lgkmcnt(0)" ::: "memory"); __builtin_amdgcn_s_barrier(); asm volatile("" ::: "memory");
            if (flag[0] != 0u) {
                if (wid == 0) { __builtin_amdgcn_fence(__ATOMIC_ACQUIRE, "agent"); asm volatile("s_waitcnt vmcnt(0)" ::: "memory"); }
                asm volatile("s_waitcnt lgkmcnt(0)" ::: "memory"); __builtin_amdgcn_s_barrier(); asm volatile("" ::: "memory");
                thin_rows_lean<MODE, 4>(xb, mb, g, rs, out, ppm * BM + wid * 32, ppm * BM + wid * 32 + 32, lane);
            }
        }
    }
    __device__ __forceinline__ void operator()(const f32x4 (&acc)[2][2][4][2], const Unit& u, int wr, int wc, int fr, int fq) const {
        const int wid = wr * 4 + wc, lane = fq * 16 + fr;
        u32x4 w[2][4][2];
#pragma unroll
        for (int ai = 0; ai < 2; ++ai)
#pragma unroll
            for (int m = 0; m < 4; ++m)
#pragma unroll
                for (int bj = 0; bj < 2; ++bj) { const f32x4 v0 = acc[ai][bj][m][0], v1 = acc[ai][bj][m][1];
                    w[ai][m][bj].x = cvt_pk_bf16(v0[0], v0[1]); w[ai][m][bj].y = cvt_pk_bf16(v0[2], v0[3]); w[ai][m][bj].z = cvt_pk_bf16(v1[0], v1[1]); w[ai][m][bj].w = cvt_pk_bf16(v1[2], v1[3]); }
        publish(wid, lane);
        asm volatile("s_waitcnt lgkmcnt(0)" ::: "memory"); __builtin_amdgcn_s_barrier(); asm volatile("" ::: "memory");
        if (wid == 0 && lane == 0) flag[1] = (unsigned)(u.pm + 1);
        const __amdgpu_buffer_rsrc_t rsrc = __builtin_amdgcn_make_buffer_rsrc((void*)mb, 0, M * 1024 * 2, 0x00020000);
        const int row0 = u.pm * BM + wr * 64 + fr, col0 = u.pn * BM + wc * 32 + 8 * fq;
#pragma unroll
        for (int ai = 0; ai < 2; ++ai)
#pragma unroll
            for (int m = 0; m < 4; ++m)
#pragma unroll
                for (int bj = 0; bj < 2; ++bj) __builtin_amdgcn_raw_buffer_store_b128(w[ai][m][bj], rsrc, ((row0 + ai * HALF + m * 16) * 1024 + col0 + bj * HALF) * 2, 0, 16);
    }
    __device__ __forceinline__ void flush(const Unit&, int wr, int wc, int fr, int fq) const {
        const int wid = wr * 4 + wc, lane = fq * 16 + fr;
        publish(wid, lane);
        asm volatile("s_waitcnt lgkmcnt(0)" ::: "memory"); __builtin_amdgcn_s_barrier(); asm volatile("" ::: "memory");
        if (wid == 0 && lane == 0) flag[1] = 0u;
        asm volatile("s_waitcnt lgkmcnt(0)" ::: "memory"); __builtin_amdgcn_s_barrier(); asm volatile("" ::: "memory");
    }
};

struct EpiNull {
    static constexpr bool PERM = true, AFTER_DRAIN = false, HAS_FLUSH = false, PERM_A = false;
    float* sink;
    __device__ __forceinline__ void operator()(const f32x4 (&acc)[2][2][4][2], const Unit& u, int wr, int wc, int fr, int fq) const {
        float s = 0.f;
#pragma unroll
        for (int ai = 0; ai < 2; ++ai)
#pragma unroll
            for (int bj = 0; bj < 2; ++bj)
#pragma unroll
                for (int m = 0; m < 4; ++m)
#pragma unroll
                    for (int n = 0; n < 2; ++n) s += acc[ai][bj][m][n][0] + acc[ai][bj][m][n][1] + acc[ai][bj][m][n][2] + acc[ai][bj][m][n][3];
        if (s == 123456.789f) sink[0] = s;
    }
};
template <class Epi, class Sched, bool ALIGN_EPI = false, bool SP2 = false>
__device__ __forceinline__ void gemm_phase(PG8_LAS unsigned char* lds, const Gemm g, const Sched& S, const Epi& E, int wave_arg, unsigned* tpw = nullptr) {
    const int wid = wave_arg, lane = LANE_ID(), tid = wid * 64 + lane, wr = wid >> 2, wc = wid & 3, fr = lane & 15, fq = lane >> 4;
    const int K = g.K, nt = K / BK;
#if GEMM_KROT
    const int krot = (int)(((blockIdx.x & 7u) * (unsigned)nt) >> 3);
#define PG8_KOF(j) ((size_t)(((j) + krot) >= nt ? ((j) + krot) - nt : ((j) + krot)) * kstep)
#else
#define PG8_KOF(j) ((size_t)(j) * kstep)
#endif
    unsigned voffA[2], voffB[2];
#pragma unroll
    for (int i = 0; i < 2; ++i) { int R, C; stage_rc(tid * 16 + i * 8192, R, C); const int Rb = Epi::PERM ? ((R & ~31) + perm32(R & 31)) : R;
        const int Ra = Epi::PERM_A ? ((R & 64) | ((R & 15) << 2) | ((R >> 4) & 3)) : R;
        voffA[i] = (unsigned)(Ra * K + C) * 2u; voffB[i] = (unsigned)(Rb * K + C) * 2u; }
    const size_t kstep = (size_t)(BK * 2);
    const size_t hstep = (size_t)HALF * K * 2;
    const size_t tstep = 2 * hstep;
    const unsigned ldsw = (unsigned)wid * 1024u;
    const int aoff = lds_byte(wr * 64 + fr, fq * 8), boff = lds_byte(wc * 32 + fr, fq * 8);
#define PG8_SA(b, h) (((b) * 2 + (h)) * HTB)
#define PG8_SB(b, h) ((4 + (b) * 2 + (h)) * HTB)
#define PG8_STAGE(bufoff, gbase, voff) do { _Pragma("unroll") for (int _i = 0; _i < 2; ++_i) \
        __builtin_amdgcn_global_load_lds((const unsigned*)((const char*)(gbase) + (voff)[_i]), (PG8_LAS unsigned*)(lds + (bufoff) + ldsw + _i * 8192), 16, 0, 0); } while (0)
#define PG8_LDA(dst, b, h) do { _Pragma("unroll") for (int m = 0; m < 4; ++m) _Pragma("unroll") for (int k = 0; k < 2; ++k) dst[m][k] = *(const PG8_LAS bf16x8*)(lds + PG8_SA(b, h) + aoff + m * 2048 + k * 1024); } while (0)
#define PG8_LDB(dst, b, h) do { _Pragma("unroll") for (int n = 0; n < 2; ++n) _Pragma("unroll") for (int k = 0; k < 2; ++k) dst[n][k] = *(const PG8_LAS bf16x8*)(lds + PG8_SB(b, h) + boff + n * 2048 + k * 1024); } while (0)
#define PG8_MMA(ai, bj, At, Bt) do { __builtin_amdgcn_s_setprio(1); _Pragma("unroll") for (int m = 0; m < 4; ++m) _Pragma("unroll") for (int n = 0; n < 2; ++n) _Pragma("unroll") for (int k = 0; k < 2; ++k) \
        acc[ai][bj][m][n] = __builtin_amdgcn_mfma_f32_16x16x32_bf16(Bt[n][k], At[m][k], acc[ai][bj][m][n], 0, 0, 0); __builtin_amdgcn_s_setprio(0); } while (0)
#define PG8_WAIT_V(n) asm volatile("s_waitcnt vmcnt(" #n ")" ::: "memory")
#define PG8_WAIT_L(n) asm volatile("s_waitcnt lgkmcnt(" #n ")" ::: "memory")
#define PG8_BAR __builtin_amdgcn_s_barrier()
#define PG8_SCHED __builtin_amdgcn_sched_barrier(0)
    Unit cur, nxt; int ui = 0;
    if (!S.next(0, cur)) return;
#if defined(GPROBE)
    unsigned long long gp_acc = 0, gp_t = 0; const bool gp_on = tpw != nullptr && blockIdx.x == 0 && wid == 0;
#define GP_MARK() do { if (gp_on) gp_t = __builtin_amdgcn_s_memrealtime(); } while (0)
#define GP_ADD() do { if (gp_on) gp_acc += __builtin_amdgcn_s_memrealtime() - gp_t; } while (0)
#else
#define GP_MARK() do {} while (0)
#define GP_ADD() do {} while (0)
#endif
#if defined(GEMM_STAGGER_TICKS)
    { const unsigned long long t0_ = __builtin_amdgcn_s_memrealtime(); const unsigned long long dly_ = (unsigned long long)((blockIdx.x >> 3) & 3) * GEMM_STAGGER_TICKS;
      while (__builtin_amdgcn_s_memrealtime() - t0_ < dly_) __builtin_amdgcn_s_sleep(8); }
#endif
    f32x4 acc[2][2][4][2];
#pragma unroll
    for (int a = 0; a < 2; ++a)
#pragma unroll
        for (int b = 0; b < 2; ++b)
#pragma unroll
            for (int m = 0; m < 4; ++m)
#pragma unroll
                for (int n = 0; n < 2; ++n) acc[a][b][m][n] = (f32x4){0.f, 0.f, 0.f, 0.f};
    bf16x8 At[4][2], B0[2][2], B1[2][2];
    const char* cA = (const char*)g.A + (size_t)cur.pm * g.tstepA; const char* cB = (const char*)g.Bt + (size_t)cur.pn * tstep;
    S.a_ready(cur);
    if constexpr (SP2) {
        PG8_STAGE(PG8_SB(0, 0), cB + PG8_KOF(0), voffB); PG8_STAGE(PG8_SB(0, 1), cB + hstep + PG8_KOF(0), voffB); PG8_STAGE(PG8_SA(0, 0), cA + PG8_KOF(0), voffA); PG8_STAGE(PG8_SA(0, 1), cA + hstep + PG8_KOF(0), voffA);
        if (wr == 1) PG8_BAR;
        PG8_WAIT_V(2); PG8_BAR;
        PG8_STAGE(PG8_SB(1, 0), cB + PG8_KOF(1), voffB); PG8_STAGE(PG8_SA(1, 0), cA + PG8_KOF(1), voffA); PG8_STAGE(PG8_SB(1, 1), cB + hstep + PG8_KOF(1), voffB);
        PG8_WAIT_V(6); PG8_BAR;
    } else {
        PG8_STAGE(PG8_SB(0, 0), cB + PG8_KOF(0), voffB); PG8_STAGE(PG8_SA(0, 0), cA + PG8_KOF(0), voffA); PG8_STAGE(PG8_SB(0, 1), cB + hstep + PG8_KOF(0), voffB); PG8_STAGE(PG8_SA(0, 1), cA + hstep + PG8_KOF(0), voffA);
        if (wr == 1) PG8_BAR;
        PG8_WAIT_V(4); PG8_BAR;
        PG8_STAGE(PG8_SB(1, 0), cB + PG8_KOF(1), voffB); PG8_STAGE(PG8_SA(1, 0), cA + PG8_KOF(1), voffA); PG8_STAGE(PG8_SB(1, 1), cB + hstep + PG8_KOF(1), voffB);
        PG8_WAIT_V(6); PG8_BAR;
    }
    for (;;) {
        const bool has_next = S.next(ui + 1, nxt);
        const char* nA = has_next ? (const char*)g.A + (size_t)nxt.pm * g.tstepA : cA; const char* nB = has_next ? (const char*)g.Bt + (size_t)nxt.pn * tstep : cB;
        for (int t = 0; t < nt; t += 2) {
            const bool last = (t == nt - 2);
#if defined(GPROBE) && GPROBE == 2
            if (t == 0) GP_MARK(); if (t == 4) GP_ADD();
#elif defined(GPROBE) && GPROBE == 3
            if (t == 4) GP_MARK(); if (t == 6) GP_ADD();
#elif defined(GPROBE) && GPROBE == 8
            if (t == 2) GP_MARK(); if (t == 4) GP_ADD();
#elif defined(GPROBE) && GPROBE == 4
            if (t == nt - 2) GP_MARK();
#endif
#if GEMM_KROT
            const size_t o1 = PG8_KOF(t + 1), o2 = last ? PG8_KOF(0) : PG8_KOF(t + 2), o3 = last ? PG8_KOF(1) : PG8_KOF(t + 3);
            const char* a1 = cA + o1;
            const char* a2 = (last ? nA : cA) + o2; const char* b2 = (last ? nB : cB) + o2;
            const char* a3 = (last ? nA : cA) + o3; const char* b3 = (last ? nB : cB) + o3;
#else
            const char* a1 = cA + (size_t)(t + 1) * kstep;
            const char* a2 = last ? nA : cA + (size_t)(t + 2) * kstep; const char* b2 = last ? nB : cB + (size_t)(t + 2) * kstep;
            const char* a3 = a2 + kstep; const char* b3 = b2 + kstep;
#endif
            if (last && has_next) S.a_ready(nxt);
            if constexpr (SP2) {
            PG8_LDB(B0, 0, 0); PG8_LDB(B1, 0, 1); PG8_SCHED; PG8_LDA(At, 0, 0); PG8_STAGE(PG8_SA(1, 1), a1 + hstep, voffA);
            PG8_WAIT_V(8); PG8_WAIT_L(0); PG8_BAR; PG8_MMA(0, 0, At, B0); PG8_MMA(0, 1, At, B1); PG8_BAR; PG8_SCHED;
            PG8_LDA(At, 0, 1); PG8_STAGE(PG8_SB(0, 0), b2, voffB); PG8_STAGE(PG8_SB(0, 1), b2 + hstep, voffB); PG8_STAGE(PG8_SA(0, 0), a2, voffA);
            PG8_WAIT_V(8); PG8_WAIT_L(0); PG8_BAR; PG8_MMA(1, 0, At, B0); PG8_MMA(1, 1, At, B1); PG8_BAR; PG8_SCHED;
            PG8_LDB(B0, 1, 0); PG8_LDB(B1, 1, 1); PG8_SCHED; PG8_LDA(At, 1, 0); PG8_STAGE(PG8_SA(0, 1), a2 + hstep, voffA);
            PG8_WAIT_V(8); PG8_WAIT_L(0); PG8_BAR; PG8_MMA(0, 0, At, B0); PG8_MMA(0, 1, At, B1); PG8_BAR; PG8_SCHED;
            PG8_LDA(At, 1, 1); PG8_STAGE(PG8_SB(1, 0), b3, voffB); PG8_STAGE(PG8_SB(1, 1), b3 + hstep, voffB); PG8_STAGE(PG8_SA(1, 0), a3, voffA);
            PG8_WAIT_V(8); PG8_WAIT_L(0); PG8_BAR; PG8_MMA(1, 0, At, B0); PG8_MMA(1, 1, At, B1); PG8_BAR; PG8_SCHED;
            } else {
            PG8_LDB(B0, 0, 0); PG8_SCHED; PG8_LDA(At, 0, 0); PG8_STAGE(PG8_SA(1, 1), a1 + hstep, voffA);
            PG8_WAIT_L(8); PG8_BAR; PG8_WAIT_L(0); PG8_MMA(0, 0, At, B0); PG8_BAR; PG8_SCHED;
            PG8_LDB(B1, 0, 1); PG8_STAGE(PG8_SB(0, 0), b2, voffB);
            PG8_BAR; PG8_WAIT_L(0); PG8_MMA(0, 1, At, B1); PG8_BAR;
            PG8_LDA(At, 0, 1); PG8_STAGE(PG8_SA(0, 0), a2, voffA);
            PG8_BAR; PG8_WAIT_L(0); PG8_MMA(1, 0, At, B0); PG8_BAR; PG8_SCHED;
            PG8_STAGE(PG8_SB(0, 1), b2 + hstep, voffB);
            PG8_WAIT_V(6); PG8_BAR; PG8_MMA(1, 1, At, B1); PG8_BAR;
            PG8_LDB(B0, 1, 0); PG8_SCHED; PG8_LDA(At, 1, 0); PG8_STAGE(PG8_SA(0, 1), a2 + hstep, voffA);
            PG8_WAIT_L(8); PG8_BAR; PG8_WAIT_L(0); PG8_MMA(0, 0, At, B0); PG8_BAR; PG8_SCHED;
            PG8_LDB(B1, 1, 1); PG8_STAGE(PG8_SB(1, 0), b3, voffB);
            PG8_BAR; PG8_WAIT_L(0); PG8_MMA(0, 1, At, B1); PG8_BAR;
            PG8_LDA(At, 1, 1); PG8_STAGE(PG8_SA(1, 0), a3, voffA);
            PG8_BAR; PG8_WAIT_L(0); PG8_MMA(1, 0, At, B0); PG8_BAR; PG8_SCHED;
            PG8_STAGE(PG8_SB(1, 1), b3 + hstep, voffB);
            PG8_WAIT_V(6); PG8_BAR; PG8_MMA(1, 1, At, B1); PG8_BAR;
            }
        }
#if defined(GPROBE) && GPROBE == 4
        GP_ADD();
#endif
        if constexpr (ALIGN_EPI) { if (wr == 0) PG8_BAR; }
#if defined(GPROBE) && GPROBE == 1
        GP_MARK();
#elif defined(GPROBE) && GPROBE == 6
        if (ui > 0) GP_ADD();
#endif
        if constexpr (!Epi::AFTER_DRAIN) { E(acc, cur, wr, wc, fr, fq); S.done(cur); }
#if defined(GPROBE) && GPROBE == 1
        GP_ADD();
#elif defined(GPROBE) && GPROBE == 6
        GP_MARK();
#endif
        if (!has_next) break;
#pragma unroll
        for (int a = 0; a < 2; ++a)
#pragma unroll
            for (int b = 0; b < 2; ++b)
#pragma unroll
                for (int m = 0; m < 4; ++m)
#pragma unroll
                    for (int n = 0; n < 2; ++n) acc[a][b][m][n] = (f32x4){0.f, 0.f, 0.f, 0.f};
        cur = nxt; cA = nA; cB = nB; ++ui;
        if constexpr (ALIGN_EPI) { if (wr == 1) PG8_BAR; }
    }
#if defined(GPROBE)
    if (gp_on && lane == 0) tpw[0] = (unsigned)gp_acc;
#endif
    PG8_WAIT_V(0);
    if constexpr (!ALIGN_EPI) { if (wr == 0) PG8_BAR; }
    PG8_BAR;
    if constexpr (Epi::AFTER_DRAIN) { E.fused(acc, cur, wr, wc, fr, fq, lds, wid, lane); S.done(cur); }
    if constexpr (Epi::HAS_FLUSH) E.flush(cur, wr, wc, fr, fq);
#undef PG8_KOF
#undef PG8_SA
#undef PG8_SB
#undef PG8_STAGE
#undef PG8_LDA
#undef PG8_LDB
#undef PG8_MMA
#undef PG8_WAIT_V
#undef PG8_WAIT_L
#undef PG8_BAR
#undef PG8_SCHED
}
}

namespace att {
#define ATT_LAS __attribute__((address_space(3)))
typedef unsigned short bf16_t;
using bf16x8 = __attribute__((ext_vector_type(8))) short;
using s16x4  = __attribute__((ext_vector_type(4))) short;
using f32x16 = __attribute__((ext_vector_type(16))) float;
using f32x4  = __attribute__((ext_vector_type(4))) float;
using u32x4  = __attribute__((ext_vector_type(4))) unsigned;
typedef ATT_LAS char* lptr;
#define SBAR() __builtin_amdgcn_sched_barrier(0)
constexpr int PITCH = 1024;
constexpr float QSCALE = 0.125f * 1.4426950408889634f;
constexpr float THRL = 8.0f * 1.4426950408889634f;
__device__ __forceinline__ int crow(int r, int hi) { return (r & 3) + 8 * (r >> 2) + 4 * hi; }
__device__ __forceinline__ unsigned cvtpk(float lo, float hi) { unsigned r; asm volatile("v_cvt_pk_bf16_f32 %0, %1, %2" : "=v"(r) : "v"(lo), "v"(hi)); return r; }
__device__ __forceinline__ int koff(int row, int c) { return c * 1024 + ((row ^ c) << 4); }
__device__ __forceinline__ int v_st(int k, int c) { const int kk = (k & ~0xC) | ((k & 4) << 1) | ((k & 8) >> 1); return ((kk >> 3) * 4 + (c >> 5)) * 512 + ((kk & 7) * 32 + (c & 31)) * 2; }
__device__ __forceinline__ int v_rd_base(int lane) { return ((lane & 3) << 3) | (((lane >> 2) & 3) << 6) | (((lane >> 4) & 1) << 5) | (((lane >> 5) & 1) << 8); }
constexpr int v_rd_off(int d0, int ks, int half) { return d0 * 512 + ks * 4096 + half * 2048; }
template <int OFF> __device__ __forceinline__ s16x4 tr_read(int vb) { s16x4 r; asm volatile("ds_read_b64_tr_b16 %0, %1 offset:%2" : "=&v"(r) : "v"(vb), "i"(OFF) : "memory"); return r; }
template <int D0> __device__ __forceinline__ void pv_one(f32x16& od, int vb, bf16x8 pa0, bf16x8 pa1, bf16x8 pa2, bf16x8 pa3) {
  const s16x4 l0 = tr_read<v_rd_off(D0, 0, 0)>(vb), h0 = tr_read<v_rd_off(D0, 0, 1)>(vb), l1 = tr_read<v_rd_off(D0, 1, 0)>(vb), h1 = tr_read<v_rd_off(D0, 1, 1)>(vb);
  const s16x4 l2 = tr_read<v_rd_off(D0, 2, 0)>(vb), h2 = tr_read<v_rd_off(D0, 2, 1)>(vb), l3 = tr_read<v_rd_off(D0, 3, 0)>(vb), h3 = tr_read<v_rd_off(D0, 3, 1)>(vb);
  asm volatile("s_waitcnt lgkmcnt(0)" ::: "memory"); SBAR();
#define PK(L, H) (bf16x8){L[0], L[1], L[2], L[3], H[0], H[1], H[2], H[3]}
  od = __builtin_amdgcn_mfma_f32_32x32x16_bf16(pa0, PK(l0, h0), od, 0, 0, 0);
  od = __builtin_amdgcn_mfma_f32_32x32x16_bf16(pa1, PK(l1, h1), od, 0, 0, 0);
  od = __builtin_amdgcn_mfma_f32_32x32x16_bf16(pa2, PK(l2, h2), od, 0, 0, 0);
  od = __builtin_amdgcn_mfma_f32_32x32x16_bf16(pa3, PK(l3, h3), od, 0, 0, 0);
#undef PK
}
__device__ __forceinline__ void qkt(f32x16& p0, f32x16& p1, lptr Ks, const bf16x8* qr, int r32, int hi) {
  bf16x8 kf[8];
#pragma unroll
  for (int d0 = 0; d0 < 4; ++d0) { const int c = 2 * d0 + hi; kf[2 * d0] = *(const ATT_LAS bf16x8*)(Ks + koff(r32, c)); kf[2 * d0 + 1] = *(const ATT_LAS bf16x8*)(Ks + koff(32 + r32, c)); }
  __builtin_amdgcn_sched_barrier(0);
  p0 = __builtin_amdgcn_mfma_f32_32x32x16_bf16(kf[0], qr[0], f32x16{}, 0, 0, 0); p1 = __builtin_amdgcn_mfma_f32_32x32x16_bf16(kf[1], qr[0], f32x16{}, 0, 0, 0);
#pragma unroll
  for (int d0 = 1; d0 < 4; ++d0) { p0 = __builtin_amdgcn_mfma_f32_32x32x16_bf16(kf[2 * d0], qr[d0], p0, 0, 0, 0); p1 = __builtin_amdgcn_mfma_f32_32x32x16_bf16(kf[2 * d0 + 1], qr[d0], p1, 0, 0, 0); }
  __builtin_amdgcn_sched_barrier(0);
}
__device__ __forceinline__ int koff_row(int row, int c) { return row * 128 + ((c ^ ((row >> 1) & 7)) << 4); }
__device__ __forceinline__ void qkt_row(f32x16& p0, f32x16& p1, lptr Ks, const bf16x8* qr, int r32, int hi) {
  bf16x8 kf[8];
#pragma unroll
  for (int d0 = 0; d0 < 4; ++d0) { const int c = 2 * d0 + hi; kf[2 * d0] = *(const ATT_LAS bf16x8*)(Ks + koff_row(r32, c)); kf[2 * d0 + 1] = *(const ATT_LAS bf16x8*)(Ks + koff_row(32 + r32, c)); }
  __builtin_amdgcn_sched_barrier(0);
  p0 = __builtin_amdgcn_mfma_f32_32x32x16_bf16(kf[0], qr[0], f32x16{}, 0, 0, 0); p1 = __builtin_amdgcn_mfma_f32_32x32x16_bf16(kf[1], qr[0], f32x16{}, 0, 0, 0);
#pragma unroll
  for (int d0 = 1; d0 < 4; ++d0) { p0 = __builtin_amdgcn_mfma_f32_32x32x16_bf16(kf[2 * d0], qr[d0], p0, 0, 0, 0); p1 = __builtin_amdgcn_mfma_f32_32x32x16_bf16(kf[2 * d0 + 1], qr[d0], p1, 0, 0, 0); }
  __builtin_amdgcn_sched_barrier(0);
}
__device__ __forceinline__ float rowmax32(const f32x16& p0, const f32x16& p1) {
  float pmax = p0[0];
#pragma unroll
  for (int r = 1; r < 16; ++r) pmax = fmaxf(pmax, p0[r]);
#pragma unroll
  for (int r = 0; r < 16; ++r) pmax = fmaxf(pmax, p1[r]);
  auto rr = __builtin_amdgcn_permlane32_swap(__float_as_uint(pmax), __float_as_uint(pmax), false, false);
  return fmaxf(__uint_as_float(rr[0]), __uint_as_float(rr[1]));
}
__device__ __forceinline__ void partialSM(f32x16& p0, f32x16& p1, float& m_reg, float& mn, float& alpha) {
  const float pmax = rowmax32(p0, p1);
  if (__builtin_expect(__all(pmax - m_reg <= THRL), 1)) { mn = m_reg; alpha = 1.f; }
  else { mn = fmaxf(m_reg, pmax); alpha = __builtin_amdgcn_exp2f(m_reg - mn); m_reg = mn; }
#pragma unroll
  for (int r = 0; r < 16; ++r) p0[r] = p0[r] - mn;
#pragma unroll
  for (int r = 0; r < 16; ++r) p1[r] = p1[r] - mn;
#pragma unroll
  for (int r = 0; r < 16; ++r) p0[r] = __builtin_amdgcn_exp2f(p0[r]);
}
__device__ __forceinline__ void finishSM(f32x16& p0, f32x16& p1, float alpha, float& l_reg, bf16x8& pa0, bf16x8& pa1, bf16x8& pa2, bf16x8& pa3) {
#pragma unroll
  for (int r = 0; r < 16; ++r) p1[r] = __builtin_amdgcn_exp2f(p1[r]);
  float ps = 0;
#pragma unroll
  for (int r = 0; r < 16; ++r) ps += p0[r];
#pragma unroll
  for (int r = 0; r < 16; ++r) ps += p1[r];
  { auto rr = __builtin_amdgcn_permlane32_swap(__float_as_uint(ps), __float_as_uint(ps), false, false); ps = __uint_as_float(rr[0]) + __uint_as_float(rr[1]); }
  l_reg = l_reg * alpha + ps;
#define PK4(P, BASE, OUT) do { unsigned a0 = cvtpk(P[BASE + 0], P[BASE + 1]), a1 = cvtpk(P[BASE + 2], P[BASE + 3]);   \
    unsigned b0 = cvtpk(P[BASE + 4], P[BASE + 5]), b1 = cvtpk(P[BASE + 6], P[BASE + 7]);                              \
    auto r0 = __builtin_amdgcn_permlane32_swap(a0, b0, false, false); auto r1 = __builtin_amdgcn_permlane32_swap(a1, b1, false, false); \
    u32x4 w = {r0[0], r1[0], r0[1], r1[1]}; OUT = __builtin_bit_cast(bf16x8, w); } while (0)
  PK4(p0, 0, pa0); PK4(p0, 8, pa1); PK4(p1, 0, pa2); PK4(p1, 8, pa3);
#undef PK4
}

__device__ __forceinline__ void finishSM_noexp(f32x16& p0, f32x16& p1, float& l_reg, bf16x8& pa0, bf16x8& pa1, bf16x8& pa2, bf16x8& pa3) {
  float ps = 0;
#pragma unroll
  for (int r = 0; r < 16; ++r) ps += p0[r];
#pragma unroll
  for (int r = 0; r < 16; ++r) ps += p1[r];
  { auto rr = __builtin_amdgcn_permlane32_swap(__float_as_uint(ps), __float_as_uint(ps), false, false); ps = __uint_as_float(rr[0]) + __uint_as_float(rr[1]); }
  l_reg += ps;
#define PK4(P, BASE, OUT) do { unsigned a0 = cvtpk(P[BASE + 0], P[BASE + 1]), a1 = cvtpk(P[BASE + 2], P[BASE + 3]);   \
    unsigned b0 = cvtpk(P[BASE + 4], P[BASE + 5]), b1 = cvtpk(P[BASE + 6], P[BASE + 7]);                              \
    auto r0 = __builtin_amdgcn_permlane32_swap(a0, b0, false, false); auto r1 = __builtin_amdgcn_permlane32_swap(a1, b1, false, false); \
    u32x4 w = {r0[0], r1[0], r0[1], r1[1]}; OUT = __builtin_bit_cast(bf16x8, w); } while (0)
  PK4(p0, 0, pa0); PK4(p0, 8, pa1); PK4(p1, 0, pa2); PK4(p1, 8, pa3);
#undef PK4
}

__device__ __forceinline__ void finish_T(const f32x16& p0, const f32x16& p1, float& l_reg, bf16x8& pa0, bf16x8& pa1, bf16x8& pa2, bf16x8& pa3) {
  float ps = 0;
#pragma unroll
  for (int r = 0; r < 16; ++r) ps += p0[r];
#pragma unroll
  for (int r = 0; r < 16; ++r) ps += p1[r];
  l_reg += ps;
#define PK8(P, BASE, OUT) do { u32x4 w = {cvtpk(P[BASE + 0], P[BASE + 1]), cvtpk(P[BASE + 2], P[BASE + 3]), cvtpk(P[BASE + 4], P[BASE + 5]), cvtpk(P[BASE + 6], P[BASE + 7])}; OUT = __builtin_bit_cast(bf16x8, w); } while (0)
  PK8(p0, 0, pa0); PK8(p0, 8, pa1); PK8(p1, 0, pa2); PK8(p1, 8, pa3);
#undef PK8
}

constexpr int DA_SHM_V = 16384, DA_SHM_K = 8192, DA_LDS_V = 0, DA_LDS_K = 2 * DA_SHM_V, DA_LDS_WS = DA_LDS_K + 2 * DA_SHM_K, DA_LDS_BYTES = DA_LDS_WS + 8 * 256;
__device__ __forceinline__ void da_pass(const bf16_t* __restrict__ Qw, const bf16_t* __restrict__ Kh, const bf16_t* __restrict__ Vh, int NT, lptr lds, int tid, int wid, int lane,
                                        f32x16 (&o)[4], float& l_out) {
  const int r32 = lane & 31, hi = lane >> 5;
  const lptr V_lds = lds + DA_LDS_V, K_lds = lds + DA_LDS_K;
  ATT_LAS float* al_l = (ATT_LAS float*)(lds + DA_LDS_WS) + wid * 64 + 32;
  float m_reg = -1e30f, l_reg = 0.f;
#pragma unroll
  for (int d = 0; d < 4; ++d) o[d] = f32x16{};
  bf16x8 qr[4];
#pragma unroll
  for (int d0 = 0; d0 < 4; ++d0) qr[d0] = *(const bf16x8*)(Qw + d0 * 16);
  const int sr = tid >> 4, sc = (tid & 15) * 8, vst0 = v_st(sr, sc), vst1 = v_st(32 + sr, sc);
  const int kr = tid >> 3, kc = tid & 7, kst = koff(kr, kc);
  const int vb0 = (int)(unsigned)(uintptr_t)V_lds + v_rd_base(lane);
  bf16x8 sv0[2], sv1[2], sk[2];
#define SLOAD(i, k0) do { sv0[i] = *(const bf16x8*)(Vh + (size_t)((k0) + sr) * PITCH + sc); sv1[i] = *(const bf16x8*)(Vh + (size_t)((k0) + 32 + sr) * PITCH + sc); \
    sk[i] = *(const bf16x8*)(Kh + (size_t)((k0) + kr) * PITCH + kc * 8); } while (0)
#define SWRITE(b, i) do { *(ATT_LAS bf16x8*)(V_lds + (b) * DA_SHM_V + vst0) = sv0[i]; *(ATT_LAS bf16x8*)(V_lds + (b) * DA_SHM_V + vst1) = sv1[i]; \
    *(ATT_LAS bf16x8*)(K_lds + (b) * DA_SHM_K + kst) = sk[i]; } while (0)
#define SWAIT() asm volatile("s_waitcnt vmcnt(3)" ::: "memory")
#define RESC(a) do { if (__any((a) < 1.f)) { if (hi == 0) al_l[r32] = (a); asm volatile("s_waitcnt lgkmcnt(0)" ::: "memory"); \
    _Pragma("unroll") for (int d = 0; d < 4; ++d) _Pragma("unroll") for (int r = 0; r < 16; ++r) o[d][r] *= al_l[crow(r, hi)]; } } while (0)
#define PVALL(vb) do { pv_one<0>(o[0], (vb), pa0, pa1, pa2, pa3); pv_one<1>(o[1], (vb), pa0, pa1, pa2, pa3); pv_one<2>(o[2], (vb), pa0, pa1, pa2, pa3); pv_one<3>(o[3], (vb), pa0, pa1, pa2, pa3); } while (0)
  f32x16 pA0, pA1, pB0, pB1; float mnA, mnB, alA, alB; bf16x8 pa0, pa1, pa2, pa3;
  SLOAD(0, 0); asm volatile("s_waitcnt vmcnt(0)" ::: "memory"); SWRITE(0, 0); __syncthreads();
  qkt(pA0, pA1, K_lds, qr, r32, hi); partialSM(pA0, pA1, m_reg, mnA, alA);
  SLOAD(1, 64); if (2 < NT) SLOAD(0, 128);
  SWAIT(); SWRITE(1, 1); __syncthreads();
  for (int j = 1; j + 1 < NT; j += 2) {
    SBAR(); qkt(pB0, pB1, K_lds + DA_SHM_K, qr, r32, hi);
    finishSM(pA0, pA1, alA, l_reg, pa0, pa1, pa2, pa3); SBAR();
    SLOAD(1, (j + 2) * 64); SBAR();
    PVALL(vb0); partialSM(pB0, pB1, m_reg, mnB, alB);
    __syncthreads(); SWAIT(); SWRITE(0, 0);
    RESC(alB); __syncthreads();
    SBAR(); qkt(pA0, pA1, K_lds, qr, r32, hi);
    finishSM(pB0, pB1, alB, l_reg, pa0, pa1, pa2, pa3); SBAR();
    if (j + 3 < NT) SLOAD(0, (j + 3) * 64); SBAR();
    PVALL(vb0 + DA_SHM_V); partialSM(pA0, pA1, m_reg, mnA, alA);
    __syncthreads(); SWAIT(); SWRITE(1, 1);
    RESC(alA); __syncthreads();
  }
  SBAR(); qkt(pB0, pB1, K_lds + DA_SHM_K, qr, r32, hi);
  finishSM(pA0, pA1, alA, l_reg, pa0, pa1, pa2, pa3); SBAR();
  PVALL(vb0); partialSM(pB0, pB1, m_reg, mnB, alB);
  __syncthreads(); RESC(alB);
  finishSM(pB0, pB1, alB, l_reg, pa0, pa1, pa2, pa3); SBAR();
  PVALL(vb0 + DA_SHM_V);
  l_out = l_reg;
  __syncthreads();
#undef SLOAD
#undef SWRITE
#undef SWAIT
#undef RESC
#undef PVALL
}
#ifndef DA_SP
#define DA_SP 0
#endif
#ifndef PP_PREF
#define PP_PREF 0
#endif
#ifndef PP_DMA_LATE
#define PP_DMA_LATE 0
#endif
#ifndef PP_DMA_IN_M
#define PP_DMA_IN_M 1
#endif
#ifndef PP_PRIO
#define PP_PRIO 1
#endif
#ifndef PP_NS
#define PP_NS 3
#endif
#ifndef PP_MIDBAR
#define PP_MIDBAR 0
#endif
#define PP_MID() do { if (PP_MIDBAR) PP_BAR(); else __builtin_amdgcn_sched_barrier(0); } while (0)
constexpr int PP_K = 0, PP_V = PP_NS * 8192, PP_WS = PP_V + PP_NS * 16384, PP_BYTES = PP_WS + 8 * 256;
typedef short v4i16_t __attribute__((ext_vector_type(4)));
__device__ __forceinline__ short qr_raw(const bf16x8& v, int e) { return v[e]; }
__device__ __forceinline__ s16x4 vtr(lptr p) { return __builtin_bit_cast(s16x4, __builtin_amdgcn_ds_read_tr16_b64_v4i16((ATT_LAS v4i16_t*)p)); }
#define PP_BAR() do { __builtin_amdgcn_sched_barrier(0); asm volatile("s_waitcnt lgkmcnt(0)" ::: "memory"); __builtin_amdgcn_s_barrier(); __builtin_amdgcn_sched_barrier(0); } while (0)
template <int GRP>
__device__ __forceinline__ void da_pass_pp(const bf16_t* __restrict__ Qw, const bf16_t* __restrict__ Kh, const bf16_t* __restrict__ Vh, int NT, lptr lds, int wid, int lane,
                                           float kmax2, f32x16 (&o)[4], float& l_out, unsigned* dbg = nullptr, int variant = 0) {
  const int r32 = lane & 31, hi = lane >> 5;
  const lptr Kr = lds + PP_K, Vr = lds + PP_V;
  ATT_LAS float* al_l = (ATT_LAS float*)(lds + PP_WS) + wid * 64 + 32;
#if DA_KROW
  const bf16_t* ksrc; { const int kr_l = wid * 8 + (lane >> 3), c_l = (lane & 7) ^ ((kr_l >> 1) & 7); ksrc = Kh + (size_t)kr_l * PITCH + c_l * 8; }
#define DA_KOFF koff_row
#else
  const bf16_t* ksrc = Kh + (size_t)(lane ^ wid) * PITCH + wid * 8;
#define DA_KOFF koff
#endif
  const bf16_t* vsrc0;
  { const int j = lane & 31, sidx = 2 * (2 * wid) + (lane >> 5), kk = (sidx >> 2) * 8 + (j >> 2), col = (sidx & 3) * 32 + (j & 3) * 8; vsrc0 = Vh + (size_t)kk * PITCH + col; }
#define DMA_K(t, slot) __builtin_amdgcn_global_load_lds((const unsigned*)(ksrc + (size_t)(t) * 64 * PITCH), (ATT_LAS unsigned*)(Kr + (slot) * 8192 + wid * 1024), 16, 0, 0)
#define DMA_V0(t, slot) __builtin_amdgcn_global_load_lds((const unsigned*)(vsrc0 + (size_t)(t) * 64 * PITCH), (ATT_LAS unsigned*)(Vr + (slot) * 16384 + (2 * wid) * 1024), 16, 0, 0)
#define DMA_V1(t, slot) __builtin_amdgcn_global_load_lds((const unsigned*)(vsrc0 + 64 + (size_t)(t) * 64 * PITCH), (ATT_LAS unsigned*)(Vr + (slot) * 16384 + (2 * wid + 1) * 1024), 16, 0, 0)
#define DMA_V(t, slot) do { DMA_V0(t, slot); DMA_V1(t, slot); } while (0)
  bf16x8 qr[4];
#pragma unroll
  for (int d0 = 0; d0 < 4; ++d0) qr[d0] = *(const bf16x8*)(Qw + d0 * 16);
  DMA_K(0, 0); DMA_V(0, 0); DMA_K(1, 1); if (PP_NS == 4) { DMA_K(2, 2); DMA_V(1, 1); }
  bool fast;
  { float qn = 0.f;
#pragma unroll
    for (int d0 = 0; d0 < 4; ++d0) {
#pragma unroll
      for (int e = 0; e < 8; ++e) { const float v = __uint_as_float(((unsigned)(unsigned short)qr_raw(qr[d0], e)) << 16); qn += v * v; } }
    { auto rr = __builtin_amdgcn_permlane32_swap(__float_as_uint(qn), __float_as_uint(qn), false, false); qn = __uint_as_float(rr[0]) + __uint_as_float(rr[1]); }
#ifdef PROBE_FORCE_FAST
    fast = true; }
#elif defined(PROBE_FORCE_SLOW)
    fast = false; }
#else
    fast = __all(qn * kmax2 * 1.05f < 10000.f) != 0; }
#endif
#pragma unroll
  for (int d = 0; d < 4; ++d) o[d] = f32x16{};
  float mref = 0.f, l_reg = 0.f;
  f32x16 S0, S1; bf16x8 pa0, pa1, pa2, pa3; const f32x16 zero16 = f32x16{};
  const int kq0 = DA_KOFF(r32, hi), kq1 = DA_KOFF(32 + r32, hi);
  const int vbase = v_rd_base(lane);
  asm volatile("s_waitcnt vmcnt(0)" ::: "memory");
  PP_BAR();
  int ks_cur = 0, vs_prev = PP_NS - 1, vs_new = PP_NS - 2;
#define SB0() __builtin_amdgcn_sched_barrier(0)
#define VRD8(d0, L0, H0, L1, H1, L2, H2, L3, H3) do { L0 = vtr(Vt + v_rd_off(d0, 0, 0)); H0 = vtr(Vt + v_rd_off(d0, 0, 1)); L1 = vtr(Vt + v_rd_off(d0, 1, 0)); H1 = vtr(Vt + v_rd_off(d0, 1, 1)); \
    L2 = vtr(Vt + v_rd_off(d0, 2, 0)); H2 = vtr(Vt + v_rd_off(d0, 2, 1)); L3 = vtr(Vt + v_rd_off(d0, 3, 0)); H3 = vtr(Vt + v_rd_off(d0, 3, 1)); } while (0)
#define PV4(d0, L0, H0, L1, H1, L2, H2, L3, H3) do { \
    o[d0] = __builtin_amdgcn_mfma_f32_32x32x16_bf16((bf16x8){L0[0], L0[1], L0[2], L0[3], H0[0], H0[1], H0[2], H0[3]}, pa0, o[d0], 0, 0, 0); \
    o[d0] = __builtin_amdgcn_mfma_f32_32x32x16_bf16((bf16x8){L1[0], L1[1], L1[2], L1[3], H1[0], H1[1], H1[2], H1[3]}, pa1, o[d0], 0, 0, 0); \
    o[d0] = __builtin_amdgcn_mfma_f32_32x32x16_bf16((bf16x8){L2[0], L2[1], L2[2], L2[3], H2[0], H2[1], H2[2], H2[3]}, pa2, o[d0], 0, 0, 0); \
    o[d0] = __builtin_amdgcn_mfma_f32_32x32x16_bf16((bf16x8){L3[0], L3[1], L3[2], L3[3], H3[0], H3[1], H3[2], H3[3]}, pa3, o[d0], 0, 0, 0); } while (0)
#define KRD8(KS) do { const lptr Kt = Kr + (KS) * 8192; \
    kf[0] = *(const ATT_LAS bf16x8*)(Kt + DA_KOFF(r32, hi)); kf[1] = *(const ATT_LAS bf16x8*)(Kt + DA_KOFF(32 + r32, hi)); \
    kf[2] = *(const ATT_LAS bf16x8*)(Kt + DA_KOFF(r32, 2 + hi)); kf[3] = *(const ATT_LAS bf16x8*)(Kt + DA_KOFF(32 + r32, 2 + hi)); \
    kf[4] = *(const ATT_LAS bf16x8*)(Kt + DA_KOFF(r32, 4 + hi)); kf[5] = *(const ATT_LAS bf16x8*)(Kt + DA_KOFF(32 + r32, 4 + hi)); \
    kf[6] = *(const ATT_LAS bf16x8*)(Kt + DA_KOFF(r32, 6 + hi)); kf[7] = *(const ATT_LAS bf16x8*)(Kt + DA_KOFF(32 + r32, 6 + hi)); } while (0)
#define KRD4A(KS) do { const lptr Kt = Kr + (KS) * 8192; \
    kf[0] = *(const ATT_LAS bf16x8*)(Kt + DA_KOFF(r32, hi)); kf[1] = *(const ATT_LAS bf16x8*)(Kt + DA_KOFF(32 + r32, hi)); } while (0)
#define KRD4B(KS) do { const lptr Kt = Kr + (KS) * 8192; \
    kf[2] = *(const ATT_LAS bf16x8*)(Kt + DA_KOFF(r32, 2 + hi)); kf[3] = *(const ATT_LAS bf16x8*)(Kt + DA_KOFF(32 + r32, 2 + hi)); \
    kf[4] = *(const ATT_LAS bf16x8*)(Kt + DA_KOFF(r32, 4 + hi)); kf[5] = *(const ATT_LAS bf16x8*)(Kt + DA_KOFF(32 + r32, 4 + hi)); \
    kf[6] = *(const ATT_LAS bf16x8*)(Kt + DA_KOFF(r32, 6 + hi)); kf[7] = *(const ATT_LAS bf16x8*)(Kt + DA_KOFF(32 + r32, 6 + hi)); } while (0)
#define QK8() do { \
    S0 = __builtin_amdgcn_mfma_f32_32x32x16_bf16(kf[0], qr[0], zero16, 0, 0, 0); S1 = __builtin_amdgcn_mfma_f32_32x32x16_bf16(kf[1], qr[0], zero16, 0, 0, 0); \
    S0 = __builtin_amdgcn_mfma_f32_32x32x16_bf16(kf[2], qr[1], S0, 0, 0, 0);   S1 = __builtin_amdgcn_mfma_f32_32x32x16_bf16(kf[3], qr[1], S1, 0, 0, 0); \
    S0 = __builtin_amdgcn_mfma_f32_32x32x16_bf16(kf[4], qr[2], S0, 0, 0, 0);   S1 = __builtin_amdgcn_mfma_f32_32x32x16_bf16(kf[5], qr[2], S1, 0, 0, 0); \
    S0 = __builtin_amdgcn_mfma_f32_32x32x16_bf16(kf[6], qr[3], S0, 0, 0, 0);   S1 = __builtin_amdgcn_mfma_f32_32x32x16_bf16(kf[7], qr[3], S1, 0, 0, 0); } while (0)
  bf16x8 kf[8]; s16x4 a0, a1, a2, a3, a4, a5, a6, a7, b0_, b1_, b2_, b3_, b4_, b5_, b6_, b7_;
#define NXT3(x) ((x) == PP_NS - 1 ? 0 : (x) + 1)
#define PREF(DO_K, DO_V, kslot, vslot) do { if (DO_V) { const lptr Vt = Vr + (vslot) * 16384 + vbase; VRD8(0, a0, a1, a2, a3, a4, a5, a6, a7); } \
    if (DO_K) { const int ks_cur_ = (kslot); KRD8(ks_cur_); } } while (0)
#define MB_DMA_K(tt) do { if (PP_DMA_IN_M && (tt) + PP_NS - 1 < NT) { DMA_K((tt) + PP_NS - 1, vs_prev); SB0(); } } while (0)
#define MB_DMA_V0(tt) do { if (PP_DMA_IN_M && (tt) + PP_NS - 2 < NT) { DMA_V0((tt) + PP_NS - 2, vs_new); SB0(); } } while (0)
#define MB_DMA_V1(tt) do { if (PP_DMA_IN_M && (tt) + PP_NS - 2 < NT) { DMA_V1((tt) + PP_NS - 2, vs_new); SB0(); } } while (0)
#define MBLOCK(DO_QK, DO_PV, tt) do { if (PP_PRIO == 1) __builtin_amdgcn_s_setprio(1); const lptr Vt = Vr + vs_prev * 16384 + vbase; \
    if (PP_PREF == 0 || PP_PREF == 4) { if (DO_QK) { if (PP_PREF == 0 || GRP == 0) { KRD8(ks_cur); SB0(); } } else if (DO_PV) { VRD8(0, a0, a1, a2, a3, a4, a5, a6, a7); SB0(); } } \
    if (PP_PREF == 3) { if (DO_QK) KRD4B(ks_cur); if (DO_PV) VRD8(0, a0, a1, a2, a3, a4, a5, a6, a7); SB0(); } \
    if (DO_QK && variant != 2) { QK8(); SB0(); if ((PP_PREF == 0 || PP_PREF == 4) && DO_PV) { VRD8(0, a0, a1, a2, a3, a4, a5, a6, a7); SB0(); } } \
    if (DO_PV && variant != 2) { VRD8(1, b0_, b1_, b2_, b3_, b4_, b5_, b6_, b7_); SB0(); PV4(0, a0, a1, a2, a3, a4, a5, a6, a7); SB0(); MB_DMA_K(tt); VRD8(2, a0, a1, a2, a3, a4, a5, a6, a7); SB0(); \
                 PV4(1, b0_, b1_, b2_, b3_, b4_, b5_, b6_, b7_); SB0(); MB_DMA_V0(tt); VRD8(3, b0_, b1_, b2_, b3_, b4_, b5_, b6_, b7_); SB0(); \
                 PV4(2, a0, a1, a2, a3, a4, a5, a6, a7); SB0(); MB_DMA_V1(tt); \
                 PV4(3, b0_, b1_, b2_, b3_, b4_, b5_, b6_, b7_); SB0(); \
                 if (PP_PREF == 3 && (tt) + 1 < NT) { KRD4A(NXT3(ks_cur)); SB0(); } } \
    else { MB_DMA_K(tt); MB_DMA_V0(tt); MB_DMA_V1(tt); if (PP_PREF == 3 && (tt) + 1 < NT) { KRD4A(NXT3(ks_cur)); SB0(); } } \
    if (PP_PRIO == 1) __builtin_amdgcn_s_setprio(0); } while (0)
#define VBLOCK(t) do { if ((t) >= 0 && (t) < NT && variant != 1) { if (PP_PRIO == 2) __builtin_amdgcn_s_setprio(1); \
    if (!fast) { const float rm = rowmax32(S0, S1); \
      if ((t) == 0 || __any(rm - mref > THRL)) { const float mn = (t) == 0 ? rm : fmaxf(rm, mref); \
        if ((t) != 0) { const float f = __builtin_amdgcn_exp2f(mref - mn); l_reg *= f; \
          _Pragma("unroll") for (int d = 0; d < 4; ++d) _Pragma("unroll") for (int r = 0; r < 16; ++r) o[d][r] *= f; } \
        mref = mn; } \
      _Pragma("unroll") for (int r = 0; r < 16; ++r) { S0[r] -= mref; S1[r] -= mref; } } \
    _Pragma("unroll") for (int r = 0; r < 16; ++r) { S0[r] = __builtin_amdgcn_exp2f(S0[r]); S1[r] = __builtin_amdgcn_exp2f(S1[r]); } \
    finish_T(S0, S1, l_reg, pa0, pa1, pa2, pa3); if (PP_PRIO == 2) __builtin_amdgcn_s_setprio(0); } } while (0)
#define ROT3() do { vs_new = vs_prev; vs_prev = ks_cur; ks_cur = ks_cur == PP_NS - 1 ? 0 : ks_cur + 1; } while (0)
#define TAILWAIT(t) do { if (PP_PREF == 3) { if ((t) + 3 < NT) asm volatile("s_waitcnt vmcnt(3)" ::: "memory"); else if ((t) + 2 < NT) asm volatile("s_waitcnt vmcnt(2)" ::: "memory"); else asm volatile("s_waitcnt vmcnt(0)" ::: "memory"); } \
    else if (PP_NS == 3) { if ((t) + 2 < NT) asm volatile("s_waitcnt vmcnt(3)" ::: "memory"); else if ((t) + 1 < NT) asm volatile("s_waitcnt vmcnt(2)" ::: "memory"); else asm volatile("s_waitcnt vmcnt(0)" ::: "memory"); } \
    else { if ((t) + 3 < NT) asm volatile("s_waitcnt vmcnt(6)" ::: "memory"); else if ((t) + 2 < NT) asm volatile("s_waitcnt vmcnt(5)" ::: "memory"); else if ((t) + 1 < NT) asm volatile("s_waitcnt vmcnt(2)" ::: "memory"); else asm volatile("s_waitcnt vmcnt(0)" ::: "memory"); } } while (0)
#if defined(DPROBE)
  unsigned long long dp_acc = 0, dp_prev = 0; const bool dp_on = dbg != nullptr && blockIdx.x == 0 && wid == (DPROBE_GRP ? 4 : 0) && GRP == DPROBE_GRP;
#define DP_T(i) do { if (dp_on) { const unsigned long long now_ = __builtin_amdgcn_s_memtime(); if ((i) == DPROBE) dp_acc += now_ - dp_prev; dp_prev = now_; } } while (0)
#else
#define DP_T(i) do {} while (0)
#endif
#define DMA_ISSUE(t) do { if ((t) + PP_NS - 1 < NT) DMA_K((t) + PP_NS - 1, vs_prev); if ((t) + PP_NS - 2 < NT) DMA_V((t) + PP_NS - 2, vs_new); } while (0)
#if DA_SP
  bf16x8 pb0, pb1, pb2, pb3; float resf = 1.f; bool resc = false;
#define SP_PRELUDE(t) do { resc = false; if (!fast) { const float rm = rowmax32(S0, S1); \
      if ((t) == 0 || __any(rm - mref > THRL)) { const float mn = (t) == 0 ? rm : fmaxf(rm, mref); resf = (t) == 0 ? 1.f : __builtin_amdgcn_exp2f(mref - mn); resc = (t) != 0; mref = mn; } \
      _Pragma("unroll") for (int r = 0; r < 16; ++r) { S0[r] -= mref; S1[r] -= mref; } } } while (0)
#define SP_EXP0() do { _Pragma("unroll") for (int r = 0; r < 16; ++r) S0[r] = __builtin_amdgcn_exp2f(S0[r]); } while (0)
#define SP_EXP1() do { _Pragma("unroll") for (int r = 0; r < 16; ++r) S1[r] = __builtin_amdgcn_exp2f(S1[r]); } while (0)
#define SP_SUM() do { float ps = 0.f; _Pragma("unroll") for (int r = 0; r < 16; ++r) ps += S0[r]; _Pragma("unroll") for (int r = 0; r < 16; ++r) ps += S1[r]; \
      l_reg = resc ? l_reg * resf + ps : l_reg + ps; } while (0)
#define SP_PACK() do { u32x4 w0_ = {cvtpk(S0[0], S0[1]), cvtpk(S0[2], S0[3]), cvtpk(S0[4], S0[5]), cvtpk(S0[6], S0[7])}; pb0 = __builtin_bit_cast(bf16x8, w0_); \
      u32x4 w1_ = {cvtpk(S0[8], S0[9]), cvtpk(S0[10], S0[11]), cvtpk(S0[12], S0[13]), cvtpk(S0[14], S0[15])}; pb1 = __builtin_bit_cast(bf16x8, w1_); \
      u32x4 w2_ = {cvtpk(S1[0], S1[1]), cvtpk(S1[2], S1[3]), cvtpk(S1[4], S1[5]), cvtpk(S1[6], S1[7])}; pb2 = __builtin_bit_cast(bf16x8, w2_); \
      u32x4 w3_ = {cvtpk(S1[8], S1[9]), cvtpk(S1[10], S1[11]), cvtpk(S1[12], S1[13]), cvtpk(S1[14], S1[15])}; pb3 = __builtin_bit_cast(bf16x8, w3_); } while (0)
#define SP_RESC() do { if (resc) { _Pragma("unroll") for (int d = 0; d < 4; ++d) _Pragma("unroll") for (int r = 0; r < 16; ++r) o[d][r] *= resf; } } while (0)
#define SP_ROLL() do { pa0 = pb0; pa1 = pb1; pa2 = pb2; pa3 = pb3; } while (0)
  { KRD8(ks_cur); SB0(); QK8(); SB0(); MB_DMA_K(0); MB_DMA_V0(0); MB_DMA_V1(0);
    SP_PRELUDE(0); SP_EXP0(); SP_EXP1(); SP_SUM(); SP_PACK(); SP_ROLL();
    SB0(); TAILWAIT(0); PP_BAR(); ROT3(); }
#pragma clang loop unroll(disable)
  for (int t = 1; t < NT; ++t) {
    const lptr Vt = Vr + vs_prev * 16384 + vbase;
    if (PP_PRIO == 1) __builtin_amdgcn_s_setprio(1);
    KRD8(ks_cur); VRD8(0, a0, a1, a2, a3, a4, a5, a6, a7); SB0();
    QK8(); SB0();
    PV4(0, a0, a1, a2, a3, a4, a5, a6, a7); SB0(); MB_DMA_K(t); VRD8(1, a0, a1, a2, a3, a4, a5, a6, a7); SB0();
    SP_PRELUDE(t); SP_EXP0(); SB0();
    PV4(1, a0, a1, a2, a3, a4, a5, a6, a7); SB0(); MB_DMA_V0(t); VRD8(2, a0, a1, a2, a3, a4, a5, a6, a7); SB0();
    SP_EXP1(); SB0();
    PV4(2, a0, a1, a2, a3, a4, a5, a6, a7); SB0(); MB_DMA_V1(t); VRD8(3, a0, a1, a2, a3, a4, a5, a6, a7); SB0();
    SP_SUM(); SB0();
    PV4(3, a0, a1, a2, a3, a4, a5, a6, a7); SB0();
    if (PP_PRIO == 1) __builtin_amdgcn_s_setprio(0);
    SP_PACK(); SP_RESC(); SP_ROLL();
    SB0(); TAILWAIT(t); PP_BAR(); ROT3();
  }
  { const lptr Vt = Vr + vs_prev * 16384 + vbase;
    VRD8(0, a0, a1, a2, a3, a4, a5, a6, a7); SB0(); PV4(0, a0, a1, a2, a3, a4, a5, a6, a7); SB0(); VRD8(1, a0, a1, a2, a3, a4, a5, a6, a7); SB0(); PV4(1, a0, a1, a2, a3, a4, a5, a6, a7); SB0();
    VRD8(2, a0, a1, a2, a3, a4, a5, a6, a7); SB0(); PV4(2, a0, a1, a2, a3, a4, a5, a6, a7); SB0(); VRD8(3, a0, a1, a2, a3, a4, a5, a6, a7); SB0(); PV4(3, a0, a1, a2, a3, a4, a5, a6, a7); SB0();
    PP_BAR(); }
#undef SP_PRELUDE
#undef SP_EXP0
#undef SP_EXP1
#undef SP_SUM
#undef SP_PACK
#undef SP_RESC
#undef SP_ROLL
#else
  { if (!PP_DMA_IN_M && !(PP_DMA_LATE && GRP == 0)) { DMA_ISSUE(0); SB0(); }
    if (PP_PREF == 3) { KRD4A(ks_cur); SB0(); } else if (PP_PREF != 0) { PREF(true, false, ks_cur, 0); SB0(); }
    if (GRP == 0) MBLOCK(true, false, 0);
    if (!PP_DMA_IN_M && PP_DMA_LATE && GRP == 0) { SB0(); DMA_ISSUE(0); }
    SB0(); if (PP_PREF == 1 || PP_PREF == 2) TAILWAIT(0); PP_MID();
    if (GRP == 0) { if (PP_PREF == 1) { PREF(1 < NT, true, NXT3(ks_cur), NXT3(vs_prev)); SB0(); } VBLOCK(0); if (PP_PREF == 2) { SB0(); PREF(1 < NT, true, NXT3(ks_cur), NXT3(vs_prev)); } } else { if (PP_PREF == 4) { KRD8(ks_cur); SB0(); } MBLOCK(true, false, 0); }
    SB0(); if (PP_PREF == 0 || PP_PREF == 3 || PP_PREF == 4) TAILWAIT(0); PP_BAR(); ROT3(); }
#pragma clang loop unroll(disable)
  for (int t = 1; t < NT; ++t) {
    DP_T(0);
    if (!PP_DMA_IN_M && !(PP_DMA_LATE && GRP == 0)) { DMA_ISSUE(t); SB0(); }
    if (GRP == 0) MBLOCK(true, true, t); else { if (PP_PREF == 4) { KRD8(ks_cur); SB0(); } if (PP_PREF == 1) { PREF(true, true, ks_cur, vs_prev); SB0(); } VBLOCK(t - 1); if (PP_PREF == 2) { SB0(); PREF(true, true, ks_cur, vs_prev); } }
    if (!PP_DMA_IN_M && PP_DMA_LATE && GRP == 0) { SB0(); DMA_ISSUE(t); }
    SB0(); if (PP_PREF == 1 || PP_PREF == 2) TAILWAIT(t); DP_T(1); PP_MID(); DP_T(2);
    if (GRP == 0) { if (PP_PREF == 1) { PREF(t + 1 < NT, true, NXT3(ks_cur), NXT3(vs_prev)); SB0(); } VBLOCK(t); if (PP_PREF == 2) { SB0(); PREF(t + 1 < NT, true, NXT3(ks_cur), NXT3(vs_prev)); } } else MBLOCK(true, true, t);
    SB0(); if (PP_PREF == 0 || PP_PREF == 3 || PP_PREF == 4) TAILWAIT(t); DP_T(3); PP_BAR(); DP_T(4); ROT3();
  }
  { if (GRP == 0) MBLOCK(false, true, NT); else { if (PP_PREF == 1) { PREF(false, true, 0, vs_prev); SB0(); } VBLOCK(NT - 1); if (PP_PREF == 2) { SB0(); PREF(false, true, 0, vs_prev); } }
    PP_MID();
    if (GRP == 1) MBLOCK(false, true, NT);
    PP_BAR(); }
#endif
#if defined(DPROBE)
  if (dp_on && lane == 0) atomicAdd(dbg, (unsigned)(dp_acc >> 4));
#endif
  l_out = l_reg;
#undef DMA_K
#undef DMA_V
#undef MBLOCK
#undef MB_DMA_K
#undef MB_DMA_V0
#undef MB_DMA_V1
#undef VBLOCK
#undef SB0
#undef VRD8
#undef PV4
#undef KRD8
#undef KRD4A
#undef KRD4B
#undef QK8
#undef ROT3
#undef TAILWAIT
#undef PREF
#undef NXT3
#undef DMA_ISSUE
}
constexpr int DA_LDS_OST = 0, DA_LDS_TOTAL = PP_BYTES;
__device__ __forceinline__ void da_unit(size_t rowbase, int T, int h, int qb, const bf16_t* Q, const bf16_t* K, const bf16_t* V, bf16_t* O, float* park, unsigned lam_bits, float outscale,
                                        const float* __restrict__ subg, const unsigned* kmaxp, lptr lds, int tid, int wid, int lane, unsigned* dbg = nullptr, int variant = 0) {
  const int NT = T / 64;
  const size_t qrow = rowbase + (size_t)qb * 256 + wid * 32;
  f32x16 o[4]; float l_reg;
#pragma clang loop unroll(disable)
  for (int sub = 0; sub < 2; ++sub) {
    asm volatile("" : "+v"(tid)); lane = tid & 63;
    const int r32 = lane & 31, hi = lane >> 5;
    ATT_LAS float* li_l = (ATT_LAS float*)(lds + PP_WS) + wid * 64;
    const float kmax2 = __uint_as_float(__builtin_nontemporal_load(kmaxp + 2 * h + sub));
    if (wid < 4) da_pass_pp<0>(Q + (qrow + r32) * PITCH + (2 * h + sub) * 64 + hi * 8, K + rowbase * PITCH + (2 * h + sub) * 64, V + rowbase * PITCH + h * 128, NT, lds, wid, lane, kmax2, o, l_reg, dbg, variant);
    else da_pass_pp<1>(Q + (qrow + r32) * PITCH + (2 * h + sub) * 64 + hi * 8, K + rowbase * PITCH + (2 * h + sub) * 64, V + rowbase * PITCH + h * 128, NT, lds, wid, lane, kmax2, o, l_reg, dbg, variant);
    { auto rr = __builtin_amdgcn_permlane32_swap(__float_as_uint(l_reg), __float_as_uint(l_reg), false, false); l_reg = __uint_as_float(rr[0]) + __uint_as_float(rr[1]); }
    const float rl = __builtin_amdgcn_rcpf(l_reg);
    f32x4* pk = (f32x4*)(park + ((size_t)wid * 64 + lane) * 64);
    if (sub == 0) {
#pragma unroll
      for (int d0 = 0; d0 < 4; ++d0)
#pragma unroll
        for (int q = 0; q < 4; ++q) { f32x4 v; v[0] = o[d0][4 * q] * rl; v[1] = o[d0][4 * q + 1] * rl; v[2] = o[d0][4 * q + 2] * rl; v[3] = o[d0][4 * q + 3] * rl; pk[d0 * 4 + q] = v; }
    } else {
      const float rll = rl * __uint_as_float(lam_bits); float ss = 0.f;
#pragma unroll
      for (int d0 = 0; d0 < 4; ++d0)
#pragma unroll
        for (int q = 0; q < 4; ++q) { const f32x4 p = pk[d0 * 4 + q];
#pragma unroll
          for (int j = 0; j < 4; ++j) { const float v = p[j] - o[d0][4 * q + j] * rll; o[d0][4 * q + j] = v; ss += v * v; } }
      { auto rr = __builtin_amdgcn_permlane32_swap(__float_as_uint(ss), __float_as_uint(ss), false, false); ss = __uint_as_float(rr[0]) + __uint_as_float(rr[1]); }
      const float rstd = __builtin_amdgcn_rsqf(ss * (1.0f / 128.0f) + 1e-5f) * outscale;
      ATT_LAS bf16_t* stg = (ATT_LAS bf16_t*)(lds + DA_LDS_OST) + wid * 4096;
#pragma unroll
      for (int d0 = 0; d0 < 4; ++d0)
#pragma unroll
        for (int q = 0; q < 4; ++q) { const f32x4 gv = *(const f32x4*)(subg + d0 * 32 + 8 * q + 4 * hi);
          typedef unsigned u32x2v __attribute__((ext_vector_type(2))); u32x2v w;
          w.x = cvtpk(o[d0][4 * q] * rstd * gv[0], o[d0][4 * q + 1] * rstd * gv[1]); w.y = cvtpk(o[d0][4 * q + 2] * rstd * gv[2], o[d0][4 * q + 3] * rstd * gv[3]);
          *(ATT_LAS u32x2v*)(stg + r32 * 128 + d0 * 32 + 8 * q + 4 * hi) = w; }
      asm volatile("s_waitcnt lgkmcnt(0)" ::: "memory");
      bf16_t* Ow = O + qrow * PITCH + h * 128;
#pragma unroll
      for (int i = 0; i < 8; ++i) { const int row = i * 4 + (lane >> 4), ch = lane & 15; const u32x4 v = *(const ATT_LAS u32x4*)(stg + row * 128 + ch * 8); *(u32x4*)(Ow + (size_t)row * PITCH + ch * 8) = v; }
      asm volatile("s_waitcnt lgkmcnt(0)" ::: "memory"); __builtin_amdgcn_s_barrier();
    }
  }
}

#ifndef NA_PP
#define NA_PP 0
#endif
constexpr int NA_NS = NA_PP ? 5 : 4, NA_SLOT = 16384, NA_LDS_B = NA_NS * NA_SLOT, NA_LDS_WS = NA_LDS_B + 2560, NA_LDS_OST = NA_LDS_WS + 8 * 256, NA_LDS_BYTES = NA_LDS_OST + 8 * 4096, NA_BPAD = 64;
template <int D0, int KS0, int KS1> __device__ __forceinline__ void pv_ks(f32x16& od, int vb, bf16x8 pa0, bf16x8 pa1, bf16x8 pa2, bf16x8 pa3) {
  s16x4 l[4], h[4];
#pragma unroll
  for (int ks = 0; ks < 4; ++ks) if (ks >= KS0 && ks <= KS1) {
      asm volatile("ds_read_b64_tr_b16 %0, %1 offset:%2" : "=&v"(l[ks]) : "v"(vb), "i"(D0 * 512 + ks * 2048) : "memory");
      asm volatile("ds_read_b64_tr_b16 %0, %1 offset:%2" : "=&v"(h[ks]) : "v"(vb), "i"(D0 * 512 + ks * 2048 + 1024) : "memory"); }
  asm volatile("s_waitcnt lgkmcnt(0)" ::: "memory"); SBAR();
#define PK(L, H) (bf16x8){L[0], L[1], L[2], L[3], H[0], H[1], H[2], H[3]}
  if (0 >= KS0 && 0 <= KS1) od = __builtin_amdgcn_mfma_f32_32x32x16_bf16(pa0, PK(l[0], h[0]), od, 0, 0, 0);
  if (1 >= KS0 && 1 <= KS1) od = __builtin_amdgcn_mfma_f32_32x32x16_bf16(pa1, PK(l[1], h[1]), od, 0, 0, 0);
  if (2 >= KS0 && 2 <= KS1) od = __builtin_amdgcn_mfma_f32_32x32x16_bf16(pa2, PK(l[2], h[2]), od, 0, 0, 0);
  if (3 >= KS0 && 3 <= KS1) od = __builtin_amdgcn_mfma_f32_32x32x16_bf16(pa3, PK(l[3], h[3]), od, 0, 0, 0);
#undef PK
}
template <int KS0, int KS1> __device__ __forceinline__ void pv_ks2(f32x16& o0, f32x16& o1, int vb, bf16x8 pa0, bf16x8 pa1, bf16x8 pa2, bf16x8 pa3) {
  s16x4 l[2][4], h[2][4];
#pragma unroll
  for (int d = 0; d < 2; ++d)
#pragma unroll
    for (int ks = 0; ks < 4; ++ks) if (ks >= KS0 && ks <= KS1) {
        if (d == 0) { asm volatile("ds_read_b64_tr_b16 %0, %1 offset:%2" : "=&v"(l[0][ks]) : "v"(vb), "i"(ks * 2048) : "memory"); asm volatile("ds_read_b64_tr_b16 %0, %1 offset:%2" : "=&v"(h[0][ks]) : "v"(vb), "i"(ks * 2048 + 1024) : "memory"); }
        else        { asm volatile("ds_read_b64_tr_b16 %0, %1 offset:%2" : "=&v"(l[1][ks]) : "v"(vb), "i"(512 + ks * 2048) : "memory"); asm volatile("ds_read_b64_tr_b16 %0, %1 offset:%2" : "=&v"(h[1][ks]) : "v"(vb), "i"(512 + ks * 2048 + 1024) : "memory"); } }
  asm volatile("s_waitcnt lgkmcnt(0)" ::: "memory"); SBAR();
#define PK(L, H) (bf16x8){L[0], L[1], L[2], L[3], H[0], H[1], H[2], H[3]}
  if (0 >= KS0 && 0 <= KS1) { o0 = __builtin_amdgcn_mfma_f32_32x32x16_bf16(pa0, PK(l[0][0], h[0][0]), o0, 0, 0, 0); o1 = __builtin_amdgcn_mfma_f32_32x32x16_bf16(pa0, PK(l[1][0], h[1][0]), o1, 0, 0, 0); }
  if (1 >= KS0 && 1 <= KS1) { o0 = __builtin_amdgcn_mfma_f32_32x32x16_bf16(pa1, PK(l[0][1], h[0][1]), o0, 0, 0, 0); o1 = __builtin_amdgcn_mfma_f32_32x32x16_bf16(pa1, PK(l[1][1], h[1][1]), o1, 0, 0, 0); }
  if (2 >= KS0 && 2 <= KS1) { o0 = __builtin_amdgcn_mfma_f32_32x32x16_bf16(pa2, PK(l[0][2], h[0][2]), o0, 0, 0, 0); o1 = __builtin_amdgcn_mfma_f32_32x32x16_bf16(pa2, PK(l[1][2], h[1][2]), o1, 0, 0, 0); }
  if (3 >= KS0 && 3 <= KS1) { o0 = __builtin_amdgcn_mfma_f32_32x32x16_bf16(pa3, PK(l[0][3], h[0][3]), o0, 0, 0, 0); o1 = __builtin_amdgcn_mfma_f32_32x32x16_bf16(pa3, PK(l[1][3], h[1][3]), o1, 0, 0, 0); }
#undef PK
}
template <int H>
__device__ __forceinline__ void na_tiles(size_t tok0, int rows, int h, int R, int qrow, const bf16_t* Q, const bf16_t* K, const bf16_t* V, bf16_t* O, lptr lds, int tid, int wid, int lane, const float* __restrict__ rpb_h, unsigned* np = nullptr) {
#if defined(NPROBE)
  unsigned long long np_t = __builtin_amdgcn_s_memrealtime(), np_acc = 0; const bool np_on = np != nullptr && wid == 0;
#define NP_MARK() do { if (np_on) np_t = __builtin_amdgcn_s_memrealtime(); } while (0)
#define NP_ADD() do { if (np_on) np_acc += __builtin_amdgcn_s_memrealtime() - np_t; } while (0)
#else
#define NP_MARK() do {} while (0)
#define NP_ADD() do {} while (0)
#endif
  const int r32 = lane & 31, hi = lane >> 5;
  ATT_LAS float* bias = (ATT_LAS float*)(lds + NA_LDS_B);
  ATT_LAS float* li_l = (ATT_LAS float*)(lds + NA_LDS_WS) + wid * 64; ATT_LAS float* al_l = li_l + 32;
  const int c = 32 * H + r32;
  const int c0 = min(max(c - 8, 0), 48), tmask = 4 * hi - c0;
  const int rlo_w = min(max(qrow - 4, 0), rows - 8);
  const int kr_lo = min(max(R - 4, 0), rows - 8), kr_hi = min(max(R + 3 - 4, 0), rows - 8) + 7, nt = kr_hi - kr_lo + 1;
  const size_t qtok = tok0 + (size_t)qrow * 64 + c;
  bf16x8 qr[4];
#pragma unroll
  for (int d0 = 0; d0 < 4; ++d0) qr[d0] = *(const bf16x8*)(Q + qtok * PITCH + h * 64 + d0 * 16 + hi * 8);
  const int vb0 = (int)(unsigned)(uintptr_t)lds + v_rd_base(lane);
#if NA_KROW
  const bf16_t* ksrc; { const int kr_l = wid * 8 + (lane >> 3), c_l = (lane & 7) ^ ((kr_l >> 1) & 7); ksrc = K + (tok0 + (size_t)kr_l) * PITCH + h * 64 + c_l * 8; }
#else
  const bf16_t* ksrc = K + (tok0 + (size_t)(lane ^ wid)) * PITCH + h * 64 + wid * 8;
#endif
  const bf16_t* vsrc;
  { const int j = lane & 31, kk = wid * 8 + (j >> 2), col = (lane >> 5) * 32 + (j & 3) * 8, k = (kk & ~0xC) | ((kk & 4) << 1) | ((kk & 8) >> 1); vsrc = V + (tok0 + (size_t)k) * PITCH + h * 64 + col; }
#define NDMA(row, slot) do { __builtin_amdgcn_global_load_lds((const unsigned*)(vsrc + (size_t)(row) * 64 * PITCH), (ATT_LAS unsigned*)(lds + (slot) * NA_SLOT + wid * 1024), 16, 0, 0); \
                             __builtin_amdgcn_global_load_lds((const unsigned*)(ksrc + (size_t)(row) * 64 * PITCH), (ATT_LAS unsigned*)(lds + (slot) * NA_SLOT + 8192 + wid * 1024), 16, 0, 0); } while (0)
#define NBAR() do { __builtin_amdgcn_sched_barrier(0); asm volatile("s_waitcnt lgkmcnt(0)" ::: "memory"); __builtin_amdgcn_s_barrier(); __builtin_amdgcn_sched_barrier(0); } while (0)
  float mref = 0.f, l_reg = 0.f; f32x16 o[2]; o[0] = f32x16{}; o[1] = f32x16{};
#if !NA_BIAS_LATE
  asm volatile("" :: "v"(qr[0]), "v"(qr[1]), "v"(qr[2]), "v"(qr[3]));
#endif
  NDMA(kr_lo, 0); if (1 < nt) NDMA(kr_lo + 1, 1); if (2 < nt) NDMA(kr_lo + 2, 2);
#if NA_BIAS_LATE
  for (int i = tid; i < 465; i += 512) bias[NA_BPAD + i] = rpb_h[i] * 1.4426950408889634f;
  asm volatile("" :: "v"(qr[0]), "v"(qr[1]), "v"(qr[2]), "v"(qr[3]));
#endif
  int slot = 0;
  for (int t = 0; t < nt; ++t) {
    const int krow = kr_lo + t;
#if defined(NPROBE) && NPROBE == 5
    NP_MARK();
#endif
    if (t + 2 < nt) asm volatile("s_waitcnt vmcnt(4)" ::: "memory"); else if (t + 1 < nt) asm volatile("s_waitcnt vmcnt(2)" ::: "memory"); else asm volatile("s_waitcnt vmcnt(0)" ::: "memory");
    NBAR();
#if defined(NPROBE) && NPROBE == 1
    if (t == 0) NP_ADD();
#elif defined(NPROBE) && NPROBE == 2
    if (t == 0) NP_MARK();
#elif defined(NPROBE) && NPROBE == 5
    NP_ADD();
#elif defined(NPROBE) && NPROBE == 6
    NP_MARK();
#endif
    if (t + 3 < nt) NDMA(krow + 3, (slot + 3) & 3);
    __builtin_amdgcn_sched_barrier(0);
    if (krow >= rlo_w && krow < rlo_w + 8) {
      f32x16 p0, p1;
#if NA_KROW
      qkt_row(p0, p1, lds + slot * NA_SLOT + 8192, qr, r32, hi);
#else
      qkt(p0, p1, lds + slot * NA_SLOT + 8192, qr, r32, hi);
#endif
      const int bofs = NA_BPAD + (krow - qrow + 7) * 31 + 15 - c + 4 * hi;
      float bvF[16], bvP[4];
#define BKC(r, koffc) (bofs + ((r) & 3) + 8 * ((r) >> 2) + (koffc))
      if (H == 0) {
#pragma unroll
        for (int r = 0; r < 16; ++r) bvF[r] = bias[BKC(r, 0)];
#pragma unroll
        for (int r = 0; r < 4; ++r) bvP[r] = bias[BKC(r, 32)];
      } else {
#pragma unroll
        for (int r = 0; r < 16; ++r) bvF[r] = bias[BKC(r, 32)];
#pragma unroll
        for (int r = 0; r < 4; ++r) bvP[r] = bias[BKC(12 + r, 0)];
      }
#undef BKC
      asm volatile("" : "+v"(bvF[0]), "+v"(bvF[1]), "+v"(bvF[2]), "+v"(bvF[3]), "+v"(bvF[4]), "+v"(bvF[5]), "+v"(bvF[6]), "+v"(bvF[7]), "+v"(bvF[8]), "+v"(bvF[9]),
                        "+v"(bvF[10]), "+v"(bvF[11]), "+v"(bvF[12]), "+v"(bvF[13]), "+v"(bvF[14]), "+v"(bvF[15]), "+v"(bvP[0]), "+v"(bvP[1]), "+v"(bvP[2]), "+v"(bvP[3]));
#define BM(P, r, koffc, BV) do { const int kcol = ((r) & 3) + 8 * ((r) >> 2) + (koffc); P[r] = ((unsigned)(kcol + tmask) < 16u) ? P[r] + (BV) : -INFINITY; } while (0)
      float pm;
      if (H == 0) {
#pragma unroll
        for (int r = 0; r < 16; ++r) BM(p0, r, 0, bvF[r]);
#pragma unroll
        for (int r = 0; r < 4; ++r) BM(p1, r, 32, bvP[r]);
        pm = p0[0];
#pragma unroll
        for (int r = 1; r < 16; ++r) pm = fmaxf(pm, p0[r]);
#pragma unroll
        for (int r = 0; r < 4; ++r) pm = fmaxf(pm, p1[r]);
      } else {
#pragma unroll
        for (int r = 12; r < 16; ++r) BM(p0, r, 0, bvP[r - 12]);
#pragma unroll
        for (int r = 0; r < 16; ++r) BM(p1, r, 32, bvF[r]);
        pm = p1[0];
#pragma unroll
        for (int r = 1; r < 16; ++r) pm = fmaxf(pm, p1[r]);
#pragma unroll
        for (int r = 12; r < 16; ++r) pm = fmaxf(pm, p0[r]);
      }
#undef BM
      { auto rr = __builtin_amdgcn_permlane32_swap(__float_as_uint(pm), __float_as_uint(pm), false, false); pm = fmaxf(__uint_as_float(rr[0]), __uint_as_float(rr[1])); }
      const bool first = krow == rlo_w;
      if (first || __any(pm - mref > THRL)) { const float mn = first ? pm : fmaxf(pm, mref);
        if (!first) { const float f = __builtin_amdgcn_exp2f(mref - mn); l_reg *= f; if (hi == 0) al_l[r32] = f; asm volatile("s_waitcnt lgkmcnt(0)" ::: "memory");
#pragma unroll
          for (int r = 0; r < 16; ++r) { const float a = al_l[crow(r, hi)]; o[0][r] *= a; o[1][r] *= a; } }
        mref = mn; }
      float ps = 0.f;
      if (H == 0) {
#pragma unroll
        for (int r = 0; r < 16; ++r) { p0[r] = __builtin_amdgcn_exp2f(p0[r] - mref); ps += p0[r]; }
#pragma unroll
        for (int r = 0; r < 4; ++r) { p1[r] = __builtin_amdgcn_exp2f(p1[r] - mref); ps += p1[r]; }
#pragma unroll
        for (int r = 4; r < 8; ++r) p1[r] = 0.f;
      } else {
#pragma unroll
        for (int r = 12; r < 16; ++r) { p0[r] = __builtin_amdgcn_exp2f(p0[r] - mref); ps += p0[r]; }
#pragma unroll
        for (int r = 0; r < 16; ++r) { p1[r] = __builtin_amdgcn_exp2f(p1[r] - mref); ps += p1[r]; }
#pragma unroll
        for (int r = 8; r < 12; ++r) p0[r] = 0.f;
      }
      { auto rr = __builtin_amdgcn_permlane32_swap(__float_as_uint(ps), __float_as_uint(ps), false, false); ps = __uint_as_float(rr[0]) + __uint_as_float(rr[1]); }
      l_reg += ps;
      bf16x8 pa0 = bf16x8{}, pa1, pa2, pa3 = bf16x8{};
#define PK4(P, BASE, OUT) do { unsigned a0 = cvtpk(P[BASE + 0], P[BASE + 1]), a1 = cvtpk(P[BASE + 2], P[BASE + 3]);   \
    unsigned b0 = cvtpk(P[BASE + 4], P[BASE + 5]), b1 = cvtpk(P[BASE + 6], P[BASE + 7]);                              \
    auto r0 = __builtin_amdgcn_permlane32_swap(a0, b0, false, false); auto r1 = __builtin_amdgcn_permlane32_swap(a1, b1, false, false); \
    u32x4 w = {r0[0], r1[0], r0[1], r1[1]}; OUT = __builtin_bit_cast(bf16x8, w); } while (0)
      const int vb = vb0 + slot * NA_SLOT;
      if (H == 0) { PK4(p0, 0, pa0); PK4(p0, 8, pa1); PK4(p1, 0, pa2); pv_ks2<0, 2>(o[0], o[1], vb, pa0, pa1, pa2, pa3); }
      else        { PK4(p0, 8, pa1); PK4(p1, 0, pa2); PK4(p1, 8, pa3); pv_ks2<1, 3>(o[0], o[1], vb, pa0, pa1, pa2, pa3); }
#undef PK4
    }
#if defined(NPROBE) && NPROBE == 6
    NP_ADD();
#endif
    slot = (slot + 1) & 3;
  }
#if defined(NPROBE) && NPROBE == 2
  NP_ADD();
#elif defined(NPROBE) && NPROBE == 3
  NP_MARK();
#endif
#undef NDMA
  if (hi == 0) li_l[r32] = l_reg; asm volatile("s_waitcnt lgkmcnt(0)" ::: "memory");
  ATT_LAS bf16_t* stg = (ATT_LAS bf16_t*)(lds + NA_LDS_OST) + wid * 2048;
  float rlv[16];
#pragma unroll
  for (int r = 0; r < 16; ++r) rlv[r] = li_l[crow(r, hi)];
#pragma unroll
  for (int r = 0; r < 16; ++r) { const int orow = crow(r, hi); const float rl = __builtin_amdgcn_rcpf(rlv[r]);
#pragma unroll
    for (int d0 = 0; d0 < 2; ++d0) { const unsigned w = cvtpk(o[d0][r] * rl, 0.f); stg[orow * 64 + d0 * 32 + r32] = (bf16_t)(w & 0xffffu); } }
  asm volatile("s_waitcnt lgkmcnt(0)" ::: "memory");
  bf16_t* Ow = O + (tok0 + (size_t)qrow * 64 + 32 * H) * PITCH + h * 64;
#pragma unroll
  for (int i = 0; i < 4; ++i) { const int row = i * 8 + (lane >> 3), ch = lane & 7; const u32x4 v = *(const ATT_LAS u32x4*)(stg + row * 64 + ch * 8); *(u32x4*)(Ow + (size_t)row * PITCH + ch * 8) = v; }
  NBAR();
#if defined(NPROBE)
#if NPROBE == 3 || NPROBE == 4
  NP_ADD();
#endif
  if (np_on && lane == 0) atomicAdd(np, (unsigned)np_acc);
#endif
#undef NP_MARK
#undef NP_ADD
#undef NBAR
}
#if NA_PP
template <int KS0, int KS1> __device__ __forceinline__ void pv_load(lptr vbp, s16x4 (&l)[2][4], s16x4 (&h)[2][4]) {
#pragma unroll
  for (int d = 0; d < 2; ++d)
#pragma unroll
    for (int ks = 0; ks < 4; ++ks) if (ks >= KS0 && ks <= KS1) { l[d][ks] = vtr(vbp + d * 512 + ks * 2048); h[d][ks] = vtr(vbp + d * 512 + ks * 2048 + 1024); }
}
template <int KS0, int KS1> __device__ __forceinline__ void pv_mma(f32x16& o0, f32x16& o1, const s16x4 (&l)[2][4], const s16x4 (&h)[2][4], bf16x8 pa0, bf16x8 pa1, bf16x8 pa2, bf16x8 pa3) {
#define PK(L, H) (bf16x8){L[0], L[1], L[2], L[3], H[0], H[1], H[2], H[3]}
  if (0 >= KS0 && 0 <= KS1) { o0 = __builtin_amdgcn_mfma_f32_32x32x16_bf16(pa0, PK(l[0][0], h[0][0]), o0, 0, 0, 0); o1 = __builtin_amdgcn_mfma_f32_32x32x16_bf16(pa0, PK(l[1][0], h[1][0]), o1, 0, 0, 0); }
  if (1 >= KS0 && 1 <= KS1) { o0 = __builtin_amdgcn_mfma_f32_32x32x16_bf16(pa1, PK(l[0][1], h[0][1]), o0, 0, 0, 0); o1 = __builtin_amdgcn_mfma_f32_32x32x16_bf16(pa1, PK(l[1][1], h[1][1]), o1, 0, 0, 0); }
  if (2 >= KS0 && 2 <= KS1) { o0 = __builtin_amdgcn_mfma_f32_32x32x16_bf16(pa2, PK(l[0][2], h[0][2]), o0, 0, 0, 0); o1 = __builtin_amdgcn_mfma_f32_32x32x16_bf16(pa2, PK(l[1][2], h[1][2]), o1, 0, 0, 0); }
  if (3 >= KS0 && 3 <= KS1) { o0 = __builtin_amdgcn_mfma_f32_32x32x16_bf16(pa3, PK(l[0][3], h[0][3]), o0, 0, 0, 0); o1 = __builtin_amdgcn_mfma_f32_32x32x16_bf16(pa3, PK(l[1][3], h[1][3]), o1, 0, 0, 0); }
#undef PK
}
__device__ __forceinline__ void qk_load(bf16x8 (&kf)[8], lptr Ks, int r32, int hi) {
#pragma unroll
  for (int d0 = 0; d0 < 4; ++d0) { const int c = 2 * d0 + hi;
#if NA_KROW
    kf[2 * d0] = *(const ATT_LAS bf16x8*)(Ks + koff_row(r32, c)); kf[2 * d0 + 1] = *(const ATT_LAS bf16x8*)(Ks + koff_row(32 + r32, c));
#else
    kf[2 * d0] = *(const ATT_LAS bf16x8*)(Ks + koff(r32, c)); kf[2 * d0 + 1] = *(const ATT_LAS bf16x8*)(Ks + koff(32 + r32, c));
#endif
  }
}
__device__ __forceinline__ void qk_mma(f32x16& p0, f32x16& p1, const bf16x8 (&kf)[8], const bf16x8* qr) {
  p0 = __builtin_amdgcn_mfma_f32_32x32x16_bf16(kf[0], qr[0], f32x16{}, 0, 0, 0); p1 = __builtin_amdgcn_mfma_f32_32x32x16_bf16(kf[1], qr[0], f32x16{}, 0, 0, 0);
#pragma unroll
  for (int d0 = 1; d0 < 4; ++d0) { p0 = __builtin_amdgcn_mfma_f32_32x32x16_bf16(kf[2 * d0], qr[d0], p0, 0, 0, 0); p1 = __builtin_amdgcn_mfma_f32_32x32x16_bf16(kf[2 * d0 + 1], qr[d0], p1, 0, 0, 0); }
  __builtin_amdgcn_sched_barrier(0);
}
#endif
#if NA_PP
template <int H, int GRP>
__device__ __forceinline__ void na_tiles_pp(size_t tok0, int rows, int h, int R, int qrow, const bf16_t* Q, const bf16_t* K, const bf16_t* V, bf16_t* O, lptr lds, int tid, int wid, int lane, const float* __restrict__ rpb_h) {
  const int r32 = lane & 31, hi = lane >> 5;
  ATT_LAS float* bias = (ATT_LAS float*)(lds + NA_LDS_B);
  ATT_LAS float* li_l = (ATT_LAS float*)(lds + NA_LDS_WS) + wid * 64; ATT_LAS float* al_l = li_l + 32;
  const int c = 32 * H + r32;
  const int c0 = min(max(c - 8, 0), 48), tmask = 4 * hi - c0;
  const int rlo_w = min(max(qrow - 4, 0), rows - 8);
  const int kr_lo = min(max(R - 4, 0), rows - 8), kr_hi = min(max(R + 3 - 4, 0), rows - 8) + 7, nt = kr_hi - kr_lo + 1;
  const size_t qtok = tok0 + (size_t)qrow * 64 + c;
  bf16x8 qr[4];
#pragma unroll
  for (int d0 = 0; d0 < 4; ++d0) qr[d0] = *(const bf16x8*)(Q + qtok * PITCH + h * 64 + d0 * 16 + hi * 8);
  const int vb0 = (int)(unsigned)(uintptr_t)lds + v_rd_base(lane);
#if NA_KROW
  const bf16_t* ksrc; { const int kr_l = wid * 8 + (lane >> 3), c_l = (lane & 7) ^ ((kr_l >> 1) & 7); ksrc = K + (tok0 + (size_t)kr_l) * PITCH + h * 64 + c_l * 8; }
#else
  const bf16_t* ksrc = K + (tok0 + (size_t)(lane ^ wid)) * PITCH + h * 64 + wid * 8;
#endif
  const bf16_t* vsrc;
  { const int j = lane & 31, kk = wid * 8 + (j >> 2), col = (lane >> 5) * 32 + (j & 3) * 8, k = (kk & ~0xC) | ((kk & 4) << 1) | ((kk & 8) >> 1); vsrc = V + (tok0 + (size_t)k) * PITCH + h * 64 + col; }
#define NDMA(row, slot) do { __builtin_amdgcn_global_load_lds((const unsigned*)(vsrc + (size_t)(row) * 64 * PITCH), (ATT_LAS unsigned*)(lds + (slot) * NA_SLOT + wid * 1024), 16, 0, 0); \
                             __builtin_amdgcn_global_load_lds((const unsigned*)(ksrc + (size_t)(row) * 64 * PITCH), (ATT_LAS unsigned*)(lds + (slot) * NA_SLOT + 8192 + wid * 1024), 16, 0, 0); } while (0)
#define NBAR() do { __builtin_amdgcn_sched_barrier(0); asm volatile("s_waitcnt lgkmcnt(0)" ::: "memory"); __builtin_amdgcn_s_barrier(); __builtin_amdgcn_sched_barrier(0); } while (0)
  float mref = 0.f, l_reg = 0.f; f32x16 o[2]; o[0] = f32x16{}; o[1] = f32x16{};
#if !NA_BIAS_LATE
  asm volatile("" :: "v"(qr[0]), "v"(qr[1]), "v"(qr[2]), "v"(qr[3]));
#endif
  f32x16 p0 = f32x16{}, p1 = f32x16{}; bf16x8 pa0 = bf16x8{}, pa1 = bf16x8{}, pa2 = bf16x8{}, pa3 = bf16x8{};
#define NA_ACT(t) ((t) >= 0 && (t) < nt && kr_lo + (t) >= rlo_w && kr_lo + (t) < rlo_w + 8)
#define NA_M5(x) ((x) >= NA_NS ? (x) - NA_NS : (x))
#if NA_KROW
#define NA_QK(s) qkt_row(p0, p1, lds + (s) * NA_SLOT + 8192, qr, r32, hi)
#else
#define NA_QK(s) qkt(p0, p1, lds + (s) * NA_SLOT + 8192, qr, r32, hi)
#endif
#define NA_PV(s) do { const int vb = vb0 + (s) * NA_SLOT; if (H == 0) pv_ks2<0, 2>(o[0], o[1], vb, pa0, pa1, pa2, pa3); else pv_ks2<1, 3>(o[0], o[1], vb, pa0, pa1, pa2, pa3); } while (0)
  auto softmax = [&](const int krow) __attribute__((always_inline)) {
      const int bofs = NA_BPAD + (krow - qrow + 7) * 31 + 15 - c + 4 * hi;
      float bvF[16], bvP[4];
#define BKC(r, koffc) (bofs + ((r) & 3) + 8 * ((r) >> 2) + (koffc))
      if (H == 0) {
#pragma unroll
        for (int r = 0; r < 16; ++r) bvF[r] = bias[BKC(r, 0)];
#pragma unroll
        for (int r = 0; r < 4; ++r) bvP[r] = bias[BKC(r, 32)];
      } else {
#pragma unroll
        for (int r = 0; r < 16; ++r) bvF[r] = bias[BKC(r, 32)];
#pragma unroll
        for (int r = 0; r < 4; ++r) bvP[r] = bias[BKC(12 + r, 0)];
      }
#undef BKC
      asm volatile("" : "+v"(bvF[0]), "+v"(bvF[1]), "+v"(bvF[2]), "+v"(bvF[3]), "+v"(bvF[4]), "+v"(bvF[5]), "+v"(bvF[6]), "+v"(bvF[7]), "+v"(bvF[8]), "+v"(bvF[9]),
                        "+v"(bvF[10]), "+v"(bvF[11]), "+v"(bvF[12]), "+v"(bvF[13]), "+v"(bvF[14]), "+v"(bvF[15]), "+v"(bvP[0]), "+v"(bvP[1]), "+v"(bvP[2]), "+v"(bvP[3]));
#define BM(P, r, koffc, BV) do { const int kcol = ((r) & 3) + 8 * ((r) >> 2) + (koffc); P[r] = ((unsigned)(kcol + tmask) < 16u) ? P[r] + (BV) : -INFINITY; } while (0)
      float pm;
      if (H == 0) {
#pragma unroll
        for (int r = 0; r < 16; ++r) BM(p0, r, 0, bvF[r]);
#pragma unroll
        for (int r = 0; r < 4; ++r) BM(p1, r, 32, bvP[r]);
        pm = p0[0];
#pragma unroll
        for (int r = 1; r < 16; ++r) pm = fmaxf(pm, p0[r]);
#pragma unroll
        for (int r = 0; r < 4; ++r) pm = fmaxf(pm, p1[r]);
      } else {
#pragma unroll
        for (int r = 12; r < 16; ++r) BM(p0, r, 0, bvP[r - 12]);
#pragma unroll
        for (int r = 0; r < 16; ++r) BM(p1, r, 32, bvF[r]);
        pm = p1[0];
#pragma unroll
        for (int r = 1; r < 16; ++r) pm = fmaxf(pm, p1[r]);
#pragma unroll
        for (int r = 12; r < 16; ++r) pm = fmaxf(pm, p0[r]);
      }
#undef BM
      { auto rr = __builtin_amdgcn_permlane32_swap(__float_as_uint(pm), __float_as_uint(pm), false, false); pm = fmaxf(__uint_as_float(rr[0]), __uint_as_float(rr[1])); }
      const bool first = krow == rlo_w;
      if (first || __any(pm - mref > THRL)) { const float mn = first ? pm : fmaxf(pm, mref);
        if (!first) { const float f = __builtin_amdgcn_exp2f(mref - mn); l_reg *= f; if (hi == 0) al_l[r32] = f; asm volatile("s_waitcnt lgkmcnt(0)" ::: "memory");
#pragma unroll
          for (int r = 0; r < 16; ++r) { const float a = al_l[crow(r, hi)]; o[0][r] *= a; o[1][r] *= a; } }
        mref = mn; }
      float ps = 0.f;
      if (H == 0) {
#pragma unroll
        for (int r = 0; r < 16; ++r) { p0[r] = __builtin_amdgcn_exp2f(p0[r] - mref); ps += p0[r]; }
#pragma unroll
        for (int r = 0; r < 4; ++r) { p1[r] = __builtin_amdgcn_exp2f(p1[r] - mref); ps += p1[r]; }
#pragma unroll
        for (int r = 4; r < 8; ++r) p1[r] = 0.f;
      } else {
#pragma unroll
        for (int r = 12; r < 16; ++r) { p0[r] = __builtin_amdgcn_exp2f(p0[r] - mref); ps += p0[r]; }
#pragma unroll
        for (int r = 0; r < 16; ++r) { p1[r] = __builtin_amdgcn_exp2f(p1[r] - mref); ps += p1[r]; }
#pragma unroll
        for (int r = 8; r < 12; ++r) p0[r] = 0.f;
      }
      { auto rr = __builtin_amdgcn_permlane32_swap(__float_as_uint(ps), __float_as_uint(ps), false, false); ps = __uint_as_float(rr[0]) + __uint_as_float(rr[1]); }
      l_reg += ps;
#define PK4(P, BASE, OUT) do { unsigned a0 = cvtpk(P[BASE + 0], P[BASE + 1]), a1 = cvtpk(P[BASE + 2], P[BASE + 3]);   \
    unsigned b0 = cvtpk(P[BASE + 4], P[BASE + 5]), b1 = cvtpk(P[BASE + 6], P[BASE + 7]);                              \
    auto r0 = __builtin_amdgcn_permlane32_swap(a0, b0, false, false); auto r1 = __builtin_amdgcn_permlane32_swap(a1, b1, false, false); \
    u32x4 w = {r0[0], r1[0], r0[1], r1[1]}; OUT = __builtin_bit_cast(bf16x8, w); } while (0)
    if (H == 0) { PK4(p0, 0, pa0); PK4(p0, 8, pa1); PK4(p1, 0, pa2); } else { PK4(p0, 8, pa1); PK4(p1, 0, pa2); PK4(p1, 8, pa3); }
#undef PK4
  };
  NDMA(kr_lo, 0); if (1 < nt) NDMA(kr_lo + 1, 1); if (2 < nt) NDMA(kr_lo + 2, 2);
#if NA_BIAS_LATE
  for (int i = tid; i < 465; i += 512) bias[NA_BPAD + i] = rpb_h[i] * 1.4426950408889634f;
  asm volatile("" :: "v"(qr[0]), "v"(qr[1]), "v"(qr[2]), "v"(qr[3]));
#endif
  if (2 < nt) asm volatile("s_waitcnt vmcnt(4)" ::: "memory"); else if (1 < nt) asm volatile("s_waitcnt vmcnt(2)" ::: "memory"); else asm volatile("s_waitcnt vmcnt(0)" ::: "memory");
  NBAR();
  if (GRP == 0 && NA_ACT(0)) NA_QK(0);
  int s0 = 0;
#pragma clang loop unroll(disable)
  for (int t = 0; t < nt; ++t) {
    if (t + 2 < nt) asm volatile("s_waitcnt vmcnt(2)" ::: "memory"); else asm volatile("s_waitcnt vmcnt(0)" ::: "memory");
    NBAR();
    if (t + 3 < nt) NDMA(kr_lo + t + 3, NA_M5(s0 + 3));
    __builtin_amdgcn_sched_barrier(0);
#if NA_SP
    { s16x4 lv[2][4], hv[2][4]; bf16x8 kf[8];
      const lptr vrd = lds + v_rd_base(lane);
      if (GRP == 0) {
        const bool a0 = NA_ACT(t), a1 = NA_ACT(t + 1);
        if (a0) { if (H == 0) pv_load<0, 2>(vrd + s0 * NA_SLOT, lv, hv); else pv_load<1, 3>(vrd + s0 * NA_SLOT, lv, hv); }
        if (a1) qk_load(kf, lds + NA_M5(s0 + 1) * NA_SLOT + 8192, r32, hi);
        asm volatile("" ::: "memory"); __builtin_amdgcn_sched_barrier(0);
        if (a0) { softmax(kr_lo + t); __builtin_amdgcn_sched_barrier(0);
          if (H == 0) pv_mma<0, 2>(o[0], o[1], lv, hv, pa0, pa1, pa2, pa3); else pv_mma<1, 3>(o[0], o[1], lv, hv, pa0, pa1, pa2, pa3); }
        if (a1) qk_mma(p0, p1, kf, qr);
      } else {
        const bool a0 = NA_ACT(t - 1), a1 = NA_ACT(t);
        if (a0) { if (H == 0) pv_load<0, 2>(vrd + NA_M5(s0 + NA_NS - 1) * NA_SLOT, lv, hv); else pv_load<1, 3>(vrd + NA_M5(s0 + NA_NS - 1) * NA_SLOT, lv, hv); }
        if (a1) qk_load(kf, lds + s0 * NA_SLOT + 8192, r32, hi);
        asm volatile("" ::: "memory"); __builtin_amdgcn_sched_barrier(0);
        if (a0) { if (H == 0) pv_mma<0, 2>(o[0], o[1], lv, hv, pa0, pa1, pa2, pa3); else pv_mma<1, 3>(o[0], o[1], lv, hv, pa0, pa1, pa2, pa3); }
        if (a1) { qk_mma(p0, p1, kf, qr); softmax(kr_lo + t); }
      }
    }
#else
    if (GRP == 0) {
      if (NA_ACT(t)) { softmax(kr_lo + t); __builtin_amdgcn_sched_barrier(0); NA_PV(s0); }
      if (NA_ACT(t + 1)) NA_QK(NA_M5(s0 + 1));
    } else {
      if (NA_ACT(t - 1)) NA_PV(NA_M5(s0 + NA_NS - 1));
      if (NA_ACT(t)) { NA_QK(s0); softmax(kr_lo + t); }
    }
#endif
    s0 = NA_M5(s0 + 1);
  }
  if (GRP == 1 && NA_ACT(nt - 1)) NA_PV(NA_M5(s0 + NA_NS - 1));
#undef NDMA
#undef NA_ACT
#undef NA_M5
#undef NA_QK
#undef NA_PV
  if (hi == 0) li_l[r32] = l_reg; asm volatile("s_waitcnt lgkmcnt(0)" ::: "memory");
  ATT_LAS bf16_t* stg = (ATT_LAS bf16_t*)(lds + NA_LDS_OST) + wid * 2048;
  float rlv[16];
#pragma unroll
  for (int r = 0; r < 16; ++r) rlv[r] = li_l[crow(r, hi)];
#pragma unroll
  for (int r = 0; r < 16; ++r) { const int orow = crow(r, hi); const float rl = __builtin_amdgcn_rcpf(rlv[r]);
#pragma unroll
    for (int d0 = 0; d0 < 2; ++d0) { const unsigned w = cvtpk(o[d0][r] * rl, 0.f); stg[orow * 64 + d0 * 32 + r32] = (bf16_t)(w & 0xffffu); } }
  asm volatile("s_waitcnt lgkmcnt(0)" ::: "memory");
  bf16_t* Ow = O + (tok0 + (size_t)qrow * 64 + 32 * H) * PITCH + h * 64;
#pragma unroll
  for (int i = 0; i < 4; ++i) { const int row = i * 8 + (lane >> 3), ch = lane & 7; const u32x4 v = *(const ATT_LAS u32x4*)(stg + row * 64 + ch * 8); *(u32x4*)(Ow + (size_t)row * PITCH + ch * 8) = v; }
  NBAR();
#undef NBAR
}
#endif
__device__ __forceinline__ void na_unit(size_t tok0, int rows, int h, int R, const bf16_t* Q, const bf16_t* K, const bf16_t* V, bf16_t* O, const float* __restrict__ rpb_h,
                                        lptr lds, int tid, int wid, int lane, bool fill = true, unsigned* np = nullptr) {
  asm volatile("" : "+v"(tid)); lane = tid & 63;
  ATT_LAS float* bias = (ATT_LAS float*)(lds + NA_LDS_B);
#if !NA_BIAS_LATE
  if (fill) for (int i = tid; i < 465; i += 512) bias[NA_BPAD + i] = rpb_h[i] * 1.4426950408889634f;
#endif
  const int qrow = R + (wid >> 1);
#if NA_PP
  if (wid < 4) { if ((wid & 1) == 0) na_tiles_pp<0, 0>(tok0, rows, h, R, qrow, Q, K, V, O, lds, tid, wid, lane, rpb_h); else na_tiles_pp<1, 0>(tok0, rows, h, R, qrow, Q, K, V, O, lds, tid, wid, lane, rpb_h); }
  else         { if ((wid & 1) == 0) na_tiles_pp<0, 1>(tok0, rows, h, R, qrow, Q, K, V, O, lds, tid, wid, lane, rpb_h); else na_tiles_pp<1, 1>(tok0, rows, h, R, qrow, Q, K, V, O, lds, tid, wid, lane, rpb_h); }
#else
  if ((wid & 1) == 0) na_tiles<0>(tok0, rows, h, R, qrow, Q, K, V, O, lds, tid, wid, lane, rpb_h, np);
  else                na_tiles<1>(tok0, rows, h, R, qrow, Q, K, V, O, lds, tid, wid, lane, rpb_h, np);
#endif
}
#undef SBAR
}

#define XB_TMO      128
#define XB_XCNT(j)  (256  + 64 * (j))
#define XB_XSUB(j)  (1280 + 64 * (j))
#define XB_XGEN(j)  (2304 + 64 * (j))
#define XB_TOP      3328
#define XB_TOPGEN   3392
#define XCD_BAR_WORDS 3456
#define XB_SPIN_CAP (1u << 18)

__device__ __forceinline__ unsigned xb_ld(unsigned* p)              { return __hip_atomic_load(p, __ATOMIC_RELAXED, __HIP_MEMORY_SCOPE_AGENT); }
__device__ __forceinline__ unsigned xb_add(unsigned* p, unsigned v) { return __hip_atomic_fetch_add(p, v, __ATOMIC_RELAXED, __HIP_MEMORY_SCOPE_AGENT); }
__device__ __forceinline__ unsigned xb_xcc_id() { return (unsigned)__builtin_amdgcn_s_getreg((3 << 11) | 20) & 0xFu; }
#define XB_SPIN(cond, bar) do { unsigned _sp = 0; while (cond) { __builtin_amdgcn_s_sleep(1); \
    if ((++_sp & 255u) == 0u) { if (xb_ld(&(bar)[XB_TMO])) break; if (_sp > XB_SPIN_CAP) { atomicAdd(&(bar)[XB_TMO], 1u); break; } } } } while (0)

struct XcdBarrier {
    unsigned* bar; unsigned x; int w;
    volatile LAS unsigned* st;
};

__device__ __forceinline__ XcdBarrier xcd_barrier_post(unsigned* bar, volatile LAS unsigned* st) {
    XcdBarrier b; b.bar = bar; b.x = xb_xcc_id(); b.st = st; b.w = __builtin_amdgcn_readfirstlane((int)threadIdx.x >> 6);
    if (threadIdx.x == 0) (void)xb_add(&bar[XB_XCNT(b.x)], 1u);
    return b;
}
__device__ __forceinline__ void xcd_barrier_complete(unsigned* bar, unsigned x, unsigned& nloc, unsigned& nx) {
    const unsigned G = gridDim.x * gridDim.y * gridDim.z;
    unsigned sum, cnt, mine, sp = 0u;
    for (;;) {
        sum = 0u; cnt = 0u; mine = 0u;
#pragma unroll
        for (unsigned j = 0; j < 16; ++j) { const unsigned c = xb_ld(&bar[XB_XCNT(j)]); sum += c; cnt += (c > 0u) ? 1u : 0u; mine = (j == x) ? c : mine; }
        if (sum == G) break;
        __builtin_amdgcn_s_sleep(1);
        if ((++sp & 255u) == 0u) { if (xb_ld(&bar[XB_TMO])) break; if (sp > XB_SPIN_CAP) { atomicAdd(&bar[XB_TMO], 1u); break; } }
    }
    nloc = mine > 0u ? mine : 1u; nx = cnt > 0u ? cnt : 1u;
}

__device__ __forceinline__ void xcd_barrier(const XcdBarrier& b) {
    asm volatile("s_waitcnt vmcnt(0)" ::: "memory");
    __syncthreads();
    if (b.w == 0 && LANE_ID() == 0) {
        unsigned* bar = b.bar;
        __builtin_amdgcn_s_waitcnt(0);
        unsigned nloc = b.st[0], nx = b.st[1];
        if (nloc == 0u) { xcd_barrier_complete(bar, b.x, nloc, nx); b.st[0] = nloc; b.st[1] = nx; }
        const unsigned old = xb_add(&bar[XB_XSUB(b.x)], 1u);
        const unsigned gen = old / nloc;
        if (old + 1u == (gen + 1u) * nloc) {
            __builtin_amdgcn_fence(__ATOMIC_RELEASE, "agent");
            asm volatile("s_waitcnt vmcnt(0)" ::: "memory");
            const unsigned og = xb_add(&bar[XB_TOP], 1u);
            const unsigned tg = og / nx;
            if (og + 1u == (tg + 1u) * nx) xb_add(&bar[XB_TOPGEN], 1u);
            else XB_SPIN(xb_ld(&bar[XB_TOPGEN]) == tg, bar);
            __builtin_amdgcn_fence(__ATOMIC_ACQUIRE, "agent");
            xb_add(&bar[XB_XGEN(b.x)], 1u);
            asm volatile("s_waitcnt vmcnt(0)" ::: "memory");
        } else {
            XB_SPIN(xb_ld(&bar[XB_XGEN(b.x)]) == gen, bar);
            __builtin_amdgcn_fence(__ATOMIC_ACQUIRE, "agent");
            asm volatile("s_waitcnt vmcnt(0)" ::: "memory");
        }
    }
    __syncthreads();
}

constexpr int NWAVES = 8;
#ifndef PG8_ALIGN_PLAIN
#define PG8_ALIGN_PLAIN true
#endif
#ifndef FUSE_THIN
#define FUSE_THIN 0
#endif
#ifndef MK_PER_PHASE
#define MK_PER_PHASE 0
#endif
constexpr int NPH = 15;

constexpr size_t MiB = 1u << 20;
constexpr size_t WS_CTL = 0, CTL_ZERO_BYTES = 1 * MiB;
constexpr size_t WS_ROPE_C = 1 * MiB, WS_ROPE_S = 2 * MiB, WS_RS = 3 * MiB;
constexpr size_t WS_WQKV0 = 4 * MiB, WS_WO0 = 10 * MiB, WS_WIN0 = 12 * MiB, WS_WOUT0 = 23 * MiB;
constexpr size_t WS_WQKV1 = 29 * MiB, WS_WO1 = 35 * MiB, WS_WIN1 = 37 * MiB, WS_WOUT1 = 48 * MiB;
constexpr size_t WS_XN = 56 * MiB;
constexpr size_t WS_Q = 218 * MiB, WS_K = 378 * MiB, WS_V = 538 * MiB;
constexpr size_t WS_G = 218 * MiB;
constexpr size_t WS_MB = 698 * MiB;
constexpr size_t WS_PARK = 858 * MiB;
constexpr size_t WS_END = 896 * MiB;
static_assert(WS_WOUT1 + (size_t)D * FF * 2 <= WS_XN - 4096 && WS_XN + (size_t)(NMT_CONV * 254 + 2) * D * 2 <= WS_Q && WS_G + (size_t)M * FF * 2 <= WS_MB && WS_MB + (size_t)M * D * 2 <= WS_PARK, "d_ws map");
constexpr int CW_PANEL = 16384, PANEL_BANK = 320 * 64;
constexpr int CW_TP = 8000;
constexpr int CW_KMAX = 8192;
constexpr int CW_BAR = 4096;

constexpr int RING_OFF = 0, RING_BYTES = 131072;
constexpr int LDSCTL_OFF = RING_BYTES, MISC_OFF = LDSCTL_OFF + 320;
constexpr int XCH_OFF = RING_BYTES + 1024;
constexpr int LDS_BYTES = 147456;
static_assert(XCH_OFF + 8192 + 4096 <= LDS_BYTES && att::DA_LDS_TOTAL <= RING_BYTES && att::NA_LDS_BYTES <= RING_BYTES, "LDS map");

__device__ __forceinline__ void p0_transpose_item(const float* W, int K, int N, bf16* WT, int k0, int n0, int drow0, const float* gk, LAS float* scr, int lane) {
    float wv[32], gv[32];
#pragma unroll
    for (int i = 0; i < 32; ++i) { const int kk = 2 * i + (lane >> 5); wv[i] = W[(size_t)(k0 + kk) * N + n0 + (lane & 31)]; gv[i] = gk ? gk[k0 + kk] : 1.f; }
#pragma unroll
    for (int i = 0; i < 32; ++i) { const int kk = 2 * i + (lane >> 5); scr[kk * 33 + (lane & 31)] = wv[i] * gv[i]; }
    LDS_WAIT(); asm volatile("" ::: "memory");
    const int c = lane & 7;
#pragma unroll
    for (int j = 0; j < 4; ++j) { const int n = (lane >> 3) + 8 * j; const LAS float* s = scr + (8 * c) * 33 + n;
        v4u o; o.x = pk2(s[0 * 33], s[1 * 33]); o.y = pk2(s[2 * 33], s[3 * 33]); o.z = pk2(s[4 * 33], s[5 * 33]); o.w = pk2(s[6 * 33], s[7 * 33]);
        *(GAS v4u*)(WT + (size_t)(drow0 + n) * K + k0 + 8 * c) = o; }
    LDS_WAIT(); asm volatile("" ::: "memory");
}
__device__ __forceinline__ void p0_matrix(const float* W, int K, int N, bf16* WT, const float* gk, int mode, int roff, LAS float* scr, int gw, int NGW, int lane) {
    const int nblk = N / 32, nitems = (K / 64) * nblk;
    for (int it = gw; it < nitems; it += NGW) {
        const int kb = it / nblk, nb = it % nblk, n0 = 32 * nb; int drow0;
        if (mode == 0) drow0 = roff + n0;
        else if (mode == 1) { const int bj = n0 >= FF ? 1 : 0, ch = n0 - bj * FF; drow0 = (ch >> 7) * 256 + bj * 128 + (ch & 127); }
        else { const int s = n0 >> 6, half = (n0 >> 5) & 1; drow0 = roff + (s >> 2) * 256 + half * 128 + (s & 3) * 32; }
        p0_transpose_item(W, K, N, WT, 64 * kb, n0, drow0, gk, scr, lane);
    }
}
__device__ __forceinline__ void sincos_small(double x, double& s, double& c) {
    const double x2 = x * x;
    double a = -1.0 / 25852016738884976640000.0;
    a = a * x2 + 1.0 / 51090942171709440000.0;
    a = a * x2 - 1.0 / 121645100408832000.0;
    a = a * x2 + 1.0 / 355687428096000.0;
    a = a * x2 - 1.0 / 1307674368000.0;
    a = a * x2 + 1.0 / 6227020800.0;
    a = a * x2 - 1.0 / 39916800.0;
    a = a * x2 + 1.0 / 362880.0;
    a = a * x2 - 1.0 / 5040.0;
    a = a * x2 + 1.0 / 120.0;
    a = a * x2 - 1.0 / 6.0;
    a = a * x2 + 1.0;
    s = a * x;
    double b = 1.0 / 620448401733239439360000.0;
    b = b * x2 - 1.0 / 1124000727777607680000.0;
    b = b * x2 + 1.0 / 2432902008176640000.0;
    b = b * x2 - 1.0 / 6402373705728000.0;
    b = b * x2 + 1.0 / 20922789888000.0;
    b = b * x2 - 1.0 / 87178291200.0;
    b = b * x2 + 1.0 / 479001600.0;
    b = b * x2 - 1.0 / 3628800.0;
    b = b * x2 + 1.0 / 40320.0;
    b = b * x2 - 1.0 / 720.0;
    b = b * x2 + 1.0 / 24.0;
    b = b * x2 - 0.5;
    b = b * x2 + 1.0;
    c = b;
}
struct Args { const float* in[22]; float* out; unsigned char* ws; int ph_lo, ph_hi; };
__global__ void __launch_bounds__(NWAVES * 64, 2) mega_fwd(Args args) {
    extern __shared__ __attribute__((aligned(16))) unsigned char lds_raw[];
    LAS unsigned char* lds = (LAS unsigned char*)lds_raw;
    volatile LAS unsigned* MISC = (volatile LAS unsigned*)(lds + MISC_OFF);
    const int wave = __builtin_amdgcn_readfirstlane((int)threadIdx.x >> 6);
#define lane LANE_ID()
#define tid (wave * 64 + LANE_ID())
    const int G = gridDim.x, bx = blockIdx.x, vcu = (G % 8 == 0) ? (bx % 8) * (G / 8) + bx / 8 : bx;
    const int gw = vcu * NWAVES + wave, NGW = G * NWAVES;
    unsigned char* ws = args.ws;
    gu32* ctl = (gu32*)(ws + WS_CTL);
    for (int u = tid; u < (LDS_BYTES - LDSCTL_OFF) / 4; u += NWAVES * 64) ((LAS unsigned*)(lds + LDSCTL_OFF))[u] = 0u;
    __syncthreads();
    XcdBarrier bar; bar.bar = (unsigned*)(ctl + CW_BAR); bar.x = 0; bar.st = nullptr; bar.w = wave;
    if (!MK_PER_PHASE) bar = xcd_barrier_post((unsigned*)(ctl + CW_BAR), MISC + 8);
#if defined(BPROBE)
    unsigned long long bp_acc = 0; int bp_k = 0;
#define GRID_BAR() do { const unsigned long long t_ = __builtin_amdgcn_s_memrealtime(); xcd_barrier(bar); if (bp_k >= BPROBE_LO && bp_k < BPROBE_HI) bp_acc += __builtin_amdgcn_s_memrealtime() - t_; ++bp_k; } while (0)
#else
#define GRID_BAR() do { if (!MK_PER_PHASE) xcd_barrier(bar); } while (0)
#endif
    const int lo = args.ph_lo, hi = args.ph_hi;
#ifndef PH_MASK
#define PH_MASK 0x7fff
#endif
#define IN(k) (((PH_MASK >> (k)) & 1) && lo <= (k) && (k) < hi)
#define BOTH(k) (IN(k) && IN((k) + 1))
#ifndef PROBE_DUP
#define PROBE_DUP -1
#endif
#define REPS(k) (((k) == PROBE_DUP) ? 2 : 1)

#if defined(GPROBE)
#define GP_ARG(k) ((k) == GPROBE_PHASE ? (unsigned*)(ctl + CW_TP) : (unsigned*)nullptr)
#else
#define GP_ARG(k) ((unsigned*)nullptr)
#endif
#if defined(DPROBE)
#define DP_ARG ((unsigned*)(ctl + CW_TP))
#else
#define DP_ARG ((unsigned*)nullptr)
#endif
#if defined(PPROBE)
    unsigned long long pp_t0 = 0, pp_t1 = 0;
#define PP_BEGIN(k) do { if ((k) == PPROBE) pp_t0 = __builtin_amdgcn_s_memrealtime(); } while (0)
#define PP_END(k) do { if ((k) == PPROBE) pp_t1 = __builtin_amdgcn_s_memrealtime(); } while (0)
#else
#define PP_BEGIN(k) do {} while (0)
#define PP_END(k) do {} while (0)
#endif
#if defined(TPROBE)
    unsigned long long tp_c0 = 0, tp_r0 = 0, tp_c1 = 0, tp_r1 = 0;
#define TP_BEGIN(k) do { if ((k) == TPROBE) { tp_c0 = __builtin_amdgcn_s_memtime(); tp_r0 = __builtin_amdgcn_s_memrealtime(); } } while (0)
#define TP_END(k) do { if ((k) == TPROBE) { tp_c1 = __builtin_amdgcn_s_memtime(); tp_r1 = __builtin_amdgcn_s_memrealtime(); } } while (0)
#else
#define TP_BEGIN(k) do {} while (0)
#define TP_END(k) do {} while (0)
#endif
    const float* x_p = args.in[0]; const float* x_s = args.in[1];
    const float* attn_pre_g = args.in[2]; const float* attn_post_g = args.in[3]; const float* ffn_pre_g = args.in[4]; const float* ffn_post_g = args.in[5];
    float* out = args.out;
    bf16* XN = (bf16*)(ws + WS_XN); bf16* QB = (bf16*)(ws + WS_Q); bf16* KB = (bf16*)(ws + WS_K); bf16* VB = (bf16*)(ws + WS_V); bf16* GB = (bf16*)(ws + WS_G); bf16* MB = (bf16*)(ws + WS_MB);
    float* ROPE_C = (float*)(ws + WS_ROPE_C); float* ROPE_S = (float*)(ws + WS_ROPE_S); float* RS = (float*)(ws + WS_RS);
    constexpr size_t TSTEP_D = (size_t)256 * D * 2, TSTEP_FF = (size_t)256 * FF * 2, TSTEP_CONV = (size_t)254 * D * 2;

    if (IN(0)) for (int rep_ = 0; rep_ < REPS(0); ++rep_) { PP_BEGIN(0);
        LAS float* scr = (LAS float*)(lds + RING_OFF + wave * 16384);
        p0_matrix(args.in[6], D, 3 * D, (bf16*)(ws + WS_WQKV0), attn_pre_g, 0, 0, scr, gw, NGW, lane);
        p0_matrix(args.in[8], D, D, (bf16*)(ws + WS_WO0), nullptr, 0, 0, scr, gw, NGW, lane);
        p0_matrix(args.in[18], D, FF2, (bf16*)(ws + WS_WIN0), ffn_pre_g, 1, 0, scr, gw, NGW, lane);
        p0_matrix(args.in[21], FF, D, (bf16*)(ws + WS_WOUT0), nullptr, 0, 0, scr, gw, NGW, lane);
        p0_matrix(args.in[9], D, D, (bf16*)(ws + WS_WQKV1), attn_pre_g + D, 2, 0, scr, gw, NGW, lane);
        p0_matrix(args.in[10], D, D, (bf16*)(ws + WS_WQKV1), attn_pre_g + D, 2, D, scr, gw, NGW, lane);
        p0_matrix(args.in[11], D, D, (bf16*)(ws + WS_WQKV1), attn_pre_g + D, 0, 2 * D, scr, gw, NGW, lane);
        p0_matrix(args.in[17], D, D, (bf16*)(ws + WS_WO1), nullptr, 0, 0, scr, gw, NGW, lane);
        p0_matrix(args.in[18] + (size_t)D * FF2, D, FF2, (bf16*)(ws + WS_WIN1), ffn_pre_g + D, 1, 0, scr, gw, NGW, lane);
        p0_matrix(args.in[21] + (size_t)FF * D, FF, D, (bf16*)(ws + WS_WOUT1), nullptr, 0, 0, scr, gw, NGW, lane);
        for (int i = gw * 64 + lane; i < T_S * 32; i += NGW * 64) {
            const int t = i >> 5, d = i & 31;
            double inv = 1.0; for (int q = 0; q < d; ++q) inv *= 0.7498942093324559;
            const double ang = (double)t * inv;
            const double k = __builtin_rint(ang * 0.15915494309189535);
            double xr = __builtin_fma(-k, 6.283185307179586, ang); xr = __builtin_fma(-k, 2.4492935982947064e-16, xr);
            double s, c; sincos_small(xr, s, c);
            ROPE_C[i] = (float)c; ROPE_S[i] = (float)s;
        }
        thin_pass<0>(x_p, x_s, XN, nullptr, nullptr, RS, nullptr, gw, NGW, lane);
        PP_END(0); if (BOTH(0)) GRID_BAR();
    }
    if (IN(1)) for (int rep_ = 0; rep_ < REPS(1); ++rep_) { PP_BEGIN(1);
        pg8::Gemm g{XN, (const bf16*)(ws + WS_WQKV0), M, 3 * D, D, TSTEP_D}; pg8::StaticOrder S; S.init(M, 3 * D, G, bx);
        pg8::EpiBf16<0> E{QB, D, RS, D, (size_t)(WS_K - WS_Q) / 2, att::QSCALE};
        pg8::gemm_phase<pg8::EpiBf16<0>, pg8::StaticOrder, PG8_ALIGN_PLAIN, true>(lds + RING_OFF, g, S, E, wave, GP_ARG(1));
        PP_END(1); if (BOTH(1)) GRID_BAR();
    }
    if (IN(2)) for (int rep_ = 0; rep_ < REPS(2); ++rep_) { PP_BEGIN(2);
        constexpr int NU_P = 4 * 16 * 16, NU = NU_P + 8 * 16 * 32;
        int na_last_h = -1;
#if NA_RR
        for (int u = vcu; u < NU; u += G) {
#else
        const int per = (NU + G - 1) / G, u0 = vcu * per, u1 = (u0 + per < NU) ? u0 + per : NU;
        for (int u = u0; u < u1; ++u) {
#endif
            size_t tok0; int rows, h, R;
            if (u < NU_P) { const int b = u >> 8, r = u & 255; tok0 = (size_t)b * T_P; rows = 64; h = r >> 4; R = (r & 15) * 4; }
            else { const int v = u - NU_P, b = v >> 9, r = v & 511; tok0 = (size_t)M_P + (size_t)b * T_S; rows = 128; h = r >> 5; R = (r & 31) * 4; }
            __syncthreads();
#if NA_KEEP_BIAS
            const bool fill_ = h != na_last_h; na_last_h = h;
#else
            const bool fill_ = true;
#endif
            att::na_unit(tok0, rows, h, R, QB, KB, VB, MB, args.in[7] + h * 465, (att::lptr)(lds + RING_OFF), tid, wave, lane, fill_
#if defined(NPROBE)
                         , bx == 0 ? (unsigned*)(ctl + CW_TP) : (unsigned*)nullptr
#endif
                         );
        }
        __syncthreads();
        PP_END(2); if (BOTH(2)) GRID_BAR();
    }
    if (IN(3)) for (int rep_ = 0; rep_ < REPS(3); ++rep_) { PP_BEGIN(3);
        pg8::Gemm g{MB, (const bf16*)(ws + WS_WO0), M, D, D, TSTEP_D}; pg8::StaticOrder S; S.init(M, D, G, bx);
        #if FUSE_THIN
        pg8::EpiThin<1> E{QB, XN, attn_post_g, RS, nullptr, (unsigned*)(ctl + CW_PANEL + 0 * PANEL_BANK), (PG8_LAS unsigned*)(lds + MISC_OFF + 64), D / 256};
        pg8::gemm_phase<pg8::EpiThin<1>, pg8::StaticOrder, true, true>(lds + RING_OFF, g, S, E, wave);
#else
        pg8::EpiBf16<0> E{QB, D, nullptr, 0, 0, 1.f};
        pg8::gemm_phase<pg8::EpiBf16<0>, pg8::StaticOrder, PG8_ALIGN_PLAIN, true>(lds + RING_OFF, g, S, E, wave);
#endif
        PP_END(3); if (BOTH(3)) GRID_BAR();
    }
    if (!FUSE_THIN && IN(4)) for (int rep_ = 0; rep_ < REPS(4); ++rep_) { PP_BEGIN(4); thin_pass<1>(nullptr, nullptr, XN, QB, attn_post_g, RS, nullptr, gw, NGW, lane); PP_END(4); if (BOTH(4)) GRID_BAR(); }
#if defined(PROBE_NULL5)
    if (IN(5)) {
        pg8::Gemm g{XN - D, (const bf16*)(ws + WS_WIN0), M, FF2, D, TSTEP_CONV}; pg8::StaticOrder S; S.init_tiles(NMT_CONV, FF2 / 256, G, bx);
        pg8::EpiNull E{(float*)(ws + WS_PARK)};
        pg8::gemm_phase<pg8::EpiNull, pg8::StaticOrder, true, true>(lds + RING_OFF, g, S, E, wave);
        GRID_BAR();
    }
#endif
    if (IN(5)) for (int rep_ = 0; rep_ < REPS(5); ++rep_) { PP_BEGIN(5); TP_BEGIN(5);
        pg8::Gemm g{XN - D, (const bf16*)(ws + WS_WIN0), M, FF2, D, TSTEP_CONV}; pg8::StaticOrder S; S.init_tiles(NMT_CONV, FF2 / 256, G, bx);
        pg8::EpiConvGlu E{GB, args.in[19], args.in[20], (PG8_LAS float*)(lds + XCH_OFF), M, RS, (PG8_LAS float*)(lds + XCH_OFF + 8192)};
#if GEMM_TAILQ
        pg8::TailOrder ST{S, (unsigned*)(ctl + CW_PANEL + 3 * PANEL_BANK + 64), (volatile PG8_LAS unsigned*)(lds + MISC_OFF + 128), wave, 5u};
        pg8::gemm_phase<pg8::EpiConvGlu, pg8::TailOrder, true, true>(lds + RING_OFF, g, ST, E, wave, GP_ARG(5));
#else
        pg8::gemm_phase<pg8::EpiConvGlu, pg8::StaticOrder, true, true>(lds + RING_OFF, g, S, E, wave, GP_ARG(5));
#endif
        TP_END(5); PP_END(5); if (BOTH(5)) GRID_BAR();
    }
    if (IN(6)) for (int rep_ = 0; rep_ < REPS(6); ++rep_) { PP_BEGIN(6); TP_BEGIN(6);
        pg8::Gemm g{GB, (const bf16*)(ws + WS_WOUT0), M, D, FF, TSTEP_FF}; pg8::StaticOrder S; S.init(M, D, G, bx);
        #if FUSE_THIN
        pg8::EpiThin<1> E{MB, XN, ffn_post_g, RS, nullptr, (unsigned*)(ctl + CW_PANEL + 1 * PANEL_BANK), (PG8_LAS unsigned*)(lds + MISC_OFF + 64), D / 256};
        pg8::gemm_phase<pg8::EpiThin<1>, pg8::StaticOrder, true, true>(lds + RING_OFF, g, S, E, wave);
#else
        pg8::EpiBf16<0> E{MB, D, nullptr, 0, 0, 1.f};
        pg8::gemm_phase<pg8::EpiBf16<0>, pg8::StaticOrder, PG8_ALIGN_PLAIN, true>(lds + RING_OFF, g, S, E, wave);
#endif
        TP_END(6); PP_END(6); if (BOTH(6)) GRID_BAR();
    }
    if (!FUSE_THIN && IN(7)) for (int rep_ = 0; rep_ < REPS(7); ++rep_) { PP_BEGIN(7); thin_pass<1>(nullptr, nullptr, XN, MB, ffn_post_g, RS, nullptr, gw, NGW, lane); PP_END(7); if (BOTH(7)) GRID_BAR(); }
    if (IN(8)) for (int rep_ = 0; rep_ < REPS(8); ++rep_) { PP_BEGIN(8);
        pg8::Gemm g{XN, (const bf16*)(ws + WS_WQKV1), M, 3 * D, D, TSTEP_D}; pg8::StaticOrder S; S.init(M, 3 * D, G, bx);
        pg8::EpiRope E{QB, KB, VB, ROPE_C, ROPE_S, att::QSCALE, RS, (unsigned*)(ctl + CW_KMAX)};
        pg8::gemm_phase<pg8::EpiRope, pg8::StaticOrder, true, true>(lds + RING_OFF, g, S, E, wave, GP_ARG(8));
        PP_END(8); if (BOTH(8)) GRID_BAR();
    }
#if defined(PROBE_DAV)
    if (IN(9)) for (int vrep_ = 0; vrep_ < 2; ++vrep_) { const int variant_ = vrep_ == 0 ? PROBE_DAV : 0;
#else
    if (IN(9)) { const int variant_ = 0;
#endif
    for (int rep_ = 0; rep_ < REPS(9); ++rep_) { PP_BEGIN(9); TP_BEGIN(9);
        float lam;
        { const float a = wave_sum(args.in[12][lane] * args.in[13][lane]), b = wave_sum(args.in[14][lane] * args.in[15][lane]); lam = __expf(a) - __expf(b) + LAMBDA_INIT; }
        asm volatile("" : "+v"(lam));
        const unsigned lam_bits = __builtin_amdgcn_readfirstlane(__float_as_uint(lam));
        float* park = (float*)(ws + WS_PARK) + (size_t)bx * 32768;
        constexpr int NP = 4 * 8 * 16, NS = 8 * 8 * 32;
#pragma clang loop unroll(disable)
        for (int id = vcu; id < NP + NS; id += G) {
            size_t rowbase; int T, h, qb, bidx;
            if (id < NP) { const int bh = id >> 4; qb = id & 15; bidx = bh >> 3; rowbase = (size_t)bidx * T_P; T = T_P; h = bh & 7; }
            else { const int bh = (id - NP) >> 5; qb = (id - NP) & 31; bidx = 4 + (bh >> 3); rowbase = (size_t)M_P + (size_t)(bh >> 3) * T_S; T = T_S; h = bh & 7; }
            att::da_unit(rowbase, T, h, qb, QB, KB, VB, MB, park, lam_bits, 1.0f - LAMBDA_INIT, args.in[16], (const unsigned*)(ctl + CW_KMAX) + bidx * 16, (att::lptr)(lds + RING_OFF), tid, wave, lane, DP_ARG, variant_);
#if DA_WO_OVERLAP
            asm volatile("s_waitcnt vmcnt(0)" ::: "memory"); __builtin_amdgcn_s_barrier();
            if (wave == 0) { __builtin_amdgcn_fence(__ATOMIC_RELEASE, "agent"); asm volatile("s_waitcnt vmcnt(0)" ::: "memory");
                if (lane == 0) (void)__hip_atomic_fetch_add((unsigned*)(ctl + CW_PANEL + 2 * PANEL_BANK) + 64 * (int)((rowbase >> 8) + (size_t)qb), 1u, __ATOMIC_RELAXED, __HIP_MEMORY_SCOPE_AGENT); }
#endif
        }
        TP_END(9); PP_END(9);
#if DA_WO_OVERLAP
        if (BOTH(9)) { if (wave == 0 && lane == 0) { MISC[32] = 0u; MISC[33] = 0u; } __syncthreads(); }
#else
        if (BOTH(9)) GRID_BAR();
#endif
    } }
    if (IN(10)) for (int rep_ = 0; rep_ < REPS(10); ++rep_) { PP_BEGIN(10);
        pg8::Gemm g{MB, (const bf16*)(ws + WS_WO1), M, D, D, TSTEP_D}; pg8::StaticOrder S; S.init(M, D, G, bx);
        #if FUSE_THIN
        pg8::EpiThin<1> E{QB, XN, attn_post_g + D, RS, nullptr, (unsigned*)(ctl + CW_PANEL + 2 * PANEL_BANK), (PG8_LAS unsigned*)(lds + MISC_OFF + 64), D / 256};
        pg8::gemm_phase<pg8::EpiThin<1>, pg8::StaticOrder, true, true>(lds + RING_OFF, g, S, E, wave);
#else
        pg8::EpiBf16<0> E{QB, D, nullptr, 0, 0, 1.f};
#if DA_WO_OVERLAP
        pg8::QueueOrder SQ{D / 256, (M / 256) * (D / 256), (unsigned*)(ctl + CW_PANEL + 3 * PANEL_BANK), (unsigned*)(ctl + CW_PANEL + 2 * PANEL_BANK), 8u, (volatile PG8_LAS unsigned*)(lds + MISC_OFF + 128), wave};
        pg8::gemm_phase<pg8::EpiBf16<0>, pg8::QueueOrder, PG8_ALIGN_PLAIN, true>(lds + RING_OFF, g, SQ, E, wave);
#else
        pg8::gemm_phase<pg8::EpiBf16<0>, pg8::StaticOrder, PG8_ALIGN_PLAIN, true>(lds + RING_OFF, g, S, E, wave);
#endif
#endif
        PP_END(10); if (BOTH(10)) GRID_BAR();
    }
    if (!FUSE_THIN && IN(11)) for (int rep_ = 0; rep_ < REPS(11); ++rep_) { PP_BEGIN(11); thin_pass<1>(nullptr, nullptr, XN, QB, attn_post_g + D, RS, nullptr, gw, NGW, lane); PP_END(11); if (BOTH(11)) GRID_BAR(); }
    if (IN(12)) for (int rep_ = 0; rep_ < REPS(12); ++rep_) { PP_BEGIN(12);
        pg8::Gemm g{XN - D, (const bf16*)(ws + WS_WIN1), M, FF2, D, TSTEP_CONV}; pg8::StaticOrder S; S.init_tiles(NMT_CONV, FF2 / 256, G, bx);
        pg8::EpiConvGlu E{GB, args.in[19] + 3 * FF2, args.in[20] + FF2, (PG8_LAS float*)(lds + XCH_OFF), M, RS, (PG8_LAS float*)(lds + XCH_OFF + 8192)};
#if GEMM_TAILQ
        pg8::TailOrder ST{S, (unsigned*)(ctl + CW_PANEL + 3 * PANEL_BANK + 128), (volatile PG8_LAS unsigned*)(lds + MISC_OFF + 128), wave, 12u};
        pg8::gemm_phase<pg8::EpiConvGlu, pg8::TailOrder, true, true>(lds + RING_OFF, g, ST, E, wave);
#else
        pg8::gemm_phase<pg8::EpiConvGlu, pg8::StaticOrder, true, true>(lds + RING_OFF, g, S, E, wave);
#endif
        PP_END(12); if (BOTH(12)) GRID_BAR();
    }
    if (IN(13)) for (int rep_ = 0; rep_ < REPS(13); ++rep_) { PP_BEGIN(13);
        pg8::Gemm g{GB, (const bf16*)(ws + WS_WOUT1), M, D, FF, TSTEP_FF}; pg8::StaticOrder S; S.init(M, D, G, bx);
        #if FUSE_THIN
        pg8::EpiThin<2> E{MB, XN, ffn_post_g + D, RS, out, (unsigned*)(ctl + CW_PANEL + 3 * PANEL_BANK), (PG8_LAS unsigned*)(lds + MISC_OFF + 64), D / 256};
        pg8::gemm_phase<pg8::EpiThin<2>, pg8::StaticOrder, true, true>(lds + RING_OFF, g, S, E, wave);
#else
        pg8::EpiBf16<0> E{MB, D, nullptr, 0, 0, 1.f};
        pg8::gemm_phase<pg8::EpiBf16<0>, pg8::StaticOrder, PG8_ALIGN_PLAIN, true>(lds + RING_OFF, g, S, E, wave);
#endif
        PP_END(13); if (BOTH(13)) GRID_BAR();
    }
    if (!FUSE_THIN && IN(14)) for (int rep_ = 0; rep_ < REPS(14); ++rep_) { PP_BEGIN(14); thin_pass<2>(nullptr, nullptr, XN, MB, ffn_post_g + D, nullptr, out, gw, NGW, lane); }
#if defined(DPROBE)
    if (bx == 0 && hi > 14) {
        const unsigned long long tk = (unsigned long long)__hip_atomic_load(ctl + CW_TP, __ATOMIC_RELAXED, __HIP_MEMORY_SCOPE_AGENT);
        const unsigned long long t0_ = __builtin_amdgcn_s_memrealtime(); while (__builtin_amdgcn_s_memrealtime() - t0_ < tk) __builtin_amdgcn_s_sleep(16); }
#endif
#if defined(PROBE_XBAR)
    if (hi > 14) { for (int i_ = 0; i_ < PROBE_XBAR; ++i_) xcd_barrier(bar); }
#endif
#if defined(PPROBE)
    if (hi > 14) {
        const unsigned dur = (unsigned)(pp_t1 - pp_t0);
        if (tid == 0) { if (PPROBE_STAT == 1) atomicMax((unsigned*)(ctl + CW_TP), dur); else if (PPROBE_STAT == 2) atomicMax((unsigned*)(ctl + CW_TP), 0x40000000u - dur); else if (bx == 0) __hip_atomic_store(ctl + CW_TP, dur, __ATOMIC_RELAXED, __HIP_MEMORY_SCOPE_AGENT); }
        xcd_barrier(bar);
        if (bx == 0) { unsigned v = __hip_atomic_load(ctl + CW_TP, __ATOMIC_RELAXED, __HIP_MEMORY_SCOPE_AGENT); if (PPROBE_STAT == 2) v = 0x40000000u - v;
            const unsigned long long tk = (unsigned long long)v * PPROBE_SCALE;
            const unsigned long long t0_ = __builtin_amdgcn_s_memrealtime(); while (__builtin_amdgcn_s_memrealtime() - t0_ < tk) __builtin_amdgcn_s_sleep(16); }
    }
#endif
#if defined(BPROBE)
    if (hi > 14) {
        if (bx == BPROBE_BLOCK && tid == 0) __hip_atomic_store(ctl + CW_TP, (unsigned)bp_acc, __ATOMIC_RELAXED, __HIP_MEMORY_SCOPE_AGENT);
        xcd_barrier(bar);
        if (bx == 0) { const unsigned long long tk = (unsigned long long)__hip_atomic_load(ctl + CW_TP, __ATOMIC_RELAXED, __HIP_MEMORY_SCOPE_AGENT) * BPROBE_SCALE;
            const unsigned long long t0_ = __builtin_amdgcn_s_memrealtime(); while (__builtin_amdgcn_s_memrealtime() - t0_ < tk) __builtin_amdgcn_s_sleep(16); }
    }
#endif
#if defined(GPROBE)
    if (bx == 0 && hi > 14) {
        const unsigned long long tk = (unsigned long long)__hip_atomic_load(ctl + CW_TP, __ATOMIC_RELAXED, __HIP_MEMORY_SCOPE_AGENT) * GPROBE_SCALE;
        const unsigned long long t0_ = __builtin_amdgcn_s_memrealtime(); while (__builtin_amdgcn_s_memrealtime() - t0_ < tk) __builtin_amdgcn_s_sleep(16);
    }
#endif
#if defined(TPROBE)
    if (bx == 0 && hi > 14) {
        const unsigned long long mhz = (tp_c1 - tp_c0) * 100ull / (tp_r1 - tp_r0 + 1ull);
        const unsigned long long t0_ = __builtin_amdgcn_s_memrealtime(); while (__builtin_amdgcn_s_memrealtime() - t0_ < mhz * 100ull) __builtin_amdgcn_s_sleep(16);
    }
#endif
#undef IN
#undef BOTH
#undef GRID_BAR
#undef lane
#undef tid
}

extern "C" void kernel_launch(void* const* d_in, const int* in_sizes, int n_in, void* d_out, int out_size, void* d_ws, size_t ws_size, hipStream_t stream) {
    static int grid = 0;
    if (grid == 0) {
        if (n_in != 22 || in_sizes[0] != M_P * D || in_sizes[1] != M_S * D || out_size != M * D || ws_size < WS_END) {
            fprintf(stderr, "kernel_launch: unexpected shapes (n_in %d, in0 %d, in1 %d, out %d, ws %zu); nothing launched\n", n_in, n_in > 0 ? in_sizes[0] : -1, n_in > 1 ? in_sizes[1] : -1, out_size, ws_size); grid = -1; return; }
        int dev = 0, cus = 0, per_cu = 0;
        if (hipGetDevice(&dev) != hipSuccess || hipDeviceGetAttribute(&cus, hipDeviceAttributeMultiprocessorCount, dev) != hipSuccess) { fprintf(stderr, "kernel_launch: device query failed\n"); grid = -1; return; }
        if (hipFuncSetAttribute((const void*)mega_fwd, hipFuncAttributeMaxDynamicSharedMemorySize, LDS_BYTES) != hipSuccess) { fprintf(stderr, "kernel_launch: hipFuncSetAttribute failed\n"); grid = -1; return; }
        if (hipOccupancyMaxActiveBlocksPerMultiprocessor(&per_cu, (const void*)mega_fwd, NWAVES * 64, LDS_BYTES) != hipSuccess || per_cu < 1) { fprintf(stderr, "kernel_launch: occupancy query says %d blocks per CU\n", per_cu); }
        (void)hipGetLastError();
        grid = cus;
    }
    if (grid < 0) return;
    if (hipMemsetAsync((char*)d_ws + WS_CTL, 0, CTL_ZERO_BYTES, stream) != hipSuccess) { fprintf(stderr, "kernel_launch: memset failed\n"); return; }
    Args a{};
    for (int i = 0; i < 22; ++i) a.in[i] = (const float*)d_in[i];
    a.out = (float*)d_out; a.ws = (unsigned char*)d_ws;
#if MK_PER_PHASE
    for (int p = 0; p < NPH; ++p) { a.ph_lo = p; a.ph_hi = p + 1; hipLaunchKernelGGL(mega_fwd, dim3(grid), dim3(NWAVES * 64), LDS_BYTES, stream, a); }
#else
    a.ph_lo = 0; a.ph_hi = NPH;
    hipLaunchKernelGGL(mega_fwd, dim3(grid), dim3(NWAVES * 64), LDS_BYTES, stream, a);
#endif
    const hipError_t le = hipPeekAtLastError();
    if (le != hipSuccess) fprintf(stderr, "kernel_launch: launch failed: %s\n", hipGetErrorName(le));
}
```
